# Optimizing an MI355X kernel written in HIP

```python
import jax, jax.numpy as jnp
from jax import lax
import numpy as np

D_MODEL = 2048
BATCH = 1
SEQ = 8192
DEPTH = 4

HEAD_DIM = 64
MIX_WIDTH = D_MODEL
A_WIDTH = 3 * MIX_WIDTH // 8
A_HEADS = A_WIDTH // HEAD_DIM
DILATED_BRANCHES = ((128, 1), (512, 4), (2048, 16))
BAND_BLOCK = 128
B_WIDTH = MIX_WIDTH // 4
B_HEADS = B_WIDTH // HEAD_DIM
FOX_BLOCK = 128
C_VWIDTH = MIX_WIDTH - A_WIDTH - B_WIDTH
C_HEADS = 4
C_DV = C_VWIDTH // C_HEADS
C_DK = C_DV // 2
C_KWIDTH = C_HEADS * C_DK
GATE_RANK = 16
GATE_TEMP = 16.0
GLA_CHUNK = 64
RMS_EPS = 1e-6

IN_SPLITS = (A_WIDTH, A_WIDTH, A_WIDTH, A_WIDTH,
             B_WIDTH, B_WIDTH, B_WIDTH, B_WIDTH, B_HEADS,
             C_KWIDTH, C_KWIDTH, C_VWIDTH, C_VWIDTH, GATE_RANK)
IN_WIDTH = int(sum(IN_SPLITS))
SPLIT_IDX = [int(i) for i in np.cumsum(IN_SPLITS)[:-1]]

kernel_name = "hymba_style_dilated_fox_gla_hybrid"


def rms_norm(x, g):
    xf = x.astype(jnp.float32)
    y = xf * lax.rsqrt(jnp.mean(xf * xf, axis=-1, keepdims=True) + RMS_EPS)
    return (y * g.astype(jnp.float32)).astype(x.dtype)


def dilated_branch(q, k, v, window, dilation):
    bsz, s, h, hd = q.shape
    steps = window // dilation
    L = s // dilation
    nb = -(-L // BAND_BLOCK)
    lp = nb * BAND_BLOCK

    def to_blocks(t):
        t = t.reshape(bsz, L, dilation, h, hd).transpose(0, 2, 1, 3, 4)
        t = jnp.pad(t, ((0, 0), (0, 0), (0, lp - L), (0, 0), (0, 0)))
        return t.reshape(bsz, dilation, nb, BAND_BLOCK, h, hd)

    def with_prev(t):
        prev = jnp.pad(t[:, :, :-1], ((0, 0), (0, 0), (1, 0), (0, 0), (0, 0), (0, 0)))
        return jnp.concatenate([prev, t], axis=3)

    qb = to_blocks(q)
    kb = with_prev(to_blocks(k))
    vb = with_prev(to_blocks(v))
    logits = jnp.einsum('brnqhe,brnkhe->brnhqk', qb, kb,
                        preferred_element_type=jnp.float32)
    qi = BAND_BLOCK + jnp.arange(BAND_BLOCK)
    ki = jnp.arange(2 * BAND_BLOCK)
    rel = qi[:, None] - ki[None, :]
    band = (rel >= 0) & (rel <= steps)
    key_idx = jnp.arange(nb)[:, None, None] * BAND_BLOCK - BAND_BLOCK + ki[None, None, :]
    mask = band[None] & (key_idx >= 0)
    logits = jnp.where(mask[None, None, :, None], logits, -jnp.inf)
    m = jnp.max(logits, axis=-1, keepdims=True)
    p = jnp.exp(logits - m)
    den = jnp.sum(p, axis=-1)
    out = jnp.einsum('brnhqk,brnkhe->brnqhe', p, vb.astype(jnp.float32))
    out = out / jnp.swapaxes(den, -1, -2)[..., None]
    lse = m[..., 0] + jnp.log(den)
    out = out.reshape(bsz, dilation, lp, h, hd)[:, :, :L]
    out = out.transpose(0, 2, 1, 3, 4).reshape(bsz, s, h, hd)
    lse = jnp.swapaxes(lse, -1, -2).reshape(bsz, dilation, lp, h)[:, :, :L]
    lse = lse.transpose(0, 2, 1, 3).reshape(bsz, s, h)
    return out, lse


def dilated_mixture(q, k, v):
    outs, lses = [], []
    for window, dilation in DILATED_BRANCHES:
        o, l = dilated_branch(q, k, v, window, dilation)
        outs.append(o)
        lses.append(l)
    wts = jax.nn.softmax(jnp.stack(lses), axis=0)
    return jnp.einsum('nbsh,nbshe->bshe', wts, jnp.stack(outs))


def forgetting_attention(q, k, v, log_f):
    bsz, s, h, hd = q.shape
    nb = s // FOX_BLOCK
    c = jnp.cumsum(log_f, axis=1)
    c_keys = jnp.swapaxes(c, 1, 2)
    qb = q.reshape(bsz, nb, FOX_BLOCK, h, hd).swapaxes(0, 1)
    cb = c.reshape(bsz, nb, FOX_BLOCK, h).swapaxes(0, 1)
    kpos = jnp.arange(s)
    vf = v.astype(jnp.float32)

    def block(args):
        qi, ci, i = args
        logits = jnp.einsum('bqhe,bkhe->bhqk', qi, k, preferred_element_type=jnp.float32)
        logits = logits + jnp.swapaxes(ci, 1, 2)[..., None] - c_keys[:, :, None, :]
        qpos = i * FOX_BLOCK + jnp.arange(FOX_BLOCK)
        logits = jnp.where(kpos[None, :] <= qpos[:, None], logits, -jnp.inf)
        p = jax.nn.softmax(logits, axis=-1)
        return jnp.einsum('bhqk,bkhe->bqhe', p, vf)

    out = lax.map(block, (qb, cb, jnp.arange(nb)))
    return out.swapaxes(0, 1).reshape(bsz, s, h, hd)


def gla_chunked(q, k, v, log_a):
    bsz, s, h, dk = q.shape
    dv = v.shape[-1]
    n = s // GLA_CHUNK

    def chunks(t):
        return t.astype(jnp.float32).reshape(bsz, n, GLA_CHUNK, *t.shape[2:]).swapaxes(0, 1)

    tri = jnp.tril(jnp.ones((GLA_CHUNK, GLA_CHUNK), dtype=bool))

    def step(state, inp):
        qc, kc, vc, ac = inp
        bc = jnp.cumsum(ac, axis=1)
        diff = bc[:, :, None] - bc[:, None, :]
        decay = jnp.exp(jnp.where(tri[None, :, :, None, None], diff, -jnp.inf))
        attn = jnp.einsum('bthd,bshd,btshd->bhts', qc, kc, decay)
        o = (jnp.einsum('bhts,bshv->bthv', attn, vc)
             + jnp.einsum('bthd,bhdv->bthv', qc * jnp.exp(bc), state))
        b_last = bc[:, -1]
        new_state = (state * jnp.exp(b_last)[..., None]
                     + jnp.einsum('bshd,bshv->bhdv', kc * jnp.exp(b_last[:, None] - bc), vc))
        return new_state, o

    state0 = jnp.zeros((bsz, h, dk, dv), jnp.float32)
    _, out = lax.scan(step, state0, (chunks(q), chunks(k), chunks(v), chunks(log_a)))
    return out.swapaxes(0, 1).reshape(bsz, s, h, dv)


def hybrid_layer(x, norm_g, w_in, a_q_gain, a_k_gain, b_q_gain, b_k_gain, fox_bias,
                 gla_gate_up, gla_gate_bias, gla_out_gain, w_out):
    bsz, s, _ = x.shape
    h = rms_norm(x, norm_g)
    proj = jnp.einsum('bsd,de->bse', h, w_in)
    (aq, ak, av, az, bq, bk, bv, bz, bf, cq, ck, cv, cz, cr) = jnp.split(proj, SPLIT_IDX, axis=-1)
    scale = HEAD_DIM ** -0.5

    heads_a = lambda t: t.reshape(bsz, s, A_HEADS, HEAD_DIM)
    qa = rms_norm(heads_a(aq), a_q_gain) * scale
    ka = rms_norm(heads_a(ak), a_k_gain)
    out_a = dilated_mixture(qa, ka, heads_a(av)).reshape(bsz, s, A_WIDTH)

    heads_b = lambda t: t.reshape(bsz, s, B_HEADS, HEAD_DIM)
    qb = rms_norm(heads_b(bq), b_q_gain) * scale
    kb = rms_norm(heads_b(bk), b_k_gain)
    log_f = jax.nn.log_sigmoid(bf.astype(jnp.float32) + fox_bias.astype(jnp.float32))
    out_b = forgetting_attention(qb, kb, heads_b(bv), log_f).reshape(bsz, s, B_WIDTH)

    qc = cq.reshape(bsz, s, C_HEADS, C_DK) * (C_DK ** -0.5)
    kc = ck.reshape(bsz, s, C_HEADS, C_DK)
    vc = cv.reshape(bsz, s, C_HEADS, C_DV)
    gate_logit = jnp.einsum('bsr,rk->bsk', cr, gla_gate_up) + gla_gate_bias
    log_a = (jax.nn.log_sigmoid(gate_logit.astype(jnp.float32)) / GATE_TEMP)
    log_a = log_a.reshape(bsz, s, C_HEADS, C_DK)
    out_c = rms_norm(gla_chunked(qc, kc, vc, log_a), gla_out_gain).reshape(bsz, s, C_VWIDTH)

    mixed = jnp.concatenate([
        out_a.astype(h.dtype) * jax.nn.silu(az),
        out_b.astype(h.dtype) * jax.nn.silu(bz),
        out_c.astype(h.dtype) * jax.nn.silu(cz)], axis=-1)
    return x + jnp.einsum('bse,ed->bsd', mixed, w_out)


def setup_inputs(seed: int = 0) -> dict:
    key = jax.random.key(seed)
    ks = jax.random.split(key, 13)
    nrm = jax.random.normal
    f32 = jnp.float32
    x = nrm(ks[0], (BATCH, SEQ, D_MODEL), f32)
    norm_g = 1.0 + 0.02 * nrm(ks[1], (DEPTH, D_MODEL), f32)
    w_in = nrm(ks[2], (DEPTH, D_MODEL, IN_WIDTH), f32) * D_MODEL ** -0.5
    a_q_gain = 1.0 + 0.02 * nrm(ks[3], (DEPTH, HEAD_DIM), f32)
    a_k_gain = 1.0 + 0.02 * nrm(ks[4], (DEPTH, HEAD_DIM), f32)
    b_q_gain = 1.0 + 0.02 * nrm(ks[5], (DEPTH, HEAD_DIM), f32)
    b_k_gain = 1.0 + 0.02 * nrm(ks[6], (DEPTH, HEAD_DIM), f32)
    fox_bias = (jnp.linspace(0.0, 6.0, B_HEADS, dtype=f32)[None, :]
                + 0.1 * nrm(ks[7], (DEPTH, B_HEADS), f32))
    gla_gate_up = nrm(ks[8], (DEPTH, GATE_RANK, C_KWIDTH), f32) * GATE_RANK ** -0.5
    gla_gate_bias = 0.1 * nrm(ks[9], (DEPTH, C_KWIDTH), f32)
    gla_out_gain = 1.0 + 0.02 * nrm(ks[10], (DEPTH, C_DV), f32)
    w_out = nrm(ks[11], (DEPTH, MIX_WIDTH, D_MODEL), f32) * MIX_WIDTH ** -0.5
    return {"x": x, "norm_g": norm_g, "w_in": w_in, "a_q_gain": a_q_gain,
            "a_k_gain": a_k_gain, "b_q_gain": b_q_gain, "b_k_gain": b_k_gain,
            "fox_bias": fox_bias, "gla_gate_up": gla_gate_up, "gla_gate_bias": gla_gate_bias,
            "gla_out_gain": gla_out_gain, "w_out": w_out}


def reference(x, norm_g, w_in, a_q_gain, a_k_gain, b_q_gain, b_k_gain, fox_bias,
              gla_gate_up, gla_gate_bias, gla_out_gain, w_out):
    for layer in range(DEPTH):
        x = hybrid_layer(x, norm_g[layer], w_in[layer], a_q_gain[layer], a_k_gain[layer],
                         b_q_gain[layer], b_k_gain[layer], fox_bias[layer],
                         gla_gate_up[layer], gla_gate_bias[layer], gla_out_gain[layer],
                         w_out[layer])
    return x
```

```cpp
#include <hip/hip_runtime.h>
#include <hip/hip_cooperative_groups.h>
#include <cstdio>
#include <cstdint>
namespace cg = cooperative_groups;
namespace pg8 {
#define PG8_LAS __attribute__((address_space(3)))
typedef unsigned short bf16_t;
typedef short bf16x8 __attribute__((ext_vector_type(8)));
typedef float f32x4 __attribute__((ext_vector_type(4)));
typedef unsigned u32x4 __attribute__((ext_vector_type(4)));
constexpr int BM = 256, BK = 64, HALF = 128, HTB = HALF * BK * 2  , STAGE_BYTES = 8 * HTB, NXCD = 8, WGM = 8;

__host__ __device__ __forceinline__ int lds_byte(int r, int c) { const int st = (r >> 4) * 2 + (c >> 5), rr = r & 15, cc = c & 31, ob = rr * 64 + cc * 2; return st * 1024 + (ob ^ (((ob >> 9) & 1) << 5)); }
__host__ __device__ __forceinline__ void stage_rc(int b, int& R, int& C) { const int st = b / 1024, sb = b % 1024, swz = sb ^ (((sb >> 9) & 1) << 5); R = (st >> 1) * 16 + swz / 64; C = (st & 1) * 32 + (swz % 64) / 2; }
__host__ __device__ __forceinline__ int perm32(int rho) { const int n = rho >> 4, i = rho & 15; return 8 * (i >> 2) + 4 * n + (i & 3); }

struct Unit { int pm, pn; };
struct Gemm { const bf16_t* A; const bf16_t* Bt; int M, N, K; };

struct StaticOrder {
    int nM, nN, nwg, G, c;
    __host__ __device__ void init(int M, int N, int G_, int c_) { nM = M / BM; nN = N / BM; nwg = nM * nN; G = G_; c = c_; }
    __host__ __device__ bool next(int i, Unit& u) const {
        const long L = (long)i * G + c; if (L >= nwg) return false;
        int wgid = (int)L; { const int q = nwg / NXCD, r = nwg % NXCD, xcd = wgid % NXCD, off = wgid / NXCD; wgid = (xcd < r ? xcd * (q + 1) : r * (q + 1) + (xcd - r) * q) + off; }
        const int nig = WGM * nN, gid = wgid / nig, fm = gid * WGM, gsz = (nM - fm) < WGM ? (nM - fm) : WGM;
        u.pm = fm + ((wgid % nig) % gsz); u.pn = (wgid % nig) / gsz; return true;
    }
    __device__ __forceinline__ void a_ready(const Unit&) const {}
    __device__ __forceinline__ void done(const Unit&) const {}
};

__device__ __forceinline__ unsigned cvt_pk_bf16(float lo, float hi) { unsigned r; asm volatile("v_cvt_pk_bf16_f32 %0, %1, %2" : "=v"(r) : "v"(lo), "v"(hi)); return r; }
typedef float f32x2 __attribute__((ext_vector_type(2)));
constexpr int PROJ_W = 7424;
struct EpiProj {
    static constexpr bool PERM = true, AFTER_DRAIN = false;
    bf16_t* O; float* small; const unsigned long long* ss;
    __device__ __forceinline__ void operator()(const f32x4 (&acc)[2][2][4][2], const Unit& u, int wr, int wc, int fr, int fq) const {
        const int row0 = u.pm * BM + wr * 64 + fr;
        if (u.pn < 29) {
            const int col0 = u.pn * BM + wc * 32 + 8 * fq;
#pragma unroll
            for (int ai = 0; ai < 2; ++ai)
#pragma unroll
                for (int m = 0; m < 4; ++m) { const int row = row0 + ai * HALF + m * 16; const float rs = rsqrtf((float)ss[row] * (1.0f / 1048576.0f / 2048.0f) + 1e-6f);
                    bf16_t* rowp = O + (size_t)row * PROJ_W + col0;
#pragma unroll
                    for (int bj = 0; bj < 2; ++bj) { const f32x4 v0 = acc[ai][bj][m][0] * rs, v1 = acc[ai][bj][m][1] * rs;
                        u32x4 w; w.x = cvt_pk_bf16(v0[0], v0[1]); w.y = cvt_pk_bf16(v0[2], v0[3]); w.z = cvt_pk_bf16(v1[0], v1[1]); w.w = cvt_pk_bf16(v1[2], v1[3]);
                        *(u32x4*)(rowp + bj * HALF) = w; } }
        } else if (wc == 0) {
#pragma unroll
            for (int ai = 0; ai < 2; ++ai)
#pragma unroll
                for (int m = 0; m < 4; ++m) { const int row = row0 + ai * HALF + m * 16; const float rs = rsqrtf((float)ss[row] * (1.0f / 1048576.0f / 2048.0f) + 1e-6f);
                    float* p = small + (size_t)row * 32 + 8 * fq;
                    *(f32x4*)p = acc[ai][0][m][0] * rs; *(f32x4*)(p + 4) = acc[ai][0][m][1] * rs; }
        }
    }
};
struct EpiOut {
    static constexpr bool PERM = true, AFTER_DRAIN = false;
    const float* xin; float* out; bf16_t* xb; unsigned long long* ssn;
    __device__ __forceinline__ void operator()(const f32x4 (&acc)[2][2][4][2], const Unit& u, int wr, int wc, int fr, int fq) const {
        const int row0 = u.pm * BM + wr * 64 + fr, col0 = u.pn * BM + wc * 32 + 8 * fq;
#pragma unroll
        for (int ai = 0; ai < 2; ++ai)
#pragma unroll
            for (int m = 0; m < 4; ++m) { const int row = row0 + ai * HALF + m * 16; float sq = 0.f;
#pragma unroll
                for (int bj = 0; bj < 2; ++bj) { const size_t p = (size_t)row * 2048 + col0 + bj * HALF;
                    const f32x4 a = *(const f32x4*)(xin + p) + acc[ai][bj][m][0], b = *(const f32x4*)(xin + p + 4) + acc[ai][bj][m][1];
                    *(f32x4*)(out + p) = a; *(f32x4*)(out + p + 4) = b;
                    if (xb) { u32x4 w; w.x = cvt_pk_bf16(a[0], a[1]); w.y = cvt_pk_bf16(a[2], a[3]); w.z = cvt_pk_bf16(b[0], b[1]); w.w = cvt_pk_bf16(b[2], b[3]); *(u32x4*)(xb + p) = w; }
                    sq += (a[0] * a[0] + a[1] * a[1]) + (a[2] * a[2] + a[3] * a[3]) + (b[0] * b[0] + b[1] * b[1]) + (b[2] * b[2] + b[3] * b[3]); }
                sq += __shfl_xor(sq, 16); sq += __shfl_xor(sq, 32);
                if (fq == 0 && ssn) atomicAdd(ssn + row, (unsigned long long)(sq * 1048576.0f + 0.5f)); }
    }
};
template <class Epi, class Sched, bool ALIGN_EPI = false, bool SP2 = false>
__device__ __forceinline__ void gemm_phase(PG8_LAS unsigned char* lds, const Gemm g, const Sched& S, const Epi& E) {
    int tid_ = threadIdx.x; asm volatile("" : "+v"(tid_)); const int tid = tid_, wid = __builtin_amdgcn_readfirstlane(tid >> 6), lane = tid & 63, wr = wid >> 2, wc = wid & 3, fr = lane & 15, fq = lane >> 4;
    const int K = g.K, nt = K / BK;
    unsigned voffA[2], voffB[2];
#pragma unroll
    for (int i = 0; i < 2; ++i) { int R, C; stage_rc(tid * 16 + i * 8192, R, C); const int Rb = Epi::PERM ? ((R & ~31) + perm32(R & 31)) : R;
        voffA[i] = (unsigned)(R * K + C) * 2u; voffB[i] = (unsigned)(Rb * K + C) * 2u; }
    const size_t kstep = (size_t)(BK * 2);
    const size_t hstep = (size_t)HALF * K * 2;
    const size_t tstep = 2 * hstep;
    const unsigned ldsw = (unsigned)wid * 1024u;
    const int aoff = lds_byte(wr * 64 + fr, fq * 8), boff = lds_byte(wc * 32 + fr, fq * 8);
#define PG8_SA(b, h) (((b) * 2 + (h)) * HTB)
#define PG8_SB(b, h) ((4 + (b) * 2 + (h)) * HTB)
#define PG8_STAGE(bufoff, gbase, voff) do { _Pragma("unroll") for (int _i = 0; _i < 2; ++_i) \
        __builtin_amdgcn_global_load_lds((const unsigned*)((const char*)(gbase) + (voff)[_i]), (PG8_LAS unsigned*)(lds + (bufoff) + ldsw + _i * 8192), 16, 0, 0); } while (0)
#define PG8_LDA(dst, b, h) do { _Pragma("unroll") for (int m = 0; m < 4; ++m) _Pragma("unroll") for (int k = 0; k < 2; ++k) dst[m][k] = *(const PG8_LAS bf16x8*)(lds + PG8_SA(b, h) + aoff + m * 2048 + k * 1024); } while (0)
#define PG8_LDB(dst, b, h) do { _Pragma("unroll") for (int n = 0; n < 2; ++n) _Pragma("unroll") for (int k = 0; k < 2; ++k) dst[n][k] = *(const PG8_LAS bf16x8*)(lds + PG8_SB(b, h) + boff + n * 2048 + k * 1024); } while (0)
#define PG8_MMA(ai, bj, At, Bt) do { __builtin_amdgcn_s_setprio(1); _Pragma("unroll") for (int m = 0; m < 4; ++m) _Pragma("unroll") for (int n = 0; n < 2; ++n) _Pragma("unroll") for (int k = 0; k < 2; ++k) \
        acc[ai][bj][m][n] = __builtin_amdgcn_mfma_f32_16x16x32_bf16(Bt[n][k], At[m][k], acc[ai][bj][m][n], 0, 0, 0); __builtin_amdgcn_s_setprio(0); } while (0)
#define PG8_WAIT_V(n) asm volatile("s_waitcnt vmcnt(" #n ")" ::: "memory")
#define PG8_WAIT_L(n) asm volatile("s_waitcnt lgkmcnt(" #n ")" ::: "memory")
#define PG8_BAR __builtin_amdgcn_s_barrier()
#define PG8_SCHED __builtin_amdgcn_sched_barrier(0)
    Unit cur, nxt; int ui = 0;
    if (!S.next(0, cur)) return;
    f32x4 acc[2][2][4][2];
#pragma unroll
    for (int a = 0; a < 2; ++a)
#pragma unroll
        for (int b = 0; b < 2; ++b)
#pragma unroll
            for (int m = 0; m < 4; ++m)
#pragma unroll
                for (int n = 0; n < 2; ++n) acc[a][b][m][n] = (f32x4){0.f, 0.f, 0.f, 0.f};
    bf16x8 At[4][2], B0[2][2], B1[2][2];
    const char* cA = (const char*)g.A + (size_t)cur.pm * tstep; const char* cB = (const char*)g.Bt + (size_t)cur.pn * tstep;
    S.a_ready(cur);
    if constexpr (SP2) {
        PG8_STAGE(PG8_SB(0, 0), cB, voffB); PG8_STAGE(PG8_SB(0, 1), cB + hstep, voffB); PG8_STAGE(PG8_SA(0, 0), cA, voffA); PG8_STAGE(PG8_SA(0, 1), cA + hstep, voffA);
        if (wr == 1) PG8_BAR;
        PG8_WAIT_V(2); PG8_BAR;
        PG8_STAGE(PG8_SB(1, 0), cB + kstep, voffB); PG8_STAGE(PG8_SA(1, 0), cA + kstep, voffA); PG8_STAGE(PG8_SB(1, 1), cB + hstep + kstep, voffB);
        PG8_WAIT_V(6); PG8_BAR;
    } else {
        PG8_STAGE(PG8_SB(0, 0), cB, voffB); PG8_STAGE(PG8_SA(0, 0), cA, voffA); PG8_STAGE(PG8_SB(0, 1), cB + hstep, voffB); PG8_STAGE(PG8_SA(0, 1), cA + hstep, voffA);
        if (wr == 1) PG8_BAR;
        PG8_WAIT_V(4); PG8_BAR;
        PG8_STAGE(PG8_SB(1, 0), cB + kstep, voffB); PG8_STAGE(PG8_SA(1, 0), cA + kstep, voffA); PG8_STAGE(PG8_SB(1, 1), cB + hstep + kstep, voffB);
        PG8_WAIT_V(6); PG8_BAR;
    }
    for (;;) {
        const bool has_next = S.next(ui + 1, nxt);
        const char* nA = has_next ? (const char*)g.A + (size_t)nxt.pm * tstep : cA; const char* nB = has_next ? (const char*)g.Bt + (size_t)nxt.pn * tstep : cB;
        for (int t = 0; t < nt; t += 2) {
            const bool last = (t == nt - 2);
            const char* a1 = cA + (size_t)(t + 1) * kstep;
            const char* a2 = last ? nA : cA + (size_t)(t + 2) * kstep; const char* b2 = last ? nB : cB + (size_t)(t + 2) * kstep;
            const char* a3 = a2 + kstep; const char* b3 = b2 + kstep;
            if (last && has_next) S.a_ready(nxt);
            if constexpr (SP2) {
            PG8_LDB(B0, 0, 0); PG8_LDB(B1, 0, 1); PG8_SCHED; PG8_LDA(At, 0, 0); PG8_STAGE(PG8_SA(1, 1), a1 + hstep, voffA);
            PG8_WAIT_V(8); PG8_WAIT_L(0); PG8_BAR; PG8_MMA(0, 0, At, B0); PG8_MMA(0, 1, At, B1); PG8_BAR; PG8_SCHED;
            PG8_LDA(At, 0, 1); PG8_STAGE(PG8_SB(0, 0), b2, voffB); PG8_STAGE(PG8_SB(0, 1), b2 + hstep, voffB); PG8_STAGE(PG8_SA(0, 0), a2, voffA);
            PG8_WAIT_V(8); PG8_WAIT_L(0); PG8_BAR; PG8_MMA(1, 0, At, B0); PG8_MMA(1, 1, At, B1); PG8_BAR; PG8_SCHED;
            PG8_LDB(B0, 1, 0); PG8_LDB(B1, 1, 1); PG8_SCHED; PG8_LDA(At, 1, 0); PG8_STAGE(PG8_SA(0, 1), a2 + hstep, voffA);
            PG8_WAIT_V(8); PG8_WAIT_L(0); PG8_BAR; PG8_MMA(0, 0, At, B0); PG8_MMA(0, 1, At, B1); PG8_BAR; PG8_SCHED;
            PG8_LDA(At, 1, 1); PG8_STAGE(PG8_SB(1, 0), b3, voffB); PG8_STAGE(PG8_SB(1, 1), b3 + hstep, voffB); PG8_STAGE(PG8_SA(1, 0), a3, voffA);
            PG8_WAIT_V(8); PG8_WAIT_L(0); PG8_BAR; PG8_MMA(1, 0, At, B0); PG8_MMA(1, 1, At, B1); PG8_BAR; PG8_SCHED;
            } else {
            PG8_LDB(B0, 0, 0); PG8_SCHED; PG8_LDA(At, 0, 0); PG8_STAGE(PG8_SA(1, 1), a1 + hstep, voffA);
            PG8_WAIT_L(8); PG8_BAR; PG8_WAIT_L(0); PG8_MMA(0, 0, At, B0); PG8_BAR; PG8_SCHED;
            PG8_LDB(B1, 0, 1); PG8_STAGE(PG8_SB(0, 0), b2, voffB);
            PG8_BAR; PG8_WAIT_L(0); PG8_MMA(0, 1, At, B1); PG8_BAR;
            PG8_LDA(At, 0, 1); PG8_STAGE(PG8_SA(0, 0), a2, voffA);
            PG8_BAR; PG8_WAIT_L(0); PG8_MMA(1, 0, At, B0); PG8_BAR; PG8_SCHED;
            PG8_STAGE(PG8_SB(0, 1), b2 + hstep, voffB);
            PG8_WAIT_V(6); PG8_BAR; PG8_MMA(1, 1, At, B1); PG8_BAR;
            PG8_LDB(B0, 1, 0); PG8_SCHED; PG8_LDA(At, 1, 0); PG8_STAGE(PG8_SA(0, 1), a2 + hstep, voffA);
            PG8_WAIT_L(8); PG8_BAR; PG8_WAIT_L(0); PG8_MMA(0, 0, At, B0); PG8_BAR; PG8_SCHED;
            PG8_LDB(B1, 1, 1); PG8_STAGE(PG8_SB(1, 0), b3, voffB);
            PG8_BAR; PG8_WAIT_L(0); PG8_MMA(0, 1, At, B1); PG8_BAR;
            PG8_LDA(At, 1, 1); PG8_STAGE(PG8_SA(1, 0), a3, voffA);
            PG8_BAR; PG8_WAIT_L(0); PG8_MMA(1, 0, At, B0); PG8_BAR; PG8_SCHED;
            PG8_STAGE(PG8_SB(1, 1), b3 + hstep, voffB);
            PG8_WAIT_V(6); PG8_BAR; PG8_MMA(1, 1, At, B1); PG8_BAR;
            }
        }
        if constexpr (ALIGN_EPI) { if (wr == 0) PG8_BAR; }
        if constexpr (!Epi::AFTER_DRAIN) { E(acc, cur, wr, wc, fr, fq); S.done(cur); }
        if (!has_next) break;
#pragma unroll
        for (int a = 0; a < 2; ++a)
#pragma unroll
            for (int b = 0; b < 2; ++b)
#pragma unroll
                for (int m = 0; m < 4; ++m)
#pragma unroll
                    for (int n = 0; n < 2; ++n) acc[a][b][m][n] = (f32x4){0.f, 0.f, 0.f, 0.f};
        cur = nxt; cA = nA; cB = nB; ++ui;
        if constexpr (ALIGN_EPI) { if (wr == 1) PG8_BAR; }
    }
    PG8_WAIT_V(0);
    if constexpr (!ALIGN_EPI) { if (wr == 0) PG8_BAR; }
    PG8_BAR;
    if constexpr (Epi::AFTER_DRAIN) { E.fused(acc, cur, wr, wc, fr, fq, lds, wid, lane); S.done(cur); }
#undef PG8_SA
#undef PG8_SB
#undef PG8_STAGE
#undef PG8_LDA
#undef PG8_LDB
#undef PG8_MMA
#undef PG8_WAIT_V
#undef PG8_WAIT_L
#undef PG8_BAR
#undef PG8_SCHED
}
}
constexpr int SEQ = 8192, DM = 2048, NLAYER = 4, INW = 7448, NPAD = 7680, PW = pg8::PROJ_W;
constexpr int C_AQ = 0, C_AK = 768, C_AV = 1536, C_AZ = 2304, C_BQ = 3072, C_BK = 3584, C_BV = 4096, C_BZ = 4608, C_CQ = 5120, C_CK = 5504, C_CV = 5888, C_CZ = 6656;
constexpr float LOG2E = 1.4426950408889634f, QSCALE = 0.125f * 1.4426950408889634f, EPS = 1e-6f;
constexpr size_t MiB = 1u << 20;
constexpr size_t WS_CTL = 0, WS_SS = 1 * MiB, WS_WTIN = 2 * MiB, WS_WTOUT = 122 * MiB, WS_XB = 154 * MiB, WS_PROJ = 186 * MiB, WS_SMALL = 302 * MiB,
                 WS_MIXED = 304 * MiB, WS_OA = 336 * MiB, WS_LA = 372 * MiB, WS_OB = 374 * MiB, WS_LB = 438 * MiB, WS_CL = 439 * MiB, WS_BT = WS_CL + 512 * 1024,
                 WS_DS = 440 * MiB, WS_ST = 476 * MiB, WS_DEC = 494 * MiB, WS_END = 496 * MiB;
constexpr int RING_BYTES = 131072, LDS_BYTES = 147456, QSLOT_OFF = RING_BYTES + 64;
constexpr int N_SCAN = 72, N_FOX = 640, N_AU = 1152, N_ITEMS = N_SCAN + N_FOX + N_AU;

typedef unsigned short bf16;
typedef short bf16x8 __attribute__((ext_vector_type(8)));
typedef short s16x4 __attribute__((ext_vector_type(4)));
typedef float f32x4 __attribute__((ext_vector_type(4)));
typedef float f32x2 __attribute__((ext_vector_type(2)));
typedef float f32x16 __attribute__((ext_vector_type(16)));
typedef unsigned u32x4 __attribute__((ext_vector_type(4)));
typedef unsigned u32x2 __attribute__((ext_vector_type(2)));
typedef __attribute__((address_space(3))) const char* lds_cptr;
#define LAS3 __attribute__((address_space(3)))

__device__ __forceinline__ float bf2f(unsigned b) { return __uint_as_float(b << 16); }
__device__ __forceinline__ unsigned pk2(float lo, float hi) { return pg8::cvt_pk_bf16(lo, hi); }
__device__ __forceinline__ float blo(unsigned w) { return __uint_as_float(w << 16); }
__device__ __forceinline__ float bhi(unsigned w) { return __uint_as_float(w & 0xffff0000u); }
__device__ __forceinline__ float logsig(float x) { return fminf(x, 0.f) - log1pf(expf(-fabsf(x))); }
__device__ __forceinline__ float silu(float x) { return x / (1.f + __expf(-x)); }
__device__ __forceinline__ s16x4 vtr(lds_cptr p) { return __builtin_bit_cast(s16x4, __builtin_amdgcn_ds_read_tr16_b64_v4i16((LAS3 s16x4*)p)); }
__device__ __forceinline__ bf16x8 frag_tr(lds_cptr img, int stride, int kbase, int m0, int lane) {
    const int i = lane & 15, g = lane >> 4;
    lds_cptr p = img + (kbase + 4 * (g >> 1) + (i >> 2)) * stride + (m0 + 16 * (g & 1) + 4 * (i & 3)) * 2;
    const s16x4 a = vtr(p), b = vtr(p + 8 * stride);
    return (bf16x8){a[0], a[1], a[2], a[3], b[0], b[1], b[2], b[3]};
}
__device__ __forceinline__ int rowidx(int reg, int hh) { return (reg & 3) + 8 * (reg >> 2) + 4 * hh; }
__device__ __forceinline__ void pack_p(const f32x16& p, bf16x8& f0, bf16x8& f1) {
    u32x4 a, b; a.x = pk2(p[0], p[1]); a.y = pk2(p[2], p[3]); a.z = pk2(p[4], p[5]); a.w = pk2(p[6], p[7]);
    b.x = pk2(p[8], p[9]); b.y = pk2(p[10], p[11]); b.z = pk2(p[12], p[13]); b.w = pk2(p[14], p[15]);
    f0 = __builtin_bit_cast(bf16x8, a); f1 = __builtin_bit_cast(bf16x8, b);
}
#define MFMA32(a, b, c) __builtin_amdgcn_mfma_f32_32x32x16_bf16((a), (b), (c), 0, 0, 0)

struct Ctx {
    const float *x, *norm_g, *w_in, *aqg, *akg, *bqg, *bkg, *fox_bias, *gate_up, *gate_bias, *out_gain, *w_out;
    float* out; unsigned char* ws;
    unsigned* ctl; unsigned long long* ss; bf16* wtin; bf16* wtout; bf16* xb; bf16* proj; float* small; bf16* mixed; bf16* oa; float* la; float* ob; float* lb; float* cl; float* bt;
    float* ds; bf16* st; float* dec;
    unsigned char* lds; int tid, lane, wave, G, bid;
};

__device__ __forceinline__ int orig_col(int np) { if (np < 5120) return np; if (np < 7424) return np + 8; if (np < 7432) return 5120 + (np - 7424); if (np < 7448) return np; return -1; }
__device__ __forceinline__ void p0_item(const float* W, int N, bf16* WT, const float* g, int mode, float* scr, int kb, int nb, int lane) {
    const int k0 = 64 * kb, n0 = 32 * nb, np = n0 + (lane & 31);
    const int oc = mode ? orig_col(np) : np;
    const float cs = (mode && np >= C_CQ && np < C_CK) ? 0.10206207261596577f : 1.0f;
#pragma unroll 8
    for (int i = 0; i < 32; ++i) { const int kk = 2 * i + (lane >> 5); float v = 0.f;
        if (oc >= 0) { v = W[(size_t)(k0 + kk) * N + oc] * cs; if (mode) v *= g[k0 + kk]; }
        scr[kk * 33 + (lane & 31)] = v; }
    __builtin_amdgcn_s_waitcnt(0); asm volatile("" ::: "memory");
    const int c = lane & 7;
#pragma unroll
    for (int j = 0; j < 4; ++j) { const int n = (lane >> 3) + 8 * j; const float* s = scr + (8 * c) * 33 + n;
        u32x4 o; o.x = pk2(s[0 * 33], s[1 * 33]); o.y = pk2(s[2 * 33], s[3 * 33]); o.z = pk2(s[4 * 33], s[5 * 33]); o.w = pk2(s[6 * 33], s[7 * 33]);
        *(u32x4*)(WT + (size_t)(n0 + n) * 2048 + k0 + 8 * c) = o; }
    __builtin_amdgcn_s_waitcnt(0); asm volatile("" ::: "memory");
}
__device__ __forceinline__ void phase0(Ctx& F) {
    float* scr = (float*)(F.lds + F.wave * 16384);
    const int gw = F.bid * 8 + F.wave, NGW = F.G * 8;
    if (F.bid == 0 && F.tid < 64) F.ctl[F.tid] = 0u;
    for (int i = F.bid * 512 + F.tid; i < 3 * SEQ; i += F.G * 512) F.ss[SEQ + i] = 0ull;
    constexpr int I_IN = 32 * 233, I_OUT = 32 * 64, I_L = I_IN + I_OUT;
    for (int it = gw; it < NLAYER * I_L; it += NGW) {
        const int l = it / I_L; int r = it % I_L;
        if (r < I_IN) p0_item(F.w_in + (size_t)l * DM * INW, INW, F.wtin + (size_t)l * NPAD * DM, F.norm_g + l * DM, 1, scr, r / 233, r % 233, F.lane);
        else { r -= I_IN; p0_item(F.w_out + (size_t)l * DM * DM, DM, F.wtout + (size_t)l * DM * DM, nullptr, 0, scr, r / 64, r % 64, F.lane); }
    }
    for (int m = gw; m < SEQ; m += NGW) {
        const f32x4* xr = (const f32x4*)(F.x + (size_t)m * DM) + F.lane; float s = 0.f; u32x2* o8 = (u32x2*)(F.xb + (size_t)m * DM) + F.lane;
#pragma unroll
        for (int j = 0; j < 8; ++j) { const f32x4 v = xr[64 * j]; s += (v.x * v.x + v.y * v.y) + (v.z * v.z + v.w * v.w); u32x2 w; w.x = pk2(v.x, v.y); w.y = pk2(v.z, v.w); o8[64 * j] = w; }
#pragma unroll
        for (int o = 1; o < 64; o <<= 1) s += __shfl_xor(s, o);
        if (F.lane == 0) F.ss[m] = (unsigned long long)(s * 1048576.0f + 0.5f);
    }
}

__device__ __forceinline__ void phase2(Ctx& F, int l) {
    { const int NT = F.G * 512; const int total = SEQ * 320;
      for (int base = 0; base < total; base += NT) { const int idx0 = base + F.bid * 512 + F.tid; const bool ok = idx0 < total; const int idx = ok ? idx0 : 0;
        const int row = idx / 320, c = idx % 320; int col; const float* g; float sc = 1.f;
        if (c < 192) { col = c * 8; if (col < 768) { g = F.aqg + l * 64; sc = QSCALE; } else g = F.akg + l * 64; }
        else { col = 3072 + (c - 192) * 8; if (col < C_BK) { g = F.bqg + l * 64; sc = QSCALE; } else g = F.bkg + l * 64; }
        bf16* p = F.proj + (size_t)row * PW + col; const u32x4 w = *(const u32x4*)p;
        float v[8] = {blo(w.x), bhi(w.x), blo(w.y), bhi(w.y), blo(w.z), bhi(w.z), blo(w.w), bhi(w.w)};
        float s = 0.f;
#pragma unroll
        for (int j = 0; j < 8; ++j) s += v[j] * v[j];
        s += __shfl_xor(s, 1); s += __shfl_xor(s, 2); s += __shfl_xor(s, 4);
        const float rs = rsqrtf(s * (1.f / 64.f) + EPS) * sc; const float* gg = g + (col & 63);
        const f32x4 g0 = *(const f32x4*)gg, g1 = *(const f32x4*)(gg + 4);
        u32x4 o; o.x = pk2(v[0] * rs * g0.x, v[1] * rs * g0.y); o.y = pk2(v[2] * rs * g0.z, v[3] * rs * g0.w); o.z = pk2(v[4] * rs * g1.x, v[5] * rs * g1.y); o.w = pk2(v[6] * rs * g1.z, v[7] * rs * g1.w);
        if (ok) *(u32x4*)p = o; } }
    { const int gw = F.bid * 8 + F.wave, NGW = F.G * 8;
      for (int wi = gw; wi < 512; wi += NGW) { const int blk = wi >> 3, h = wi & 7, t = blk * 128 + 2 * F.lane; const float fb = F.fox_bias[l * 8 + h];
        const float l0 = logsig(F.small[(size_t)t * 32 + h] + fb), l1 = logsig(F.small[(size_t)(t + 1) * 32 + h] + fb);
        float s = l0 + l1;
#pragma unroll
        for (int o = 1; o < 64; o <<= 1) { const float y = __shfl_up(s, o); if (F.lane >= o) s += y; }
        const float ex = s - (l0 + l1); F.cl[t * 8 + h] = ex + l0; F.cl[(t + 1) * 8 + h] = s; if (F.lane == 63) F.bt[blk * 8 + h] = s; } }
    { float* LA = (float*)F.lds;
      unsigned char* KH = F.lds + 24576;
      unsigned char* VV = F.lds + 24576 + 13312;
      const float* gup = F.gate_up + (size_t)l * 16 * 384; const float* gbs = F.gate_bias + l * 384;
      for (int u = F.bid; u < 512; u += F.G) { const int h = u & 3, n = u >> 2, t0 = n * 64;
        for (int e = F.tid; e < 6144; e += 512) { const int t = e / 96, d = e % 96; float a = gbs[h * 96 + d]; const float* cr = F.small + (size_t)(t0 + t) * 32 + 8;
#pragma unroll
            for (int r = 0; r < 16; ++r) a += cr[r] * gup[r * 384 + h * 96 + d];
            LA[e] = logsig(a) * (1.f / 16.f); }
        for (int e = F.tid; e < 1536; e += 512) { const int row = e / 24, ch = e % 24;
            *(u32x4*)(VV + row * 400 + ch * 16) = *(const u32x4*)(F.proj + (size_t)(t0 + row) * PW + C_CV + h * 192 + ch * 8); }
        __syncthreads();
        if (F.tid < 96) { float run = 0.f;
#pragma unroll 8
            for (int t = 0; t < 64; ++t) { run += LA[t * 96 + F.tid]; LA[t * 96 + F.tid] = run; } }
        __syncthreads();
        for (int e = F.tid; e < 768; e += 512) { const int t = e / 12, d0 = (e % 12) * 8;
            bf16* qp = F.proj + (size_t)(t0 + t) * PW + C_CQ + h * 96 + d0; bf16* kp = F.proj + (size_t)(t0 + t) * PW + C_CK + h * 96 + d0;
            const u32x4 qw = *(const u32x4*)qp, kw = *(const u32x4*)kp;
            float q[8] = {blo(qw.x), bhi(qw.x), blo(qw.y), bhi(qw.y), blo(qw.z), bhi(qw.z), blo(qw.w), bhi(qw.w)};
            float k[8] = {blo(kw.x), bhi(kw.x), blo(kw.y), bhi(kw.y), blo(kw.z), bhi(kw.z), blo(kw.w), bhi(kw.w)};
            float qt[8], kt[8], kh[8];
#pragma unroll
            for (int j = 0; j < 8; ++j) { const float bc = LA[t * 96 + d0 + j], bm = LA[31 * 96 + d0 + j], bl = LA[63 * 96 + d0 + j];
                qt[j] = q[j] * __expf(bc - bm); kt[j] = k[j] * __expf(bm - bc); kh[j] = k[j] * __expf(bl - bc); }
            u32x4 o; o.x = pk2(qt[0], qt[1]); o.y = pk2(qt[2], qt[3]); o.z = pk2(qt[4], qt[5]); o.w = pk2(qt[6], qt[7]); *(u32x4*)qp = o;
            o.x = pk2(kt[0], kt[1]); o.y = pk2(kt[2], kt[3]); o.z = pk2(kt[4], kt[5]); o.w = pk2(kt[6], kt[7]); *(u32x4*)kp = o;
            o.x = pk2(kh[0], kh[1]); o.y = pk2(kh[2], kh[3]); o.z = pk2(kh[4], kh[5]); o.w = pk2(kh[6], kh[7]); *(u32x4*)(KH + t * 208 + d0 * 2) = o; }
        if (F.tid < 96) { F.dec[(n * 4 + h) * 96 + F.tid] = __expf(LA[63 * 96 + F.tid]); F.dec[49152 + (n * 4 + h) * 96 + F.tid] = __expf(LA[31 * 96 + F.tid]); }
        __syncthreads();
        for (int id = F.wave; id < 18; id += 8) { const int vt = id / 3, dt = id % 3; f32x16 acc = {};
#pragma unroll
            for (int s = 0; s < 4; ++s) { const bf16x8 a = frag_tr((lds_cptr)VV, 400, 16 * s, 32 * vt, F.lane), b = frag_tr((lds_cptr)KH, 208, 16 * s, 32 * dt, F.lane); acc = MFMA32(a, b, acc); }
            float* dst = F.ds + ((size_t)(n * 4 + h) * 192 + 32 * vt) * 96 + 32 * dt + (F.lane & 31);
#pragma unroll
            for (int r = 0; r < 16; ++r) dst[(size_t)rowidx(r, F.lane >> 5) * 96] = acc[r]; }
        __syncthreads(); } }
}
__device__ __forceinline__ float softmax_ref2(const float* gq, const float* gk) {
    float mq = 0.f, mk = 0.f;
    for (int i = 0; i < 64; ++i) { mq = fmaxf(mq, fabsf(gq[i])); mk = fmaxf(mk, fabsf(gk[i])); }
    return 8.25f * mq * mk * LOG2E;
}
__device__ __forceinline__ void scan_item(Ctx& F, int si) {
    const int p = si * 512 + F.tid, d = 2 * (p % 48), v = (p / 48) % 192, h = p / (48 * 192);
    float s0 = 0.f, s1 = 0.f;
#pragma unroll 8
    for (int n = 0; n < 128; ++n) { const size_t idx = ((size_t)(n * 4 + h) * 192 + v) * 96 + d; const int di = (n * 4 + h) * 96 + d;
        const f32x2 dd = *(const f32x2*)(F.ds + idx), a = *(const f32x2*)(F.dec + di), em = *(const f32x2*)(F.dec + 49152 + di);
        *(unsigned*)(F.st + idx) = pk2(em.x * s0, em.y * s1);
        s0 = a.x * s0 + dd.x; s1 = a.y * s1 + dd.y; }
}
template <int KSTR>
__device__ __forceinline__ void attn_sub(const unsigned char* Kt, const unsigned char* Vt, int key_row0, const bf16x8 (&qf)[4], f32x16 S, f32x16 (&o)[2], float& lsum, int lane,
                                         bool use_mask, int lo, int hi_) {
    const int r = lane & 31, hh = lane >> 5;
#pragma unroll
    for (int s = 0; s < 4; ++s) { const bf16x8 kf = *(const bf16x8*)(Kt + (key_row0 + r) * KSTR + (16 * s + 8 * hh) * 2); S = MFMA32(kf, qf[s], S); }
    if (use_mask) {
#pragma unroll
        for (int g = 0; g < 16; ++g) { const int k = rowidx(g, hh); if (k < lo || k > hi_) S[g] = -INFINITY; } }
    float acc = 0.f;
#pragma unroll
    for (int g = 0; g < 16; ++g) { S[g] = __builtin_amdgcn_exp2f(S[g]); acc += S[g]; }
    lsum += acc;
    bf16x8 p0, p1; pack_p(S, p0, p1);
#pragma unroll
    for (int dt = 0; dt < 2; ++dt) {
        const bf16x8 v0 = frag_tr((lds_cptr)Vt, KSTR, key_row0, 32 * dt, lane), v1 = frag_tr((lds_cptr)Vt, KSTR, key_row0 + 16, 32 * dt, lane);
        o[dt] = MFMA32(v0, p0, o[dt]); o[dt] = MFMA32(v1, p1, o[dt]); }
}
__device__ __forceinline__ void fox_unit(Ctx& F, int l, int h, int qb, int seg) {
    constexpr int KS = 144;
    unsigned char* KT = F.lds; unsigned char* VT = F.lds + 18432; float* CS = (float*)(F.lds + 36864); float* PEX = (float*)(F.lds + 37376);
    const int r = F.lane & 31, hh = F.lane >> 5, w = F.wave, t0 = 256 * qb, NT = 4 * qb + 4, ts = 32 * seg, te = (ts + 32 < NT) ? ts + 32 : NT;
    if (w == 0) { const float v = F.bt[F.lane * 8 + h]; float s = v;
#pragma unroll
        for (int o = 1; o < 64; o <<= 1) { const float y = __shfl_up(s, o); if (F.lane >= o) s += y; }
        PEX[F.lane] = s - v; }
    const float mb2 = softmax_ref2(F.bqg + l * 64, F.bkg + l * 64);
    __syncthreads();
    const int tq = t0 + 32 * w + r; const float pq0 = PEX[t0 >> 7];
    const float ctq = ((PEX[tq >> 7] - pq0) + F.cl[tq * 8 + h]) * LOG2E - mb2;
    bf16x8 qf[4];
#pragma unroll
    for (int s = 0; s < 4; ++s) qf[s] = *(const bf16x8*)(F.proj + (size_t)tq * PW + C_BQ + h * 64 + 16 * s + 8 * hh);
    f32x16 o[2]; o[0] = f32x16{}; o[1] = f32x16{}; float lsum = 0.f;
    const int lrow = F.tid >> 3, lch = F.tid & 7;
    u32x4 kreg, vreg; float creg = 0.f;
    { const size_t g = (size_t)(64 * ts + lrow) * PW + h * 64 + lch * 8; kreg = *(const u32x4*)(F.proj + g + C_BK); vreg = *(const u32x4*)(F.proj + g + C_BV);
      if (F.tid < 64) creg = ((PEX[ts >> 1] - pq0) + F.cl[(64 * ts + F.tid) * 8 + h]) * LOG2E; }
    for (int kt = ts; kt < te; ++kt) { const int buf = (kt - ts) & 1;
        *(u32x4*)(KT + buf * 9216 + lrow * KS + lch * 16) = kreg; *(u32x4*)(VT + buf * 9216 + lrow * KS + lch * 16) = vreg; if (F.tid < 64) CS[buf * 64 + F.tid] = creg;
        __syncthreads();
        if (kt + 1 < te) { const size_t g = (size_t)(64 * (kt + 1) + lrow) * PW + h * 64 + lch * 8; kreg = *(const u32x4*)(F.proj + g + C_BK); vreg = *(const u32x4*)(F.proj + g + C_BV);
            if (F.tid < 64) creg = ((PEX[(kt + 1) >> 1] - pq0) + F.cl[(64 * (kt + 1) + F.tid) * 8 + h]) * LOG2E; }
        const int qlo = t0 + 32 * w;
#pragma unroll
        for (int sub = 0; sub < 2; ++sub) { const int key0 = 64 * kt + 32 * sub;
            if (key0 <= qlo + 31) {
                f32x16 S;
#pragma unroll
                for (int i = 0; i < 4; ++i) { const f32x4 c4 = *(const f32x4*)(CS + buf * 64 + 32 * sub + 8 * i + 4 * hh); S[4 * i] = ctq - c4.x; S[4 * i + 1] = ctq - c4.y; S[4 * i + 2] = ctq - c4.z; S[4 * i + 3] = ctq - c4.w; }
                attn_sub<KS>(KT + buf * 9216, VT + buf * 9216, 32 * sub, qf, S, o, lsum, F.lane, key0 + 31 > qlo, 0, tq - key0); } }
    }
    lsum += __shfl_xor(lsum, 32);
    float* ob = F.ob + ((size_t)seg * SEQ + tq) * 512 + h * 64 + 4 * hh;
#pragma unroll
    for (int dt = 0; dt < 2; ++dt)
#pragma unroll
        for (int i = 0; i < 4; ++i) *(f32x4*)(ob + 32 * dt + 8 * i) = (f32x4){o[dt][4 * i], o[dt][4 * i + 1], o[dt][4 * i + 2], o[dt][4 * i + 3]};
    if (hh == 0) F.lb[((size_t)seg * SEQ + tq) * 8 + h] = lsum;
    __syncthreads();
}
__device__ __forceinline__ void a_unit(Ctx& F, int l, int a, int n, int rres, int b2) {
    constexpr int KS = 144;
    unsigned char* KA = F.lds; unsigned char* VA = F.lds + 384 * KS;
    const int r = F.lane & 31, hh = F.lane >> 5, w = F.wave, d = (n == 0) ? 1 : (n == 1) ? 4 : 16, i0 = 256 * b2;
    for (int e = F.tid; e < 3072; e += 512) { const int j = e >> 3, ch = e & 7, idx = i0 - 128 + j; u32x4 kv = {0u, 0u, 0u, 0u}, vv = {0u, 0u, 0u, 0u};
        if (idx >= 0) { const size_t g = (size_t)(rres + d * idx) * PW + a * 64 + ch * 8; kv = *(const u32x4*)(F.proj + g + C_AK); vv = *(const u32x4*)(F.proj + g + C_AV); }
        *(u32x4*)(KA + j * KS + ch * 16) = kv; *(u32x4*)(VA + j * KS + ch * 16) = vv; }
    const int tokq = rres + d * (i0 + 32 * w + r);
    bf16x8 qf[4];
#pragma unroll
    for (int s = 0; s < 4; ++s) qf[s] = *(const bf16x8*)(F.proj + (size_t)tokq * PW + C_AQ + a * 64 + 16 * s + 8 * hh);
    const float mb2 = softmax_ref2(F.aqg + l * 64, F.akg + l * 64);
    __syncthreads();
    f32x16 o[2]; o[0] = f32x16{}; o[1] = f32x16{}; float lsum = 0.f;
    const int qj = 32 * w + r + 128;
    for (int jt = w; jt < w + 5; ++jt) { const int j0 = 32 * jt;
        if (i0 == 0 && j0 + 31 < 128) continue;
        f32x16 S;
#pragma unroll
        for (int g = 0; g < 16; ++g) S[g] = -mb2;
        int lo = qj - 128 - j0; const int hi_ = qj - j0; if (i0 == 0 && 128 - j0 > lo) lo = 128 - j0;
        attn_sub<KS>(KA, VA, j0, qf, S, o, lsum, F.lane, (jt == w) || (jt == w + 4) || (i0 == 0 && j0 < 128), lo, hi_); }
    lsum += __shfl_xor(lsum, 32);
    bf16* oa = F.oa + ((size_t)n * SEQ + tokq) * 768 + a * 64 + 4 * hh;
#pragma unroll
    for (int dt = 0; dt < 2; ++dt)
#pragma unroll
        for (int i = 0; i < 4; ++i) { u32x2 wv; wv.x = pk2(o[dt][4 * i], o[dt][4 * i + 1]); wv.y = pk2(o[dt][4 * i + 2], o[dt][4 * i + 3]); *(u32x2*)(oa + 32 * dt + 8 * i) = wv; }
    if (hh == 0) F.la[((size_t)n * SEQ + tokq) * 12 + a] = lsum;
    __syncthreads();
}
__device__ __forceinline__ void phase3(Ctx& F, int l) {
    volatile unsigned* slot = (volatile unsigned*)(F.lds + QSLOT_OFF);
    for (;;) {
        if (F.tid == 0) *slot = atomicAdd(F.ctl + l, 1u);
        __syncthreads();
        const int item = (int)*slot;
        __syncthreads();
        if (item >= N_ITEMS) break;
        if (item < N_SCAN) scan_item(F, item);
        else if (item < N_SCAN + N_FOX) { int f = item - N_SCAN, ns, qhi;
            if (f < 256) { ns = 4; qhi = 31; } else if (f < 448) { f -= 256; ns = 3; qhi = 23; } else if (f < 576) { f -= 448; ns = 2; qhi = 15; } else { f -= 576; ns = 1; qhi = 7; }
            const int per = ns * 8, qb = qhi - f / per, rem = f % per;
            fox_unit(F, l, rem & 7, qb, rem >> 3); }
        else { const int au = item - N_SCAN - N_FOX, n = au / 384, rest = au % 384, a = rest >> 5, u = rest & 31;
            const int per = (n == 0) ? 32 : (n == 1) ? 8 : 2;
            a_unit(F, l, a, n, u / per, u % per); }
    }
}
__device__ __forceinline__ void phase4(Ctx& F, int l) {
    unsigned char* VV = F.lds;
    float* SSQ = (float*)(F.lds + 51200);
    const int r = F.lane & 31, hh = F.lane >> 5, w = F.wave, ui = w >> 2, th = (w >> 1) & 1, vh = w & 1;
    const float* gain = F.out_gain + l * 192;
    for (int pu = F.bid; pu < 256; pu += F.G) {
        for (int e = F.tid; e < 3072; e += 512) { const int uu = e / 1536, e2 = e % 1536, row = e2 / 24, ch = e2 % 24, u = 2 * pu + uu, h = u & 3, n = u >> 2;
            *(u32x4*)(VV + uu * 25600 + row * 400 + ch * 16) = *(const u32x4*)(F.proj + (size_t)(n * 64 + row) * PW + C_CV + h * 192 + ch * 8); }
        __syncthreads();
        const int u = 2 * pu + ui, h = u & 3, n = u >> 2, t0 = n * 64, tq = th * 32 + r;
        bf16x8 qf[6];
#pragma unroll
        for (int kd = 0; kd < 6; ++kd) qf[kd] = *(const bf16x8*)(F.proj + (size_t)(t0 + tq) * PW + C_CQ + h * 96 + 16 * kd + 8 * hh);
        bf16x8 pf[2][2];
#pragma unroll
        for (int si = 0; si < 2; ++si) if (si <= th) { f32x16 X = {};
#pragma unroll
            for (int kd = 0; kd < 6; ++kd) { const bf16x8 kf = *(const bf16x8*)(F.proj + (size_t)(t0 + 32 * si + r) * PW + C_CK + h * 96 + 16 * kd + 8 * hh); X = MFMA32(kf, qf[kd], X); }
            if (si == th) {
#pragma unroll
                for (int g = 0; g < 16; ++g) if (rowidx(g, hh) > r) X[g] = 0.f; }
            pack_p(X, pf[si][0], pf[si][1]); }
        f32x16 O[3]; float sq = 0.f;
#pragma unroll
        for (int vt = 0; vt < 3; ++vt) { const int vtile = vh * 3 + vt; f32x16 acc = {};
#pragma unroll
            for (int si = 0; si < 2; ++si) if (si <= th) {
#pragma unroll
                for (int s2 = 0; s2 < 2; ++s2) { const bf16x8 vf = frag_tr((lds_cptr)(VV + ui * 25600), 400, 32 * si + 16 * s2, 32 * vtile, F.lane); acc = MFMA32(vf, pf[si][s2], acc); } }
#pragma unroll
            for (int kd = 0; kd < 6; ++kd) { const bf16x8 sf = *(const bf16x8*)(F.st + ((size_t)(n * 4 + h) * 192 + 32 * vtile + r) * 96 + 16 * kd + 8 * hh); acc = MFMA32(sf, qf[kd], acc); }
#pragma unroll
            for (int g = 0; g < 16; ++g) sq += acc[g] * acc[g];
            O[vt] = acc; }
        sq += __shfl_xor(sq, 32);
        if (hh == 0) SSQ[(ui * 2 + vh) * 64 + tq] = sq;
        __syncthreads();
        const float rs = rsqrtf((SSQ[(ui * 2) * 64 + tq] + SSQ[(ui * 2 + 1) * 64 + tq]) * (1.f / 192.f) + EPS);
#pragma unroll
        for (int vt = 0; vt < 3; ++vt)
#pragma unroll
            for (int i = 0; i < 4; ++i) { const int v = 32 * (vh * 3 + vt) + 8 * i + 4 * hh;
                const u32x2 zw = *(const u32x2*)(F.proj + (size_t)(t0 + tq) * PW + C_CZ + h * 192 + v); const f32x4 gg = *(const f32x4*)(gain + v);
                const float y0 = O[vt][4 * i] * rs * gg.x * silu(blo(zw.x)), y1 = O[vt][4 * i + 1] * rs * gg.y * silu(bhi(zw.x)), y2 = O[vt][4 * i + 2] * rs * gg.z * silu(blo(zw.y)), y3 = O[vt][4 * i + 3] * rs * gg.w * silu(bhi(zw.y));
                u32x2 ov; ov.x = pk2(y0, y1); ov.y = pk2(y2, y3); *(u32x2*)(F.mixed + (size_t)(t0 + tq) * DM + 1280 + h * 192 + v) = ov; }
        __syncthreads();
    }
    const int NT = F.G * 512, gt = F.bid * 512 + F.tid;
    for (int idx = gt; idx < SEQ * 96; idx += NT) { const int t = idx / 96, c = (idx % 96) * 8, a = c >> 6;
        float o[8] = {0.f, 0.f, 0.f, 0.f, 0.f, 0.f, 0.f, 0.f}; float lsum = 0.f;
#pragma unroll
        for (int n = 0; n < 3; ++n) { const u32x4 wv = *(const u32x4*)(F.oa + ((size_t)n * SEQ + t) * 768 + c); lsum += F.la[((size_t)n * SEQ + t) * 12 + a];
            o[0] += blo(wv.x); o[1] += bhi(wv.x); o[2] += blo(wv.y); o[3] += bhi(wv.y); o[4] += blo(wv.z); o[5] += bhi(wv.z); o[6] += blo(wv.w); o[7] += bhi(wv.w); }
        const float il = 1.f / lsum; const u32x4 zw = *(const u32x4*)(F.proj + (size_t)t * PW + C_AZ + c);
        u32x4 ov; ov.x = pk2(o[0] * il * silu(blo(zw.x)), o[1] * il * silu(bhi(zw.x))); ov.y = pk2(o[2] * il * silu(blo(zw.y)), o[3] * il * silu(bhi(zw.y)));
        ov.z = pk2(o[4] * il * silu(blo(zw.z)), o[5] * il * silu(bhi(zw.z))); ov.w = pk2(o[6] * il * silu(blo(zw.w)), o[7] * il * silu(bhi(zw.w)));
        *(u32x4*)(F.mixed + (size_t)t * DM + c) = ov; }
    for (int idx = gt; idx < SEQ * 64; idx += NT) { const int t = idx / 64, c = (idx % 64) * 8, h = c >> 6, nseg = (t >> 11) + 1;
        f32x4 o0 = {0.f, 0.f, 0.f, 0.f}, o1 = {0.f, 0.f, 0.f, 0.f}; float lsum = 0.f;
        for (int s = 0; s < nseg; ++s) { const float* p = F.ob + ((size_t)s * SEQ + t) * 512 + c; o0 += *(const f32x4*)p; o1 += *(const f32x4*)(p + 4); lsum += F.lb[((size_t)s * SEQ + t) * 8 + h]; }
        const float il = 1.f / lsum; const u32x4 zw = *(const u32x4*)(F.proj + (size_t)t * PW + C_BZ + c);
        u32x4 ov; ov.x = pk2(o0.x * il * silu(blo(zw.x)), o0.y * il * silu(bhi(zw.x))); ov.y = pk2(o0.z * il * silu(blo(zw.y)), o0.w * il * silu(bhi(zw.y)));
        ov.z = pk2(o1.x * il * silu(blo(zw.z)), o1.y * il * silu(bhi(zw.z))); ov.w = pk2(o1.z * il * silu(blo(zw.w)), o1.w * il * silu(bhi(zw.w)));
        *(u32x4*)(F.mixed + (size_t)t * DM + 768 + c) = ov; }
}

struct Args { const float* in[12]; float* out; unsigned char* ws; int ph_lo, ph_hi; };
constexpr int N_PHASES = 1 + 5 * NLAYER;
__global__ void __launch_bounds__(512, 2) mega_fwd(Args args) {
    extern __shared__ __attribute__((aligned(16))) unsigned char lds[];
    Ctx F;
    F.x = args.in[0]; F.norm_g = args.in[1]; F.w_in = args.in[2]; F.aqg = args.in[3]; F.akg = args.in[4]; F.bqg = args.in[5]; F.bkg = args.in[6];
    F.fox_bias = args.in[7]; F.gate_up = args.in[8]; F.gate_bias = args.in[9]; F.out_gain = args.in[10]; F.w_out = args.in[11];
    F.out = args.out; F.ws = args.ws; unsigned char* ws = args.ws;
    F.ctl = (unsigned*)(ws + WS_CTL); F.ss = (unsigned long long*)(ws + WS_SS); F.wtin = (bf16*)(ws + WS_WTIN); F.wtout = (bf16*)(ws + WS_WTOUT); F.xb = (bf16*)(ws + WS_XB);
    F.proj = (bf16*)(ws + WS_PROJ); F.small = (float*)(ws + WS_SMALL); F.mixed = (bf16*)(ws + WS_MIXED); F.oa = (bf16*)(ws + WS_OA); F.la = (float*)(ws + WS_LA);
    F.ob = (float*)(ws + WS_OB); F.lb = (float*)(ws + WS_LB); F.cl = (float*)(ws + WS_CL); F.bt = (float*)(ws + WS_BT); F.ds = (float*)(ws + WS_DS); F.st = (bf16*)(ws + WS_ST); F.dec = (float*)(ws + WS_DEC);
    F.lds = lds; F.tid = threadIdx.x; F.lane = F.tid & 63; F.wave = __builtin_amdgcn_readfirstlane(F.tid >> 6); F.G = gridDim.x; F.bid = blockIdx.x;
    cg::grid_group grid = cg::this_grid();
    const int lo = args.ph_lo, hi = args.ph_hi;
#define IN(k) (lo <= (k) && (k) < hi)
#define RELAUNDER() do { int t_ = threadIdx.x; asm volatile("" : "+v"(t_)); F.tid = t_; F.lane = t_ & 63; F.wave = __builtin_amdgcn_readfirstlane(t_ >> 6); } while (0)
#define SEAM(k) do { if (IN(k) && IN((k) + 1)) grid.sync(); } while (0)
    if (IN(0)) { RELAUNDER(); phase0(F); }
    SEAM(0);
    for (int l = 0; l < NLAYER; ++l) { const int pb = 1 + 5 * l;
        if (IN(pb)) { pg8::Gemm g{F.xb, F.wtin + (size_t)l * NPAD * DM, SEQ, NPAD, DM}; pg8::StaticOrder S; S.init(SEQ, NPAD, F.G, F.bid);
            pg8::EpiProj E{F.proj, F.small, F.ss + l * SEQ};
            pg8::gemm_phase<pg8::EpiProj, pg8::StaticOrder, true, true>((PG8_LAS unsigned char*)lds, g, S, E); __syncthreads(); }
        SEAM(pb);
        if (IN(pb + 1)) { RELAUNDER(); phase2(F, l); }
        SEAM(pb + 1);
        if (IN(pb + 2)) { RELAUNDER(); phase3(F, l); }
        SEAM(pb + 2);
        if (IN(pb + 3)) { RELAUNDER(); phase4(F, l); }
        SEAM(pb + 3);
        if (IN(pb + 4)) { pg8::Gemm g{F.mixed, F.wtout + (size_t)l * DM * DM, SEQ, DM, DM}; pg8::StaticOrder S; S.init(SEQ, DM, F.G, F.bid);
            const bool last = (l == NLAYER - 1);
            pg8::EpiOut E{l == 0 ? F.x : F.out, F.out, last ? nullptr : F.xb, last ? nullptr : F.ss + (l + 1) * SEQ};
            pg8::gemm_phase<pg8::EpiOut, pg8::StaticOrder, true, true>((PG8_LAS unsigned char*)lds, g, S, E); __syncthreads(); }
        SEAM(pb + 4);
    }
#undef IN
#undef SEAM
}

#ifndef MK_ONE_LAUNCH
#define MK_ONE_LAUNCH 1
#endif
extern "C" void kernel_launch(void* const* d_in, const int* in_sizes, int n_in, void* d_out, int out_size, void* d_ws, size_t ws_size, hipStream_t stream) {
    static int grid = 0;
    if (grid == 0) {
        int dev = 0, cus = 0, per_cu = 0;
        hipGetDevice(&dev); hipDeviceGetAttribute(&cus, hipDeviceAttributeMultiprocessorCount, dev);
        hipFuncSetAttribute((const void*)mega_fwd, hipFuncAttributeMaxDynamicSharedMemorySize, LDS_BYTES);
        hipOccupancyMaxActiveBlocksPerMultiprocessor(&per_cu, mega_fwd, 512, LDS_BYTES);
        grid = cus * per_cu; if (grid <= 0) grid = 256;
        if (ws_size < WS_END) { fprintf(stderr, "workspace too small: %zu < %zu\n", ws_size, (size_t)WS_END); }
    }
    Args a{}; for (int i = 0; i < 12; ++i) a.in[i] = (const float*)d_in[i]; a.out = (float*)d_out; a.ws = (unsigned char*)d_ws;
#if MK_ONE_LAUNCH
    a.ph_lo = 0; a.ph_hi = N_PHASES; void* kargs[] = {&a};
    hipError_t e = hipLaunchCooperativeKernel((const void*)mega_fwd, dim3(grid), dim3(512), kargs, LDS_BYTES, stream);
    if (e != hipSuccess) fprintf(stderr, "cooperative launch failed: %s (grid %d)\n", hipGetErrorString(e), grid);
#else
    for (int p = 0; p < N_PHASES; ++p) { a.ph_lo = p; a.ph_hi = p + 1; hipLaunchKernelGGL(mega_fwd, dim3(grid), dim3(512), LDS_BYTES, stream, a); }
#endif
}
```

```cpp
#include <hip/hip_runtime.h>
#include <hip/hip_cooperative_groups.h>
#include <cstdio>
#include <cstdint>
namespace cg = cooperative_groups;
namespace pg8 {
#define PG8_LAS __attribute__((address_space(3)))
typedef unsigned short bf16_t;
typedef short bf16x8 __attribute__((ext_vector_type(8)));
typedef float f32x4 __attribute__((ext_vector_type(4)));
typedef unsigned u32x4 __attribute__((ext_vector_type(4)));
constexpr int BM = 256, BK = 64, HALF = 128, HTB = HALF * BK * 2  , STAGE_BYTES = 8 * HTB, NXCD = 8, WGM = 8;

__host__ __device__ __forceinline__ int lds_byte(int r, int c) { const int st = (r >> 4) * 2 + (c >> 5), rr = r & 15, cc = c & 31, ob = rr * 64 + cc * 2; return st * 1024 + (ob ^ (((ob >> 9) & 1) << 5)); }
__host__ __device__ __forceinline__ void stage_rc(int b, int& R, int& C) { const int st = b / 1024, sb = b % 1024, swz = sb ^ (((sb >> 9) & 1) << 5); R = (st >> 1) * 16 + swz / 64; C = (st & 1) * 32 + (swz % 64) / 2; }
__host__ __device__ __forceinline__ int perm32(int rho) { const int n = rho >> 4, i = rho & 15; return 8 * (i >> 2) + 4 * n + (i & 3); }

struct Unit { int pm, pn; };
struct Gemm { const bf16_t* A; const bf16_t* Bt; int M, N, K; };

struct StaticOrder {
    int nM, nN, nwg, G, c;
    __host__ __device__ void init(int M, int N, int G_, int c_) { nM = M / BM; nN = N / BM; nwg = nM * nN; G = G_; c = c_; }
    __host__ __device__ bool next(int i, Unit& u) const {
        const long L = (long)i * G + c; if (L >= nwg) return false;
        int wgid = (int)L; { const int q = nwg / NXCD, r = nwg % NXCD, xcd = wgid % NXCD, off = wgid / NXCD; wgid = (xcd < r ? xcd * (q + 1) : r * (q + 1) + (xcd - r) * q) + off; }
        const int nig = WGM * nN, gid = wgid / nig, fm = gid * WGM, gsz = (nM - fm) < WGM ? (nM - fm) : WGM;
        u.pm = fm + ((wgid % nig) % gsz); u.pn = (wgid % nig) / gsz; return true;
    }
    __device__ __forceinline__ void a_ready(const Unit&) const {}
    __device__ __forceinline__ void done(const Unit&) const {}
};

__device__ __forceinline__ unsigned cvt_pk_bf16(float lo, float hi) { unsigned r; asm volatile("v_cvt_pk_bf16_f32 %0, %1, %2" : "=v"(r) : "v"(lo), "v"(hi)); return r; }
typedef float f32x2 __attribute__((ext_vector_type(2)));
constexpr int PROJ_W = 7424;
struct EpiProj {
    static constexpr bool PERM = true, AFTER_DRAIN = false;
    bf16_t* O; float* small; const unsigned long long* ss;
    __device__ __forceinline__ void operator()(const f32x4 (&acc)[2][2][4][2], const Unit& u, int wr, int wc, int fr, int fq) const {
        const int row0 = u.pm * BM + wr * 64 + fr;
        if (u.pn < 29) {
            const int col0 = u.pn * BM + wc * 32 + 8 * fq;
#pragma unroll
            for (int ai = 0; ai < 2; ++ai)
#pragma unroll
                for (int m = 0; m < 4; ++m) { const int row = row0 + ai * HALF + m * 16; const float rs = rsqrtf((float)ss[row] * (1.0f / 1048576.0f / 2048.0f) + 1e-6f);
                    bf16_t* rowp = O + (size_t)row * PROJ_W + col0;
#pragma unroll
                    for (int bj = 0; bj < 2; ++bj) { const f32x4 v0 = acc[ai][bj][m][0] * rs, v1 = acc[ai][bj][m][1] * rs;
                        u32x4 w; w.x = cvt_pk_bf16(v0[0], v0[1]); w.y = cvt_pk_bf16(v0[2], v0[3]); w.z = cvt_pk_bf16(v1[0], v1[1]); w.w = cvt_pk_bf16(v1[2], v1[3]);
                        *(u32x4*)(rowp + bj * HALF) = w; } }
        } else if (wc == 0) {
#pragma unroll
            for (int ai = 0; ai < 2; ++ai)
#pragma unroll
                for (int m = 0; m < 4; ++m) { const int row = row0 + ai * HALF + m * 16; const float rs = rsqrtf((float)ss[row] * (1.0f / 1048576.0f / 2048.0f) + 1e-6f);
                    float* p = small + (size_t)row * 32 + 8 * fq;
                    *(f32x4*)p = acc[ai][0][m][0] * rs; *(f32x4*)(p + 4) = acc[ai][0][m][1] * rs; }
        }
    }
};
struct EpiOut {
    static constexpr bool PERM = true, AFTER_DRAIN = false;
    const float* xin; float* out; bf16_t* xb; unsigned long long* ssn;
    __device__ __forceinline__ void operator()(const f32x4 (&acc)[2][2][4][2], const Unit& u, int wr, int wc, int fr, int fq) const {
        const int row0 = u.pm * BM + wr * 64 + fr, col0 = u.pn * BM + wc * 32 + 8 * fq;
#pragma unroll
        for (int ai = 0; ai < 2; ++ai)
#pragma unroll
            for (int m = 0; m < 4; ++m) { const int row = row0 + ai * HALF + m * 16; float sq = 0.f;
#pragma unroll
                for (int bj = 0; bj < 2; ++bj) { const size_t p = (size_t)row * 2048 + col0 + bj * HALF;
                    const f32x4 a = *(const f32x4*)(xin + p) + acc[ai][bj][m][0], b = *(const f32x4*)(xin + p + 4) + acc[ai][bj][m][1];
                    *(f32x4*)(out + p) = a; *(f32x4*)(out + p + 4) = b;
                    if (xb) { u32x4 w; w.x = cvt_pk_bf16(a[0], a[1]); w.y = cvt_pk_bf16(a[2], a[3]); w.z = cvt_pk_bf16(b[0], b[1]); w.w = cvt_pk_bf16(b[2], b[3]); *(u32x4*)(xb + p) = w; }
                    sq += (a[0] * a[0] + a[1] * a[1]) + (a[2] * a[2] + a[3] * a[3]) + (b[0] * b[0] + b[1] * b[1]) + (b[2] * b[2] + b[3] * b[3]); }
                sq += __shfl_xor(sq, 16); sq += __shfl_xor(sq, 32);
                if (fq == 0 && ssn) atomicAdd(ssn + row, (unsigned long long)(sq * 1048576.0f + 0.5f)); }
    }
};
template <class Epi, class Sched, bool ALIGN_EPI = false, bool SP2 = false>
__device__ __forceinline__ void gemm_phase(PG8_LAS unsigned char* lds, const Gemm g, const Sched& S, const Epi& E) {
    int tid_ = threadIdx.x; asm volatile("" : "+v"(tid_)); const int tid = tid_, wid = __builtin_amdgcn_readfirstlane(tid >> 6), lane = tid & 63, wr = wid >> 2, wc = wid & 3, fr = lane & 15, fq = lane >> 4;
    const int K = g.K, nt = K / BK;
    unsigned voffA[2], voffB[2];
#pragma unroll
    for (int i = 0; i < 2; ++i) { int R, C; stage_rc(tid * 16 + i * 8192, R, C); const int Rb = Epi::PERM ? ((R & ~31) + perm32(R & 31)) : R;
        voffA[i] = (unsigned)(R * K + C) * 2u; voffB[i] = (unsigned)(Rb * K + C) * 2u; }
    const size_t kstep = (size_t)(BK * 2);
    const size_t hstep = (size_t)HALF * K * 2;
    const size_t tstep = 2 * hstep;
    const unsigned ldsw = (unsigned)wid * 1024u;
    const int aoff = lds_byte(wr * 64 + fr, fq * 8), boff = lds_byte(wc * 32 + fr, fq * 8);
#define PG8_SA(b, h) (((b) * 2 + (h)) * HTB)
#define PG8_SB(b, h) ((4 + (b) * 2 + (h)) * HTB)
#define PG8_STAGE(bufoff, gbase, voff) do { _Pragma("unroll") for (int _i = 0; _i < 2; ++_i) \
        __builtin_amdgcn_global_load_lds((const unsigned*)((const char*)(gbase) + (voff)[_i]), (PG8_LAS unsigned*)(lds + (bufoff) + ldsw + _i * 8192), 16, 0, 0); } while (0)
#define PG8_LDA(dst, b, h) do { _Pragma("unroll") for (int m = 0; m < 4; ++m) _Pragma("unroll") for (int k = 0; k < 2; ++k) dst[m][k] = *(const PG8_LAS bf16x8*)(lds + PG8_SA(b, h) + aoff + m * 2048 + k * 1024); } while (0)
#define PG8_LDB(dst, b, h) do { _Pragma("unroll") for (int n = 0; n < 2; ++n) _Pragma("unroll") for (int k = 0; k < 2; ++k) dst[n][k] = *(const PG8_LAS bf16x8*)(lds + PG8_SB(b, h) + boff + n * 2048 + k * 1024); } while (0)
#define PG8_MMA(ai, bj, At, Bt) do { __builtin_amdgcn_s_setprio(1); _Pragma("unroll") for (int m = 0; m < 4; ++m) _Pragma("unroll") for (int n = 0; n < 2; ++n) _Pragma("unroll") for (int k = 0; k < 2; ++k) \
        acc[ai][bj][m][n] = __builtin_amdgcn_mfma_f32_16x16x32_bf16(Bt[n][k], At[m][k], acc[ai][bj][m][n], 0, 0, 0); __builtin_amdgcn_s_setprio(0); } while (0)
#define PG8_WAIT_V(n) asm volatile("s_waitcnt vmcnt(" #n ")" ::: "memory")
#define PG8_WAIT_L(n) asm volatile("s_waitcnt lgkmcnt(" #n ")" ::: "memory")
#define PG8_BAR __builtin_amdgcn_s_barrier()
#define PG8_SCHED __builtin_amdgcn_sched_barrier(0)
    Unit cur, nxt; int ui = 0;
    if (!S.next(0, cur)) return;
    f32x4 acc[2][2][4][2];
#pragma unroll
    for (int a = 0; a < 2; ++a)
#pragma unroll
        for (int b = 0; b < 2; ++b)
#pragma unroll
            for (int m = 0; m < 4; ++m)
#pragma unroll
                for (int n = 0; n < 2; ++n) acc[a][b][m][n] = (f32x4){0.f, 0.f, 0.f, 0.f};
    bf16x8 At[4][2], B0[2][2], B1[2][2];
    const char* cA = (const char*)g.A + (size_t)cur.pm * tstep; const char* cB = (const char*)g.Bt + (size_t)cur.pn * tstep;
    S.a_ready(cur);
    if constexpr (SP2) {
        PG8_STAGE(PG8_SB(0, 0), cB, voffB); PG8_STAGE(PG8_SB(0, 1), cB + hstep, voffB); PG8_STAGE(PG8_SA(0, 0), cA, voffA); PG8_STAGE(PG8_SA(0, 1), cA + hstep, voffA);
        if (wr == 1) PG8_BAR;
        PG8_WAIT_V(2); PG8_BAR;
        PG8_STAGE(PG8_SB(1, 0), cB + kstep, voffB); PG8_STAGE(PG8_SA(1, 0), cA + kstep, voffA); PG8_STAGE(PG8_SB(1, 1), cB + hstep + kstep, voffB);
        PG8_WAIT_V(6); PG8_BAR;
    } else {
        PG8_STAGE(PG8_SB(0, 0), cB, voffB); PG8_STAGE(PG8_SA(0, 0), cA, voffA); PG8_STAGE(PG8_SB(0, 1), cB + hstep, voffB); PG8_STAGE(PG8_SA(0, 1), cA + hstep, voffA);
        if (wr == 1) PG8_BAR;
        PG8_WAIT_V(4); PG8_BAR;
        PG8_STAGE(PG8_SB(1, 0), cB + kstep, voffB); PG8_STAGE(PG8_SA(1, 0), cA + kstep, voffA); PG8_STAGE(PG8_SB(1, 1), cB + hstep + kstep, voffB);
        PG8_WAIT_V(6); PG8_BAR;
    }
    for (;;) {
        const bool has_next = S.next(ui + 1, nxt);
        const char* nA = has_next ? (const char*)g.A + (size_t)nxt.pm * tstep : cA; const char* nB = has_next ? (const char*)g.Bt + (size_t)nxt.pn * tstep : cB;
        for (int t = 0; t < nt; t += 2) {
            const bool last = (t == nt - 2);
            const char* a1 = cA + (size_t)(t + 1) * kstep;
            const char* a2 = last ? nA : cA + (size_t)(t + 2) * kstep; const char* b2 = last ? nB : cB + (size_t)(t + 2) * kstep;
            const char* a3 = a2 + kstep; const char* b3 = b2 + kstep;
            if (last && has_next) S.a_ready(nxt);
            if constexpr (SP2) {
            PG8_LDB(B0, 0, 0); PG8_LDB(B1, 0, 1); PG8_SCHED; PG8_LDA(At, 0, 0); PG8_STAGE(PG8_SA(1, 1), a1 + hstep, voffA);
            PG8_WAIT_V(8); PG8_WAIT_L(0); PG8_BAR; PG8_MMA(0, 0, At, B0); PG8_MMA(0, 1, At, B1); PG8_BAR; PG8_SCHED;
            PG8_LDA(At, 0, 1); PG8_STAGE(PG8_SB(0, 0), b2, voffB); PG8_STAGE(PG8_SB(0, 1), b2 + hstep, voffB); PG8_STAGE(PG8_SA(0, 0), a2, voffA);
            PG8_WAIT_V(8); PG8_WAIT_L(0); PG8_BAR; PG8_MMA(1, 0, At, B0); PG8_MMA(1, 1, At, B1); PG8_BAR; PG8_SCHED;
            PG8_LDB(B0, 1, 0); PG8_LDB(B1, 1, 1); PG8_SCHED; PG8_LDA(At, 1, 0); PG8_STAGE(PG8_SA(0, 1), a2 + hstep, voffA);
            PG8_WAIT_V(8); PG8_WAIT_L(0); PG8_BAR; PG8_MMA(0, 0, At, B0); PG8_MMA(0, 1, At, B1); PG8_BAR; PG8_SCHED;
            PG8_LDA(At, 1, 1); PG8_STAGE(PG8_SB(1, 0), b3, voffB); PG8_STAGE(PG8_SB(1, 1), b3 + hstep, voffB); PG8_STAGE(PG8_SA(1, 0), a3, voffA);
            PG8_WAIT_V(8); PG8_WAIT_L(0); PG8_BAR; PG8_MMA(1, 0, At, B0); PG8_MMA(1, 1, At, B1); PG8_BAR; PG8_SCHED;
            } else {
            PG8_LDB(B0, 0, 0); PG8_SCHED; PG8_LDA(At, 0, 0); PG8_STAGE(PG8_SA(1, 1), a1 + hstep, voffA);
            PG8_WAIT_L(8); PG8_BAR; PG8_WAIT_L(0); PG8_MMA(0, 0, At, B0); PG8_BAR; PG8_SCHED;
            PG8_LDB(B1, 0, 1); PG8_STAGE(PG8_SB(0, 0), b2, voffB);
            PG8_BAR; PG8_WAIT_L(0); PG8_MMA(0, 1, At, B1); PG8_BAR;
            PG8_LDA(At, 0, 1); PG8_STAGE(PG8_SA(0, 0), a2, voffA);
            PG8_BAR; PG8_WAIT_L(0); PG8_MMA(1, 0, At, B0); PG8_BAR; PG8_SCHED;
            PG8_STAGE(PG8_SB(0, 1), b2 + hstep, voffB);
            PG8_WAIT_V(6); PG8_BAR; PG8_MMA(1, 1, At, B1); PG8_BAR;
            PG8_LDB(B0, 1, 0); PG8_SCHED; PG8_LDA(At, 1, 0); PG8_STAGE(PG8_SA(0, 1), a2 + hstep, voffA);
            PG8_WAIT_L(8); PG8_BAR; PG8_WAIT_L(0); PG8_MMA(0, 0, At, B0); PG8_BAR; PG8_SCHED;
            PG8_LDB(B1, 1, 1); PG8_STAGE(PG8_SB(1, 0), b3, voffB);
            PG8_BAR; PG8_WAIT_L(0); PG8_MMA(0, 1, At, B1); PG8_BAR;
            PG8_LDA(At, 1, 1); PG8_STAGE(PG8_SA(1, 0), a3, voffA);
            PG8_BAR; PG8_WAIT_L(0); PG8_MMA(1, 0, At, B0); PG8_BAR; PG8_SCHED;
            PG8_STAGE(PG8_SB(1, 1), b3 + hstep, voffB);
            PG8_WAIT_V(6); PG8_BAR; PG8_MMA(1, 1, At, B1); PG8_BAR;
            }
        }
        if constexpr (ALIGN_EPI) { if (wr == 0) PG8_BAR; }
        if constexpr (!Epi::AFTER_DRAIN) { E(acc, cur, wr, wc, fr, fq); S.done(cur); }
        if (!has_next) break;
#pragma unroll
        for (int a = 0; a < 2; ++a)
#pragma unroll
            for (int b = 0; b < 2; ++b)
#pragma unroll
                for (int m = 0; m < 4; ++m)
#pragma unroll
                    for (int n = 0; n < 2; ++n) acc[a][b][m][n] = (f32x4){0.f, 0.f, 0.f, 0.f};
        cur = nxt; cA = nA; cB = nB; ++ui;
        if constexpr (ALIGN_EPI) { if (wr == 1) PG8_BAR; }
    }
    PG8_WAIT_V(0);
    if constexpr (!ALIGN_EPI) { if (wr == 0) PG8_BAR; }
    PG8_BAR;
    if constexpr (Epi::AFTER_DRAIN) { E.fused(acc, cur, wr, wc, fr, fq, lds, wid, lane); S.done(cur); }
#undef PG8_SA
#undef PG8_SB
#undef PG8_STAGE
#undef PG8_LDA
#undef PG8_LDB
#undef PG8_MMA
#undef PG8_WAIT_V
#undef PG8_WAIT_L
#undef PG8_BAR
#undef PG8_SCHED
}
}
constexpr int SEQ = 8192, DM = 2048, NLAYER = 4, INW = 7448, NPAD = 7680, PW = pg8::PROJ_W;
constexpr int C_AQ = 0, C_AK = 768, C_AV = 1536, C_AZ = 2304, C_BQ = 3072, C_BK = 3584, C_BV = 4096, C_BZ = 4608, C_CQ = 5120, C_CK = 5504, C_CV = 5888, C_CZ = 6656;
constexpr float LOG2E = 1.4426950408889634f, QSCALE = 0.125f * 1.4426950408889634f, EPS = 1e-6f;
constexpr size_t MiB = 1u << 20;
constexpr size_t WS_CTL = 0, WS_SS = 1 * MiB, WS_WTIN = 2 * MiB, WS_WTOUT = 122 * MiB, WS_XB = 154 * MiB, WS_PROJ = 186 * MiB, WS_SMALL = 302 * MiB,
                 WS_MIXED = 304 * MiB, WS_OA = 336 * MiB, WS_LA = 372 * MiB, WS_OB = 374 * MiB, WS_LB = 438 * MiB, WS_CL = 439 * MiB, WS_BT = WS_CL + 512 * 1024,
                 WS_DS = 440 * MiB, WS_ST = 476 * MiB, WS_DEC = 494 * MiB, WS_END = 496 * MiB;
constexpr int RING_BYTES = 131072, LDS_BYTES = 147456, QSLOT_OFF = RING_BYTES + 64, MISC_OFF = RING_BYTES + 256;
constexpr int N_SCAN = 72, N_FOX = 640, N_AU = 1152, N_ITEMS = N_SCAN + N_FOX + N_AU;

typedef unsigned short bf16;
typedef short bf16x8 __attribute__((ext_vector_type(8)));
typedef short s16x4 __attribute__((ext_vector_type(4)));
typedef float f32x4 __attribute__((ext_vector_type(4)));
typedef float f32x2 __attribute__((ext_vector_type(2)));
typedef float f32x16 __attribute__((ext_vector_type(16)));
typedef unsigned u32x4 __attribute__((ext_vector_type(4)));
typedef unsigned u32x2 __attribute__((ext_vector_type(2)));
typedef __attribute__((address_space(3))) const char* lds_cptr;
#define LAS3 __attribute__((address_space(3)))

__device__ __forceinline__ float bf2f(unsigned b) { return __uint_as_float(b << 16); }
__device__ __forceinline__ unsigned pk2(float lo, float hi) { return pg8::cvt_pk_bf16(lo, hi); }
__device__ __forceinline__ float blo(unsigned w) { return __uint_as_float(w << 16); }
__device__ __forceinline__ float bhi(unsigned w) { return __uint_as_float(w & 0xffff0000u); }
__device__ __forceinline__ float logsig(float x) { return fminf(x, 0.f) - log1pf(expf(-fabsf(x))); }
__device__ __forceinline__ float silu(float x) { return x / (1.f + __expf(-x)); }
__device__ __forceinline__ s16x4 vtr(lds_cptr p) { return __builtin_bit_cast(s16x4, __builtin_amdgcn_ds_read_tr16_b64_v4i16((LAS3 s16x4*)p)); }
__device__ __forceinline__ bf16x8 frag_tr(lds_cptr img, int stride, int kbase, int m0, int lane) {
    const int i = lane & 15, g = lane >> 4;
    lds_cptr p = img + (kbase + 4 * (g >> 1) + (i >> 2)) * stride + (m0 + 16 * (g & 1) + 4 * (i & 3)) * 2;
    const s16x4 a = vtr(p), b = vtr(p + 8 * stride);
    return (bf16x8){a[0], a[1], a[2], a[3], b[0], b[1], b[2], b[3]};
}
__device__ __forceinline__ int rowidx(int reg, int hh) { return (reg & 3) + 8 * (reg >> 2) + 4 * hh; }
__device__ __forceinline__ void pack_p(const f32x16& p, bf16x8& f0, bf16x8& f1) {
    u32x4 a, b; a.x = pk2(p[0], p[1]); a.y = pk2(p[2], p[3]); a.z = pk2(p[4], p[5]); a.w = pk2(p[6], p[7]);
    b.x = pk2(p[8], p[9]); b.y = pk2(p[10], p[11]); b.z = pk2(p[12], p[13]); b.w = pk2(p[14], p[15]);
    f0 = __builtin_bit_cast(bf16x8, a); f1 = __builtin_bit_cast(bf16x8, b);
}
#define MFMA32(a, b, c) __builtin_amdgcn_mfma_f32_32x32x16_bf16((a), (b), (c), 0, 0, 0)

struct Ctx {
    const float *x, *norm_g, *w_in, *aqg, *akg, *bqg, *bkg, *fox_bias, *gate_up, *gate_bias, *out_gain, *w_out;
    float* out; unsigned char* ws;
    unsigned* ctl; unsigned long long* ss; bf16* wtin; bf16* wtout; bf16* xb; bf16* proj; float* small; bf16* mixed; bf16* oa; float* la; float* ob; float* lb; float* cl; float* bt;
    float* ds; bf16* st; float* dec;
    unsigned char* lds; int tid, lane, wave, G, bid;
};

__device__ __forceinline__ int orig_col(int np) { if (np < 5120) return np; if (np < 7424) return np + 8; if (np < 7432) return 5120 + (np - 7424); if (np < 7448) return np; return -1; }
__device__ __forceinline__ void p0_item(const float* W, int N, bf16* WT, const float* g, int mode, float* scr, int kb, int nb, int lane) {
    const int k0 = 64 * kb, n0 = 32 * nb, np = n0 + (lane & 31);
    const int oc = mode ? orig_col(np) : np;
    const float cs = (mode && np >= C_CQ && np < C_CK) ? 0.10206207261596577f : 1.0f;
#pragma unroll 8
    for (int i = 0; i < 32; ++i) { const int kk = 2 * i + (lane >> 5); float v = 0.f;
        if (oc >= 0) { v = W[(size_t)(k0 + kk) * N + oc] * cs; if (mode) v *= g[k0 + kk]; }
        scr[kk * 33 + (lane & 31)] = v; }
    __builtin_amdgcn_s_waitcnt(0); asm volatile("" ::: "memory");
    const int c = lane & 7;
#pragma unroll
    for (int j = 0; j < 4; ++j) { const int n = (lane >> 3) + 8 * j; const float* s = scr + (8 * c) * 33 + n;
        u32x4 o; o.x = pk2(s[0 * 33], s[1 * 33]); o.y = pk2(s[2 * 33], s[3 * 33]); o.z = pk2(s[4 * 33], s[5 * 33]); o.w = pk2(s[6 * 33], s[7 * 33]);
        *(u32x4*)(WT + (size_t)(n0 + n) * 2048 + k0 + 8 * c) = o; }
    __builtin_amdgcn_s_waitcnt(0); asm volatile("" ::: "memory");
}
__device__ __forceinline__ void phase0(Ctx& F) {
    float* scr = (float*)(F.lds + F.wave * 16384);
    const int gw = F.bid * 8 + F.wave, NGW = F.G * 8;
    if (F.bid == 0 && F.tid < 64) F.ctl[F.tid] = 0u;
    for (int i = F.bid * 512 + F.tid; i < 3 * SEQ; i += F.G * 512) F.ss[SEQ + i] = 0ull;
    constexpr int I_IN = 32 * 233, I_OUT = 32 * 64, I_L = I_IN + I_OUT;
    for (int it = gw; it < NLAYER * I_L; it += NGW) {
        const int l = it / I_L; int r = it % I_L;
        if (r < I_IN) p0_item(F.w_in + (size_t)l * DM * INW, INW, F.wtin + (size_t)l * NPAD * DM, F.norm_g + l * DM, 1, scr, r / 233, r % 233, F.lane);
        else { r -= I_IN; p0_item(F.w_out + (size_t)l * DM * DM, DM, F.wtout + (size_t)l * DM * DM, nullptr, 0, scr, r / 64, r % 64, F.lane); }
    }
    for (int m = gw; m < SEQ; m += NGW) {
        const f32x4* xr = (const f32x4*)(F.x + (size_t)m * DM) + F.lane; float s = 0.f; u32x2* o8 = (u32x2*)(F.xb + (size_t)m * DM) + F.lane;
#pragma unroll
        for (int j = 0; j < 8; ++j) { const f32x4 v = xr[64 * j]; s += (v.x * v.x + v.y * v.y) + (v.z * v.z + v.w * v.w); u32x2 w; w.x = pk2(v.x, v.y); w.y = pk2(v.z, v.w); o8[64 * j] = w; }
#pragma unroll
        for (int o = 1; o < 64; o <<= 1) s += __shfl_xor(s, o);
        if (F.lane == 0) F.ss[m] = (unsigned long long)(s * 1048576.0f + 0.5f);
    }
}

__device__ __forceinline__ void phase2(Ctx& F, int l) {
    { const int NT = F.G * 512; const int total = SEQ * 320;
      for (int base = 0; base < total; base += NT) { const int idx0 = base + F.bid * 512 + F.tid; const bool ok = idx0 < total; const int idx = ok ? idx0 : 0;
        const int row = idx / 320, c = idx % 320; int col; const float* g; float sc = 1.f;
        if (c < 192) { col = c * 8; if (col < 768) { g = F.aqg + l * 64; sc = QSCALE; } else g = F.akg + l * 64; }
        else { col = 3072 + (c - 192) * 8; if (col < C_BK) { g = F.bqg + l * 64; sc = QSCALE; } else g = F.bkg + l * 64; }
        bf16* p = F.proj + (size_t)row * PW + col; const u32x4 w = *(const u32x4*)p;
        float v[8] = {blo(w.x), bhi(w.x), blo(w.y), bhi(w.y), blo(w.z), bhi(w.z), blo(w.w), bhi(w.w)};
        float s = 0.f;
#pragma unroll
        for (int j = 0; j < 8; ++j) s += v[j] * v[j];
        s += __shfl_xor(s, 1); s += __shfl_xor(s, 2); s += __shfl_xor(s, 4);
        const float rs = rsqrtf(s * (1.f / 64.f) + EPS) * sc; const float* gg = g + (col & 63);
        const f32x4 g0 = *(const f32x4*)gg, g1 = *(const f32x4*)(gg + 4);
        u32x4 o; o.x = pk2(v[0] * rs * g0.x, v[1] * rs * g0.y); o.y = pk2(v[2] * rs * g0.z, v[3] * rs * g0.w); o.z = pk2(v[4] * rs * g1.x, v[5] * rs * g1.y); o.w = pk2(v[6] * rs * g1.z, v[7] * rs * g1.w);
        if (ok) *(u32x4*)p = o; } }
    { const int gw = F.bid * 8 + F.wave, NGW = F.G * 8;
      for (int wi = gw; wi < 512; wi += NGW) { const int blk = wi >> 3, h = wi & 7, t = blk * 128 + 2 * F.lane; const float fb = F.fox_bias[l * 8 + h];
        const float l0 = logsig(F.small[(size_t)t * 32 + h] + fb), l1 = logsig(F.small[(size_t)(t + 1) * 32 + h] + fb);
        float s = l0 + l1;
#pragma unroll
        for (int o = 1; o < 64; o <<= 1) { const float y = __shfl_up(s, o); if (F.lane >= o) s += y; }
        const float ex = s - (l0 + l1); F.cl[t * 8 + h] = ex + l0; F.cl[(t + 1) * 8 + h] = s; if (F.lane == 63) F.bt[blk * 8 + h] = s; } }
    { float* LA = (float*)F.lds;
      unsigned char* KH = F.lds + 24576;
      unsigned char* VV = F.lds + 24576 + 13312;
      const float* gup = F.gate_up + (size_t)l * 16 * 384; const float* gbs = F.gate_bias + l * 384;
      for (int u = F.bid; u < 512; u += F.G) { const int h = u & 3, n = u >> 2, t0 = n * 64;
        for (int e = F.tid; e < 6144; e += 512) { const int t = e / 96, d = e % 96; float a = gbs[h * 96 + d]; const float* cr = F.small + (size_t)(t0 + t) * 32 + 8;
#pragma unroll
            for (int r = 0; r < 16; ++r) a += cr[r] * gup[r * 384 + h * 96 + d];
            LA[e] = logsig(a) * (1.f / 16.f); }
        for (int e = F.tid; e < 1536; e += 512) { const int row = e / 24, ch = e % 24;
            *(u32x4*)(VV + row * 400 + ch * 16) = *(const u32x4*)(F.proj + (size_t)(t0 + row) * PW + C_CV + h * 192 + ch * 8); }
        __syncthreads();
        if (F.tid < 96) { float run = 0.f;
#pragma unroll 8
            for (int t = 0; t < 64; ++t) { run += LA[t * 96 + F.tid]; LA[t * 96 + F.tid] = run; } }
        __syncthreads();
        for (int e = F.tid; e < 768; e += 512) { const int t = e / 12, d0 = (e % 12) * 8;
            bf16* qp = F.proj + (size_t)(t0 + t) * PW + C_CQ + h * 96 + d0; bf16* kp = F.proj + (size_t)(t0 + t) * PW + C_CK + h * 96 + d0;
            const u32x4 qw = *(const u32x4*)qp, kw = *(const u32x4*)kp;
            float q[8] = {blo(qw.x), bhi(qw.x), blo(qw.y), bhi(qw.y), blo(qw.z), bhi(qw.z), blo(qw.w), bhi(qw.w)};
            float k[8] = {blo(kw.x), bhi(kw.x), blo(kw.y), bhi(kw.y), blo(kw.z), bhi(kw.z), blo(kw.w), bhi(kw.w)};
            float qt[8], kt[8], kh[8];
#pragma unroll
            for (int j = 0; j < 8; ++j) { const float bc = LA[t * 96 + d0 + j], bm = LA[31 * 96 + d0 + j], bl = LA[63 * 96 + d0 + j];
                qt[j] = q[j] * __expf(bc - bm); kt[j] = k[j] * __expf(bm - bc); kh[j] = k[j] * __expf(bl - bc); }
            u32x4 o; o.x = pk2(qt[0], qt[1]); o.y = pk2(qt[2], qt[3]); o.z = pk2(qt[4], qt[5]); o.w = pk2(qt[6], qt[7]); *(u32x4*)qp = o;
            o.x = pk2(kt[0], kt[1]); o.y = pk2(kt[2], kt[3]); o.z = pk2(kt[4], kt[5]); o.w = pk2(kt[6], kt[7]); *(u32x4*)kp = o;
            o.x = pk2(kh[0], kh[1]); o.y = pk2(kh[2], kh[3]); o.z = pk2(kh[4], kh[5]); o.w = pk2(kh[6], kh[7]); *(u32x4*)(KH + t * 208 + d0 * 2) = o; }
        if (F.tid < 96) { F.dec[(n * 4 + h) * 96 + F.tid] = __expf(LA[63 * 96 + F.tid]); F.dec[49152 + (n * 4 + h) * 96 + F.tid] = __expf(LA[31 * 96 + F.tid]); }
        __syncthreads();
        for (int id = F.wave; id < 18; id += 8) { const int vt = id / 3, dt = id % 3; f32x16 acc = {};
#pragma unroll
            for (int s = 0; s < 4; ++s) { const bf16x8 a = frag_tr((lds_cptr)VV, 400, 16 * s, 32 * vt, F.lane), b = frag_tr((lds_cptr)KH, 208, 16 * s, 32 * dt, F.lane); acc = MFMA32(a, b, acc); }
            float* dst = F.ds + ((size_t)(n * 4 + h) * 192 + 32 * vt) * 96 + 32 * dt + (F.lane & 31);
#pragma unroll
            for (int r = 0; r < 16; ++r) dst[(size_t)rowidx(r, F.lane >> 5) * 96] = acc[r]; }
        __syncthreads(); } }
}
__device__ __forceinline__ float softmax_ref2(const float* gq, const float* gk) {
    float mq = 0.f, mk = 0.f;
    for (int i = 0; i < 64; ++i) { mq = fmaxf(mq, fabsf(gq[i])); mk = fmaxf(mk, fabsf(gk[i])); }
    return 8.25f * mq * mk * LOG2E;
}
__device__ __forceinline__ void scan_item(Ctx& F, int si) {
    const int p = si * 512 + F.tid, d = 2 * (p % 48), v = (p / 48) % 192, h = p / (48 * 192);
    float s0 = 0.f, s1 = 0.f;
#pragma unroll 8
    for (int n = 0; n < 128; ++n) { const size_t idx = ((size_t)(n * 4 + h) * 192 + v) * 96 + d; const int di = (n * 4 + h) * 96 + d;
        const f32x2 dd = *(const f32x2*)(F.ds + idx), a = *(const f32x2*)(F.dec + di), em = *(const f32x2*)(F.dec + 49152 + di);
        *(unsigned*)(F.st + idx) = pk2(em.x * s0, em.y * s1);
        s0 = a.x * s0 + dd.x; s1 = a.y * s1 + dd.y; }
}
template <int KSTR>
__device__ __forceinline__ void attn_sub(const unsigned char* Kt, const unsigned char* Vt, int key_row0, const bf16x8 (&qf)[4], f32x16 S, f32x16 (&o)[2], float& lsum, int lane,
                                         bool use_mask, int lo, int hi_) {
    const int r = lane & 31, hh = lane >> 5;
#pragma unroll
    for (int s = 0; s < 4; ++s) { const bf16x8 kf = *(const bf16x8*)(Kt + (key_row0 + r) * KSTR + (16 * s + 8 * hh) * 2); S = MFMA32(kf, qf[s], S); }
    if (use_mask) {
#pragma unroll
        for (int g = 0; g < 16; ++g) { const int k = rowidx(g, hh); if (k < lo || k > hi_) S[g] = -INFINITY; } }
    float acc = 0.f;
#pragma unroll
    for (int g = 0; g < 16; ++g) { S[g] = __builtin_amdgcn_exp2f(S[g]); acc += S[g]; }
    lsum += acc;
    bf16x8 p0, p1; pack_p(S, p0, p1);
#pragma unroll
    for (int dt = 0; dt < 2; ++dt) {
        const bf16x8 v0 = frag_tr((lds_cptr)Vt, KSTR, key_row0, 32 * dt, lane), v1 = frag_tr((lds_cptr)Vt, KSTR, key_row0 + 16, 32 * dt, lane);
        o[dt] = MFMA32(v0, p0, o[dt]); o[dt] = MFMA32(v1, p1, o[dt]); }
}
__device__ __forceinline__ void fox_unit(Ctx& F, int l, int h, int qb, int seg) {
    constexpr int KS = 144;
    unsigned char* KT = F.lds; unsigned char* VT = F.lds + 18432; float* CS = (float*)(F.lds + 36864); float* PEX = (float*)(F.lds + 37376);
    const int r = F.lane & 31, hh = F.lane >> 5, w = F.wave, t0 = 256 * qb, NT = 4 * qb + 4, ts = 32 * seg, te = (ts + 32 < NT) ? ts + 32 : NT;
    if (w == 0) { const float v = F.bt[F.lane * 8 + h]; float s = v;
#pragma unroll
        for (int o = 1; o < 64; o <<= 1) { const float y = __shfl_up(s, o); if (F.lane >= o) s += y; }
        PEX[F.lane] = s - v; }
    const float mb2 = softmax_ref2(F.bqg + l * 64, F.bkg + l * 64);
    __syncthreads();
    const int tq = t0 + 32 * w + r; const float pq0 = PEX[t0 >> 7];
    const float ctq = ((PEX[tq >> 7] - pq0) + F.cl[tq * 8 + h]) * LOG2E - mb2;
    bf16x8 qf[4];
#pragma unroll
    for (int s = 0; s < 4; ++s) qf[s] = *(const bf16x8*)(F.proj + (size_t)tq * PW + C_BQ + h * 64 + 16 * s + 8 * hh);
    f32x16 o[2]; o[0] = f32x16{}; o[1] = f32x16{}; float lsum = 0.f;
    const int lrow = F.tid >> 3, lch = F.tid & 7;
    u32x4 kreg, vreg; float creg = 0.f;
    { const size_t g = (size_t)(64 * ts + lrow) * PW + h * 64 + lch * 8; kreg = *(const u32x4*)(F.proj + g + C_BK); vreg = *(const u32x4*)(F.proj + g + C_BV);
      if (F.tid < 64) creg = ((PEX[ts >> 1] - pq0) + F.cl[(64 * ts + F.tid) * 8 + h]) * LOG2E; }
    for (int kt = ts; kt < te; ++kt) { const int buf = (kt - ts) & 1;
        *(u32x4*)(KT + buf * 9216 + lrow * KS + lch * 16) = kreg; *(u32x4*)(VT + buf * 9216 + lrow * KS + lch * 16) = vreg; if (F.tid < 64) CS[buf * 64 + F.tid] = creg;
        __syncthreads();
        if (kt + 1 < te) { const size_t g = (size_t)(64 * (kt + 1) + lrow) * PW + h * 64 + lch * 8; kreg = *(const u32x4*)(F.proj + g + C_BK); vreg = *(const u32x4*)(F.proj + g + C_BV);
            if (F.tid < 64) creg = ((PEX[(kt + 1) >> 1] - pq0) + F.cl[(64 * (kt + 1) + F.tid) * 8 + h]) * LOG2E; }
        const int qlo = t0 + 32 * w;
#pragma unroll
        for (int sub = 0; sub < 2; ++sub) { const int key0 = 64 * kt + 32 * sub;
            if (key0 <= qlo + 31) {
                f32x16 S;
#pragma unroll
                for (int i = 0; i < 4; ++i) { const f32x4 c4 = *(const f32x4*)(CS + buf * 64 + 32 * sub + 8 * i + 4 * hh); S[4 * i] = ctq - c4.x; S[4 * i + 1] = ctq - c4.y; S[4 * i + 2] = ctq - c4.z; S[4 * i + 3] = ctq - c4.w; }
                attn_sub<KS>(KT + buf * 9216, VT + buf * 9216, 32 * sub, qf, S, o, lsum, F.lane, key0 + 31 > qlo, 0, tq - key0); } }
    }
    lsum += __shfl_xor(lsum, 32);
    float* ob = F.ob + ((size_t)seg * SEQ + tq) * 512 + h * 64 + 4 * hh;
#pragma unroll
    for (int dt = 0; dt < 2; ++dt)
#pragma unroll
        for (int i = 0; i < 4; ++i) *(f32x4*)(ob + 32 * dt + 8 * i) = (f32x4){o[dt][4 * i], o[dt][4 * i + 1], o[dt][4 * i + 2], o[dt][4 * i + 3]};
    if (hh == 0) F.lb[((size_t)seg * SEQ + tq) * 8 + h] = lsum;
    __syncthreads();
}
__device__ __forceinline__ void a_unit(Ctx& F, int l, int a, int n, int rres, int b2) {
    constexpr int KS = 144;
    unsigned char* KA = F.lds; unsigned char* VA = F.lds + 384 * KS;
    const int r = F.lane & 31, hh = F.lane >> 5, w = F.wave, d = (n == 0) ? 1 : (n == 1) ? 4 : 16, i0 = 256 * b2;
    for (int e = F.tid; e < 3072; e += 512) { const int j = e >> 3, ch = e & 7, idx = i0 - 128 + j; u32x4 kv = {0u, 0u, 0u, 0u}, vv = {0u, 0u, 0u, 0u};
        if (idx >= 0) { const size_t g = (size_t)(rres + d * idx) * PW + a * 64 + ch * 8; kv = *(const u32x4*)(F.proj + g + C_AK); vv = *(const u32x4*)(F.proj + g + C_AV); }
        *(u32x4*)(KA + j * KS + ch * 16) = kv; *(u32x4*)(VA + j * KS + ch * 16) = vv; }
    const int tokq = rres + d * (i0 + 32 * w + r);
    bf16x8 qf[4];
#pragma unroll
    for (int s = 0; s < 4; ++s) qf[s] = *(const bf16x8*)(F.proj + (size_t)tokq * PW + C_AQ + a * 64 + 16 * s + 8 * hh);
    const float mb2 = softmax_ref2(F.aqg + l * 64, F.akg + l * 64);
    __syncthreads();
    f32x16 o[2]; o[0] = f32x16{}; o[1] = f32x16{}; float lsum = 0.f;
    const int qj = 32 * w + r + 128;
    for (int jt = w; jt < w + 5; ++jt) { const int j0 = 32 * jt;
        if (i0 == 0 && j0 + 31 < 128) continue;
        f32x16 S;
#pragma unroll
        for (int g = 0; g < 16; ++g) S[g] = -mb2;
        int lo = qj - 128 - j0; const int hi_ = qj - j0; if (i0 == 0 && 128 - j0 > lo) lo = 128 - j0;
        attn_sub<KS>(KA, VA, j0, qf, S, o, lsum, F.lane, (jt == w) || (jt == w + 4) || (i0 == 0 && j0 < 128), lo, hi_); }
    lsum += __shfl_xor(lsum, 32);
    bf16* oa = F.oa + ((size_t)n * SEQ + tokq) * 768 + a * 64 + 4 * hh;
#pragma unroll
    for (int dt = 0; dt < 2; ++dt)
#pragma unroll
        for (int i = 0; i < 4; ++i) { u32x2 wv; wv.x = pk2(o[dt][4 * i], o[dt][4 * i + 1]); wv.y = pk2(o[dt][4 * i + 2], o[dt][4 * i + 3]); *(u32x2*)(oa + 32 * dt + 8 * i) = wv; }
    if (hh == 0) F.la[((size_t)n * SEQ + tokq) * 12 + a] = lsum;
    __syncthreads();
}
__device__ __forceinline__ void phase3(Ctx& F, int l) {
    volatile unsigned* slot = (volatile unsigned*)(F.lds + QSLOT_OFF);
    for (;;) {
        if (F.tid == 0) *slot = atomicAdd(F.ctl + l, 1u);
        __syncthreads();
        const int item = (int)*slot;
        __syncthreads();
        if (item >= N_ITEMS) break;
        if (item < N_SCAN) scan_item(F, item);
        else if (item < N_SCAN + N_FOX) { int f = item - N_SCAN, ns, qhi;
            if (f < 256) { ns = 4; qhi = 31; } else if (f < 448) { f -= 256; ns = 3; qhi = 23; } else if (f < 576) { f -= 448; ns = 2; qhi = 15; } else { f -= 576; ns = 1; qhi = 7; }
            const int per = ns * 8, qb = qhi - f / per, rem = f % per;
            fox_unit(F, l, rem & 7, qb, rem >> 3); }
        else { const int au = item - N_SCAN - N_FOX, n = au / 384, rest = au % 384, a = rest >> 5, u = rest & 31;
            const int per = (n == 0) ? 32 : (n == 1) ? 8 : 2;
            a_unit(F, l, a, n, u / per, u % per); }
    }
}
__device__ __forceinline__ void phase4(Ctx& F, int l) {
    unsigned char* VV = F.lds;
    float* SSQ = (float*)(F.lds + 51200);
    const int r = F.lane & 31, hh = F.lane >> 5, w = F.wave, ui = w >> 2, th = (w >> 1) & 1, vh = w & 1;
    const float* gain = F.out_gain + l * 192;
    for (int pu = F.bid; pu < 256; pu += F.G) {
        for (int e = F.tid; e < 3072; e += 512) { const int uu = e / 1536, e2 = e % 1536, row = e2 / 24, ch = e2 % 24, u = 2 * pu + uu, h = u & 3, n = u >> 2;
            *(u32x4*)(VV + uu * 25600 + row * 400 + ch * 16) = *(const u32x4*)(F.proj + (size_t)(n * 64 + row) * PW + C_CV + h * 192 + ch * 8); }
        __syncthreads();
        const int u = 2 * pu + ui, h = u & 3, n = u >> 2, t0 = n * 64, tq = th * 32 + r;
        bf16x8 qf[6];
#pragma unroll
        for (int kd = 0; kd < 6; ++kd) qf[kd] = *(const bf16x8*)(F.proj + (size_t)(t0 + tq) * PW + C_CQ + h * 96 + 16 * kd + 8 * hh);
        bf16x8 pf[2][2];
#pragma unroll
        for (int si = 0; si < 2; ++si) if (si <= th) { f32x16 X = {};
#pragma unroll
            for (int kd = 0; kd < 6; ++kd) { const bf16x8 kf = *(const bf16x8*)(F.proj + (size_t)(t0 + 32 * si + r) * PW + C_CK + h * 96 + 16 * kd + 8 * hh); X = MFMA32(kf, qf[kd], X); }
            if (si == th) {
#pragma unroll
                for (int g = 0; g < 16; ++g) if (rowidx(g, hh) > r) X[g] = 0.f; }
            pack_p(X, pf[si][0], pf[si][1]); }
        f32x16 O[3]; float sq = 0.f;
#pragma unroll
        for (int vt = 0; vt < 3; ++vt) { const int vtile = vh * 3 + vt; f32x16 acc = {};
#pragma unroll
            for (int si = 0; si < 2; ++si) if (si <= th) {
#pragma unroll
                for (int s2 = 0; s2 < 2; ++s2) { const bf16x8 vf = frag_tr((lds_cptr)(VV + ui * 25600), 400, 32 * si + 16 * s2, 32 * vtile, F.lane); acc = MFMA32(vf, pf[si][s2], acc); } }
#pragma unroll
            for (int kd = 0; kd < 6; ++kd) { const bf16x8 sf = *(const bf16x8*)(F.st + ((size_t)(n * 4 + h) * 192 + 32 * vtile + r) * 96 + 16 * kd + 8 * hh); acc = MFMA32(sf, qf[kd], acc); }
#pragma unroll
            for (int g = 0; g < 16; ++g) sq += acc[g] * acc[g];
            O[vt] = acc; }
        sq += __shfl_xor(sq, 32);
        if (hh == 0) SSQ[(ui * 2 + vh) * 64 + tq] = sq;
        __syncthreads();
        const float rs = rsqrtf((SSQ[(ui * 2) * 64 + tq] + SSQ[(ui * 2 + 1) * 64 + tq]) * (1.f / 192.f) + EPS);
#pragma unroll
        for (int vt = 0; vt < 3; ++vt)
#pragma unroll
            for (int i = 0; i < 4; ++i) { const int v = 32 * (vh * 3 + vt) + 8 * i + 4 * hh;
                const u32x2 zw = *(const u32x2*)(F.proj + (size_t)(t0 + tq) * PW + C_CZ + h * 192 + v); const f32x4 gg = *(const f32x4*)(gain + v);
                const float y0 = O[vt][4 * i] * rs * gg.x * silu(blo(zw.x)), y1 = O[vt][4 * i + 1] * rs * gg.y * silu(bhi(zw.x)), y2 = O[vt][4 * i + 2] * rs * gg.z * silu(blo(zw.y)), y3 = O[vt][4 * i + 3] * rs * gg.w * silu(bhi(zw.y));
                u32x2 ov; ov.x = pk2(y0, y1); ov.y = pk2(y2, y3); *(u32x2*)(F.mixed + (size_t)(t0 + tq) * DM + 1280 + h * 192 + v) = ov; }
        __syncthreads();
    }
    const int NT = F.G * 512, gt = F.bid * 512 + F.tid;
    for (int idx = gt; idx < SEQ * 96; idx += NT) { const int t = idx / 96, c = (idx % 96) * 8, a = c >> 6;
        float o[8] = {0.f, 0.f, 0.f, 0.f, 0.f, 0.f, 0.f, 0.f}; float lsum = 0.f;
#pragma unroll
        for (int n = 0; n < 3; ++n) { const u32x4 wv = *(const u32x4*)(F.oa + ((size_t)n * SEQ + t) * 768 + c); lsum += F.la[((size_t)n * SEQ + t) * 12 + a];
            o[0] += blo(wv.x); o[1] += bhi(wv.x); o[2] += blo(wv.y); o[3] += bhi(wv.y); o[4] += blo(wv.z); o[5] += bhi(wv.z); o[6] += blo(wv.w); o[7] += bhi(wv.w); }
        const float il = 1.f / lsum; const u32x4 zw = *(const u32x4*)(F.proj + (size_t)t * PW + C_AZ + c);
        u32x4 ov; ov.x = pk2(o[0] * il * silu(blo(zw.x)), o[1] * il * silu(bhi(zw.x))); ov.y = pk2(o[2] * il * silu(blo(zw.y)), o[3] * il * silu(bhi(zw.y)));
        ov.z = pk2(o[4] * il * silu(blo(zw.z)), o[5] * il * silu(bhi(zw.z))); ov.w = pk2(o[6] * il * silu(blo(zw.w)), o[7] * il * silu(bhi(zw.w)));
        *(u32x4*)(F.mixed + (size_t)t * DM + c) = ov; }
    for (int idx = gt; idx < SEQ * 64; idx += NT) { const int t = idx / 64, c = (idx % 64) * 8, h = c >> 6, nseg = (t >> 11) + 1;
        f32x4 o0 = {0.f, 0.f, 0.f, 0.f}, o1 = {0.f, 0.f, 0.f, 0.f}; float lsum = 0.f;
        for (int s = 0; s < nseg; ++s) { const float* p = F.ob + ((size_t)s * SEQ + t) * 512 + c; o0 += *(const f32x4*)p; o1 += *(const f32x4*)(p + 4); lsum += F.lb[((size_t)s * SEQ + t) * 8 + h]; }
        const float il = 1.f / lsum; const u32x4 zw = *(const u32x4*)(F.proj + (size_t)t * PW + C_BZ + c);
        u32x4 ov; ov.x = pk2(o0.x * il * silu(blo(zw.x)), o0.y * il * silu(bhi(zw.x))); ov.y = pk2(o0.z * il * silu(blo(zw.y)), o0.w * il * silu(bhi(zw.y)));
        ov.z = pk2(o1.x * il * silu(blo(zw.z)), o1.y * il * silu(bhi(zw.z))); ov.w = pk2(o1.z * il * silu(blo(zw.w)), o1.w * il * silu(bhi(zw.w)));
        *(u32x4*)(F.mixed + (size_t)t * DM + 768 + c) = ov; }
}

#define LAS __attribute__((address_space(3)))
#define XB_TMO      128
#define XB_XCNT(j)  (256  + 64 * (j))
#define XB_XSUB(j)  (1280 + 64 * (j))
#define XB_XGEN(j)  (2304 + 64 * (j))
#define XB_TOP      3328
#define XB_TOPGEN   3392
#define XCD_BAR_WORDS 3456
#define XB_SPIN_CAP (1u << 18)

__device__ __forceinline__ unsigned xb_ld(unsigned* p)              { return __hip_atomic_load(p, __ATOMIC_RELAXED, __HIP_MEMORY_SCOPE_AGENT); }
__device__ __forceinline__ unsigned xb_add(unsigned* p, unsigned v) { return __hip_atomic_fetch_add(p, v, __ATOMIC_RELAXED, __HIP_MEMORY_SCOPE_AGENT); }
__device__ __forceinline__ unsigned xb_xcc_id() { return (unsigned)__builtin_amdgcn_s_getreg((3 << 11) | 20) & 0xFu; }
#define XB_SPIN(cond, bar) do { unsigned _sp = 0; while (cond) { __builtin_amdgcn_s_sleep(1); \
    if ((++_sp & 255u) == 0u) { if (xb_ld(&(bar)[XB_TMO])) break; if (_sp > XB_SPIN_CAP) { atomicAdd(&(bar)[XB_TMO], 1u); break; } } } } while (0)

struct XcdBarrier {
    unsigned* bar; unsigned x;
    volatile LAS unsigned* st;
};

__device__ __forceinline__ XcdBarrier xcd_barrier_post(unsigned* bar, volatile LAS unsigned* st) {
    XcdBarrier b; b.bar = bar; b.x = xb_xcc_id(); b.st = st;
    if (threadIdx.x == 0) (void)xb_add(&bar[XB_XCNT(b.x)], 1u);
    return b;
}
__device__ __forceinline__ void xcd_barrier_complete(unsigned* bar, unsigned x, unsigned& nloc, unsigned& nx) {
    const unsigned G = gridDim.x * gridDim.y * gridDim.z;
    unsigned sum, cnt, mine, sp = 0u;
    for (;;) {
        sum = 0u; cnt = 0u; mine = 0u;
#pragma unroll
        for (unsigned j = 0; j < 16; ++j) { const unsigned c = xb_ld(&bar[XB_XCNT(j)]); sum += c; cnt += (c > 0u) ? 1u : 0u; mine = (j == x) ? c : mine; }
        if (sum == G) break;
        __builtin_amdgcn_s_sleep(1);
        if ((++sp & 255u) == 0u) { if (xb_ld(&bar[XB_TMO])) break; if (sp > XB_SPIN_CAP) { atomicAdd(&bar[XB_TMO], 1u); break; } }
    }
    nloc = mine > 0u ? mine : 1u; nx = cnt > 0u ? cnt : 1u;
}

__device__ __forceinline__ void xcd_barrier(const XcdBarrier& b) {
    asm volatile("s_waitcnt vmcnt(0)" ::: "memory");
    __syncthreads();
    if (threadIdx.x == 0) {
        unsigned* bar = b.bar;
        __builtin_amdgcn_s_waitcnt(0);
        unsigned nloc = b.st[0], nx = b.st[1];
        if (nloc == 0u) { xcd_barrier_complete(bar, b.x, nloc, nx); b.st[0] = nloc; b.st[1] = nx; }
        const unsigned old = xb_add(&bar[XB_XSUB(b.x)], 1u);
        const unsigned gen = old / nloc;
        if (old + 1u == (gen + 1u) * nloc) {
            __builtin_amdgcn_fence(__ATOMIC_RELEASE, "agent");
            asm volatile("s_waitcnt vmcnt(0)" ::: "memory");
            const unsigned og = xb_add(&bar[XB_TOP], 1u);
            const unsigned tg = og / nx;
            if (og + 1u == (tg + 1u) * nx) xb_add(&bar[XB_TOPGEN], 1u);
            else XB_SPIN(xb_ld(&bar[XB_TOPGEN]) == tg, bar);
            __builtin_amdgcn_fence(__ATOMIC_ACQUIRE, "agent");
            xb_add(&bar[XB_XGEN(b.x)], 1u);
            asm volatile("s_waitcnt vmcnt(0)" ::: "memory");
        } else {
            XB_SPIN(xb_ld(&bar[XB_XGEN(b.x)]) == gen, bar);
            __builtin_amdgcn_fence(__ATOMIC_ACQUIRE, "agent");
            asm volatile("s_waitcnt vmcnt(0)" ::: "memory");
        }
    }
    __syncthreads();
}

struct Args { const float* in[12]; float* out; unsigned char* ws; int ph_lo, ph_hi; };
constexpr int N_PHASES = 1 + 5 * NLAYER;
__global__ void __launch_bounds__(512, 2) mega_fwd(Args args) {
    extern __shared__ __attribute__((aligned(16))) unsigned char lds[];
    Ctx F;
    F.x = args.in[0]; F.norm_g = args.in[1]; F.w_in = args.in[2]; F.aqg = args.in[3]; F.akg = args.in[4]; F.bqg = args.in[5]; F.bkg = args.in[6];
    F.fox_bias = args.in[7]; F.gate_up = args.in[8]; F.gate_bias = args.in[9]; F.out_gain = args.in[10]; F.w_out = args.in[11];
    F.out = args.out; F.ws = args.ws; unsigned char* ws = args.ws;
    F.ctl = (unsigned*)(ws + WS_CTL); F.ss = (unsigned long long*)(ws + WS_SS); F.wtin = (bf16*)(ws + WS_WTIN); F.wtout = (bf16*)(ws + WS_WTOUT); F.xb = (bf16*)(ws + WS_XB);
    F.proj = (bf16*)(ws + WS_PROJ); F.small = (float*)(ws + WS_SMALL); F.mixed = (bf16*)(ws + WS_MIXED); F.oa = (bf16*)(ws + WS_OA); F.la = (float*)(ws + WS_LA);
    F.ob = (float*)(ws + WS_OB); F.lb = (float*)(ws + WS_LB); F.cl = (float*)(ws + WS_CL); F.bt = (float*)(ws + WS_BT); F.ds = (float*)(ws + WS_DS); F.st = (bf16*)(ws + WS_ST); F.dec = (float*)(ws + WS_DEC);
    F.lds = lds; F.tid = threadIdx.x; F.lane = F.tid & 63; F.wave = __builtin_amdgcn_readfirstlane(F.tid >> 6); F.G = gridDim.x; F.bid = blockIdx.x;
    cg::grid_group grid = cg::this_grid();
    if (threadIdx.x < 8) ((volatile LAS unsigned*)((LAS unsigned char*)lds + MISC_OFF))[threadIdx.x] = 0u;
    __syncthreads();
    XcdBarrier bar = xcd_barrier_post((unsigned*)(ws + WS_CTL) + 4096, (volatile LAS unsigned*)((LAS unsigned char*)lds + MISC_OFF));
    const int lo = args.ph_lo, hi = args.ph_hi;
#define IN(k) (lo <= (k) && (k) < hi)
#define RELAUNDER() do { int t_ = threadIdx.x; asm volatile("" : "+v"(t_)); F.tid = t_; F.lane = t_ & 63; F.wave = __builtin_amdgcn_readfirstlane(t_ >> 6); } while (0)
#define SEAM(k) do { if (IN(k) && IN((k) + 1)) { if ((k) == 0) grid.sync(); else xcd_barrier(bar); } } while (0)
    if (IN(0)) { RELAUNDER(); phase0(F); }
    SEAM(0);
    for (int l = 0; l < NLAYER; ++l) { const int pb = 1 + 5 * l;
        if (IN(pb)) { pg8::Gemm g{F.xb, F.wtin + (size_t)l * NPAD * DM, SEQ, NPAD, DM}; pg8::StaticOrder S; S.init(SEQ, NPAD, F.G, F.bid);
            pg8::EpiProj E{F.proj, F.small, F.ss + l * SEQ};
            pg8::gemm_phase<pg8::EpiProj, pg8::StaticOrder, true, true>((PG8_LAS unsigned char*)lds, g, S, E); __syncthreads(); }
        SEAM(pb);
        if (IN(pb + 1)) { RELAUNDER(); phase2(F, l); }
        SEAM(pb + 1);
        if (IN(pb + 2)) { RELAUNDER(); phase3(F, l); }
        SEAM(pb + 2);
        if (IN(pb + 3)) { RELAUNDER(); phase4(F, l); }
        SEAM(pb + 3);
        if (IN(pb + 4)) { pg8::Gemm g{F.mixed, F.wtout + (size_t)l * DM * DM, SEQ, DM, DM}; pg8::StaticOrder S; S.init(SEQ, DM, F.G, F.bid);
            const bool last = (l == NLAYER - 1);
            pg8::EpiOut E{l == 0 ? F.x : F.out, F.out, last ? nullptr : F.xb, last ? nullptr : F.ss + (l + 1) * SEQ};
            pg8::gemm_phase<pg8::EpiOut, pg8::StaticOrder, true, true>((PG8_LAS unsigned char*)lds, g, S, E); __syncthreads(); }
        SEAM(pb + 4);
    }
#undef IN
#undef SEAM
}

#ifndef MK_ONE_LAUNCH
#define MK_ONE_LAUNCH 1
#endif
extern "C" void kernel_launch(void* const* d_in, const int* in_sizes, int n_in, void* d_out, int out_size, void* d_ws, size_t ws_size, hipStream_t stream) {
    static int grid = 0;
    if (grid == 0) {
        int dev = 0, cus = 0, per_cu = 0;
        hipGetDevice(&dev); hipDeviceGetAttribute(&cus, hipDeviceAttributeMultiprocessorCount, dev);
        hipFuncSetAttribute((const void*)mega_fwd, hipFuncAttributeMaxDynamicSharedMemorySize, LDS_BYTES);
        hipOccupancyMaxActiveBlocksPerMultiprocessor(&per_cu, mega_fwd, 512, LDS_BYTES);
        grid = cus * per_cu; if (grid <= 0) grid = 256;
        if (ws_size < WS_END) { fprintf(stderr, "workspace too small: %zu < %zu\n", ws_size, (size_t)WS_END); }
    }
    Args a{}; for (int i = 0; i < 12; ++i) a.in[i] = (const float*)d_in[i]; a.out = (float*)d_out; a.ws = (unsigned char*)d_ws;
#if MK_ONE_LAUNCH
    a.ph_lo = 0; a.ph_hi = N_PHASES; void* kargs[] = {&a};
    (void)hipMemsetAsync(d_ws, 0, 65536, stream);
    hipError_t e = hipLaunchCooperativeKernel((const void*)mega_fwd, dim3(grid), dim3(512), kargs, LDS_BYTES, stream);
    if (e != hipSuccess) fprintf(stderr, "cooperative launch failed: %s (grid %d)\n", hipGetErrorString(e), grid);
#else
    for (int p = 0; p < N_PHASES; ++p) { a.ph_lo = p; a.ph_hi = p + 1; hipLaunchKernelGGL(mega_fwd, dim3(grid), dim3(512), LDS_BYTES, stream, a); }
#endif
}
```

```cpp
#include <hip/hip_runtime.h>
#include <hip/hip_cooperative_groups.h>
#include <cstdio>
#include <cstdint>
namespace cg = cooperative_groups;
namespace pg8 {
#define PG8_LAS __attribute__((address_space(3)))
typedef unsigned short bf16_t;
typedef short bf16x8 __attribute__((ext_vector_type(8)));
typedef float f32x4 __attribute__((ext_vector_type(4)));
typedef unsigned u32x4 __attribute__((ext_vector_type(4)));
constexpr int BM = 256, BK = 64, HALF = 128, HTB = HALF * BK * 2  , STAGE_BYTES = 8 * HTB, NXCD = 8, WGM = 8;

__host__ __device__ __forceinline__ int lds_byte(int r, int c) { const int st = (r >> 4) * 2 + (c >> 5), rr = r & 15, cc = c & 31, ob = rr * 64 + cc * 2; return st * 1024 + (ob ^ (((ob >> 9) & 1) << 5)); }
__host__ __device__ __forceinline__ void stage_rc(int b, int& R, int& C) { const int st = b / 1024, sb = b % 1024, swz = sb ^ (((sb >> 9) & 1) << 5); R = (st >> 1) * 16 + swz / 64; C = (st & 1) * 32 + (swz % 64) / 2; }
__host__ __device__ __forceinline__ int perm32(int rho) { const int n = rho >> 4, i = rho & 15; return 8 * (i >> 2) + 4 * n + (i & 3); }

struct Unit { int pm, pn; };
struct Gemm { const bf16_t* A; const bf16_t* Bt; int M, N, K; };

struct StaticOrder {
    int nM, nN, nwg, G, c;
    __host__ __device__ void init(int M, int N, int G_, int c_) { nM = M / BM; nN = N / BM; nwg = nM * nN; G = G_; c = c_; }
    __host__ __device__ bool next(int i, Unit& u) const {
        const long L = (long)i * G + c; if (L >= nwg) return false;
        int wgid = (int)L; { const int q = nwg / NXCD, r = nwg % NXCD, xcd = wgid % NXCD, off = wgid / NXCD; wgid = (xcd < r ? xcd * (q + 1) : r * (q + 1) + (xcd - r) * q) + off; }
        const int nig = WGM * nN, gid = wgid / nig, fm = gid * WGM, gsz = (nM - fm) < WGM ? (nM - fm) : WGM;
        u.pm = fm + ((wgid % nig) % gsz); u.pn = (wgid % nig) / gsz; return true;
    }
    __device__ __forceinline__ void a_ready(const Unit&) const {}
    __device__ __forceinline__ void done(const Unit&) const {}
};

__device__ __forceinline__ unsigned cvt_pk_bf16(float lo, float hi) { unsigned r; asm volatile("v_cvt_pk_bf16_f32 %0, %1, %2" : "=v"(r) : "v"(lo), "v"(hi)); return r; }
typedef float f32x2 __attribute__((ext_vector_type(2)));
constexpr int PROJ_W = 7424;
struct EpiProj {
    static constexpr bool PERM = true, AFTER_DRAIN = false;
    bf16_t* O; float* small; const unsigned long long* ss;
    __device__ __forceinline__ void operator()(const f32x4 (&acc)[2][2][4][2], const Unit& u, int wr, int wc, int fr, int fq) const {
        const int row0 = u.pm * BM + wr * 64 + fr;
        if (u.pn < 29) {
            const int col0 = u.pn * BM + wc * 32 + 8 * fq;
#pragma unroll
            for (int ai = 0; ai < 2; ++ai)
#pragma unroll
                for (int m = 0; m < 4; ++m) { const int row = row0 + ai * HALF + m * 16; const float rs = rsqrtf((float)ss[row] * (1.0f / 1048576.0f / 2048.0f) + 1e-6f);
                    bf16_t* rowp = O + (size_t)row * PROJ_W + col0;
#pragma unroll
                    for (int bj = 0; bj < 2; ++bj) { const f32x4 v0 = acc[ai][bj][m][0] * rs, v1 = acc[ai][bj][m][1] * rs;
                        u32x4 w; w.x = cvt_pk_bf16(v0[0], v0[1]); w.y = cvt_pk_bf16(v0[2], v0[3]); w.z = cvt_pk_bf16(v1[0], v1[1]); w.w = cvt_pk_bf16(v1[2], v1[3]);
                        *(u32x4*)(rowp + bj * HALF) = w; } }
        } else if (wc == 0) {
#pragma unroll
            for (int ai = 0; ai < 2; ++ai)
#pragma unroll
                for (int m = 0; m < 4; ++m) { const int row = row0 + ai * HALF + m * 16; const float rs = rsqrtf((float)ss[row] * (1.0f / 1048576.0f / 2048.0f) + 1e-6f);
                    float* p = small + (size_t)row * 32 + 8 * fq;
                    *(f32x4*)p = acc[ai][0][m][0] * rs; *(f32x4*)(p + 4) = acc[ai][0][m][1] * rs; }
        }
    }
};
struct EpiOut {
    static constexpr bool PERM = true, AFTER_DRAIN = false;
    const float* xin; float* out; bf16_t* xb; unsigned long long* ssn;
    __device__ __forceinline__ void operator()(const f32x4 (&acc)[2][2][4][2], const Unit& u, int wr, int wc, int fr, int fq) const {
        const int row0 = u.pm * BM + wr * 64 + fr, col0 = u.pn * BM + wc * 32 + 8 * fq;
#pragma unroll
        for (int ai = 0; ai < 2; ++ai)
#pragma unroll
            for (int m = 0; m < 4; ++m) { const int row = row0 + ai * HALF + m * 16; float sq = 0.f;
#pragma unroll
                for (int bj = 0; bj < 2; ++bj) { const size_t p = (size_t)row * 2048 + col0 + bj * HALF;
                    const f32x4 a = *(const f32x4*)(xin + p) + acc[ai][bj][m][0], b = *(const f32x4*)(xin + p + 4) + acc[ai][bj][m][1];
                    *(f32x4*)(out + p) = a; *(f32x4*)(out + p + 4) = b;
                    if (xb) { u32x4 w; w.x = cvt_pk_bf16(a[0], a[1]); w.y = cvt_pk_bf16(a[2], a[3]); w.z = cvt_pk_bf16(b[0], b[1]); w.w = cvt_pk_bf16(b[2], b[3]); *(u32x4*)(xb + p) = w; }
                    sq += (a[0] * a[0] + a[1] * a[1]) + (a[2] * a[2] + a[3] * a[3]) + (b[0] * b[0] + b[1] * b[1]) + (b[2] * b[2] + b[3] * b[3]); }
                sq += __shfl_xor(sq, 16); sq += __shfl_xor(sq, 32);
                if (fq == 0 && ssn) atomicAdd(ssn + row, (unsigned long long)(sq * 1048576.0f + 0.5f)); }
    }
};
template <class Epi, class Sched, bool ALIGN_EPI = false, bool SP2 = false>
__device__ __forceinline__ void gemm_phase(PG8_LAS unsigned char* lds, const Gemm g, const Sched& S, const Epi& E) {
    int tid_ = threadIdx.x; asm volatile("" : "+v"(tid_)); const int tid = tid_, wid = __builtin_amdgcn_readfirstlane(tid >> 6), lane = tid & 63, wr = wid >> 2, wc = wid & 3, fr = lane & 15, fq = lane >> 4;
    const int K = g.K, nt = K / BK;
    unsigned voffA[2], voffB[2];
#pragma unroll
    for (int i = 0; i < 2; ++i) { int R, C; stage_rc(tid * 16 + i * 8192, R, C); const int Rb = Epi::PERM ? ((R & ~31) + perm32(R & 31)) : R;
        voffA[i] = (unsigned)(R * K + C) * 2u; voffB[i] = (unsigned)(Rb * K + C) * 2u; }
    const size_t kstep = (size_t)(BK * 2);
    const size_t hstep = (size_t)HALF * K * 2;
    const size_t tstep = 2 * hstep;
    const unsigned ldsw = (unsigned)wid * 1024u;
    const int aoff = lds_byte(wr * 64 + fr, fq * 8), boff = lds_byte(wc * 32 + fr, fq * 8);
#define PG8_SA(b, h) (((b) * 2 + (h)) * HTB)
#define PG8_SB(b, h) ((4 + (b) * 2 + (h)) * HTB)
#define PG8_STAGE(bufoff, gbase, voff) do { _Pragma("unroll") for (int _i = 0; _i < 2; ++_i) \
        __builtin_amdgcn_global_load_lds((const unsigned*)((const char*)(gbase) + (voff)[_i]), (PG8_LAS unsigned*)(lds + (bufoff) + ldsw + _i * 8192), 16, 0, 0); } while (0)
#define PG8_LDA(dst, b, h) do { _Pragma("unroll") for (int m = 0; m < 4; ++m) _Pragma("unroll") for (int k = 0; k < 2; ++k) dst[m][k] = *(const PG8_LAS bf16x8*)(lds + PG8_SA(b, h) + aoff + m * 2048 + k * 1024); } while (0)
#define PG8_LDB(dst, b, h) do { _Pragma("unroll") for (int n = 0; n < 2; ++n) _Pragma("unroll") for (int k = 0; k < 2; ++k) dst[n][k] = *(const PG8_LAS bf16x8*)(lds + PG8_SB(b, h) + boff + n * 2048 + k * 1024); } while (0)
#define PG8_MMA(ai, bj, At, Bt) do { __builtin_amdgcn_s_setprio(1); _Pragma("unroll") for (int m = 0; m < 4; ++m) _Pragma("unroll") for (int n = 0; n < 2; ++n) _Pragma("unroll") for (int k = 0; k < 2; ++k) \
        acc[ai][bj][m][n] = __builtin_amdgcn_mfma_f32_16x16x32_bf16(Bt[n][k], At[m][k], acc[ai][bj][m][n], 0, 0, 0); __builtin_amdgcn_s_setprio(0); } while (0)
#define PG8_WAIT_V(n) asm volatile("s_waitcnt vmcnt(" #n ")" ::: "memory")
#define PG8_WAIT_L(n) asm volatile("s_waitcnt lgkmcnt(" #n ")" ::: "memory")
#define PG8_BAR __builtin_amdgcn_s_barrier()
#define PG8_SCHED __builtin_amdgcn_sched_barrier(0)
    Unit cur, nxt; int ui = 0;
    if (!S.next(0, cur)) return;
    f32x4 acc[2][2][4][2];
#pragma unroll
    for (int a = 0; a < 2; ++a)
#pragma unroll
        for (int b = 0; b < 2; ++b)
#pragma unroll
            for (int m = 0; m < 4; ++m)
#pragma unroll
                for (int n = 0; n < 2; ++n) acc[a][b][m][n] = (f32x4){0.f, 0.f, 0.f, 0.f};
    bf16x8 At[4][2], B0[2][2], B1[2][2];
    const char* cA = (const char*)g.A + (size_t)cur.pm * tstep; const char* cB = (const char*)g.Bt + (size_t)cur.pn * tstep;
    S.a_ready(cur);
    if constexpr (SP2) {
        PG8_STAGE(PG8_SB(0, 0), cB, voffB); PG8_STAGE(PG8_SB(0, 1), cB + hstep, voffB); PG8_STAGE(PG8_SA(0, 0), cA, voffA); PG8_STAGE(PG8_SA(0, 1), cA + hstep, voffA);
        if (wr == 1) PG8_BAR;
        PG8_WAIT_V(2); PG8_BAR;
        PG8_STAGE(PG8_SB(1, 0), cB + kstep, voffB); PG8_STAGE(PG8_SA(1, 0), cA + kstep, voffA); PG8_STAGE(PG8_SB(1, 1), cB + hstep + kstep, voffB);
        PG8_WAIT_V(6); PG8_BAR;
    } else {
        PG8_STAGE(PG8_SB(0, 0), cB, voffB); PG8_STAGE(PG8_SA(0, 0), cA, voffA); PG8_STAGE(PG8_SB(0, 1), cB + hstep, voffB); PG8_STAGE(PG8_SA(0, 1), cA + hstep, voffA);
        if (wr == 1) PG8_BAR;
        PG8_WAIT_V(4); PG8_BAR;
        PG8_STAGE(PG8_SB(1, 0), cB + kstep, voffB); PG8_STAGE(PG8_SA(1, 0), cA + kstep, voffA); PG8_STAGE(PG8_SB(1, 1), cB + hstep + kstep, voffB);
        PG8_WAIT_V(6); PG8_BAR;
    }
    for (;;) {
        const bool has_next = S.next(ui + 1, nxt);
        const char* nA = has_next ? (const char*)g.A + (size_t)nxt.pm * tstep : cA; const char* nB = has_next ? (const char*)g.Bt + (size_t)nxt.pn * tstep : cB;
        for (int t = 0; t < nt; t += 2) {
            const bool last = (t == nt - 2);
            const char* a1 = cA + (size_t)(t + 1) * kstep;
            const char* a2 = last ? nA : cA + (size_t)(t + 2) * kstep; const char* b2 = last ? nB : cB + (size_t)(t + 2) * kstep;
            const char* a3 = a2 + kstep; const char* b3 = b2 + kstep;
            if (last && has_next) S.a_ready(nxt);
            if constexpr (SP2) {
            PG8_LDB(B0, 0, 0); PG8_LDB(B1, 0, 1); PG8_SCHED; PG8_LDA(At, 0, 0); PG8_STAGE(PG8_SA(1, 1), a1 + hstep, voffA);
            PG8_WAIT_V(8); PG8_WAIT_L(0); PG8_BAR; PG8_MMA(0, 0, At, B0); PG8_MMA(0, 1, At, B1); PG8_BAR; PG8_SCHED;
            PG8_LDA(At, 0, 1); PG8_STAGE(PG8_SB(0, 0), b2, voffB); PG8_STAGE(PG8_SB(0, 1), b2 + hstep, voffB); PG8_STAGE(PG8_SA(0, 0), a2, voffA);
            PG8_WAIT_V(8); PG8_WAIT_L(0); PG8_BAR; PG8_MMA(1, 0, At, B0); PG8_MMA(1, 1, At, B1); PG8_BAR; PG8_SCHED;
            PG8_LDB(B0, 1, 0); PG8_LDB(B1, 1, 1); PG8_SCHED; PG8_LDA(At, 1, 0); PG8_STAGE(PG8_SA(0, 1), a2 + hstep, voffA);
            PG8_WAIT_V(8); PG8_WAIT_L(0); PG8_BAR; PG8_MMA(0, 0, At, B0); PG8_MMA(0, 1, At, B1); PG8_BAR; PG8_SCHED;
            PG8_LDA(At, 1, 1); PG8_STAGE(PG8_SB(1, 0), b3, voffB); PG8_STAGE(PG8_SB(1, 1), b3 + hstep, voffB); PG8_STAGE(PG8_SA(1, 0), a3, voffA);
            PG8_WAIT_V(8); PG8_WAIT_L(0); PG8_BAR; PG8_MMA(1, 0, At, B0); PG8_MMA(1, 1, At, B1); PG8_BAR; PG8_SCHED;
            } else {
            PG8_LDB(B0, 0, 0); PG8_SCHED; PG8_LDA(At, 0, 0); PG8_STAGE(PG8_SA(1, 1), a1 + hstep, voffA);
            PG8_WAIT_L(8); PG8_BAR; PG8_WAIT_L(0); PG8_MMA(0, 0, At, B0); PG8_BAR; PG8_SCHED;
            PG8_LDB(B1, 0, 1); PG8_STAGE(PG8_SB(0, 0), b2, voffB);
            PG8_BAR; PG8_WAIT_L(0); PG8_MMA(0, 1, At, B1); PG8_BAR;
            PG8_LDA(At, 0, 1); PG8_STAGE(PG8_SA(0, 0), a2, voffA);
            PG8_BAR; PG8_WAIT_L(0); PG8_MMA(1, 0, At, B0); PG8_BAR; PG8_SCHED;
            PG8_STAGE(PG8_SB(0, 1), b2 + hstep, voffB);
            PG8_WAIT_V(6); PG8_BAR; PG8_MMA(1, 1, At, B1); PG8_BAR;
            PG8_LDB(B0, 1, 0); PG8_SCHED; PG8_LDA(At, 1, 0); PG8_STAGE(PG8_SA(0, 1), a2 + hstep, voffA);
            PG8_WAIT_L(8); PG8_BAR; PG8_WAIT_L(0); PG8_MMA(0, 0, At, B0); PG8_BAR; PG8_SCHED;
            PG8_LDB(B1, 1, 1); PG8_STAGE(PG8_SB(1, 0), b3, voffB);
            PG8_BAR; PG8_WAIT_L(0); PG8_MMA(0, 1, At, B1); PG8_BAR;
            PG8_LDA(At, 1, 1); PG8_STAGE(PG8_SA(1, 0), a3, voffA);
            PG8_BAR; PG8_WAIT_L(0); PG8_MMA(1, 0, At, B0); PG8_BAR; PG8_SCHED;
            PG8_STAGE(PG8_SB(1, 1), b3 + hstep, voffB);
            PG8_WAIT_V(6); PG8_BAR; PG8_MMA(1, 1, At, B1); PG8_BAR;
            }
        }
        if constexpr (ALIGN_EPI) { if (wr == 0) PG8_BAR; }
        if constexpr (!Epi::AFTER_DRAIN) { E(acc, cur, wr, wc, fr, fq); S.done(cur); }
        if (!has_next) break;
#pragma unroll
        for (int a = 0; a < 2; ++a)
#pragma unroll
            for (int b = 0; b < 2; ++b)
#pragma unroll
                for (int m = 0; m < 4; ++m)
#pragma unroll
                    for (int n = 0; n < 2; ++n) acc[a][b][m][n] = (f32x4){0.f, 0.f, 0.f, 0.f};
        cur = nxt; cA = nA; cB = nB; ++ui;
        if constexpr (ALIGN_EPI) { if (wr == 1) PG8_BAR; }
    }
    PG8_WAIT_V(0);
    if constexpr (!ALIGN_EPI) { if (wr == 0) PG8_BAR; }
    PG8_BAR;
    if constexpr (Epi::AFTER_DRAIN) { E.fused(acc, cur, wr, wc, fr, fq, lds, wid, lane); S.done(cur); }
#undef PG8_SA
#undef PG8_SB
#undef PG8_STAGE
#undef PG8_LDA
#undef PG8_LDB
#undef PG8_MMA
#undef PG8_WAIT_V
#undef PG8_WAIT_L
#undef PG8_BAR
#undef PG8_SCHED
}
}
constexpr int SEQ = 8192, DM = 2048, NLAYER = 4, INW = 7448, NPAD = 7680, PW = pg8::PROJ_W;
constexpr int C_AQ = 0, C_AK = 768, C_AV = 1536, C_AZ = 2304, C_BQ = 3072, C_BK = 3584, C_BV = 4096, C_BZ = 4608, C_CQ = 5120, C_CK = 5504, C_CV = 5888, C_CZ = 6656;
constexpr float LOG2E = 1.4426950408889634f, QSCALE = 0.125f * 1.4426950408889634f, EPS = 1e-6f;
constexpr size_t MiB = 1u << 20;
constexpr size_t WS_CTL = 0, WS_SS = 1 * MiB, WS_WTIN = 2 * MiB, WS_WTOUT = 122 * MiB, WS_XB = 154 * MiB, WS_PROJ = 186 * MiB, WS_SMALL = 302 * MiB,
                 WS_MIXED = 304 * MiB, WS_OA = 336 * MiB, WS_LA = 372 * MiB, WS_OB = 374 * MiB, WS_LB = 438 * MiB, WS_CL = 439 * MiB, WS_BT = WS_CL + 512 * 1024,
                 WS_DS = 440 * MiB, WS_ST = 476 * MiB, WS_DEC = 494 * MiB, WS_END = 496 * MiB;
constexpr int RING_BYTES = 131072, LDS_BYTES = 147456, QSLOT_OFF = RING_BYTES + 64, MISC_OFF = RING_BYTES + 256;
constexpr int N_SCAN = 72, N_FOX = 640, N_AU = 1152, N_ITEMS = N_SCAN + N_FOX + N_AU;

typedef unsigned short bf16;
typedef short bf16x8 __attribute__((ext_vector_type(8)));
typedef short s16x4 __attribute__((ext_vector_type(4)));
typedef float f32x4 __attribute__((ext_vector_type(4)));
typedef float f32x2 __attribute__((ext_vector_type(2)));
typedef float f32x16 __attribute__((ext_vector_type(16)));
typedef unsigned u32x4 __attribute__((ext_vector_type(4)));
typedef unsigned u32x2 __attribute__((ext_vector_type(2)));
typedef __attribute__((address_space(3))) const char* lds_cptr;
#define LAS3 __attribute__((address_space(3)))

__device__ __forceinline__ float bf2f(unsigned b) { return __uint_as_float(b << 16); }
__device__ __forceinline__ unsigned pk2(float lo, float hi) { return pg8::cvt_pk_bf16(lo, hi); }
__device__ __forceinline__ float blo(unsigned w) { return __uint_as_float(w << 16); }
__device__ __forceinline__ float bhi(unsigned w) { return __uint_as_float(w & 0xffff0000u); }
__device__ __forceinline__ float logsig(float x) { return fminf(x, 0.f) - log1pf(expf(-fabsf(x))); }
__device__ __forceinline__ float silu(float x) { return x / (1.f + __expf(-x)); }
__device__ __forceinline__ s16x4 vtr(lds_cptr p) { return __builtin_bit_cast(s16x4, __builtin_amdgcn_ds_read_tr16_b64_v4i16((LAS3 s16x4*)p)); }
__device__ __forceinline__ bf16x8 frag_tr(lds_cptr img, int stride, int kbase, int m0, int lane) {
    const int i = lane & 15, g = lane >> 4;
    lds_cptr p = img + (kbase + 4 * (g >> 1) + (i >> 2)) * stride + (m0 + 16 * (g & 1) + 4 * (i & 3)) * 2;
    const s16x4 a = vtr(p), b = vtr(p + 8 * stride);
    return (bf16x8){a[0], a[1], a[2], a[3], b[0], b[1], b[2], b[3]};
}
__device__ __forceinline__ int rowidx(int reg, int hh) { return (reg & 3) + 8 * (reg >> 2) + 4 * hh; }
__device__ __forceinline__ void pack_p(const f32x16& p, bf16x8& f0, bf16x8& f1) {
    u32x4 a, b; a.x = pk2(p[0], p[1]); a.y = pk2(p[2], p[3]); a.z = pk2(p[4], p[5]); a.w = pk2(p[6], p[7]);
    b.x = pk2(p[8], p[9]); b.y = pk2(p[10], p[11]); b.z = pk2(p[12], p[13]); b.w = pk2(p[14], p[15]);
    f0 = __builtin_bit_cast(bf16x8, a); f1 = __builtin_bit_cast(bf16x8, b);
}
#define MFMA32(a, b, c) __builtin_amdgcn_mfma_f32_32x32x16_bf16((a), (b), (c), 0, 0, 0)

struct Ctx {
    const float *x, *norm_g, *w_in, *aqg, *akg, *bqg, *bkg, *fox_bias, *gate_up, *gate_bias, *out_gain, *w_out;
    float* out; unsigned char* ws;
    unsigned* ctl; unsigned long long* ss; bf16* wtin; bf16* wtout; bf16* xb; bf16* proj; float* small; bf16* mixed; bf16* oa; float* la; float* ob; float* lb; float* cl; float* bt;
    float* ds; bf16* st; float* dec;
    unsigned char* lds; int tid, lane, wave, G, bid;
};

__device__ __forceinline__ int orig_col(int np) { if (np < 5120) return np; if (np < 7424) return np + 8; if (np < 7432) return 5120 + (np - 7424); if (np < 7448) return np; return -1; }
__device__ __forceinline__ void p0_item(const float* W, int N, bf16* WT, const float* g, int mode, float* scr, int kb, int nb, int lane) {
    const int k0 = 64 * kb, n0 = 32 * nb, c4 = 4 * (lane & 7), np = n0 + c4;
    const int oc = mode ? orig_col(np) : np;
    const float cs = (mode && np >= C_CQ && np < C_CK) ? 0.10206207261596577f : 1.0f;
    f32x4 v[8];
#pragma unroll
    for (int i = 0; i < 8; ++i) { const int kk = 8 * i + (lane >> 3); v[i] = (f32x4){0.f, 0.f, 0.f, 0.f};
        if (oc >= 0) { v[i] = *(const f32x4*)(W + (size_t)(k0 + kk) * N + oc); const float sc = mode ? cs * g[k0 + kk] : 1.0f; v[i] = v[i] * sc; } }
#pragma unroll
    for (int i = 0; i < 8; ++i) { const int kk = 8 * i + (lane >> 3); float* d = scr + kk * 33 + c4; d[0] = v[i].x; d[1] = v[i].y; d[2] = v[i].z; d[3] = v[i].w; }
    __builtin_amdgcn_s_waitcnt(0); asm volatile("" ::: "memory");
    const int c = lane & 7;
#pragma unroll
    for (int j = 0; j < 4; ++j) { const int n = (lane >> 3) + 8 * j; const float* s = scr + (8 * c) * 33 + n;
        u32x4 o; o.x = pk2(s[0 * 33], s[1 * 33]); o.y = pk2(s[2 * 33], s[3 * 33]); o.z = pk2(s[4 * 33], s[5 * 33]); o.w = pk2(s[6 * 33], s[7 * 33]);
        *(u32x4*)(WT + (size_t)(n0 + n) * 2048 + k0 + 8 * c) = o; }
    __builtin_amdgcn_s_waitcnt(0); asm volatile("" ::: "memory");
}
__device__ __forceinline__ void phase0(Ctx& F) {
    float* scr = (float*)(F.lds + F.wave * 16384);
    const int gw = F.bid * 8 + F.wave, NGW = F.G * 8;
    if (F.bid == 0 && F.tid < 64) F.ctl[F.tid] = 0u;
    for (int i = F.bid * 512 + F.tid; i < 3 * SEQ; i += F.G * 512) F.ss[SEQ + i] = 0ull;
    constexpr int I_IN = 32 * 233, I_OUT = 32 * 64, I_L = I_IN + I_OUT;
    for (int it = gw; it < NLAYER * I_L; it += NGW) {
        const int l = it / I_L; int r = it % I_L;
        if (r < I_IN) p0_item(F.w_in + (size_t)l * DM * INW, INW, F.wtin + (size_t)l * NPAD * DM, F.norm_g + l * DM, 1, scr, r / 233, r % 233, F.lane);
        else { r -= I_IN; p0_item(F.w_out + (size_t)l * DM * DM, DM, F.wtout + (size_t)l * DM * DM, nullptr, 0, scr, r / 64, r % 64, F.lane); }
    }
    for (int m = gw; m < SEQ; m += NGW) {
        const f32x4* xr = (const f32x4*)(F.x + (size_t)m * DM) + F.lane; float s = 0.f; u32x2* o8 = (u32x2*)(F.xb + (size_t)m * DM) + F.lane;
#pragma unroll
        for (int j = 0; j < 8; ++j) { const f32x4 v = xr[64 * j]; s += (v.x * v.x + v.y * v.y) + (v.z * v.z + v.w * v.w); u32x2 w; w.x = pk2(v.x, v.y); w.y = pk2(v.z, v.w); o8[64 * j] = w; }
#pragma unroll
        for (int o = 1; o < 64; o <<= 1) s += __shfl_xor(s, o);
        if (F.lane == 0) F.ss[m] = (unsigned long long)(s * 1048576.0f + 0.5f);
    }
}

__device__ __forceinline__ void phase2(Ctx& F, int l) {
    { const int NT = F.G * 512; const int total = SEQ * 320;
      for (int base = 0; base < total; base += NT) { const int idx0 = base + F.bid * 512 + F.tid; const bool ok = idx0 < total; const int idx = ok ? idx0 : 0;
        const int row = idx / 320, c = idx % 320; int col; const float* g; float sc = 1.f;
        if (c < 192) { col = c * 8; if (col < 768) { g = F.aqg + l * 64; sc = QSCALE; } else g = F.akg + l * 64; }
        else { col = 3072 + (c - 192) * 8; if (col < C_BK) { g = F.bqg + l * 64; sc = QSCALE; } else g = F.bkg + l * 64; }
        bf16* p = F.proj + (size_t)row * PW + col; const u32x4 w = *(const u32x4*)p;
        float v[8] = {blo(w.x), bhi(w.x), blo(w.y), bhi(w.y), blo(w.z), bhi(w.z), blo(w.w), bhi(w.w)};
        float s = 0.f;
#pragma unroll
        for (int j = 0; j < 8; ++j) s += v[j] * v[j];
        s += __shfl_xor(s, 1); s += __shfl_xor(s, 2); s += __shfl_xor(s, 4);
        const float rs = rsqrtf(s * (1.f / 64.f) + EPS) * sc; const float* gg = g + (col & 63);
        const f32x4 g0 = *(const f32x4*)gg, g1 = *(const f32x4*)(gg + 4);
        u32x4 o; o.x = pk2(v[0] * rs * g0.x, v[1] * rs * g0.y); o.y = pk2(v[2] * rs * g0.z, v[3] * rs * g0.w); o.z = pk2(v[4] * rs * g1.x, v[5] * rs * g1.y); o.w = pk2(v[6] * rs * g1.z, v[7] * rs * g1.w);
        if (ok) *(u32x4*)p = o; } }
    { const int gw = F.bid * 8 + F.wave, NGW = F.G * 8;
      for (int wi = gw; wi < 512; wi += NGW) { const int blk = wi >> 3, h = wi & 7, t = blk * 128 + 2 * F.lane; const float fb = F.fox_bias[l * 8 + h];
        const float l0 = logsig(F.small[(size_t)t * 32 + h] + fb), l1 = logsig(F.small[(size_t)(t + 1) * 32 + h] + fb);
        float s = l0 + l1;
#pragma unroll
        for (int o = 1; o < 64; o <<= 1) { const float y = __shfl_up(s, o); if (F.lane >= o) s += y; }
        const float ex = s - (l0 + l1); F.cl[t * 8 + h] = ex + l0; F.cl[(t + 1) * 8 + h] = s; if (F.lane == 63) F.bt[blk * 8 + h] = s; } }
    { float* LA = (float*)F.lds;
      unsigned char* KH = F.lds + 24576;
      unsigned char* VV = F.lds + 24576 + 13312;
      const float* gup = F.gate_up + (size_t)l * 16 * 384; const float* gbs = F.gate_bias + l * 384;
      for (int u = F.bid; u < 512; u += F.G) { const int h = u & 3, n = u >> 2, t0 = n * 64;
        for (int e = F.tid; e < 6144; e += 512) { const int t = e / 96, d = e % 96; float a = gbs[h * 96 + d]; const float* cr = F.small + (size_t)(t0 + t) * 32 + 8;
#pragma unroll
            for (int r = 0; r < 16; ++r) a += cr[r] * gup[r * 384 + h * 96 + d];
            LA[e] = logsig(a) * (1.f / 16.f); }
        for (int e = F.tid; e < 1536; e += 512) { const int row = e / 24, ch = e % 24;
            *(u32x4*)(VV + row * 400 + ch * 16) = *(const u32x4*)(F.proj + (size_t)(t0 + row) * PW + C_CV + h * 192 + ch * 8); }
        __syncthreads();
        if (F.tid < 96) { float run = 0.f;
#pragma unroll 8
            for (int t = 0; t < 64; ++t) { run += LA[t * 96 + F.tid]; LA[t * 96 + F.tid] = run; } }
        __syncthreads();
        for (int e = F.tid; e < 768; e += 512) { const int t = e / 12, d0 = (e % 12) * 8;
            bf16* qp = F.proj + (size_t)(t0 + t) * PW + C_CQ + h * 96 + d0; bf16* kp = F.proj + (size_t)(t0 + t) * PW + C_CK + h * 96 + d0;
            const u32x4 qw = *(const u32x4*)qp, kw = *(const u32x4*)kp;
            float q[8] = {blo(qw.x), bhi(qw.x), blo(qw.y), bhi(qw.y), blo(qw.z), bhi(qw.z), blo(qw.w), bhi(qw.w)};
            float k[8] = {blo(kw.x), bhi(kw.x), blo(kw.y), bhi(kw.y), blo(kw.z), bhi(kw.z), blo(kw.w), bhi(kw.w)};
            float qt[8], kt[8], kh[8];
#pragma unroll
            for (int j = 0; j < 8; ++j) { const float bc = LA[t * 96 + d0 + j], bm = LA[31 * 96 + d0 + j], bl = LA[63 * 96 + d0 + j];
                qt[j] = q[j] * __expf(bc - bm); kt[j] = k[j] * __expf(bm - bc); kh[j] = k[j] * __expf(bl - bc); }
            u32x4 o; o.x = pk2(qt[0], qt[1]); o.y = pk2(qt[2], qt[3]); o.z = pk2(qt[4], qt[5]); o.w = pk2(qt[6], qt[7]); *(u32x4*)qp = o;
            o.x = pk2(kt[0], kt[1]); o.y = pk2(kt[2], kt[3]); o.z = pk2(kt[4], kt[5]); o.w = pk2(kt[6], kt[7]); *(u32x4*)kp = o;
            o.x = pk2(kh[0], kh[1]); o.y = pk2(kh[2], kh[3]); o.z = pk2(kh[4], kh[5]); o.w = pk2(kh[6], kh[7]); *(u32x4*)(KH + t * 208 + d0 * 2) = o; }
        if (F.tid < 96) { F.dec[(n * 4 + h) * 96 + F.tid] = __expf(LA[63 * 96 + F.tid]); F.dec[49152 + (n * 4 + h) * 96 + F.tid] = __expf(LA[31 * 96 + F.tid]); }
        __syncthreads();
        for (int id = F.wave; id < 18; id += 8) { const int vt = id / 3, dt = id % 3; f32x16 acc = {};
#pragma unroll
            for (int s = 0; s < 4; ++s) { const bf16x8 a = frag_tr((lds_cptr)VV, 400, 16 * s, 32 * vt, F.lane), b = frag_tr((lds_cptr)KH, 208, 16 * s, 32 * dt, F.lane); acc = MFMA32(a, b, acc); }
            float* dst = F.ds + ((size_t)(n * 4 + h) * 192 + 32 * vt) * 96 + 32 * dt + (F.lane & 31);
#pragma unroll
            for (int r = 0; r < 16; ++r) dst[(size_t)rowidx(r, F.lane >> 5) * 96] = acc[r]; }
        __syncthreads(); } }
}
__device__ __forceinline__ float softmax_ref2(const float* gq, const float* gk) {
    float mq = 0.f, mk = 0.f;
    for (int i = 0; i < 64; ++i) { mq = fmaxf(mq, fabsf(gq[i])); mk = fmaxf(mk, fabsf(gk[i])); }
    return 8.25f * mq * mk * LOG2E;
}
__device__ __forceinline__ void scan_item(Ctx& F, int si) {
    const int p = si * 512 + F.tid, d = 2 * (p % 48), v = (p / 48) % 192, h = p / (48 * 192);
    float s0 = 0.f, s1 = 0.f;
#pragma unroll 8
    for (int n = 0; n < 128; ++n) { const size_t idx = ((size_t)(n * 4 + h) * 192 + v) * 96 + d; const int di = (n * 4 + h) * 96 + d;
        const f32x2 dd = *(const f32x2*)(F.ds + idx), a = *(const f32x2*)(F.dec + di), em = *(const f32x2*)(F.dec + 49152 + di);
        *(unsigned*)(F.st + idx) = pk2(em.x * s0, em.y * s1);
        s0 = a.x * s0 + dd.x; s1 = a.y * s1 + dd.y; }
}
template <int KSTR>
__device__ __forceinline__ void attn_sub(const unsigned char* Kt, const unsigned char* Vt, int key_row0, const bf16x8 (&qf)[4], f32x16 S, f32x16 (&o)[2], float& lsum, int lane,
                                         bool use_mask, int lo, int hi_) {
    const int r = lane & 31, hh = lane >> 5;
#pragma unroll
    for (int s = 0; s < 4; ++s) { const bf16x8 kf = *(const bf16x8*)(Kt + (key_row0 + r) * KSTR + (16 * s + 8 * hh) * 2); S = MFMA32(kf, qf[s], S); }
    if (use_mask) {
#pragma unroll
        for (int g = 0; g < 16; ++g) { const int k = rowidx(g, hh); if (k < lo || k > hi_) S[g] = -INFINITY; } }
    float acc = 0.f;
#pragma unroll
    for (int g = 0; g < 16; ++g) { S[g] = __builtin_amdgcn_exp2f(S[g]); acc += S[g]; }
    lsum += acc;
    bf16x8 p0, p1; pack_p(S, p0, p1);
#pragma unroll
    for (int dt = 0; dt < 2; ++dt) {
        const bf16x8 v0 = frag_tr((lds_cptr)Vt, KSTR, key_row0, 32 * dt, lane), v1 = frag_tr((lds_cptr)Vt, KSTR, key_row0 + 16, 32 * dt, lane);
        o[dt] = MFMA32(v0, p0, o[dt]); o[dt] = MFMA32(v1, p1, o[dt]); }
}
template <int NSUB, int KSTR>
__device__ __forceinline__ void attn_multi(const unsigned char* Kt, const unsigned char* Vt, int key_row0, const bf16x8 (&qf)[4], f32x16 (&S)[NSUB], f32x16 (&o)[2], float& lsum, int lane) {
    const int r = lane & 31, hh = lane >> 5;
#pragma unroll
    for (int s = 0; s < 4; ++s)
#pragma unroll
        for (int u = 0; u < NSUB; ++u) { const bf16x8 kf = *(const bf16x8*)(Kt + (key_row0 + 32 * u + r) * KSTR + (16 * s + 8 * hh) * 2); S[u] = MFMA32(kf, qf[s], S[u]); }
#pragma unroll
    for (int u = 0; u < NSUB; ++u) { float acc = 0.f;
#pragma unroll
        for (int g = 0; g < 16; ++g) { S[u][g] = __builtin_amdgcn_exp2f(S[u][g]); acc += S[u][g]; }
        lsum += acc;
        bf16x8 p0, p1; pack_p(S[u], p0, p1);
#pragma unroll
        for (int dt = 0; dt < 2; ++dt) {
            const bf16x8 v0 = frag_tr((lds_cptr)Vt, KSTR, key_row0 + 32 * u, 32 * dt, lane), v1 = frag_tr((lds_cptr)Vt, KSTR, key_row0 + 32 * u + 16, 32 * dt, lane);
            o[dt] = MFMA32(v0, p0, o[dt]); o[dt] = MFMA32(v1, p1, o[dt]); } }
}
__device__ __forceinline__ void fox_unit(Ctx& F, int l, int h, int qb, int seg) {
    constexpr int KS = 144, BUFB = 128 * KS;
    unsigned char* KT = F.lds; unsigned char* VT = F.lds + 2 * BUFB; float* CS = (float*)(F.lds + 4 * BUFB); float* PEX = (float*)(F.lds + 4 * BUFB + 1024);
    const int r = F.lane & 31, hh = F.lane >> 5, w = F.wave, t0 = 256 * qb, NT = 2 * qb + 2, ts = 16 * seg, te = (ts + 16 < NT) ? ts + 16 : NT;
    if (w == 0) { const float v = F.bt[F.lane * 8 + h]; float s = v;
#pragma unroll
        for (int o = 1; o < 64; o <<= 1) { const float y = __shfl_up(s, o); if (F.lane >= o) s += y; }
        PEX[F.lane] = s - v; }
    const float mb2 = softmax_ref2(F.bqg + l * 64, F.bkg + l * 64);
    __syncthreads();
    const int tq = t0 + 32 * w + r; const float pq0 = PEX[t0 >> 7];
    int kt0 = ts; { const float thr = -(26.f + 2.f * mb2 * (1.f / LOG2E)); while (kt0 < te && kt0 < 2 * qb && (pq0 - PEX[kt0 + 1]) < thr) ++kt0; }
    const float ctq = ((PEX[tq >> 7] - pq0) + F.cl[tq * 8 + h]) * LOG2E - mb2;
    bf16x8 qf[4];
#pragma unroll
    for (int s = 0; s < 4; ++s) qf[s] = *(const bf16x8*)(F.proj + (size_t)tq * PW + C_BQ + h * 64 + 16 * s + 8 * hh);
    f32x16 o[2]; o[0] = f32x16{}; o[1] = f32x16{}; float lsum = 0.f;
    const int lrow = F.tid >> 3, lch = F.tid & 7;
    u32x4 kreg[2], vreg[2]; float creg = 0.f;
    if (kt0 < te) {
#pragma unroll
        for (int i = 0; i < 2; ++i) { const size_t g = (size_t)(128 * kt0 + 64 * i + lrow) * PW + h * 64 + lch * 8; kreg[i] = *(const u32x4*)(F.proj + g + C_BK); vreg[i] = *(const u32x4*)(F.proj + g + C_BV); }
        if (F.tid < 128) creg = ((PEX[kt0] - pq0) + F.cl[(128 * kt0 + F.tid) * 8 + h]) * LOG2E; }
    for (int kt = kt0; kt < te; ++kt) { const int buf = (kt - kt0) & 1;
#pragma unroll
        for (int i = 0; i < 2; ++i) { *(u32x4*)(KT + buf * BUFB + (64 * i + lrow) * KS + lch * 16) = kreg[i]; *(u32x4*)(VT + buf * BUFB + (64 * i + lrow) * KS + lch * 16) = vreg[i]; }
        if (F.tid < 128) CS[buf * 128 + F.tid] = creg;
        __syncthreads();
        if (kt + 1 < te) {
#pragma unroll
            for (int i = 0; i < 2; ++i) { const size_t g = (size_t)(128 * (kt + 1) + 64 * i + lrow) * PW + h * 64 + lch * 8; kreg[i] = *(const u32x4*)(F.proj + g + C_BK); vreg[i] = *(const u32x4*)(F.proj + g + C_BV); }
            if (F.tid < 128) creg = ((PEX[kt + 1] - pq0) + F.cl[(128 * (kt + 1) + F.tid) * 8 + h]) * LOG2E; }
        const unsigned char* Kb = KT + buf * BUFB; const unsigned char* Vb = VT + buf * BUFB; const float* Cb = CS + buf * 128;
        if (kt < 2 * qb) {
            f32x16 S[4];
#pragma unroll
            for (int u = 0; u < 4; ++u)
#pragma unroll
                for (int i = 0; i < 4; ++i) { const f32x4 c4 = *(const f32x4*)(Cb + 32 * u + 8 * i + 4 * hh); S[u][4 * i] = ctq - c4.x; S[u][4 * i + 1] = ctq - c4.y; S[u][4 * i + 2] = ctq - c4.z; S[u][4 * i + 3] = ctq - c4.w; }
            attn_multi<4, KS>(Kb, Vb, 0, qf, S, o, lsum, F.lane);
        } else {
            const int qlo = t0 + 32 * w;
#pragma unroll
            for (int sub = 0; sub < 4; ++sub) { const int key0 = 128 * kt + 32 * sub;
                if (key0 <= qlo + 31) {
                    f32x16 S;
#pragma unroll
                    for (int i = 0; i < 4; ++i) { const f32x4 c4 = *(const f32x4*)(Cb + 32 * sub + 8 * i + 4 * hh); S[4 * i] = ctq - c4.x; S[4 * i + 1] = ctq - c4.y; S[4 * i + 2] = ctq - c4.z; S[4 * i + 3] = ctq - c4.w; }
                    attn_sub<KS>(Kb, Vb, 32 * sub, qf, S, o, lsum, F.lane, key0 + 31 > qlo, 0, tq - key0); } }
        }
    }
    lsum += __shfl_xor(lsum, 32);
    float* ob = F.ob + ((size_t)seg * SEQ + tq) * 512 + h * 64 + 4 * hh;
#pragma unroll
    for (int dt = 0; dt < 2; ++dt)
#pragma unroll
        for (int i = 0; i < 4; ++i) *(f32x4*)(ob + 32 * dt + 8 * i) = (f32x4){o[dt][4 * i], o[dt][4 * i + 1], o[dt][4 * i + 2], o[dt][4 * i + 3]};
    if (hh == 0) F.lb[((size_t)seg * SEQ + tq) * 8 + h] = lsum;
    __syncthreads();
}
__device__ __forceinline__ void a_unit(Ctx& F, int l, int a, int n, int rres, int b2) {
    constexpr int KS = 144;
    unsigned char* KA = F.lds; unsigned char* VA = F.lds + 384 * KS;
    const int r = F.lane & 31, hh = F.lane >> 5, w = F.wave, d = (n == 0) ? 1 : (n == 1) ? 4 : 16, i0 = 256 * b2;
    for (int e = F.tid; e < 3072; e += 512) { const int j = e >> 3, ch = e & 7, idx = i0 - 128 + j; u32x4 kv = {0u, 0u, 0u, 0u}, vv = {0u, 0u, 0u, 0u};
        if (idx >= 0) { const size_t g = (size_t)(rres + d * idx) * PW + a * 64 + ch * 8; kv = *(const u32x4*)(F.proj + g + C_AK); vv = *(const u32x4*)(F.proj + g + C_AV); }
        *(u32x4*)(KA + j * KS + ch * 16) = kv; *(u32x4*)(VA + j * KS + ch * 16) = vv; }
    const int tokq = rres + d * (i0 + 32 * w + r);
    bf16x8 qf[4];
#pragma unroll
    for (int s = 0; s < 4; ++s) qf[s] = *(const bf16x8*)(F.proj + (size_t)tokq * PW + C_AQ + a * 64 + 16 * s + 8 * hh);
    const float mb2 = softmax_ref2(F.aqg + l * 64, F.akg + l * 64);
    __syncthreads();
    f32x16 o[2]; o[0] = f32x16{}; o[1] = f32x16{}; float lsum = 0.f;
    const int qj = 32 * w + r + 128;
    if (i0 != 0) {
        { f32x16 S;
#pragma unroll
          for (int g = 0; g < 16; ++g) S[g] = -mb2;
          attn_sub<KS>(KA, VA, 32 * w, qf, S, o, lsum, F.lane, true, qj - 128 - 32 * w, 31); }
        { f32x16 S[3];
#pragma unroll
          for (int u = 0; u < 3; ++u)
#pragma unroll
              for (int g = 0; g < 16; ++g) S[u][g] = -mb2;
          attn_multi<3, KS>(KA, VA, 32 * (w + 1), qf, S, o, lsum, F.lane); }
        { f32x16 S;
#pragma unroll
          for (int g = 0; g < 16; ++g) S[g] = -mb2;
          attn_sub<KS>(KA, VA, 32 * (w + 4), qf, S, o, lsum, F.lane, true, 0, qj - 32 * (w + 4)); }
    } else
    for (int jt = w; jt < w + 5; ++jt) { const int j0 = 32 * jt;
        if (j0 + 31 < 128) continue;
        f32x16 S;
#pragma unroll
        for (int g = 0; g < 16; ++g) S[g] = -mb2;
        int lo = qj - 128 - j0; const int hi_ = qj - j0; if (128 - j0 > lo) lo = 128 - j0;
        attn_sub<KS>(KA, VA, j0, qf, S, o, lsum, F.lane, true, lo, hi_); }
    lsum += __shfl_xor(lsum, 32);
    bf16* oa = F.oa + ((size_t)n * SEQ + tokq) * 768 + a * 64 + 4 * hh;
#pragma unroll
    for (int dt = 0; dt < 2; ++dt)
#pragma unroll
        for (int i = 0; i < 4; ++i) { u32x2 wv; wv.x = pk2(o[dt][4 * i], o[dt][4 * i + 1]); wv.y = pk2(o[dt][4 * i + 2], o[dt][4 * i + 3]); *(u32x2*)(oa + 32 * dt + 8 * i) = wv; }
    if (hh == 0) F.la[((size_t)n * SEQ + tokq) * 12 + a] = lsum;
    __syncthreads();
}
__device__ __forceinline__ void phase3(Ctx& F, int l) {
    volatile unsigned* slot = (volatile unsigned*)(F.lds + QSLOT_OFF);
    for (;;) {
        if (F.tid == 0) *slot = atomicAdd(F.ctl + l, 1u);
        __syncthreads();
        const int item = (int)*slot;
        __syncthreads();
        if (item >= N_ITEMS) break;
        if (item < N_SCAN) scan_item(F, item);
        else if (item < N_SCAN + N_FOX) { int f = item - N_SCAN, ns, qhi;
            if (f < 256) { ns = 4; qhi = 31; } else if (f < 448) { f -= 256; ns = 3; qhi = 23; } else if (f < 576) { f -= 448; ns = 2; qhi = 15; } else { f -= 576; ns = 1; qhi = 7; }
            const int per = ns * 8, qb = qhi - f / per, rem = f % per;
            fox_unit(F, l, rem & 7, qb, rem >> 3); }
        else { const int au = item - N_SCAN - N_FOX, n = au / 384, rest = au % 384, a = rest >> 5, u = rest & 31;
            const int per = (n == 0) ? 32 : (n == 1) ? 8 : 2;
            a_unit(F, l, a, n, u / per, u % per); }
    }
}
__device__ __forceinline__ void phase4(Ctx& F, int l) {
    unsigned char* VV = F.lds;
    float* SSQ = (float*)(F.lds + 51200);
    const int r = F.lane & 31, hh = F.lane >> 5, w = F.wave, ui = w >> 2, th = (w >> 1) & 1, vh = w & 1;
    const float* gain = F.out_gain + l * 192;
    for (int pu = F.bid; pu < 256; pu += F.G) {
        for (int e = F.tid; e < 3072; e += 512) { const int uu = e / 1536, e2 = e % 1536, row = e2 / 24, ch = e2 % 24, u = 2 * pu + uu, h = u & 3, n = u >> 2;
            *(u32x4*)(VV + uu * 25600 + row * 400 + ch * 16) = *(const u32x4*)(F.proj + (size_t)(n * 64 + row) * PW + C_CV + h * 192 + ch * 8); }
        __syncthreads();
        const int u = 2 * pu + ui, h = u & 3, n = u >> 2, t0 = n * 64, tq = th * 32 + r;
        bf16x8 qf[6];
#pragma unroll
        for (int kd = 0; kd < 6; ++kd) qf[kd] = *(const bf16x8*)(F.proj + (size_t)(t0 + tq) * PW + C_CQ + h * 96 + 16 * kd + 8 * hh);
        bf16x8 pf[2][2];
#pragma unroll
        for (int si = 0; si < 2; ++si) if (si <= th) { f32x16 X = {};
#pragma unroll
            for (int kd = 0; kd < 6; ++kd) { const bf16x8 kf = *(const bf16x8*)(F.proj + (size_t)(t0 + 32 * si + r) * PW + C_CK + h * 96 + 16 * kd + 8 * hh); X = MFMA32(kf, qf[kd], X); }
            if (si == th) {
#pragma unroll
                for (int g = 0; g < 16; ++g) if (rowidx(g, hh) > r) X[g] = 0.f; }
            pack_p(X, pf[si][0], pf[si][1]); }
        f32x16 O[3]; float sq = 0.f;
#pragma unroll
        for (int vt = 0; vt < 3; ++vt) { const int vtile = vh * 3 + vt; f32x16 acc = {};
#pragma unroll
            for (int si = 0; si < 2; ++si) if (si <= th) {
#pragma unroll
                for (int s2 = 0; s2 < 2; ++s2) { const bf16x8 vf = frag_tr((lds_cptr)(VV + ui * 25600), 400, 32 * si + 16 * s2, 32 * vtile, F.lane); acc = MFMA32(vf, pf[si][s2], acc); } }
#pragma unroll
            for (int kd = 0; kd < 6; ++kd) { const bf16x8 sf = *(const bf16x8*)(F.st + ((size_t)(n * 4 + h) * 192 + 32 * vtile + r) * 96 + 16 * kd + 8 * hh); acc = MFMA32(sf, qf[kd], acc); }
#pragma unroll
            for (int g = 0; g < 16; ++g) sq += acc[g] * acc[g];
            O[vt] = acc; }
        sq += __shfl_xor(sq, 32);
        if (hh == 0) SSQ[(ui * 2 + vh) * 64 + tq] = sq;
        __syncthreads();
        const float rs = rsqrtf((SSQ[(ui * 2) * 64 + tq] + SSQ[(ui * 2 + 1) * 64 + tq]) * (1.f / 192.f) + EPS);
#pragma unroll
        for (int vt = 0; vt < 3; ++vt)
#pragma unroll
            for (int i = 0; i < 4; ++i) { const int v = 32 * (vh * 3 + vt) + 8 * i + 4 * hh;
                const u32x2 zw = *(const u32x2*)(F.proj + (size_t)(t0 + tq) * PW + C_CZ + h * 192 + v); const f32x4 gg = *(const f32x4*)(gain + v);
                const float y0 = O[vt][4 * i] * rs * gg.x * silu(blo(zw.x)), y1 = O[vt][4 * i + 1] * rs * gg.y * silu(bhi(zw.x)), y2 = O[vt][4 * i + 2] * rs * gg.z * silu(blo(zw.y)), y3 = O[vt][4 * i + 3] * rs * gg.w * silu(bhi(zw.y));
                u32x2 ov; ov.x = pk2(y0, y1); ov.y = pk2(y2, y3); *(u32x2*)(F.mixed + (size_t)(t0 + tq) * DM + 1280 + h * 192 + v) = ov; }
        __syncthreads();
    }
    const int NT = F.G * 512, gt = F.bid * 512 + F.tid;
    for (int idx = gt; idx < SEQ * 96; idx += NT) { const int t = idx / 96, c = (idx % 96) * 8, a = c >> 6;
        float o[8] = {0.f, 0.f, 0.f, 0.f, 0.f, 0.f, 0.f, 0.f}; float lsum = 0.f;
#pragma unroll
        for (int n = 0; n < 3; ++n) { const u32x4 wv = *(const u32x4*)(F.oa + ((size_t)n * SEQ + t) * 768 + c); lsum += F.la[((size_t)n * SEQ + t) * 12 + a];
            o[0] += blo(wv.x); o[1] += bhi(wv.x); o[2] += blo(wv.y); o[3] += bhi(wv.y); o[4] += blo(wv.z); o[5] += bhi(wv.z); o[6] += blo(wv.w); o[7] += bhi(wv.w); }
        const float il = 1.f / lsum; const u32x4 zw = *(const u32x4*)(F.proj + (size_t)t * PW + C_AZ + c);
        u32x4 ov; ov.x = pk2(o[0] * il * silu(blo(zw.x)), o[1] * il * silu(bhi(zw.x))); ov.y = pk2(o[2] * il * silu(blo(zw.y)), o[3] * il * silu(bhi(zw.y)));
        ov.z = pk2(o[4] * il * silu(blo(zw.z)), o[5] * il * silu(bhi(zw.z))); ov.w = pk2(o[6] * il * silu(blo(zw.w)), o[7] * il * silu(bhi(zw.w)));
        *(u32x4*)(F.mixed + (size_t)t * DM + c) = ov; }
    for (int idx = gt; idx < SEQ * 64; idx += NT) { const int t = idx / 64, c = (idx % 64) * 8, h = c >> 6, nseg = (t >> 11) + 1;
        f32x4 o0 = {0.f, 0.f, 0.f, 0.f}, o1 = {0.f, 0.f, 0.f, 0.f}; float lsum = 0.f;
        for (int s = 0; s < nseg; ++s) { const float* p = F.ob + ((size_t)s * SEQ + t) * 512 + c; o0 += *(const f32x4*)p; o1 += *(const f32x4*)(p + 4); lsum += F.lb[((size_t)s * SEQ + t) * 8 + h]; }
        const float il = 1.f / lsum; const u32x4 zw = *(const u32x4*)(F.proj + (size_t)t * PW + C_BZ + c);
        u32x4 ov; ov.x = pk2(o0.x * il * silu(blo(zw.x)), o0.y * il * silu(bhi(zw.x))); ov.y = pk2(o0.z * il * silu(blo(zw.y)), o0.w * il * silu(bhi(zw.y)));
        ov.z = pk2(o1.x * il * silu(blo(zw.z)), o1.y * il * silu(bhi(zw.z))); ov.w = pk2(o1.z * il * silu(blo(zw.w)), o1.w * il * silu(bhi(zw.w)));
        *(u32x4*)(F.mixed + (size_t)t * DM + 768 + c) = ov; }
}

#define LAS __attribute__((address_space(3)))
#define XB_TMO      128
#define XB_XCNT(j)  (256  + 64 * (j))
#define XB_XSUB(j)  (1280 + 64 * (j))
#define XB_XGEN(j)  (2304 + 64 * (j))
#define XB_TOP      3328
#define XB_TOPGEN   3392
#define XCD_BAR_WORDS 3456
#define XB_SPIN_CAP (1u << 18)

__device__ __forceinline__ unsigned xb_ld(unsigned* p)              { return __hip_atomic_load(p, __ATOMIC_RELAXED, __HIP_MEMORY_SCOPE_AGENT); }
__device__ __forceinline__ unsigned xb_add(unsigned* p, unsigned v) { return __hip_atomic_fetch_add(p, v, __ATOMIC_RELAXED, __HIP_MEMORY_SCOPE_AGENT); }
__device__ __forceinline__ unsigned xb_xcc_id() { return (unsigned)__builtin_amdgcn_s_getreg((3 << 11) | 20) & 0xFu; }
#define XB_SPIN(cond, bar) do { unsigned _sp = 0; while (cond) { __builtin_amdgcn_s_sleep(1); \
    if ((++_sp & 255u) == 0u) { if (xb_ld(&(bar)[XB_TMO])) break; if (_sp > XB_SPIN_CAP) { atomicAdd(&(bar)[XB_TMO], 1u); break; } } } } while (0)

struct XcdBarrier {
    unsigned* bar; unsigned x;
    volatile LAS unsigned* st;
};

__device__ __forceinline__ XcdBarrier xcd_barrier_post(unsigned* bar, volatile LAS unsigned* st) {
    XcdBarrier b; b.bar = bar; b.x = xb_xcc_id(); b.st = st;
    if (threadIdx.x == 0) (void)xb_add(&bar[XB_XCNT(b.x)], 1u);
    return b;
}
__device__ __forceinline__ void xcd_barrier_complete(unsigned* bar, unsigned x, unsigned& nloc, unsigned& nx) {
    const unsigned G = gridDim.x * gridDim.y * gridDim.z;
    unsigned sum, cnt, mine, sp = 0u;
    for (;;) {
        sum = 0u; cnt = 0u; mine = 0u;
#pragma unroll
        for (unsigned j = 0; j < 16; ++j) { const unsigned c = xb_ld(&bar[XB_XCNT(j)]); sum += c; cnt += (c > 0u) ? 1u : 0u; mine = (j == x) ? c : mine; }
        if (sum == G) break;
        __builtin_amdgcn_s_sleep(1);
        if ((++sp & 255u) == 0u) { if (xb_ld(&bar[XB_TMO])) break; if (sp > XB_SPIN_CAP) { atomicAdd(&bar[XB_TMO], 1u); break; } }
    }
    nloc = mine > 0u ? mine : 1u; nx = cnt > 0u ? cnt : 1u;
}

__device__ __forceinline__ void xcd_barrier(const XcdBarrier& b) {
    asm volatile("s_waitcnt vmcnt(0)" ::: "memory");
    __syncthreads();
    if (threadIdx.x == 0) {
        unsigned* bar = b.bar;
        __builtin_amdgcn_s_waitcnt(0);
        unsigned nloc = b.st[0], nx = b.st[1];
        if (nloc == 0u) { xcd_barrier_complete(bar, b.x, nloc, nx); b.st[0] = nloc; b.st[1] = nx; }
        const unsigned old = xb_add(&bar[XB_XSUB(b.x)], 1u);
        const unsigned gen = old / nloc;
        if (old + 1u == (gen + 1u) * nloc) {
            __builtin_amdgcn_fence(__ATOMIC_RELEASE, "agent");
            asm volatile("s_waitcnt vmcnt(0)" ::: "memory");
            const unsigned og = xb_add(&bar[XB_TOP], 1u);
            const unsigned tg = og / nx;
            if (og + 1u == (tg + 1u) * nx) xb_add(&bar[XB_TOPGEN], 1u);
            else XB_SPIN(xb_ld(&bar[XB_TOPGEN]) == tg, bar);
            __builtin_amdgcn_fence(__ATOMIC_ACQUIRE, "agent");
            xb_add(&bar[XB_XGEN(b.x)], 1u);
            asm volatile("s_waitcnt vmcnt(0)" ::: "memory");
        } else {
            XB_SPIN(xb_ld(&bar[XB_XGEN(b.x)]) == gen, bar);
            __builtin_amdgcn_fence(__ATOMIC_ACQUIRE, "agent");
            asm volatile("s_waitcnt vmcnt(0)" ::: "memory");
        }
    }
    __syncthreads();
}

struct Args { const float* in[12]; float* out; unsigned char* ws; int ph_lo, ph_hi; };
constexpr int N_PHASES = 1 + 5 * NLAYER;
__global__ void __launch_bounds__(512, 2) mega_fwd(Args args) {
    extern __shared__ __attribute__((aligned(16))) unsigned char lds[];
    Ctx F;
    F.x = args.in[0]; F.norm_g = args.in[1]; F.w_in = args.in[2]; F.aqg = args.in[3]; F.akg = args.in[4]; F.bqg = args.in[5]; F.bkg = args.in[6];
    F.fox_bias = args.in[7]; F.gate_up = args.in[8]; F.gate_bias = args.in[9]; F.out_gain = args.in[10]; F.w_out = args.in[11];
    F.out = args.out; F.ws = args.ws; unsigned char* ws = args.ws;
    F.ctl = (unsigned*)(ws + WS_CTL); F.ss = (unsigned long long*)(ws + WS_SS); F.wtin = (bf16*)(ws + WS_WTIN); F.wtout = (bf16*)(ws + WS_WTOUT); F.xb = (bf16*)(ws + WS_XB);
    F.proj = (bf16*)(ws + WS_PROJ); F.small = (float*)(ws + WS_SMALL); F.mixed = (bf16*)(ws + WS_MIXED); F.oa = (bf16*)(ws + WS_OA); F.la = (float*)(ws + WS_LA);
    F.ob = (float*)(ws + WS_OB); F.lb = (float*)(ws + WS_LB); F.cl = (float*)(ws + WS_CL); F.bt = (float*)(ws + WS_BT); F.ds = (float*)(ws + WS_DS); F.st = (bf16*)(ws + WS_ST); F.dec = (float*)(ws + WS_DEC);
    F.lds = lds; F.tid = threadIdx.x; F.lane = F.tid & 63; F.wave = __builtin_amdgcn_readfirstlane(F.tid >> 6); F.G = gridDim.x; F.bid = blockIdx.x;
    cg::grid_group grid = cg::this_grid();
    if (threadIdx.x < 8) ((volatile LAS unsigned*)((LAS unsigned char*)lds + MISC_OFF))[threadIdx.x] = 0u;
    __syncthreads();
    XcdBarrier bar = xcd_barrier_post((unsigned*)(ws + WS_CTL) + 4096, (volatile LAS unsigned*)((LAS unsigned char*)lds + MISC_OFF));
    const int lo = args.ph_lo, hi = args.ph_hi;
#define IN(k) (lo <= (k) && (k) < hi)
#define RELAUNDER() do { int t_ = threadIdx.x; asm volatile("" : "+v"(t_)); F.tid = t_; F.lane = t_ & 63; F.wave = __builtin_amdgcn_readfirstlane(t_ >> 6); } while (0)
#define SEAM(k) do { if (IN(k) && IN((k) + 1)) { if ((k) == 0) grid.sync(); else xcd_barrier(bar); } } while (0)
    if (IN(0)) { RELAUNDER(); phase0(F); }
    SEAM(0);
    for (int l = 0; l < NLAYER; ++l) { const int pb = 1 + 5 * l;
        if (IN(pb)) { pg8::Gemm g{F.xb, F.wtin + (size_t)l * NPAD * DM, SEQ, NPAD, DM}; pg8::StaticOrder S; S.init(SEQ, NPAD, F.G, F.bid);
            pg8::EpiProj E{F.proj, F.small, F.ss + l * SEQ};
            pg8::gemm_phase<pg8::EpiProj, pg8::StaticOrder, true, true>((PG8_LAS unsigned char*)lds, g, S, E); __syncthreads(); }
        SEAM(pb);
        if (IN(pb + 1)) { RELAUNDER(); phase2(F, l); }
        SEAM(pb + 1);
        if (IN(pb + 2)) { RELAUNDER(); phase3(F, l); }
        SEAM(pb + 2);
        if (IN(pb + 3)) { RELAUNDER(); phase4(F, l); }
        SEAM(pb + 3);
        if (IN(pb + 4)) { pg8::Gemm g{F.mixed, F.wtout + (size_t)l * DM * DM, SEQ, DM, DM}; pg8::StaticOrder S; S.init(SEQ, DM, F.G, F.bid);
            const bool last = (l == NLAYER - 1);
            pg8::EpiOut E{l == 0 ? F.x : F.out, F.out, last ? nullptr : F.xb, last ? nullptr : F.ss + (l + 1) * SEQ};
            pg8::gemm_phase<pg8::EpiOut, pg8::StaticOrder, true, true>((PG8_LAS unsigned char*)lds, g, S, E); __syncthreads(); }
        SEAM(pb + 4);
    }
#undef IN
#undef SEAM
}

#ifndef MK_ONE_LAUNCH
#define MK_ONE_LAUNCH 1
#endif
extern "C" void kernel_launch(void* const* d_in, const int* in_sizes, int n_in, void* d_out, int out_size, void* d_ws, size_t ws_size, hipStream_t stream) {
    static int grid = 0;
    if (grid == 0) {
        int dev = 0, cus = 0, per_cu = 0;
        hipGetDevice(&dev); hipDeviceGetAttribute(&cus, hipDeviceAttributeMultiprocessorCount, dev);
        hipFuncSetAttribute((const void*)mega_fwd, hipFuncAttributeMaxDynamicSharedMemorySize, LDS_BYTES);
        hipOccupancyMaxActiveBlocksPerMultiprocessor(&per_cu, mega_fwd, 512, LDS_BYTES);
        grid = cus * per_cu; if (grid <= 0) grid = 256;
        if (ws_size < WS_END) { fprintf(stderr, "workspace too small: %zu < %zu\n", ws_size, (size_t)WS_END); }
    }
    Args a{}; for (int i = 0; i < 12; ++i) a.in[i] = (const float*)d_in[i]; a.out = (float*)d_out; a.ws = (unsigned char*)d_ws;
#if MK_ONE_LAUNCH
    a.ph_lo = 0; a.ph_hi = N_PHASES; void* kargs[] = {&a};
    (void)hipMemsetAsync(d_ws, 0, 65536, stream);
    hipError_t e = hipLaunchCooperativeKernel((const void*)mega_fwd, dim3(grid), dim3(512), kargs, LDS_BYTES, stream);
    if (e != hipSuccess) fprintf(stderr, "cooperative launch failed: %s (grid %d)\n", hipGetErrorString(e), grid);
#else
    for (int p = 0; p < N_PHASES; ++p) { a.ph_lo = p; a.ph_hi = p + 1; hipLaunchKernelGGL(mega_fwd, dim3(grid), dim3(512), LDS_BYTES, stream, a); }
#endif
}
```

```cpp
#include <hip/hip_runtime.h>
#include <hip/hip_cooperative_groups.h>
#include <cstdio>
#include <cstdint>
namespace cg = cooperative_groups;
namespace pg8 {
#define PG8_LAS __attribute__((address_space(3)))
typedef unsigned short bf16_t;
typedef short bf16x8 __attribute__((ext_vector_type(8)));
typedef float f32x4 __attribute__((ext_vector_type(4)));
typedef unsigned u32x4 __attribute__((ext_vector_type(4)));
constexpr int BM = 256, BK = 64, HALF = 128, HTB = HALF * BK * 2  , STAGE_BYTES = 8 * HTB, NXCD = 8, WGM = 8;

__host__ __device__ __forceinline__ int lds_byte(int r, int c) { const int st = (r >> 4) * 2 + (c >> 5), rr = r & 15, cc = c & 31, ob = rr * 64 + cc * 2; return st * 1024 + (ob ^ (((ob >> 9) & 1) << 5)); }
__host__ __device__ __forceinline__ void stage_rc(int b, int& R, int& C) { const int st = b / 1024, sb = b % 1024, swz = sb ^ (((sb >> 9) & 1) << 5); R = (st >> 1) * 16 + swz / 64; C = (st & 1) * 32 + (swz % 64) / 2; }
__host__ __device__ __forceinline__ int perm32(int rho) { const int n = rho >> 4, i = rho & 15; return 8 * (i >> 2) + 4 * n + (i & 3); }

struct Unit { int pm, pn; };
struct Gemm { const bf16_t* A; const bf16_t* Bt; int M, N, K; };

struct StaticOrder {
    int nM, nN, nwg, G, c;
    __host__ __device__ void init(int M, int N, int G_, int c_) { nM = M / BM; nN = N / BM; nwg = nM * nN; G = G_; c = c_; }
    __host__ __device__ bool next(int i, Unit& u) const {
        const long L = (long)i * G + c; if (L >= nwg) return false;
        int wgid = (int)L; { const int q = nwg / NXCD, r = nwg % NXCD, xcd = wgid % NXCD, off = wgid / NXCD; wgid = (xcd < r ? xcd * (q + 1) : r * (q + 1) + (xcd - r) * q) + off; }
        const int nig = WGM * nN, gid = wgid / nig, fm = gid * WGM, gsz = (nM - fm) < WGM ? (nM - fm) : WGM;
        u.pm = fm + ((wgid % nig) % gsz); u.pn = (wgid % nig) / gsz; return true;
    }
    __device__ __forceinline__ void a_ready(const Unit&) const {}
    __device__ __forceinline__ void done(const Unit&) const {}
};

__device__ __forceinline__ unsigned cvt_pk_bf16(float lo, float hi) { unsigned r; asm volatile("v_cvt_pk_bf16_f32 %0, %1, %2" : "=v"(r) : "v"(lo), "v"(hi)); return r; }
typedef float f32x2 __attribute__((ext_vector_type(2)));
constexpr int PROJ_W = 7424;
struct EpiProj {
    static constexpr bool PERM = true, AFTER_DRAIN = false;
    bf16_t* O; float* small; const unsigned long long* ss; float* xch; const float* gaq; const float* gak; const float* gbq; const float* gbk;
    __device__ __forceinline__ void operator()(const f32x4 (&acc)[2][2][4][2], const Unit& u, int wr, int wc, int fr, int fq) const {
        const int row0 = u.pm * BM + wr * 64 + fr;
        if (u.pn < 29) {
            const int col0 = u.pn * BM + wc * 32 + 8 * fq;
            const bool isA = u.pn < 6, isB = (u.pn >= 12 && u.pn < 16);
            if (isA || isB) {
#pragma unroll
                for (int ai = 0; ai < 2; ++ai)
#pragma unroll
                    for (int m = 0; m < 4; ++m) { const int row = row0 + ai * HALF + m * 16; const float rs = rsqrtf((float)ss[row] * (1.0f / 1048576.0f / 2048.0f) + 1e-6f);
#pragma unroll
                        for (int bj = 0; bj < 2; ++bj) { const f32x4 v0 = acc[ai][bj][m][0] * rs, v1 = acc[ai][bj][m][1] * rs;
                            float sq = (v0[0] * v0[0] + v0[1] * v0[1]) + (v0[2] * v0[2] + v0[3] * v0[3]) + (v1[0] * v1[0] + v1[1] * v1[1]) + (v1[2] * v1[2] + v1[3] * v1[3]);
                            sq += __shfl_xor(sq, 16); sq += __shfl_xor(sq, 32);
                            if (fq == 0) xch[((ai * HALF + wr * 64 + m * 16 + fr) * 2 + bj) * 4 + wc] = sq; } }
                asm volatile("s_waitcnt lgkmcnt(0)" ::: "memory"); __builtin_amdgcn_s_barrier(); asm volatile("" ::: "memory");
                const bool isq = (u.pn < 3) || (u.pn == 12) || (u.pn == 13);
                const float* ga0 = gaq; const float* ga1 = gak; const float* gb0 = gbq; const float* gb1 = gbk;
                const float* gsel = isA ? ga0 : gb0; { const float* gk = isA ? ga1 : gb1; if (!isq) gsel = gk; }
                const float* g = gsel + 32 * (wc & 1) + 8 * fq;
                const float sc = isq ? 0.18033688011112042f : 1.0f;
                const f32x4 g0 = *(const f32x4*)g * sc, g1 = *(const f32x4*)(g + 4) * sc;
#pragma unroll
                for (int ai = 0; ai < 2; ++ai)
#pragma unroll
                    for (int m = 0; m < 4; ++m) { const int row = row0 + ai * HALF + m * 16; bf16_t* rowp = O + (size_t)row * PROJ_W + col0;
                        const float rs = rsqrtf((float)ss[row] * (1.0f / 1048576.0f / 2048.0f) + 1e-6f);
#pragma unroll
                        for (int bj = 0; bj < 2; ++bj) { const float* xp = xch + ((ai * HALF + wr * 64 + m * 16 + fr) * 2 + bj) * 4 + (wc & 2); const float tot = xp[0] + xp[1];
                            const float r2 = rsqrtf(tot * (1.0f / 64.0f) + 1e-6f) * rs;
                            const f32x4 v0 = acc[ai][bj][m][0] * r2 * g0, v1 = acc[ai][bj][m][1] * r2 * g1;
                            u32x4 w; w.x = cvt_pk_bf16(v0[0], v0[1]); w.y = cvt_pk_bf16(v0[2], v0[3]); w.z = cvt_pk_bf16(v1[0], v1[1]); w.w = cvt_pk_bf16(v1[2], v1[3]);
                            *(u32x4*)(rowp + bj * HALF) = w; } }
            } else {
#pragma unroll
            for (int ai = 0; ai < 2; ++ai)
#pragma unroll
                for (int m = 0; m < 4; ++m) { const int row = row0 + ai * HALF + m * 16; const float rs = rsqrtf((float)ss[row] * (1.0f / 1048576.0f / 2048.0f) + 1e-6f);
                    bf16_t* rowp = O + (size_t)row * PROJ_W + col0;
#pragma unroll
                    for (int bj = 0; bj < 2; ++bj) { const f32x4 v0 = acc[ai][bj][m][0] * rs, v1 = acc[ai][bj][m][1] * rs;
                        u32x4 w; w.x = cvt_pk_bf16(v0[0], v0[1]); w.y = cvt_pk_bf16(v0[2], v0[3]); w.z = cvt_pk_bf16(v1[0], v1[1]); w.w = cvt_pk_bf16(v1[2], v1[3]);
                        *(u32x4*)(rowp + bj * HALF) = w; } }
            }
        } else if (wc == 0) {
#pragma unroll
            for (int ai = 0; ai < 2; ++ai)
#pragma unroll
                for (int m = 0; m < 4; ++m) { const int row = row0 + ai * HALF + m * 16; const float rs = rsqrtf((float)ss[row] * (1.0f / 1048576.0f / 2048.0f) + 1e-6f);
                    float* p = small + (size_t)row * 32 + 8 * fq;
                    *(f32x4*)p = acc[ai][0][m][0] * rs; *(f32x4*)(p + 4) = acc[ai][0][m][1] * rs; }
        }
    }
};
struct EpiOut {
    static constexpr bool PERM = true, AFTER_DRAIN = false;
    const float* xin; float* out; bf16_t* xb; unsigned long long* ssn;
    __device__ __forceinline__ void operator()(const f32x4 (&acc)[2][2][4][2], const Unit& u, int wr, int wc, int fr, int fq) const {
        const int row0 = u.pm * BM + wr * 64 + fr, col0 = u.pn * BM + wc * 32 + 8 * fq;
#pragma unroll
        for (int ai = 0; ai < 2; ++ai)
#pragma unroll
            for (int m = 0; m < 4; ++m) { const int row = row0 + ai * HALF + m * 16; float sq = 0.f;
#pragma unroll
                for (int bj = 0; bj < 2; ++bj) { const size_t p = (size_t)row * 2048 + col0 + bj * HALF;
                    const f32x4 a = *(const f32x4*)(xin + p) + acc[ai][bj][m][0], b = *(const f32x4*)(xin + p + 4) + acc[ai][bj][m][1];
                    *(f32x4*)(out + p) = a; *(f32x4*)(out + p + 4) = b;
                    if (xb) { u32x4 w; w.x = cvt_pk_bf16(a[0], a[1]); w.y = cvt_pk_bf16(a[2], a[3]); w.z = cvt_pk_bf16(b[0], b[1]); w.w = cvt_pk_bf16(b[2], b[3]); *(u32x4*)(xb + p) = w; }
                    sq += (a[0] * a[0] + a[1] * a[1]) + (a[2] * a[2] + a[3] * a[3]) + (b[0] * b[0] + b[1] * b[1]) + (b[2] * b[2] + b[3] * b[3]); }
                sq += __shfl_xor(sq, 16); sq += __shfl_xor(sq, 32);
                if (fq == 0 && ssn) atomicAdd(ssn + row, (unsigned long long)(sq * 1048576.0f + 0.5f)); }
    }
};
template <class Epi, class Sched, bool ALIGN_EPI = false, bool SP2 = false>
__device__ __forceinline__ void gemm_phase(PG8_LAS unsigned char* lds, const Gemm g, const Sched& S, const Epi& E) {
    int tid_ = threadIdx.x; asm volatile("" : "+v"(tid_)); const int tid = tid_, wid = __builtin_amdgcn_readfirstlane(tid >> 6), lane = tid & 63, wr = wid >> 2, wc = wid & 3, fr = lane & 15, fq = lane >> 4;
    const int K = g.K, nt = K / BK;
    unsigned voffA[2], voffB[2];
#pragma unroll
    for (int i = 0; i < 2; ++i) { int R, C; stage_rc(tid * 16 + i * 8192, R, C); const int Rb = Epi::PERM ? ((R & ~31) + perm32(R & 31)) : R;
        voffA[i] = (unsigned)(R * K + C) * 2u; voffB[i] = (unsigned)(Rb * K + C) * 2u; }
    const size_t kstep = (size_t)(BK * 2);
    const size_t hstep = (size_t)HALF * K * 2;
    const size_t tstep = 2 * hstep;
    const unsigned ldsw = (unsigned)wid * 1024u;
    const int aoff = lds_byte(wr * 64 + fr, fq * 8), boff = lds_byte(wc * 32 + fr, fq * 8);
#define PG8_SA(b, h) (((b) * 2 + (h)) * HTB)
#define PG8_SB(b, h) ((4 + (b) * 2 + (h)) * HTB)
#define PG8_STAGE(bufoff, gbase, voff) do { _Pragma("unroll") for (int _i = 0; _i < 2; ++_i) \
        __builtin_amdgcn_global_load_lds((const unsigned*)((const char*)(gbase) + (voff)[_i]), (PG8_LAS unsigned*)(lds + (bufoff) + ldsw + _i * 8192), 16, 0, 0); } while (0)
#define PG8_LDA(dst, b, h) do { _Pragma("unroll") for (int m = 0; m < 4; ++m) _Pragma("unroll") for (int k = 0; k < 2; ++k) dst[m][k] = *(const PG8_LAS bf16x8*)(lds + PG8_SA(b, h) + aoff + m * 2048 + k * 1024); } while (0)
#define PG8_LDB(dst, b, h) do { _Pragma("unroll") for (int n = 0; n < 2; ++n) _Pragma("unroll") for (int k = 0; k < 2; ++k) dst[n][k] = *(const PG8_LAS bf16x8*)(lds + PG8_SB(b, h) + boff + n * 2048 + k * 1024); } while (0)
#define PG8_MMA(ai, bj, At, Bt) do { __builtin_amdgcn_s_setprio(1); _Pragma("unroll") for (int m = 0; m < 4; ++m) _Pragma("unroll") for (int n = 0; n < 2; ++n) _Pragma("unroll") for (int k = 0; k < 2; ++k) \
        acc[ai][bj][m][n] = __builtin_amdgcn_mfma_f32_16x16x32_bf16(Bt[n][k], At[m][k], acc[ai][bj][m][n], 0, 0, 0); __builtin_amdgcn_s_setprio(0); } while (0)
#define PG8_WAIT_V(n) asm volatile("s_waitcnt vmcnt(" #n ")" ::: "memory")
#define PG8_WAIT_L(n) asm volatile("s_waitcnt lgkmcnt(" #n ")" ::: "memory")
#define PG8_BAR __builtin_amdgcn_s_barrier()
#define PG8_SCHED __builtin_amdgcn_sched_barrier(0)
    Unit cur, nxt; int ui = 0;
    if (!S.next(0, cur)) return;
    f32x4 acc[2][2][4][2];
#pragma unroll
    for (int a = 0; a < 2; ++a)
#pragma unroll
        for (int b = 0; b < 2; ++b)
#pragma unroll
            for (int m = 0; m < 4; ++m)
#pragma unroll
                for (int n = 0; n < 2; ++n) acc[a][b][m][n] = (f32x4){0.f, 0.f, 0.f, 0.f};
    bf16x8 At[4][2], B0[2][2], B1[2][2];
    const char* cA = (const char*)g.A + (size_t)cur.pm * tstep; const char* cB = (const char*)g.Bt + (size_t)cur.pn * tstep;
    S.a_ready(cur);
    if constexpr (SP2) {
        PG8_STAGE(PG8_SB(0, 0), cB, voffB); PG8_STAGE(PG8_SB(0, 1), cB + hstep, voffB); PG8_STAGE(PG8_SA(0, 0), cA, voffA); PG8_STAGE(PG8_SA(0, 1), cA + hstep, voffA);
        if (wr == 1) PG8_BAR;
        PG8_WAIT_V(2); PG8_BAR;
        PG8_STAGE(PG8_SB(1, 0), cB + kstep, voffB); PG8_STAGE(PG8_SA(1, 0), cA + kstep, voffA); PG8_STAGE(PG8_SB(1, 1), cB + hstep + kstep, voffB);
        PG8_WAIT_V(6); PG8_BAR;
    } else {
        PG8_STAGE(PG8_SB(0, 0), cB, voffB); PG8_STAGE(PG8_SA(0, 0), cA, voffA); PG8_STAGE(PG8_SB(0, 1), cB + hstep, voffB); PG8_STAGE(PG8_SA(0, 1), cA + hstep, voffA);
        if (wr == 1) PG8_BAR;
        PG8_WAIT_V(4); PG8_BAR;
        PG8_STAGE(PG8_SB(1, 0), cB + kstep, voffB); PG8_STAGE(PG8_SA(1, 0), cA + kstep, voffA); PG8_STAGE(PG8_SB(1, 1), cB + hstep + kstep, voffB);
        PG8_WAIT_V(6); PG8_BAR;
    }
    for (;;) {
        const bool has_next = S.next(ui + 1, nxt);
        const char* nA = has_next ? (const char*)g.A + (size_t)nxt.pm * tstep : cA; const char* nB = has_next ? (const char*)g.Bt + (size_t)nxt.pn * tstep : cB;
        for (int t = 0; t < nt; t += 2) {
            const bool last = (t == nt - 2);
            const char* a1 = cA + (size_t)(t + 1) * kstep;
            const char* a2 = last ? nA : cA + (size_t)(t + 2) * kstep; const char* b2 = last ? nB : cB + (size_t)(t + 2) * kstep;
            const char* a3 = a2 + kstep; const char* b3 = b2 + kstep;
            if (last && has_next) S.a_ready(nxt);
            if constexpr (SP2) {
            PG8_LDB(B0, 0, 0); PG8_LDB(B1, 0, 1); PG8_SCHED; PG8_LDA(At, 0, 0); PG8_STAGE(PG8_SA(1, 1), a1 + hstep, voffA);
            PG8_WAIT_V(8); PG8_WAIT_L(0); PG8_BAR; PG8_MMA(0, 0, At, B0); PG8_MMA(0, 1, At, B1); PG8_BAR; PG8_SCHED;
            PG8_LDA(At, 0, 1); PG8_STAGE(PG8_SB(0, 0), b2, voffB); PG8_STAGE(PG8_SB(0, 1), b2 + hstep, voffB); PG8_STAGE(PG8_SA(0, 0), a2, voffA);
            PG8_WAIT_V(8); PG8_WAIT_L(0); PG8_BAR; PG8_MMA(1, 0, At, B0); PG8_MMA(1, 1, At, B1); PG8_BAR; PG8_SCHED;
            PG8_LDB(B0, 1, 0); PG8_LDB(B1, 1, 1); PG8_SCHED; PG8_LDA(At, 1, 0); PG8_STAGE(PG8_SA(0, 1), a2 + hstep, voffA);
            PG8_WAIT_V(8); PG8_WAIT_L(0); PG8_BAR; PG8_MMA(0, 0, At, B0); PG8_MMA(0, 1, At, B1); PG8_BAR; PG8_SCHED;
            PG8_LDA(At, 1, 1); PG8_STAGE(PG8_SB(1, 0), b3, voffB); PG8_STAGE(PG8_SB(1, 1), b3 + hstep, voffB); PG8_STAGE(PG8_SA(1, 0), a3, voffA);
            PG8_WAIT_V(8); PG8_WAIT_L(0); PG8_BAR; PG8_MMA(1, 0, At, B0); PG8_MMA(1, 1, At, B1); PG8_BAR; PG8_SCHED;
            } else {
            PG8_LDB(B0, 0, 0); PG8_SCHED; PG8_LDA(At, 0, 0); PG8_STAGE(PG8_SA(1, 1), a1 + hstep, voffA);
            PG8_WAIT_L(8); PG8_BAR; PG8_WAIT_L(0); PG8_MMA(0, 0, At, B0); PG8_BAR; PG8_SCHED;
            PG8_LDB(B1, 0, 1); PG8_STAGE(PG8_SB(0, 0), b2, voffB);
            PG8_BAR; PG8_WAIT_L(0); PG8_MMA(0, 1, At, B1); PG8_BAR;
            PG8_LDA(At, 0, 1); PG8_STAGE(PG8_SA(0, 0), a2, voffA);
            PG8_BAR; PG8_WAIT_L(0); PG8_MMA(1, 0, At, B0); PG8_BAR; PG8_SCHED;
            PG8_STAGE(PG8_SB(0, 1), b2 + hstep, voffB);
            PG8_WAIT_V(6); PG8_BAR; PG8_MMA(1, 1, At, B1); PG8_BAR;
            PG8_LDB(B0, 1, 0); PG8_SCHED; PG8_LDA(At, 1, 0); PG8_STAGE(PG8_SA(0, 1), a2 + hstep, voffA);
            PG8_WAIT_L(8); PG8_BAR; PG8_WAIT_L(0); PG8_MMA(0, 0, At, B0); PG8_BAR; PG8_SCHED;
            PG8_LDB(B1, 1, 1); PG8_STAGE(PG8_SB(1, 0), b3, voffB);
            PG8_BAR; PG8_WAIT_L(0); PG8_MMA(0, 1, At, B1); PG8_BAR;
            PG8_LDA(At, 1, 1); PG8_STAGE(PG8_SA(1, 0), a3, voffA);
            PG8_BAR; PG8_WAIT_L(0); PG8_MMA(1, 0, At, B0); PG8_BAR; PG8_SCHED;
            PG8_STAGE(PG8_SB(1, 1), b3 + hstep, voffB);
            PG8_WAIT_V(6); PG8_BAR; PG8_MMA(1, 1, At, B1); PG8_BAR;
            }
        }
        if constexpr (ALIGN_EPI) { if (wr == 0) PG8_BAR; }
        if constexpr (!Epi::AFTER_DRAIN) { E(acc, cur, wr, wc, fr, fq); S.done(cur); }
        if (!has_next) break;
#pragma unroll
        for (int a = 0; a < 2; ++a)
#pragma unroll
            for (int b = 0; b < 2; ++b)
#pragma unroll
                for (int m = 0; m < 4; ++m)
#pragma unroll
                    for (int n = 0; n < 2; ++n) acc[a][b][m][n] = (f32x4){0.f, 0.f, 0.f, 0.f};
        cur = nxt; cA = nA; cB = nB; ++ui;
        if constexpr (ALIGN_EPI) { if (wr == 1) PG8_BAR; }
    }
    PG8_WAIT_V(0);
    if constexpr (!ALIGN_EPI) { if (wr == 0) PG8_BAR; }
    PG8_BAR;
    if constexpr (Epi::AFTER_DRAIN) { E.fused(acc, cur, wr, wc, fr, fq, lds, wid, lane); S.done(cur); }
#undef PG8_SA
#undef PG8_SB
#undef PG8_STAGE
#undef PG8_LDA
#undef PG8_LDB
#undef PG8_MMA
#undef PG8_WAIT_V
#undef PG8_WAIT_L
#undef PG8_BAR
#undef PG8_SCHED
}
}
constexpr int SEQ = 8192, DM = 2048, NLAYER = 4, INW = 7448, NPAD = 7680, PW = pg8::PROJ_W;
constexpr int C_AQ = 0, C_AK = 768, C_AV = 1536, C_AZ = 2304, C_BQ = 3072, C_BK = 3584, C_BV = 4096, C_BZ = 4608, C_CQ = 5120, C_CK = 5504, C_CV = 5888, C_CZ = 6656;
constexpr float LOG2E = 1.4426950408889634f, QSCALE = 0.125f * 1.4426950408889634f, EPS = 1e-6f;
constexpr size_t MiB = 1u << 20;
constexpr size_t WS_CTL = 0, WS_SS = 1 * MiB, WS_WTIN = 2 * MiB, WS_WTOUT = 122 * MiB, WS_XB = 154 * MiB, WS_PROJ = 186 * MiB, WS_SMALL = 302 * MiB,
                 WS_MIXED = 304 * MiB, WS_OA = 336 * MiB, WS_LA = 372 * MiB, WS_OB = 374 * MiB, WS_LB = 438 * MiB, WS_CL = 439 * MiB, WS_BT = WS_CL + 512 * 1024,
                 WS_DS = 440 * MiB, WS_ST = 476 * MiB, WS_DEC = 494 * MiB, WS_END = 496 * MiB;
constexpr int RING_BYTES = 131072, LDS_BYTES = 147456, QSLOT_OFF = RING_BYTES + 64, MISC_OFF = RING_BYTES + 256;
constexpr int N_SCAN = 72, N_FOX = 640, N_AU = 1152, N_ITEMS = N_SCAN + N_FOX + N_AU;

typedef unsigned short bf16;
typedef short bf16x8 __attribute__((ext_vector_type(8)));
typedef short s16x4 __attribute__((ext_vector_type(4)));
typedef float f32x4 __attribute__((ext_vector_type(4)));
typedef float f32x2 __attribute__((ext_vector_type(2)));
typedef float f32x16 __attribute__((ext_vector_type(16)));
typedef unsigned u32x4 __attribute__((ext_vector_type(4)));
typedef unsigned u32x2 __attribute__((ext_vector_type(2)));
typedef __attribute__((address_space(3))) const char* lds_cptr;
#define LAS3 __attribute__((address_space(3)))

__device__ __forceinline__ float bf2f(unsigned b) { return __uint_as_float(b << 16); }
__device__ __forceinline__ unsigned pk2(float lo, float hi) { return pg8::cvt_pk_bf16(lo, hi); }
__device__ __forceinline__ float blo(unsigned w) { return __uint_as_float(w << 16); }
__device__ __forceinline__ float bhi(unsigned w) { return __uint_as_float(w & 0xffff0000u); }
__device__ __forceinline__ float logsig(float x) { return fminf(x, 0.f) - log1pf(expf(-fabsf(x))); }
__device__ __forceinline__ float silu(float x) { return x / (1.f + __expf(-x)); }
__device__ __forceinline__ s16x4 vtr(lds_cptr p) { return __builtin_bit_cast(s16x4, __builtin_amdgcn_ds_read_tr16_b64_v4i16((LAS3 s16x4*)p)); }
__device__ __forceinline__ bf16x8 frag_tr(lds_cptr img, int stride, int kbase, int m0, int lane) {
    const int i = lane & 15, g = lane >> 4;
    lds_cptr p = img + (kbase + 4 * (g >> 1) + (i >> 2)) * stride + (m0 + 16 * (g & 1) + 4 * (i & 3)) * 2;
    const s16x4 a = vtr(p), b = vtr(p + 8 * stride);
    return (bf16x8){a[0], a[1], a[2], a[3], b[0], b[1], b[2], b[3]};
}
__device__ __forceinline__ int rowidx(int reg, int hh) { return (reg & 3) + 8 * (reg >> 2) + 4 * hh; }
__device__ __forceinline__ void pack_p(const f32x16& p, bf16x8& f0, bf16x8& f1) {
    u32x4 a, b; a.x = pk2(p[0], p[1]); a.y = pk2(p[2], p[3]); a.z = pk2(p[4], p[5]); a.w = pk2(p[6], p[7]);
    b.x = pk2(p[8], p[9]); b.y = pk2(p[10], p[11]); b.z = pk2(p[12], p[13]); b.w = pk2(p[14], p[15]);
    f0 = __builtin_bit_cast(bf16x8, a); f1 = __builtin_bit_cast(bf16x8, b);
}
#define MFMA32(a, b, c) __builtin_amdgcn_mfma_f32_32x32x16_bf16((a), (b), (c), 0, 0, 0)

struct Ctx {
    const float *x, *norm_g, *w_in, *aqg, *akg, *bqg, *bkg, *fox_bias, *gate_up, *gate_bias, *out_gain, *w_out;
    float* out; unsigned char* ws;
    unsigned* ctl; unsigned long long* ss; bf16* wtin; bf16* wtout; bf16* xb; bf16* proj; float* small; bf16* mixed; bf16* oa; float* la; float* ob; float* lb; float* cl; float* bt;
    float* ds; bf16* st; float* dec;
    unsigned char* lds; int tid, lane, wave, G, bid;
};

__device__ __forceinline__ int orig_col(int np) { if (np < 5120) return np; if (np < 7424) return np + 8; if (np < 7432) return 5120 + (np - 7424); if (np < 7448) return np; return -1; }
__device__ __forceinline__ void p0_item(const float* W, int N, bf16* WT, const float* g, int mode, float* scr, int kb, int nb, int lane) {
    const int k0 = 64 * kb, n0 = 32 * nb, c4 = 4 * (lane & 7), np = n0 + c4;
    const int oc = mode ? orig_col(np) : np;
    const float cs = (mode && np >= C_CQ && np < C_CK) ? 0.10206207261596577f : 1.0f;
    f32x4 v[8];
#pragma unroll
    for (int i = 0; i < 8; ++i) { const int kk = 8 * i + (lane >> 3); v[i] = (f32x4){0.f, 0.f, 0.f, 0.f};
        if (oc >= 0) { v[i] = *(const f32x4*)(W + (size_t)(k0 + kk) * N + oc); const float sc = mode ? cs * g[k0 + kk] : 1.0f; v[i] = v[i] * sc; } }
#pragma unroll
    for (int i = 0; i < 8; ++i) { const int kk = 8 * i + (lane >> 3); float* d = scr + kk * 33 + c4; d[0] = v[i].x; d[1] = v[i].y; d[2] = v[i].z; d[3] = v[i].w; }
    __builtin_amdgcn_s_waitcnt(0); asm volatile("" ::: "memory");
    const int c = lane & 7;
#pragma unroll
    for (int j = 0; j < 4; ++j) { const int n = (lane >> 3) + 8 * j; const float* s = scr + (8 * c) * 33 + n;
        u32x4 o; o.x = pk2(s[0 * 33], s[1 * 33]); o.y = pk2(s[2 * 33], s[3 * 33]); o.z = pk2(s[4 * 33], s[5 * 33]); o.w = pk2(s[6 * 33], s[7 * 33]);
        *(u32x4*)(WT + (size_t)(n0 + n) * 2048 + k0 + 8 * c) = o; }
    __builtin_amdgcn_s_waitcnt(0); asm volatile("" ::: "memory");
}
__device__ __forceinline__ void phase0(Ctx& F) {
    float* scr = (float*)(F.lds + F.wave * 16384);
    const int gw = F.bid * 8 + F.wave, NGW = F.G * 8;
    if (F.bid == 0 && F.tid < 64) F.ctl[F.tid] = 0u;
    for (int i = F.bid * 512 + F.tid; i < 3 * SEQ; i += F.G * 512) F.ss[SEQ + i] = 0ull;
    constexpr int I_IN = 32 * 233, I_OUT = 32 * 64, I_L = I_IN + I_OUT;
    for (int it = gw; it < NLAYER * I_L; it += NGW) {
        const int l = it / I_L; int r = it % I_L;
        if (r < I_IN) p0_item(F.w_in + (size_t)l * DM * INW, INW, F.wtin + (size_t)l * NPAD * DM, F.norm_g + l * DM, 1, scr, r / 233, r % 233, F.lane);
        else { r -= I_IN; p0_item(F.w_out + (size_t)l * DM * DM, DM, F.wtout + (size_t)l * DM * DM, nullptr, 0, scr, r / 64, r % 64, F.lane); }
    }
    for (int m = gw; m < SEQ; m += NGW) {
        const f32x4* xr = (const f32x4*)(F.x + (size_t)m * DM) + F.lane; float s = 0.f; u32x2* o8 = (u32x2*)(F.xb + (size_t)m * DM) + F.lane;
#pragma unroll
        for (int j = 0; j < 8; ++j) { const f32x4 v = xr[64 * j]; s += (v.x * v.x + v.y * v.y) + (v.z * v.z + v.w * v.w); u32x2 w; w.x = pk2(v.x, v.y); w.y = pk2(v.z, v.w); o8[64 * j] = w; }
#pragma unroll
        for (int o = 1; o < 64; o <<= 1) s += __shfl_xor(s, o);
        if (F.lane == 0) F.ss[m] = (unsigned long long)(s * 1048576.0f + 0.5f);
    }
}

__device__ __forceinline__ void phase2(Ctx& F, int l) {
    { const int gw = F.bid * 8 + F.wave, NGW = F.G * 8;
      for (int wi = gw; wi < 512; wi += NGW) { const int blk = wi >> 3, h = wi & 7, t = blk * 128 + 2 * F.lane; const float fb = F.fox_bias[l * 8 + h];
        const float l0 = logsig(F.small[(size_t)t * 32 + h] + fb), l1 = logsig(F.small[(size_t)(t + 1) * 32 + h] + fb);
        float s = l0 + l1;
#pragma unroll
        for (int o = 1; o < 64; o <<= 1) { const float y = __shfl_up(s, o); if (F.lane >= o) s += y; }
        const float ex = s - (l0 + l1); F.cl[t * 8 + h] = ex + l0; F.cl[(t + 1) * 8 + h] = s; if (F.lane == 63) F.bt[blk * 8 + h] = s; } }
    { float* CR = (float*)F.lds;
      float* GT = (float*)(F.lds + 4096);
      unsigned char* KH = F.lds + 8192;
      unsigned char* VV = F.lds + 8192 + 13312;
      const float* gup = F.gate_up + (size_t)l * 16 * 384; const float* gbs = F.gate_bias + l * 384;
      for (int u = F.bid; u < 512; u += F.G) { const int h = u & 3, n = u >> 2, t0 = n * 64;
        if (F.tid < 256) *(f32x4*)(CR + F.tid * 4) = *(const f32x4*)(F.small + (size_t)(t0 + (F.tid >> 2)) * 32 + 8 + 4 * (F.tid & 3));
        for (int e = F.tid; e < 1536; e += 512) { const int row = e / 24, ch = e % 24;
            *(u32x4*)(VV + row * 400 + ch * 16) = *(const u32x4*)(F.proj + (size_t)(t0 + row) * PW + C_CV + h * 192 + ch * 8); }
        __syncthreads();
        const int d = F.tid % 96, tg = F.tid / 96;
        float bc[16];
        if (F.tid < 384) { float g[16];
#pragma unroll
            for (int r = 0; r < 16; ++r) g[r] = gup[r * 384 + h * 96 + d];
            const float gb = gbs[h * 96 + d]; float run = 0.f;
#pragma unroll
            for (int i = 0; i < 16; ++i) { const float* cr = CR + (16 * tg + i) * 16; float a = gb;
#pragma unroll
                for (int r4 = 0; r4 < 4; ++r4) { const f32x4 c = *(const f32x4*)(cr + 4 * r4); a += c.x * g[4 * r4] + c.y * g[4 * r4 + 1] + c.z * g[4 * r4 + 2] + c.w * g[4 * r4 + 3]; }
                const float ls = fminf(a, 0.f) - __logf(1.f + __expf(-fabsf(a)));
                run += ls * (1.f / 16.f); bc[i] = run; }
            GT[tg * 96 + d] = run; }
        __syncthreads();
        if (F.tid < 384) { const float g0 = GT[d], g1 = GT[96 + d], g2 = GT[192 + d], g3 = GT[288 + d];
            const float pre = (tg > 0 ? g0 : 0.f) + (tg > 1 ? g1 : 0.f) + (tg > 2 ? g2 : 0.f);
            const float bm = g0 + g1, bl = (g0 + g1) + (g2 + g3);
            bf16* qp = F.proj + (size_t)(t0 + 16 * tg) * PW + C_CQ + h * 96 + d; bf16* kp = F.proj + (size_t)(t0 + 16 * tg) * PW + C_CK + h * 96 + d;
            float qv[16], kv[16];
#pragma unroll
            for (int i = 0; i < 16; ++i) { qv[i] = bf2f(qp[(size_t)i * PW]); kv[i] = bf2f(kp[(size_t)i * PW]); }
#pragma unroll
            for (int i = 0; i < 16; ++i) { const float b = bc[i] + pre; const float eq = __expf(b - bm), ek = __expf(bm - b), eh = __expf(bl - b);
                qp[(size_t)i * PW] = (bf16)(pk2(qv[i] * eq, 0.f) & 0xffffu); kp[(size_t)i * PW] = (bf16)(pk2(kv[i] * ek, 0.f) & 0xffffu);
                *(bf16*)(KH + (16 * tg + i) * 208 + d * 2) = (bf16)(pk2(kv[i] * eh, 0.f) & 0xffffu); }
            if (tg == 0) { F.dec[(n * 4 + h) * 96 + d] = __expf(bl); F.dec[49152 + (n * 4 + h) * 96 + d] = __expf(bm); } }
        __syncthreads();
        for (int id = F.wave; id < 18; id += 8) { const int vt = id / 3, dt = id % 3; f32x16 acc = {};
#pragma unroll
            for (int s = 0; s < 4; ++s) { const bf16x8 a = frag_tr((lds_cptr)VV, 400, 16 * s, 32 * vt, F.lane), b = frag_tr((lds_cptr)KH, 208, 16 * s, 32 * dt, F.lane); acc = MFMA32(a, b, acc); }
            float* dst = F.ds + ((size_t)(n * 4 + h) * 192 + 32 * vt) * 96 + 32 * dt + (F.lane & 31);
#pragma unroll
            for (int r = 0; r < 16; ++r) dst[(size_t)rowidx(r, F.lane >> 5) * 96] = acc[r]; }
        __syncthreads(); } }
}
__device__ __forceinline__ float softmax_ref2(const float* gq, const float* gk) {
    float mq = 0.f, mk = 0.f;
    for (int i = 0; i < 64; ++i) { mq = fmaxf(mq, fabsf(gq[i])); mk = fmaxf(mk, fabsf(gk[i])); }
    return 8.25f * mq * mk * LOG2E;
}
__device__ __forceinline__ void scan_item(Ctx& F, int si) {
    const int p = si * 512 + F.tid, d = 2 * (p % 48), v = (p / 48) % 192, h = p / (48 * 192);
    float s0 = 0.f, s1 = 0.f;
#pragma unroll 8
    for (int n = 0; n < 128; ++n) { const size_t idx = ((size_t)(n * 4 + h) * 192 + v) * 96 + d; const int di = (n * 4 + h) * 96 + d;
        const f32x2 dd = *(const f32x2*)(F.ds + idx), a = *(const f32x2*)(F.dec + di), em = *(const f32x2*)(F.dec + 49152 + di);
        *(unsigned*)(F.st + idx) = pk2(em.x * s0, em.y * s1);
        s0 = a.x * s0 + dd.x; s1 = a.y * s1 + dd.y; }
}
template <int KSTR, int VSTR>
__device__ __forceinline__ void attn_sub(const unsigned char* Kt, const unsigned char* Vt, int key_row0, const bf16x8 (&qf)[4], f32x16 S, f32x16 (&o)[2], float& lsum, int lane,
                                         bool use_mask, int lo, int hi_) {
    const int r = lane & 31, hh = lane >> 5;
#pragma unroll
    for (int s = 0; s < 4; ++s) { const bf16x8 kf = *(const bf16x8*)(Kt + (key_row0 + r) * KSTR + (16 * s + 8 * hh) * 2); S = MFMA32(kf, qf[s], S); }
    if (use_mask) {
#pragma unroll
        for (int g = 0; g < 16; ++g) { const int k = rowidx(g, hh); if (k < lo || k > hi_) S[g] = -INFINITY; } }
    float acc = 0.f;
#pragma unroll
    for (int g = 0; g < 16; ++g) { S[g] = __builtin_amdgcn_exp2f(S[g]); acc += S[g]; }
    lsum += acc;
    bf16x8 p0, p1; pack_p(S, p0, p1);
#pragma unroll
    for (int dt = 0; dt < 2; ++dt) {
        const bf16x8 v0 = frag_tr((lds_cptr)Vt, VSTR, key_row0, 32 * dt, lane), v1 = frag_tr((lds_cptr)Vt, VSTR, key_row0 + 16, 32 * dt, lane);
        o[dt] = MFMA32(v0, p0, o[dt]); o[dt] = MFMA32(v1, p1, o[dt]); }
}
template <int NSUB, int KSTR, int VSTR>
__device__ __forceinline__ void attn_multi(const unsigned char* Kt, const unsigned char* Vt, int key_row0, const bf16x8 (&qf)[4], f32x16 (&S)[NSUB], f32x16 (&o)[2], float& lsum, int lane) {
    const int r = lane & 31, hh = lane >> 5;
#pragma unroll
    for (int s = 0; s < 4; ++s)
#pragma unroll
        for (int u = 0; u < NSUB; ++u) { const bf16x8 kf = *(const bf16x8*)(Kt + (key_row0 + 32 * u + r) * KSTR + (16 * s + 8 * hh) * 2); S[u] = MFMA32(kf, qf[s], S[u]); }
#pragma unroll
    for (int u = 0; u < NSUB; ++u) { float acc = 0.f;
#pragma unroll
        for (int g = 0; g < 16; ++g) { S[u][g] = __builtin_amdgcn_exp2f(S[u][g]); acc += S[u][g]; }
        lsum += acc;
        bf16x8 p0, p1; pack_p(S[u], p0, p1);
#pragma unroll
        for (int dt = 0; dt < 2; ++dt) {
            const bf16x8 v0 = frag_tr((lds_cptr)Vt, VSTR, key_row0 + 32 * u, 32 * dt, lane), v1 = frag_tr((lds_cptr)Vt, VSTR, key_row0 + 32 * u + 16, 32 * dt, lane);
            o[dt] = MFMA32(v0, p0, o[dt]); o[dt] = MFMA32(v1, p1, o[dt]); } }
}
__device__ __forceinline__ void fox_unit(Ctx& F, int l, int h, int qb, int seg) {
    constexpr int KS = 144, VS = 192, BUFB = 128 * KS, BUFV = 128 * VS;
    unsigned char* KT = F.lds; unsigned char* VT = F.lds + 2 * BUFB; float* CS = (float*)(F.lds + 2 * BUFB + 2 * BUFV); float* PEX = (float*)(F.lds + 2 * BUFB + 2 * BUFV + 1024);
    const int r = F.lane & 31, hh = F.lane >> 5, w = F.wave, t0 = 256 * qb, NT = 2 * qb + 2, ts = 16 * seg, te = (ts + 16 < NT) ? ts + 16 : NT;
    if (w == 0) { const float v = F.bt[F.lane * 8 + h]; float s = v;
#pragma unroll
        for (int o = 1; o < 64; o <<= 1) { const float y = __shfl_up(s, o); if (F.lane >= o) s += y; }
        PEX[F.lane] = s - v; }
    const float mb2 = softmax_ref2(F.bqg + l * 64, F.bkg + l * 64);
    __syncthreads();
    const int tq = t0 + 32 * w + r; const float pq0 = PEX[t0 >> 7];
    int kt0 = ts; { const float thr = -(26.f + 2.f * mb2 * (1.f / LOG2E)); while (kt0 < te && kt0 < 2 * qb && (pq0 - PEX[kt0 + 1]) < thr) ++kt0; kt0 = __builtin_amdgcn_readfirstlane(kt0); }
    const float ctq = ((PEX[tq >> 7] - pq0) + F.cl[tq * 8 + h]) * LOG2E - mb2;
    bf16x8 qf[4];
#pragma unroll
    for (int s = 0; s < 4; ++s) qf[s] = *(const bf16x8*)(F.proj + (size_t)tq * PW + C_BQ + h * 64 + 16 * s + 8 * hh);
    f32x16 o[2]; o[0] = f32x16{}; o[1] = f32x16{}; float lsum = 0.f;
    const int lrow = F.tid >> 3, lch = F.tid & 7;
    u32x4 kreg[2], vreg[2]; float creg = 0.f;
    if (kt0 < te) {
#pragma unroll
        for (int i = 0; i < 2; ++i) { const size_t g = (size_t)(128 * kt0 + 64 * i + lrow) * PW + h * 64 + lch * 8; kreg[i] = *(const u32x4*)(F.proj + g + C_BK); vreg[i] = *(const u32x4*)(F.proj + g + C_BV); }
        if (F.tid < 128) creg = ((PEX[kt0] - pq0) + F.cl[(128 * kt0 + F.tid) * 8 + h]) * LOG2E; }
    for (int kt = kt0; kt < te; ++kt) { const int buf = (kt - kt0) & 1;
#pragma unroll
        for (int i = 0; i < 2; ++i) { *(u32x4*)(KT + buf * BUFB + (64 * i + lrow) * KS + lch * 16) = kreg[i]; *(u32x4*)(VT + buf * BUFV + (64 * i + lrow) * VS + lch * 16) = vreg[i]; }
        if (F.tid < 128) CS[buf * 128 + F.tid] = creg;
        __syncthreads();
        if (kt + 1 < te) {
#pragma unroll
            for (int i = 0; i < 2; ++i) { const size_t g = (size_t)(128 * (kt + 1) + 64 * i + lrow) * PW + h * 64 + lch * 8; kreg[i] = *(const u32x4*)(F.proj + g + C_BK); vreg[i] = *(const u32x4*)(F.proj + g + C_BV); }
            if (F.tid < 128) creg = ((PEX[kt + 1] - pq0) + F.cl[(128 * (kt + 1) + F.tid) * 8 + h]) * LOG2E; }
        const unsigned char* Kb = KT + buf * BUFB; const unsigned char* Vb = VT + buf * BUFV; const float* Cb = CS + buf * 128;
        if (kt < 2 * qb) {
            f32x16 S[4];
#pragma unroll
            for (int u = 0; u < 4; ++u)
#pragma unroll
                for (int i = 0; i < 4; ++i) { const f32x4 c4 = *(const f32x4*)(Cb + 32 * u + 8 * i + 4 * hh); S[u][4 * i] = ctq - c4.x; S[u][4 * i + 1] = ctq - c4.y; S[u][4 * i + 2] = ctq - c4.z; S[u][4 * i + 3] = ctq - c4.w; }
            attn_multi<4, KS, VS>(Kb, Vb, 0, qf, S, o, lsum, F.lane);
        } else {
            const int qlo = t0 + 32 * w;
#pragma unroll
            for (int sub = 0; sub < 4; ++sub) { const int key0 = 128 * kt + 32 * sub;
                if (key0 <= qlo + 31) {
                    f32x16 S;
#pragma unroll
                    for (int i = 0; i < 4; ++i) { const f32x4 c4 = *(const f32x4*)(Cb + 32 * sub + 8 * i + 4 * hh); S[4 * i] = ctq - c4.x; S[4 * i + 1] = ctq - c4.y; S[4 * i + 2] = ctq - c4.z; S[4 * i + 3] = ctq - c4.w; }
                    attn_sub<KS, VS>(Kb, Vb, 32 * sub, qf, S, o, lsum, F.lane, key0 + 31 > qlo, 0, tq - key0); } }
        }
    }
    lsum += __shfl_xor(lsum, 32);
    float* ob = F.ob + ((size_t)seg * SEQ + tq) * 512 + h * 64 + 4 * hh;
#pragma unroll
    for (int dt = 0; dt < 2; ++dt)
#pragma unroll
        for (int i = 0; i < 4; ++i) *(f32x4*)(ob + 32 * dt + 8 * i) = (f32x4){o[dt][4 * i], o[dt][4 * i + 1], o[dt][4 * i + 2], o[dt][4 * i + 3]};
    if (hh == 0) F.lb[((size_t)seg * SEQ + tq) * 8 + h] = lsum;
    __syncthreads();
}
__device__ __forceinline__ void a_unit(Ctx& F, int l, int a, int n, int rres, int b2) {
    constexpr int KS = 144, VS = 192;
    unsigned char* KA = F.lds; unsigned char* VA = F.lds + 384 * KS;
    const int r = F.lane & 31, hh = F.lane >> 5, w = F.wave, d = (n == 0) ? 1 : (n == 1) ? 4 : 16, i0 = 256 * b2;
    for (int e = F.tid; e < 3072; e += 512) { const int j = e >> 3, ch = e & 7, idx = i0 - 128 + j; u32x4 kv = {0u, 0u, 0u, 0u}, vv = {0u, 0u, 0u, 0u};
        if (idx >= 0) { const size_t g = (size_t)(rres + d * idx) * PW + a * 64 + ch * 8; kv = *(const u32x4*)(F.proj + g + C_AK); vv = *(const u32x4*)(F.proj + g + C_AV); }
        *(u32x4*)(KA + j * KS + ch * 16) = kv; *(u32x4*)(VA + j * VS + ch * 16) = vv; }
    const int tokq = rres + d * (i0 + 32 * w + r);
    bf16x8 qf[4];
#pragma unroll
    for (int s = 0; s < 4; ++s) qf[s] = *(const bf16x8*)(F.proj + (size_t)tokq * PW + C_AQ + a * 64 + 16 * s + 8 * hh);
    const float mb2 = softmax_ref2(F.aqg + l * 64, F.akg + l * 64);
    __syncthreads();
    f32x16 o[2]; o[0] = f32x16{}; o[1] = f32x16{}; float lsum = 0.f;
    const int qj = 32 * w + r + 128;
    if (i0 != 0) {
        { f32x16 S;
#pragma unroll
          for (int g = 0; g < 16; ++g) S[g] = -mb2;
          attn_sub<KS, VS>(KA, VA, 32 * w, qf, S, o, lsum, F.lane, true, qj - 128 - 32 * w, 31); }
        { f32x16 S[3];
#pragma unroll
          for (int u = 0; u < 3; ++u)
#pragma unroll
              for (int g = 0; g < 16; ++g) S[u][g] = -mb2;
          attn_multi<3, KS, VS>(KA, VA, 32 * (w + 1), qf, S, o, lsum, F.lane); }
        { f32x16 S;
#pragma unroll
          for (int g = 0; g < 16; ++g) S[g] = -mb2;
          attn_sub<KS, VS>(KA, VA, 32 * (w + 4), qf, S, o, lsum, F.lane, true, 0, qj - 32 * (w + 4)); }
    } else
    for (int jt = w; jt < w + 5; ++jt) { const int j0 = 32 * jt;
        if (j0 + 31 < 128) continue;
        f32x16 S;
#pragma unroll
        for (int g = 0; g < 16; ++g) S[g] = -mb2;
        int lo = qj - 128 - j0; const int hi_ = qj - j0; if (128 - j0 > lo) lo = 128 - j0;
        attn_sub<KS, VS>(KA, VA, j0, qf, S, o, lsum, F.lane, true, lo, hi_); }
    lsum += __shfl_xor(lsum, 32);
    bf16* oa = F.oa + ((size_t)n * SEQ + tokq) * 768 + a * 64 + 4 * hh;
#pragma unroll
    for (int dt = 0; dt < 2; ++dt)
#pragma unroll
        for (int i = 0; i < 4; ++i) { u32x2 wv; wv.x = pk2(o[dt][4 * i], o[dt][4 * i + 1]); wv.y = pk2(o[dt][4 * i + 2], o[dt][4 * i + 3]); *(u32x2*)(oa + 32 * dt + 8 * i) = wv; }
    if (hh == 0) F.la[((size_t)n * SEQ + tokq) * 12 + a] = lsum;
    __syncthreads();
}
__device__ __forceinline__ void phase3(Ctx& F, int l) {
    volatile unsigned* slot = (volatile unsigned*)(F.lds + QSLOT_OFF);
    for (;;) {
        if (F.tid == 0) *slot = atomicAdd(F.ctl + l, 1u);
        __syncthreads();
        const int item = __builtin_amdgcn_readfirstlane((int)*slot);
        __syncthreads();
        if (item >= N_ITEMS) break;
        if (item < N_SCAN) scan_item(F, item);
        else if (item < N_SCAN + N_FOX) { int f = item - N_SCAN, ns, qhi;
            if (f < 256) { ns = 4; qhi = 31; } else if (f < 448) { f -= 256; ns = 3; qhi = 23; } else if (f < 576) { f -= 448; ns = 2; qhi = 15; } else { f -= 576; ns = 1; qhi = 7; }
            const int per = ns * 8, qb = qhi - f / per, rem = f % per;
            fox_unit(F, l, rem & 7, qb, rem >> 3); }
        else { const int au = item - N_SCAN - N_FOX, n = au / 384, rest = au % 384, a = rest >> 5, u = rest & 31;
            const int per = (n == 0) ? 32 : (n == 1) ? 8 : 2;
            a_unit(F, l, a, n, u / per, u % per); }
    }
}
__device__ __forceinline__ void phase4(Ctx& F, int l) {
    unsigned char* VV = F.lds;
    float* SSQ = (float*)(F.lds + 51200);
    const int r = F.lane & 31, hh = F.lane >> 5, w = F.wave, ui = w >> 2, th = (w >> 1) & 1, vh = w & 1;
    const float* gain = F.out_gain + l * 192;
    for (int pu = F.bid; pu < 256; pu += F.G) {
        for (int e = F.tid; e < 3072; e += 512) { const int uu = e / 1536, e2 = e % 1536, row = e2 / 24, ch = e2 % 24, u = 2 * pu + uu, h = u & 3, n = u >> 2;
            *(u32x4*)(VV + uu * 25600 + row * 400 + ch * 16) = *(const u32x4*)(F.proj + (size_t)(n * 64 + row) * PW + C_CV + h * 192 + ch * 8); }
        __syncthreads();
        const int u = 2 * pu + ui, h = u & 3, n = u >> 2, t0 = n * 64, tq = th * 32 + r;
        bf16x8 qf[6];
#pragma unroll
        for (int kd = 0; kd < 6; ++kd) qf[kd] = *(const bf16x8*)(F.proj + (size_t)(t0 + tq) * PW + C_CQ + h * 96 + 16 * kd + 8 * hh);
        bf16x8 pf[2][2];
#pragma unroll
        for (int si = 0; si < 2; ++si) if (si <= th) { f32x16 X = {};
#pragma unroll
            for (int kd = 0; kd < 6; ++kd) { const bf16x8 kf = *(const bf16x8*)(F.proj + (size_t)(t0 + 32 * si + r) * PW + C_CK + h * 96 + 16 * kd + 8 * hh); X = MFMA32(kf, qf[kd], X); }
            if (si == th) {
#pragma unroll
                for (int g = 0; g < 16; ++g) if (rowidx(g, hh) > r) X[g] = 0.f; }
            pack_p(X, pf[si][0], pf[si][1]); }
        f32x16 O[3]; float sq = 0.f;
#pragma unroll
        for (int vt = 0; vt < 3; ++vt) { const int vtile = vh * 3 + vt; f32x16 acc = {};
#pragma unroll
            for (int si = 0; si < 2; ++si) if (si <= th) {
#pragma unroll
                for (int s2 = 0; s2 < 2; ++s2) { const bf16x8 vf = frag_tr((lds_cptr)(VV + ui * 25600), 400, 32 * si + 16 * s2, 32 * vtile, F.lane); acc = MFMA32(vf, pf[si][s2], acc); } }
#pragma unroll
            for (int kd = 0; kd < 6; ++kd) { const bf16x8 sf = *(const bf16x8*)(F.st + ((size_t)(n * 4 + h) * 192 + 32 * vtile + r) * 96 + 16 * kd + 8 * hh); acc = MFMA32(sf, qf[kd], acc); }
#pragma unroll
            for (int g = 0; g < 16; ++g) sq += acc[g] * acc[g];
            O[vt] = acc; }
        sq += __shfl_xor(sq, 32);
        if (hh == 0) SSQ[(ui * 2 + vh) * 64 + tq] = sq;
        __syncthreads();
        const float rs = rsqrtf((SSQ[(ui * 2) * 64 + tq] + SSQ[(ui * 2 + 1) * 64 + tq]) * (1.f / 192.f) + EPS);
#pragma unroll
        for (int vt = 0; vt < 3; ++vt)
#pragma unroll
            for (int i = 0; i < 4; ++i) { const int v = 32 * (vh * 3 + vt) + 8 * i + 4 * hh;
                const u32x2 zw = *(const u32x2*)(F.proj + (size_t)(t0 + tq) * PW + C_CZ + h * 192 + v); const f32x4 gg = *(const f32x4*)(gain + v);
                const float y0 = O[vt][4 * i] * rs * gg.x * silu(blo(zw.x)), y1 = O[vt][4 * i + 1] * rs * gg.y * silu(bhi(zw.x)), y2 = O[vt][4 * i + 2] * rs * gg.z * silu(blo(zw.y)), y3 = O[vt][4 * i + 3] * rs * gg.w * silu(bhi(zw.y));
                u32x2 ov; ov.x = pk2(y0, y1); ov.y = pk2(y2, y3); *(u32x2*)(F.mixed + (size_t)(t0 + tq) * DM + 1280 + h * 192 + v) = ov; }
        __syncthreads();
    }
    const int NT = F.G * 512, gt = F.bid * 512 + F.tid;
    for (int idx = gt; idx < SEQ * 96; idx += NT) { const int t = idx / 96, c = (idx % 96) * 8, a = c >> 6;
        float o[8] = {0.f, 0.f, 0.f, 0.f, 0.f, 0.f, 0.f, 0.f}; float lsum = 0.f;
#pragma unroll
        for (int n = 0; n < 3; ++n) { const u32x4 wv = *(const u32x4*)(F.oa + ((size_t)n * SEQ + t) * 768 + c); lsum += F.la[((size_t)n * SEQ + t) * 12 + a];
            o[0] += blo(wv.x); o[1] += bhi(wv.x); o[2] += blo(wv.y); o[3] += bhi(wv.y); o[4] += blo(wv.z); o[5] += bhi(wv.z); o[6] += blo(wv.w); o[7] += bhi(wv.w); }
        const float il = 1.f / lsum; const u32x4 zw = *(const u32x4*)(F.proj + (size_t)t * PW + C_AZ + c);
        u32x4 ov; ov.x = pk2(o[0] * il * silu(blo(zw.x)), o[1] * il * silu(bhi(zw.x))); ov.y = pk2(o[2] * il * silu(blo(zw.y)), o[3] * il * silu(bhi(zw.y)));
        ov.z = pk2(o[4] * il * silu(blo(zw.z)), o[5] * il * silu(bhi(zw.z))); ov.w = pk2(o[6] * il * silu(blo(zw.w)), o[7] * il * silu(bhi(zw.w)));
        *(u32x4*)(F.mixed + (size_t)t * DM + c) = ov; }
    for (int idx = gt; idx < SEQ * 64; idx += NT) { const int t = idx / 64, c = (idx % 64) * 8, h = c >> 6, nseg = (t >> 11) + 1;
        f32x4 o0 = {0.f, 0.f, 0.f, 0.f}, o1 = {0.f, 0.f, 0.f, 0.f}; float lsum = 0.f;
        for (int s = 0; s < nseg; ++s) { const float* p = F.ob + ((size_t)s * SEQ + t) * 512 + c; o0 += *(const f32x4*)p; o1 += *(const f32x4*)(p + 4); lsum += F.lb[((size_t)s * SEQ + t) * 8 + h]; }
        const float il = 1.f / lsum; const u32x4 zw = *(const u32x4*)(F.proj + (size_t)t * PW + C_BZ + c);
        u32x4 ov; ov.x = pk2(o0.x * il * silu(blo(zw.x)), o0.y * il * silu(bhi(zw.x))); ov.y = pk2(o0.z * il * silu(blo(zw.y)), o0.w * il * silu(bhi(zw.y)));
        ov.z = pk2(o1.x * il * silu(blo(zw.z)), o1.y * il * silu(bhi(zw.z))); ov.w = pk2(o1.z * il * silu(blo(zw.w)), o1.w * il * silu(bhi(zw.w)));
        *(u32x4*)(F.mixed + (size_t)t * DM + 768 + c) = ov; }
}

#define LAS __attribute__((address_space(3)))
#define XB_TMO      128
#define XB_XCNT(j)  (256  + 64 * (j))
#define XB_XSUB(j)  (1280 + 64 * (j))
#define XB_XGEN(j)  (2304 + 64 * (j))
#define XB_TOP      3328
#define XB_TOPGEN   3392
#define XCD_BAR_WORDS 3456
#define XB_SPIN_CAP (1u << 18)

__device__ __forceinline__ unsigned xb_ld(unsigned* p)              { return __hip_atomic_load(p, __ATOMIC_RELAXED, __HIP_MEMORY_SCOPE_AGENT); }
__device__ __forceinline__ unsigned xb_add(unsigned* p, unsigned v) { return __hip_atomic_fetch_add(p, v, __ATOMIC_RELAXED, __HIP_MEMORY_SCOPE_AGENT); }
__device__ __forceinline__ unsigned xb_xcc_id() { return (unsigned)__builtin_amdgcn_s_getreg((3 << 11) | 20) & 0xFu; }
#define XB_SPIN(cond, bar) do { unsigned _sp = 0; while (cond) { __builtin_amdgcn_s_sleep(1); \
    if ((++_sp & 255u) == 0u) { if (xb_ld(&(bar)[XB_TMO])) break; if (_sp > XB_SPIN_CAP) { atomicAdd(&(bar)[XB_TMO], 1u); break; } } } } while (0)

struct XcdBarrier {
    unsigned* bar; unsigned x;
    volatile LAS unsigned* st;
};

__device__ __forceinline__ XcdBarrier xcd_barrier_post(unsigned* bar, volatile LAS unsigned* st) {
    XcdBarrier b; b.bar = bar; b.x = xb_xcc_id(); b.st = st;
    if (threadIdx.x == 0) (void)xb_add(&bar[XB_XCNT(b.x)], 1u);
    return b;
}
__device__ __forceinline__ void xcd_barrier_complete(unsigned* bar, unsigned x, unsigned& nloc, unsigned& nx) {
    const unsigned G = gridDim.x * gridDim.y * gridDim.z;
    unsigned sum, cnt, mine, sp = 0u;
    for (;;) {
        sum = 0u; cnt = 0u; mine = 0u;
#pragma unroll
        for (unsigned j = 0; j < 16; ++j) { const unsigned c = xb_ld(&bar[XB_XCNT(j)]); sum += c; cnt += (c > 0u) ? 1u : 0u; mine = (j == x) ? c : mine; }
        if (sum == G) break;
        __builtin_amdgcn_s_sleep(1);
        if ((++sp & 255u) == 0u) { if (xb_ld(&bar[XB_TMO])) break; if (sp > XB_SPIN_CAP) { atomicAdd(&bar[XB_TMO], 1u); break; } }
    }
    nloc = mine > 0u ? mine : 1u; nx = cnt > 0u ? cnt : 1u;
}

__device__ __forceinline__ void xcd_barrier(const XcdBarrier& b) {
    asm volatile("s_waitcnt vmcnt(0)" ::: "memory");
    __syncthreads();
    if (threadIdx.x == 0) {
        unsigned* bar = b.bar;
        __builtin_amdgcn_s_waitcnt(0);
        unsigned nloc = b.st[0], nx = b.st[1];
        if (nloc == 0u) { xcd_barrier_complete(bar, b.x, nloc, nx); b.st[0] = nloc; b.st[1] = nx; }
        const unsigned old = xb_add(&bar[XB_XSUB(b.x)], 1u);
        const unsigned gen = old / nloc;
        if (old + 1u == (gen + 1u) * nloc) {
            __builtin_amdgcn_fence(__ATOMIC_RELEASE, "agent");
            asm volatile("s_waitcnt vmcnt(0)" ::: "memory");
            const unsigned og = xb_add(&bar[XB_TOP], 1u);
            const unsigned tg = og / nx;
            if (og + 1u == (tg + 1u) * nx) xb_add(&bar[XB_TOPGEN], 1u);
            else XB_SPIN(xb_ld(&bar[XB_TOPGEN]) == tg, bar);
            __builtin_amdgcn_fence(__ATOMIC_ACQUIRE, "agent");
            xb_add(&bar[XB_XGEN(b.x)], 1u);
            asm volatile("s_waitcnt vmcnt(0)" ::: "memory");
        } else {
            XB_SPIN(xb_ld(&bar[XB_XGEN(b.x)]) == gen, bar);
            __builtin_amdgcn_fence(__ATOMIC_ACQUIRE, "agent");
            asm volatile("s_waitcnt vmcnt(0)" ::: "memory");
        }
    }
    __syncthreads();
}

struct Args { const float* in[12]; float* out; unsigned char* ws; int ph_lo, ph_hi; };
constexpr int N_PHASES = 1 + 5 * NLAYER;
__global__ void __launch_bounds__(512, 2) mega_fwd(Args args) {
    extern __shared__ __attribute__((aligned(16))) unsigned char lds[];
    Ctx F;
#define BUILD() do { const Args* ap_ = &args; \
    F.x = ap_->in[0]; F.norm_g = ap_->in[1]; F.w_in = ap_->in[2]; F.aqg = ap_->in[3]; F.akg = ap_->in[4]; F.bqg = ap_->in[5]; F.bkg = ap_->in[6]; \
    F.fox_bias = ap_->in[7]; F.gate_up = ap_->in[8]; F.gate_bias = ap_->in[9]; F.out_gain = ap_->in[10]; F.w_out = ap_->in[11]; \
    F.out = ap_->out; unsigned char* ws = ap_->ws; F.ws = ws; \
    F.ctl = (unsigned*)(ws + WS_CTL); F.ss = (unsigned long long*)(ws + WS_SS); F.wtin = (bf16*)(ws + WS_WTIN); F.wtout = (bf16*)(ws + WS_WTOUT); F.xb = (bf16*)(ws + WS_XB); \
    F.proj = (bf16*)(ws + WS_PROJ); F.small = (float*)(ws + WS_SMALL); F.mixed = (bf16*)(ws + WS_MIXED); F.oa = (bf16*)(ws + WS_OA); F.la = (float*)(ws + WS_LA); \
    F.ob = (float*)(ws + WS_OB); F.lb = (float*)(ws + WS_LB); F.cl = (float*)(ws + WS_CL); F.bt = (float*)(ws + WS_BT); F.ds = (float*)(ws + WS_DS); F.st = (bf16*)(ws + WS_ST); F.dec = (float*)(ws + WS_DEC); \
    F.lds = lds; F.G = gridDim.x; F.bid = blockIdx.x; \
    int t_ = threadIdx.x; asm volatile("" : "+v"(t_)); F.tid = t_; F.lane = t_ & 63; F.wave = __builtin_amdgcn_readfirstlane(t_ >> 6); } while (0)
    BUILD();
    cg::grid_group grid = cg::this_grid();
    if (threadIdx.x < 8) ((volatile LAS unsigned*)((LAS unsigned char*)lds + MISC_OFF))[threadIdx.x] = 0u;
    __syncthreads();
    XcdBarrier bar = xcd_barrier_post((unsigned*)(F.ws + WS_CTL) + 4096, (volatile LAS unsigned*)((LAS unsigned char*)lds + MISC_OFF));
    const int lo = args.ph_lo, hi = args.ph_hi;
#define IN(k) (lo <= (k) && (k) < hi)
#define RELAUNDER() do { int t_ = threadIdx.x; asm volatile("" : "+v"(t_)); F.tid = t_; F.lane = t_ & 63; F.wave = __builtin_amdgcn_readfirstlane(t_ >> 6); } while (0)
#define SEAM(k) do { if (IN(k) && IN((k) + 1)) { if ((k) == 0) grid.sync(); else xcd_barrier(bar); } } while (0)
    if (IN(0)) { BUILD(); phase0(F); }
    SEAM(0);
    for (int l = 0; l < NLAYER; ++l) { const int pb = 1 + 5 * l;
        if (IN(pb)) { BUILD(); pg8::Gemm g{F.xb, F.wtin + (size_t)l * NPAD * DM, SEQ, NPAD, DM}; pg8::StaticOrder S; S.init(SEQ, NPAD, F.G, F.bid);
            pg8::EpiProj E{F.proj, F.small, F.ss + l * SEQ, (float*)(lds + RING_BYTES + 1024), F.aqg + l * 64, F.akg + l * 64, F.bqg + l * 64, F.bkg + l * 64};
            pg8::gemm_phase<pg8::EpiProj, pg8::StaticOrder, true, true>((PG8_LAS unsigned char*)lds, g, S, E); __syncthreads(); }
        SEAM(pb);
        if (IN(pb + 1)) { BUILD(); phase2(F, l); }
        SEAM(pb + 1);
        if (IN(pb + 2)) { BUILD(); phase3(F, l); }
        SEAM(pb + 2);
        if (IN(pb + 3)) { BUILD(); phase4(F, l); }
        SEAM(pb + 3);
        if (IN(pb + 4)) { BUILD(); pg8::Gemm g{F.mixed, F.wtout + (size_t)l * DM * DM, SEQ, DM, DM}; pg8::StaticOrder S; S.init(SEQ, DM, F.G, F.bid);
            const bool last = (l == NLAYER - 1);
            pg8::EpiOut E{l == 0 ? F.x : F.out, F.out, last ? nullptr : F.xb, last ? nullptr : F.ss + (l + 1) * SEQ};
            pg8::gemm_phase<pg8::EpiOut, pg8::StaticOrder, true, true>((PG8_LAS unsigned char*)lds, g, S, E); __syncthreads(); }
        SEAM(pb + 4);
    }
#undef IN
#undef SEAM
}

#ifndef MK_ONE_LAUNCH
#define MK_ONE_LAUNCH 1
#endif
extern "C" void kernel_launch(void* const* d_in, const int* in_sizes, int n_in, void* d_out, int out_size, void* d_ws, size_t ws_size, hipStream_t stream) {
    static int grid = 0;
    if (grid == 0) {
        int dev = 0, cus = 0, per_cu = 0;
        hipGetDevice(&dev); hipDeviceGetAttribute(&cus, hipDeviceAttributeMultiprocessorCount, dev);
        hipFuncSetAttribute((const void*)mega_fwd, hipFuncAttributeMaxDynamicSharedMemorySize, LDS_BYTES);
        hipOccupancyMaxActiveBlocksPerMultiprocessor(&per_cu, mega_fwd, 512, LDS_BYTES);
        grid = cus * per_cu; if (grid <= 0) grid = 256;
        if (ws_size < WS_END) { fprintf(stderr, "workspace too small: %zu < %zu\n", ws_size, (size_t)WS_END); }
    }
    Args a{}; for (int i = 0; i < 12; ++i) a.in[i] = (const float*)d_in[i]; a.out = (float*)d_out; a.ws = (unsigned char*)d_ws;
#if MK_ONE_LAUNCH
    a.ph_lo = 0; a.ph_hi = N_PHASES; void* kargs[] = {&a};
    (void)hipMemsetAsync(d_ws, 0, 65536, stream);
    hipError_t e = hipLaunchCooperativeKernel((const void*)mega_fwd, dim3(grid), dim3(512), kargs, LDS_BYTES, stream);
    if (e != hipSuccess) fprintf(stderr, "cooperative launch failed: %s (grid %d)\n", hipGetErrorString(e), grid);
#else
    for (int p = 0; p < N_PHASES; ++p) { a.ph_lo = p; a.ph_hi = p + 1; hipLaunchKernelGGL(mega_fwd, dim3(grid), dim3(512), LDS_BYTES, stream, a); }
#endif
}
```

```cpp
#include <hip/hip_runtime.h>
#include <hip/hip_cooperative_groups.h>
#include <cstdio>
#include <cstdint>
namespace cg = cooperative_groups;
namespace pg8 {
#define PG8_LAS __attribute__((address_space(3)))
typedef unsigned short bf16_t;
typedef short bf16x8 __attribute__((ext_vector_type(8)));
typedef float f32x4 __attribute__((ext_vector_type(4)));
typedef unsigned u32x4 __attribute__((ext_vector_type(4)));
constexpr int BM = 256, BK = 64, HALF = 128, HTB = HALF * BK * 2  , STAGE_BYTES = 8 * HTB, NXCD = 8, WGM = 8;

__host__ __device__ __forceinline__ int lds_byte(int r, int c) { const int st = (r >> 4) * 2 + (c >> 5), rr = r & 15, cc = c & 31, ob = rr * 64 + cc * 2; return st * 1024 + (ob ^ (((ob >> 9) & 1) << 5)); }
__host__ __device__ __forceinline__ void stage_rc(int b, int& R, int& C) { const int st = b / 1024, sb = b % 1024, swz = sb ^ (((sb >> 9) & 1) << 5); R = (st >> 1) * 16 + swz / 64; C = (st & 1) * 32 + (swz % 64) / 2; }
__host__ __device__ __forceinline__ int perm32(int rho) { const int n = rho >> 4, i = rho & 15; return 8 * (i >> 2) + 4 * n + (i & 3); }

struct Unit { int pm, pn; };
struct Gemm { const bf16_t* A; const bf16_t* Bt; int M, N, K; };

struct StaticOrder {
    int nM, nN, nwg, G, c;
    __host__ __device__ void init(int M, int N, int G_, int c_) { nM = M / BM; nN = N / BM; nwg = nM * nN; G = G_; c = c_; }
    __host__ __device__ bool next(int i, Unit& u) const {
        const long L = (long)i * G + c; if (L >= nwg) return false;
        int wgid = (int)L; { const int q = nwg / NXCD, r = nwg % NXCD, xcd = wgid % NXCD, off = wgid / NXCD; wgid = (xcd < r ? xcd * (q + 1) : r * (q + 1) + (xcd - r) * q) + off; }
        const int nig = WGM * nN, gid = wgid / nig, fm = gid * WGM, gsz = (nM - fm) < WGM ? (nM - fm) : WGM;
        u.pm = fm + ((wgid % nig) % gsz); u.pn = (wgid % nig) / gsz; return true;
    }
    __device__ __forceinline__ void a_ready(const Unit&) const {}
    __device__ __forceinline__ void done(const Unit&) const {}
};

__device__ __forceinline__ unsigned cvt_pk_bf16(float lo, float hi) { unsigned r; asm volatile("v_cvt_pk_bf16_f32 %0, %1, %2" : "=v"(r) : "v"(lo), "v"(hi)); return r; }
typedef float f32x2 __attribute__((ext_vector_type(2)));
constexpr int PROJ_W = 7424;
struct EpiProj {
    static constexpr bool PERM = true, AFTER_DRAIN = false;
    bf16_t* O; float* small; const unsigned long long* ss; float* xch; const float* gaq; const float* gak; const float* gbq; const float* gbk;
    __device__ __forceinline__ void operator()(const f32x4 (&acc)[2][2][4][2], const Unit& u, int wr, int wc, int fr, int fq) const {
        const int row0 = u.pm * BM + wr * 64 + fr;
        if (u.pn < 29) {
            const int col0 = u.pn * BM + wc * 32 + 8 * fq;
            const bool isA = u.pn < 6, isB = (u.pn >= 12 && u.pn < 16);
            if (isA || isB) {
#pragma unroll
                for (int ai = 0; ai < 2; ++ai)
#pragma unroll
                    for (int m = 0; m < 4; ++m) { const int row = row0 + ai * HALF + m * 16; const float rs = rsqrtf((float)ss[row] * (1.0f / 1048576.0f / 2048.0f) + 1e-6f);
#pragma unroll
                        for (int bj = 0; bj < 2; ++bj) { const f32x4 v0 = acc[ai][bj][m][0] * rs, v1 = acc[ai][bj][m][1] * rs;
                            float sq = (v0[0] * v0[0] + v0[1] * v0[1]) + (v0[2] * v0[2] + v0[3] * v0[3]) + (v1[0] * v1[0] + v1[1] * v1[1]) + (v1[2] * v1[2] + v1[3] * v1[3]);
                            sq += __shfl_xor(sq, 16); sq += __shfl_xor(sq, 32);
                            if (fq == 0) xch[((ai * HALF + wr * 64 + m * 16 + fr) * 2 + bj) * 4 + wc] = sq; } }
                asm volatile("s_waitcnt lgkmcnt(0)" ::: "memory"); __builtin_amdgcn_s_barrier(); asm volatile("" ::: "memory");
                const bool isq = (u.pn < 3) || (u.pn == 12) || (u.pn == 13);
                const float* ga0 = gaq; const float* ga1 = gak; const float* gb0 = gbq; const float* gb1 = gbk;
                const float* gsel = isA ? ga0 : gb0; { const float* gk = isA ? ga1 : gb1; if (!isq) gsel = gk; }
                const float* g = gsel + 32 * (wc & 1) + 8 * fq;
                const float sc = isq ? 0.18033688011112042f : 1.0f;
                const f32x4 g0 = *(const f32x4*)g * sc, g1 = *(const f32x4*)(g + 4) * sc;
#pragma unroll
                for (int ai = 0; ai < 2; ++ai)
#pragma unroll
                    for (int m = 0; m < 4; ++m) { const int row = row0 + ai * HALF + m * 16; bf16_t* rowp = O + (size_t)row * PROJ_W + col0;
                        const float rs = rsqrtf((float)ss[row] * (1.0f / 1048576.0f / 2048.0f) + 1e-6f);
#pragma unroll
                        for (int bj = 0; bj < 2; ++bj) { const float* xp = xch + ((ai * HALF + wr * 64 + m * 16 + fr) * 2 + bj) * 4 + (wc & 2); const float tot = xp[0] + xp[1];
                            const float r2 = rsqrtf(tot * (1.0f / 64.0f) + 1e-6f) * rs;
                            const f32x4 v0 = acc[ai][bj][m][0] * r2 * g0, v1 = acc[ai][bj][m][1] * r2 * g1;
                            u32x4 w; w.x = cvt_pk_bf16(v0[0], v0[1]); w.y = cvt_pk_bf16(v0[2], v0[3]); w.z = cvt_pk_bf16(v1[0], v1[1]); w.w = cvt_pk_bf16(v1[2], v1[3]);
                            *(u32x4*)(rowp + bj * HALF) = w; } }
            } else {
#pragma unroll
            for (int ai = 0; ai < 2; ++ai)
#pragma unroll
                for (int m = 0; m < 4; ++m) { const int row = row0 + ai * HALF + m * 16; const float rs = rsqrtf((float)ss[row] * (1.0f / 1048576.0f / 2048.0f) + 1e-6f);
                    bf16_t* rowp = O + (size_t)row * PROJ_W + col0;
#pragma unroll
                    for (int bj = 0; bj < 2; ++bj) { const f32x4 v0 = acc[ai][bj][m][0] * rs, v1 = acc[ai][bj][m][1] * rs;
                        u32x4 w; w.x = cvt_pk_bf16(v0[0], v0[1]); w.y = cvt_pk_bf16(v0[2], v0[3]); w.z = cvt_pk_bf16(v1[0], v1[1]); w.w = cvt_pk_bf16(v1[2], v1[3]);
                        *(u32x4*)(rowp + bj * HALF) = w; } }
            }
        } else if (wc == 0) {
#pragma unroll
            for (int ai = 0; ai < 2; ++ai)
#pragma unroll
                for (int m = 0; m < 4; ++m) { const int row = row0 + ai * HALF + m * 16; const float rs = rsqrtf((float)ss[row] * (1.0f / 1048576.0f / 2048.0f) + 1e-6f);
                    float* p = small + (size_t)row * 32 + 8 * fq;
                    *(f32x4*)p = acc[ai][0][m][0] * rs; *(f32x4*)(p + 4) = acc[ai][0][m][1] * rs; }
        }
    }
};
struct EpiOut {
    static constexpr bool PERM = true, AFTER_DRAIN = false;
    const float* xin; float* out; bf16_t* xb; unsigned long long* ssn;
    __device__ __forceinline__ void operator()(const f32x4 (&acc)[2][2][4][2], const Unit& u, int wr, int wc, int fr, int fq) const {
        const int row0 = u.pm * BM + wr * 64 + fr, col0 = u.pn * BM + wc * 32 + 8 * fq;
#pragma unroll
        for (int ai = 0; ai < 2; ++ai)
#pragma unroll
            for (int m = 0; m < 4; ++m) { const int row = row0 + ai * HALF + m * 16; float sq = 0.f;
#pragma unroll
                for (int bj = 0; bj < 2; ++bj) { const size_t p = (size_t)row * 2048 + col0 + bj * HALF;
                    const f32x4 a = *(const f32x4*)(xin + p) + acc[ai][bj][m][0], b = *(const f32x4*)(xin + p + 4) + acc[ai][bj][m][1];
                    *(f32x4*)(out + p) = a; *(f32x4*)(out + p + 4) = b;
                    if (xb) { u32x4 w; w.x = cvt_pk_bf16(a[0], a[1]); w.y = cvt_pk_bf16(a[2], a[3]); w.z = cvt_pk_bf16(b[0], b[1]); w.w = cvt_pk_bf16(b[2], b[3]); *(u32x4*)(xb + p) = w; }
                    sq += (a[0] * a[0] + a[1] * a[1]) + (a[2] * a[2] + a[3] * a[3]) + (b[0] * b[0] + b[1] * b[1]) + (b[2] * b[2] + b[3] * b[3]); }
                sq += __shfl_xor(sq, 16); sq += __shfl_xor(sq, 32);
                if (fq == 0 && ssn) atomicAdd(ssn + row, (unsigned long long)(sq * 1048576.0f + 0.5f)); }
    }
};
template <class Epi, class Sched, bool ALIGN_EPI = false, bool SP2 = false>
__device__ __forceinline__ void gemm_phase(PG8_LAS unsigned char* lds, const Gemm g, const Sched& S, const Epi& E) {
    int tid_ = threadIdx.x; asm volatile("" : "+v"(tid_)); const int tid = tid_, wid = __builtin_amdgcn_readfirstlane(tid >> 6), lane = tid & 63, wr = wid >> 2, wc = wid & 3, fr = lane & 15, fq = lane >> 4;
    const int K = g.K, nt = K / BK;
    unsigned voffA[2], voffB[2];
#pragma unroll
    for (int i = 0; i < 2; ++i) { int R, C; stage_rc(tid * 16 + i * 8192, R, C); const int Rb = Epi::PERM ? ((R & ~31) + perm32(R & 31)) : R;
        voffA[i] = (unsigned)(R * K + C) * 2u; voffB[i] = (unsigned)(Rb * K + C) * 2u; }
    const size_t kstep = (size_t)(BK * 2);
    const size_t hstep = (size_t)HALF * K * 2;
    const size_t tstep = 2 * hstep;
    const unsigned ldsw = (unsigned)wid * 1024u;
    const int aoff = lds_byte(wr * 64 + fr, fq * 8), boff = lds_byte(wc * 32 + fr, fq * 8);
#define PG8_SA(b, h) (((b) * 2 + (h)) * HTB)
#define PG8_SB(b, h) ((4 + (b) * 2 + (h)) * HTB)
#define PG8_STAGE(bufoff, gbase, voff) do { _Pragma("unroll") for (int _i = 0; _i < 2; ++_i) \
        __builtin_amdgcn_global_load_lds((const unsigned*)((const char*)(gbase) + (voff)[_i]), (PG8_LAS unsigned*)(lds + (bufoff) + ldsw + _i * 8192), 16, 0, 0); } while (0)
#define PG8_LDA(dst, b, h) do { _Pragma("unroll") for (int m = 0; m < 4; ++m) _Pragma("unroll") for (int k = 0; k < 2; ++k) dst[m][k] = *(const PG8_LAS bf16x8*)(lds + PG8_SA(b, h) + aoff + m * 2048 + k * 1024); } while (0)
#define PG8_LDB(dst, b, h) do { _Pragma("unroll") for (int n = 0; n < 2; ++n) _Pragma("unroll") for (int k = 0; k < 2; ++k) dst[n][k] = *(const PG8_LAS bf16x8*)(lds + PG8_SB(b, h) + boff + n * 2048 + k * 1024); } while (0)
#define PG8_MMA(ai, bj, At, Bt) do { __builtin_amdgcn_s_setprio(1); _Pragma("unroll") for (int m = 0; m < 4; ++m) _Pragma("unroll") for (int n = 0; n < 2; ++n) _Pragma("unroll") for (int k = 0; k < 2; ++k) \
        acc[ai][bj][m][n] = __builtin_amdgcn_mfma_f32_16x16x32_bf16(Bt[n][k], At[m][k], acc[ai][bj][m][n], 0, 0, 0); __builtin_amdgcn_s_setprio(0); } while (0)
#define PG8_WAIT_V(n) asm volatile("s_waitcnt vmcnt(" #n ")" ::: "memory")
#define PG8_WAIT_L(n) asm volatile("s_waitcnt lgkmcnt(" #n ")" ::: "memory")
#define PG8_BAR __builtin_amdgcn_s_barrier()
#define PG8_SCHED __builtin_amdgcn_sched_barrier(0)
    Unit cur, nxt; int ui = 0;
    if (!S.next(0, cur)) return;
    f32x4 acc[2][2][4][2];
#pragma unroll
    for (int a = 0; a < 2; ++a)
#pragma unroll
        for (int b = 0; b < 2; ++b)
#pragma unroll
            for (int m = 0; m < 4; ++m)
#pragma unroll
                for (int n = 0; n < 2; ++n) acc[a][b][m][n] = (f32x4){0.f, 0.f, 0.f, 0.f};
    bf16x8 At[4][2], B0[2][2], B1[2][2];
    const char* cA = (const char*)g.A + (size_t)cur.pm * tstep; const char* cB = (const char*)g.Bt + (size_t)cur.pn * tstep;
    S.a_ready(cur);
    if constexpr (SP2) {
        PG8_STAGE(PG8_SB(0, 0), cB, voffB); PG8_STAGE(PG8_SB(0, 1), cB + hstep, voffB); PG8_STAGE(PG8_SA(0, 0), cA, voffA); PG8_STAGE(PG8_SA(0, 1), cA + hstep, voffA);
        if (wr == 1) PG8_BAR;
        PG8_WAIT_V(2); PG8_BAR;
        PG8_STAGE(PG8_SB(1, 0), cB + kstep, voffB); PG8_STAGE(PG8_SA(1, 0), cA + kstep, voffA); PG8_STAGE(PG8_SB(1, 1), cB + hstep + kstep, voffB);
        PG8_WAIT_V(6); PG8_BAR;
    } else {
        PG8_STAGE(PG8_SB(0, 0), cB, voffB); PG8_STAGE(PG8_SA(0, 0), cA, voffA); PG8_STAGE(PG8_SB(0, 1), cB + hstep, voffB); PG8_STAGE(PG8_SA(0, 1), cA + hstep, voffA);
        if (wr == 1) PG8_BAR;
        PG8_WAIT_V(4); PG8_BAR;
        PG8_STAGE(PG8_SB(1, 0), cB + kstep, voffB); PG8_STAGE(PG8_SA(1, 0), cA + kstep, voffA); PG8_STAGE(PG8_SB(1, 1), cB + hstep + kstep, voffB);
        PG8_WAIT_V(6); PG8_BAR;
    }
    for (;;) {
        const bool has_next = S.next(ui + 1, nxt);
        const char* nA = has_next ? (const char*)g.A + (size_t)nxt.pm * tstep : cA; const char* nB = has_next ? (const char*)g.Bt + (size_t)nxt.pn * tstep : cB;
        for (int t = 0; t < nt; t += 2) {
            const bool last = (t == nt - 2);
            const char* a1 = cA + (size_t)(t + 1) * kstep;
            const char* a2 = last ? nA : cA + (size_t)(t + 2) * kstep; const char* b2 = last ? nB : cB + (size_t)(t + 2) * kstep;
            const char* a3 = a2 + kstep; const char* b3 = b2 + kstep;
            if (last && has_next) S.a_ready(nxt);
            if constexpr (SP2) {
            PG8_LDB(B0, 0, 0); PG8_LDB(B1, 0, 1); PG8_SCHED; PG8_LDA(At, 0, 0); PG8_STAGE(PG8_SA(1, 1), a1 + hstep, voffA);
            PG8_WAIT_V(8); PG8_WAIT_L(0); PG8_BAR; PG8_MMA(0, 0, At, B0); PG8_MMA(0, 1, At, B1); PG8_BAR; PG8_SCHED;
            PG8_LDA(At, 0, 1); PG8_STAGE(PG8_SB(0, 0), b2, voffB); PG8_STAGE(PG8_SB(0, 1), b2 + hstep, voffB); PG8_STAGE(PG8_SA(0, 0), a2, voffA);
            PG8_WAIT_V(8); PG8_WAIT_L(0); PG8_BAR; PG8_MMA(1, 0, At, B0); PG8_MMA(1, 1, At, B1); PG8_BAR; PG8_SCHED;
            PG8_LDB(B0, 1, 0); PG8_LDB(B1, 1, 1); PG8_SCHED; PG8_LDA(At, 1, 0); PG8_STAGE(PG8_SA(0, 1), a2 + hstep, voffA);
            PG8_WAIT_V(8); PG8_WAIT_L(0); PG8_BAR; PG8_MMA(0, 0, At, B0); PG8_MMA(0, 1, At, B1); PG8_BAR; PG8_SCHED;
            PG8_LDA(At, 1, 1); PG8_STAGE(PG8_SB(1, 0), b3, voffB); PG8_STAGE(PG8_SB(1, 1), b3 + hstep, voffB); PG8_STAGE(PG8_SA(1, 0), a3, voffA);
            PG8_WAIT_V(8); PG8_WAIT_L(0); PG8_BAR; PG8_MMA(1, 0, At, B0); PG8_MMA(1, 1, At, B1); PG8_BAR; PG8_SCHED;
            } else {
            PG8_LDB(B0, 0, 0); PG8_SCHED; PG8_LDA(At, 0, 0); PG8_STAGE(PG8_SA(1, 1), a1 + hstep, voffA);
            PG8_WAIT_L(8); PG8_BAR; PG8_WAIT_L(0); PG8_MMA(0, 0, At, B0); PG8_BAR; PG8_SCHED;
            PG8_LDB(B1, 0, 1); PG8_STAGE(PG8_SB(0, 0), b2, voffB);
            PG8_BAR; PG8_WAIT_L(0); PG8_MMA(0, 1, At, B1); PG8_BAR;
            PG8_LDA(At, 0, 1); PG8_STAGE(PG8_SA(0, 0), a2, voffA);
            PG8_BAR; PG8_WAIT_L(0); PG8_MMA(1, 0, At, B0); PG8_BAR; PG8_SCHED;
            PG8_STAGE(PG8_SB(0, 1), b2 + hstep, voffB);
            PG8_WAIT_V(6); PG8_BAR; PG8_MMA(1, 1, At, B1); PG8_BAR;
            PG8_LDB(B0, 1, 0); PG8_SCHED; PG8_LDA(At, 1, 0); PG8_STAGE(PG8_SA(0, 1), a2 + hstep, voffA);
            PG8_WAIT_L(8); PG8_BAR; PG8_WAIT_L(0); PG8_MMA(0, 0, At, B0); PG8_BAR; PG8_SCHED;
            PG8_LDB(B1, 1, 1); PG8_STAGE(PG8_SB(1, 0), b3, voffB);
            PG8_BAR; PG8_WAIT_L(0); PG8_MMA(0, 1, At, B1); PG8_BAR;
            PG8_LDA(At, 1, 1); PG8_STAGE(PG8_SA(1, 0), a3, voffA);
            PG8_BAR; PG8_WAIT_L(0); PG8_MMA(1, 0, At, B0); PG8_BAR; PG8_SCHED;
            PG8_STAGE(PG8_SB(1, 1), b3 + hstep, voffB);
            PG8_WAIT_V(6); PG8_BAR; PG8_MMA(1, 1, At, B1); PG8_BAR;
            }
        }
        if constexpr (ALIGN_EPI) { if (wr == 0) PG8_BAR; }
        if constexpr (!Epi::AFTER_DRAIN) { E(acc, cur, wr, wc, fr, fq); S.done(cur); }
        if (!has_next) break;
#pragma unroll
        for (int a = 0; a < 2; ++a)
#pragma unroll
            for (int b = 0; b < 2; ++b)
#pragma unroll
                for (int m = 0; m < 4; ++m)
#pragma unroll
                    for (int n = 0; n < 2; ++n) acc[a][b][m][n] = (f32x4){0.f, 0.f, 0.f, 0.f};
        cur = nxt; cA = nA; cB = nB; ++ui;
        if constexpr (ALIGN_EPI) { if (wr == 1) PG8_BAR; }
    }
    PG8_WAIT_V(0);
    if constexpr (!ALIGN_EPI) { if (wr == 0) PG8_BAR; }
    PG8_BAR;
    if constexpr (Epi::AFTER_DRAIN) { E.fused(acc, cur, wr, wc, fr, fq, lds, wid, lane); S.done(cur); }
#undef PG8_SA
#undef PG8_SB
#undef PG8_STAGE
#undef PG8_LDA
#undef PG8_LDB
#undef PG8_MMA
#undef PG8_WAIT_V
#undef PG8_WAIT_L
#undef PG8_BAR
#undef PG8_SCHED
}
}
constexpr int SEQ = 8192, DM = 2048, NLAYER = 4, INW = 7448, NPAD = 7680, PW = pg8::PROJ_W;
constexpr int C_AQ = 0, C_AK = 768, C_AV = 1536, C_AZ = 2304, C_BQ = 3072, C_BK = 3584, C_BV = 4096, C_BZ = 4608, C_CQ = 5120, C_CK = 5504, C_CV = 5888, C_CZ = 6656;
constexpr float LOG2E = 1.4426950408889634f, QSCALE = 0.125f * 1.4426950408889634f, EPS = 1e-6f;
constexpr size_t MiB = 1u << 20;
constexpr size_t WS_CTL = 0, WS_SS = 1 * MiB, WS_WTIN = 2 * MiB, WS_WTOUT = 122 * MiB, WS_XB = 154 * MiB, WS_PROJ = 186 * MiB, WS_SMALL = 302 * MiB,
                 WS_MIXED = 304 * MiB, WS_OA = 336 * MiB, WS_LA = 372 * MiB, WS_OB = 374 * MiB, WS_LB = 438 * MiB, WS_CL = 439 * MiB, WS_BT = WS_CL + 512 * 1024,
                 WS_DS = 440 * MiB, WS_ST = 476 * MiB, WS_DEC = 494 * MiB, WS_END = 496 * MiB;
constexpr int RING_BYTES = 131072, LDS_BYTES = 147456, QSLOT_OFF = RING_BYTES + 64, MISC_OFF = RING_BYTES + 256;
constexpr int P3_EXT = RING_BYTES + 1024;
constexpr int N_SCAN = 72, N_FOX = 640, N_AU = 1152, N_ITEMS = N_SCAN + N_FOX + N_AU;

typedef unsigned short bf16;
typedef short bf16x8 __attribute__((ext_vector_type(8)));
typedef short s16x4 __attribute__((ext_vector_type(4)));
typedef float f32x4 __attribute__((ext_vector_type(4)));
typedef float f32x2 __attribute__((ext_vector_type(2)));
typedef float f32x16 __attribute__((ext_vector_type(16)));
typedef unsigned u32x4 __attribute__((ext_vector_type(4)));
typedef unsigned u32x2 __attribute__((ext_vector_type(2)));
typedef __attribute__((address_space(3))) const char* lds_cptr;
#define LAS3 __attribute__((address_space(3)))

__device__ __forceinline__ float bf2f(unsigned b) { return __uint_as_float(b << 16); }
__device__ __forceinline__ unsigned pk2(float lo, float hi) { return pg8::cvt_pk_bf16(lo, hi); }
__device__ __forceinline__ float blo(unsigned w) { return __uint_as_float(w << 16); }
__device__ __forceinline__ float bhi(unsigned w) { return __uint_as_float(w & 0xffff0000u); }
__device__ __forceinline__ float logsig(float x) { return fminf(x, 0.f) - log1pf(expf(-fabsf(x))); }
__device__ __forceinline__ float silu(float x) { return x / (1.f + __expf(-x)); }
__device__ __forceinline__ s16x4 vtr(lds_cptr p) { return __builtin_bit_cast(s16x4, __builtin_amdgcn_ds_read_tr16_b64_v4i16((LAS3 s16x4*)p)); }
__device__ __forceinline__ bf16x8 frag_tr(lds_cptr img, int stride, int kbase, int m0, int lane) {
    const int i = lane & 15, g = lane >> 4;
    lds_cptr p = img + (kbase + 4 * (g >> 1) + (i >> 2)) * stride + (m0 + 16 * (g & 1) + 4 * (i & 3)) * 2;
    const s16x4 a = vtr(p), b = vtr(p + 8 * stride);
    return (bf16x8){a[0], a[1], a[2], a[3], b[0], b[1], b[2], b[3]};
}
__device__ __forceinline__ int rowidx(int reg, int hh) { return (reg & 3) + 8 * (reg >> 2) + 4 * hh; }
__device__ __forceinline__ void pack_p(const f32x16& p, bf16x8& f0, bf16x8& f1) {
    u32x4 a, b; a.x = pk2(p[0], p[1]); a.y = pk2(p[2], p[3]); a.z = pk2(p[4], p[5]); a.w = pk2(p[6], p[7]);
    b.x = pk2(p[8], p[9]); b.y = pk2(p[10], p[11]); b.z = pk2(p[12], p[13]); b.w = pk2(p[14], p[15]);
    f0 = __builtin_bit_cast(bf16x8, a); f1 = __builtin_bit_cast(bf16x8, b);
}
#define MFMA32(a, b, c) __builtin_amdgcn_mfma_f32_32x32x16_bf16((a), (b), (c), 0, 0, 0)

struct Ctx {
    const float *x, *norm_g, *w_in, *aqg, *akg, *bqg, *bkg, *fox_bias, *gate_up, *gate_bias, *out_gain, *w_out;
    float* out; unsigned char* ws;
    unsigned* ctl; unsigned long long* ss; bf16* wtin; bf16* wtout; bf16* xb; bf16* proj; float* small; bf16* mixed; bf16* oa; float* la; float* ob; float* lb; float* cl; float* bt;
    float* ds; bf16* st; float* dec;
    unsigned char* lds; int tid, lane, wave, G, bid;
};

__device__ __forceinline__ int orig_col(int np) { if (np < 5120) return np; if (np < 7424) return np + 8; if (np < 7432) return 5120 + (np - 7424); if (np < 7448) return np; return -1; }
__device__ __forceinline__ void p0_item(const float* W, int N, bf16* WT, const float* g, int mode, float* scr, int kb, int nb, int lane) {
    const int k0 = 64 * kb, n0 = 32 * nb, c4 = 4 * (lane & 7), np = n0 + c4;
    const int oc = mode ? orig_col(np) : np;
    const float cs = (mode && np >= C_CQ && np < C_CK) ? 0.10206207261596577f : 1.0f;
    f32x4 v[8];
#pragma unroll
    for (int i = 0; i < 8; ++i) { const int kk = 8 * i + (lane >> 3); v[i] = (f32x4){0.f, 0.f, 0.f, 0.f};
        if (oc >= 0) { v[i] = *(const f32x4*)(W + (size_t)(k0 + kk) * N + oc); const float sc = mode ? cs * g[k0 + kk] : 1.0f; v[i] = v[i] * sc; } }
#pragma unroll
    for (int i = 0; i < 8; ++i) { const int kk = 8 * i + (lane >> 3); float* d = scr + kk * 33 + c4; d[0] = v[i].x; d[1] = v[i].y; d[2] = v[i].z; d[3] = v[i].w; }
    __builtin_amdgcn_s_waitcnt(0); asm volatile("" ::: "memory");
    const int c = lane & 7;
#pragma unroll
    for (int j = 0; j < 4; ++j) { const int n = (lane >> 3) + 8 * j; const float* s = scr + (8 * c) * 33 + n;
        u32x4 o; o.x = pk2(s[0 * 33], s[1 * 33]); o.y = pk2(s[2 * 33], s[3 * 33]); o.z = pk2(s[4 * 33], s[5 * 33]); o.w = pk2(s[6 * 33], s[7 * 33]);
        *(u32x4*)(WT + (size_t)(n0 + n) * 2048 + k0 + 8 * c) = o; }
    __builtin_amdgcn_s_waitcnt(0); asm volatile("" ::: "memory");
}
__device__ __forceinline__ void phase0(Ctx& F) {
    float* scr = (float*)(F.lds + F.wave * 16384);
    const int gw = F.bid * 8 + F.wave, NGW = F.G * 8;
    if (F.bid == 0 && F.tid < 64) F.ctl[F.tid] = 0u;
    for (int i = F.bid * 512 + F.tid; i < 3 * SEQ; i += F.G * 512) F.ss[SEQ + i] = 0ull;
    constexpr int I_IN = 32 * 233, I_OUT = 32 * 64, I_L = I_IN + I_OUT;
    for (int it = gw; it < NLAYER * I_L; it += NGW) {
        const int l = it / I_L; int r = it % I_L;
        if (r < I_IN) p0_item(F.w_in + (size_t)l * DM * INW, INW, F.wtin + (size_t)l * NPAD * DM, F.norm_g + l * DM, 1, scr, r / 233, r % 233, F.lane);
        else { r -= I_IN; p0_item(F.w_out + (size_t)l * DM * DM, DM, F.wtout + (size_t)l * DM * DM, nullptr, 0, scr, r / 64, r % 64, F.lane); }
    }
    for (int m = gw; m < SEQ; m += NGW) {
        const f32x4* xr = (const f32x4*)(F.x + (size_t)m * DM) + F.lane; float s = 0.f; u32x2* o8 = (u32x2*)(F.xb + (size_t)m * DM) + F.lane;
#pragma unroll
        for (int j = 0; j < 8; ++j) { const f32x4 v = xr[64 * j]; s += (v.x * v.x + v.y * v.y) + (v.z * v.z + v.w * v.w); u32x2 w; w.x = pk2(v.x, v.y); w.y = pk2(v.z, v.w); o8[64 * j] = w; }
#pragma unroll
        for (int o = 1; o < 64; o <<= 1) s += __shfl_xor(s, o);
        if (F.lane == 0) F.ss[m] = (unsigned long long)(s * 1048576.0f + 0.5f);
    }
}

__device__ __forceinline__ void phase2(Ctx& F, int l) {
    { const int gw = F.bid * 8 + F.wave, NGW = F.G * 8;
      for (int wi = gw; wi < 512; wi += NGW) { const int blk = wi >> 3, h = wi & 7, t = blk * 128 + 2 * F.lane; const float fb = F.fox_bias[l * 8 + h];
        const float l0 = logsig(F.small[(size_t)t * 32 + h] + fb), l1 = logsig(F.small[(size_t)(t + 1) * 32 + h] + fb);
        float s = l0 + l1;
#pragma unroll
        for (int o = 1; o < 64; o <<= 1) { const float y = __shfl_up(s, o); if (F.lane >= o) s += y; }
        const float ex = s - (l0 + l1); F.cl[t * 8 + h] = ex + l0; F.cl[(t + 1) * 8 + h] = s; if (F.lane == 63) F.bt[blk * 8 + h] = s; } }
    { float* CR = (float*)F.lds;
      float* GT = (float*)(F.lds + 4096);
      unsigned char* KH = F.lds + 8192;
      unsigned char* VV = F.lds + 8192 + 13312;
      const float* gup = F.gate_up + (size_t)l * 16 * 384; const float* gbs = F.gate_bias + l * 384;
      for (int u = F.bid; u < 512; u += F.G) { const int h = u & 3, n = u >> 2, t0 = n * 64;
        if (F.tid < 256) *(f32x4*)(CR + F.tid * 4) = *(const f32x4*)(F.small + (size_t)(t0 + (F.tid >> 2)) * 32 + 8 + 4 * (F.tid & 3));
        for (int e = F.tid; e < 1536; e += 512) { const int row = e / 24, ch = e % 24;
            *(u32x4*)(VV + row * 400 + ch * 16) = *(const u32x4*)(F.proj + (size_t)(t0 + row) * PW + C_CV + h * 192 + ch * 8); }
        __syncthreads();
        const int d = F.tid % 96, tg = F.tid / 96;
        float bc[16];
        if (F.tid < 384) { float g[16];
#pragma unroll
            for (int r = 0; r < 16; ++r) g[r] = gup[r * 384 + h * 96 + d];
            const float gb = gbs[h * 96 + d]; float run = 0.f;
#pragma unroll
            for (int i = 0; i < 16; ++i) { const float* cr = CR + (16 * tg + i) * 16; float a = gb;
#pragma unroll
                for (int r4 = 0; r4 < 4; ++r4) { const f32x4 c = *(const f32x4*)(cr + 4 * r4); a += c.x * g[4 * r4] + c.y * g[4 * r4 + 1] + c.z * g[4 * r4 + 2] + c.w * g[4 * r4 + 3]; }
                const float ls = fminf(a, 0.f) - __logf(1.f + __expf(-fabsf(a)));
                run += ls * (1.f / 16.f); bc[i] = run; }
            GT[tg * 96 + d] = run; }
        __syncthreads();
        if (F.tid < 384) { const float g0 = GT[d], g1 = GT[96 + d], g2 = GT[192 + d], g3 = GT[288 + d];
            const float pre = (tg > 0 ? g0 : 0.f) + (tg > 1 ? g1 : 0.f) + (tg > 2 ? g2 : 0.f);
            const float bm = g0 + g1, bl = (g0 + g1) + (g2 + g3);
            bf16* qp = F.proj + (size_t)(t0 + 16 * tg) * PW + C_CQ + h * 96 + d; bf16* kp = F.proj + (size_t)(t0 + 16 * tg) * PW + C_CK + h * 96 + d;
            float qv[16], kv[16];
#pragma unroll
            for (int i = 0; i < 16; ++i) { qv[i] = bf2f(qp[(size_t)i * PW]); kv[i] = bf2f(kp[(size_t)i * PW]); }
#pragma unroll
            for (int i = 0; i < 16; ++i) { const float b = bc[i] + pre; const float eq = __expf(b - bm), ek = __expf(bm - b), eh = __expf(bl - b);
                qp[(size_t)i * PW] = (bf16)(pk2(qv[i] * eq, 0.f) & 0xffffu); kp[(size_t)i * PW] = (bf16)(pk2(kv[i] * ek, 0.f) & 0xffffu);
                *(bf16*)(KH + (16 * tg + i) * 208 + d * 2) = (bf16)(pk2(kv[i] * eh, 0.f) & 0xffffu); }
            if (tg == 0) { F.dec[(n * 4 + h) * 96 + d] = __expf(bl); F.dec[49152 + (n * 4 + h) * 96 + d] = __expf(bm); } }
        __syncthreads();
        for (int id = F.wave; id < 18; id += 8) { const int vt = id / 3, dt = id % 3; f32x16 acc = {};
#pragma unroll
            for (int s = 0; s < 4; ++s) { const bf16x8 a = frag_tr((lds_cptr)VV, 400, 16 * s, 32 * vt, F.lane), b = frag_tr((lds_cptr)KH, 208, 16 * s, 32 * dt, F.lane); acc = MFMA32(a, b, acc); }
            float* dst = F.ds + ((size_t)(n * 4 + h) * 192 + 32 * vt) * 96 + 32 * dt + (F.lane & 31);
#pragma unroll
            for (int r = 0; r < 16; ++r) dst[(size_t)rowidx(r, F.lane >> 5) * 96] = acc[r]; }
        __syncthreads(); } }
}
__device__ __forceinline__ float softmax_ref2(const float* gq, const float* gk) {
    float mq = 0.f, mk = 0.f;
    for (int i = 0; i < 64; ++i) { mq = fmaxf(mq, fabsf(gq[i])); mk = fmaxf(mk, fabsf(gk[i])); }
    return 8.25f * mq * mk * LOG2E;
}
__device__ __forceinline__ void scan_item(Ctx& F, int si) {
    const int p = si * 512 + F.tid, d = 2 * (p % 48), v = (p / 48) % 192, h = p / (48 * 192);
    float s0 = 0.f, s1 = 0.f;
#pragma unroll 8
    for (int n = 0; n < 128; ++n) { const size_t idx = ((size_t)(n * 4 + h) * 192 + v) * 96 + d; const int di = (n * 4 + h) * 96 + d;
        const f32x2 dd = *(const f32x2*)(F.ds + idx), a = *(const f32x2*)(F.dec + di), em = *(const f32x2*)(F.dec + 49152 + di);
        *(unsigned*)(F.st + idx) = pk2(em.x * s0, em.y * s1);
        s0 = a.x * s0 + dd.x; s1 = a.y * s1 + dd.y; }
}
#define PIN4(a, b, c, d) asm volatile("" : "+v"(a), "+v"(b), "+v"(c), "+v"(d))
#define SBAR0() __builtin_amdgcn_sched_barrier(0)
template <int KSTR, int VSTR>
__device__ __forceinline__ void attn_sub(const unsigned char* Kt, const unsigned char* Vt, int key_row0, const bf16x8 (&qf)[4], f32x16 S, f32x16 (&o)[2], float& lsum, int lane,
                                         bool use_mask, int lo, int hi_) {
    const int r = lane & 31, hh = lane >> 5;
    bf16x8 kf[4];
#pragma unroll
    for (int s = 0; s < 4; ++s) kf[s] = *(const bf16x8*)(Kt + (key_row0 + r) * KSTR + (16 * s + 8 * hh) * 2);
    bf16x8 vf[2][2];
#pragma unroll
    for (int dt = 0; dt < 2; ++dt) { vf[dt][0] = frag_tr((lds_cptr)Vt, VSTR, key_row0, 32 * dt, lane); vf[dt][1] = frag_tr((lds_cptr)Vt, VSTR, key_row0 + 16, 32 * dt, lane); }
    PIN4(kf[0], kf[1], kf[2], kf[3]);
#pragma unroll
    for (int s = 0; s < 4; ++s) S = MFMA32(kf[s], qf[s], S);
    if (use_mask) {
#pragma unroll
        for (int g = 0; g < 16; ++g) { const int k = rowidx(g, hh); if (k < lo || k > hi_) S[g] = -INFINITY; } }
    float acc = 0.f;
#pragma unroll
    for (int g = 0; g < 16; ++g) { S[g] = __builtin_amdgcn_exp2f(S[g]); acc += S[g]; }
    lsum += acc;
    bf16x8 p0, p1; pack_p(S, p0, p1);
    PIN4(vf[0][0], vf[0][1], vf[1][0], vf[1][1]);
#pragma unroll
    for (int dt = 0; dt < 2; ++dt) { o[dt] = MFMA32(vf[dt][0], p0, o[dt]); o[dt] = MFMA32(vf[dt][1], p1, o[dt]); }
}
template <int NSUB, int KSTR, int VSTR>
__device__ __forceinline__ void attn_multi(const unsigned char* Kt, const unsigned char* Vt, int key_row0, const bf16x8 (&qf)[4], f32x16 (&S)[NSUB], f32x16 (&o)[2], float& lsum, int lane) {
    const int r = lane & 31, hh = lane >> 5;
    bf16x8 kf[NSUB][4];
#pragma unroll
    for (int u = 0; u < NSUB; ++u)
#pragma unroll
        for (int s = 0; s < 4; ++s) kf[u][s] = *(const bf16x8*)(Kt + (key_row0 + 32 * u + r) * KSTR + (16 * s + 8 * hh) * 2);
#pragma unroll
    for (int u = 0; u < NSUB; ++u) PIN4(kf[u][0], kf[u][1], kf[u][2], kf[u][3]);
#pragma unroll
    for (int s = 0; s < 4; ++s)
#pragma unroll
        for (int u = 0; u < NSUB; ++u) S[u] = MFMA32(kf[u][s], qf[s], S[u]);
#pragma unroll
    for (int u = 0; u < NSUB; ++u) {
        bf16x8 vf[2][2];
#pragma unroll
        for (int dt = 0; dt < 2; ++dt) { vf[dt][0] = frag_tr((lds_cptr)Vt, VSTR, key_row0 + 32 * u, 32 * dt, lane); vf[dt][1] = frag_tr((lds_cptr)Vt, VSTR, key_row0 + 32 * u + 16, 32 * dt, lane); }
        SBAR0();
        float acc = 0.f;
#pragma unroll
        for (int g = 0; g < 16; ++g) { S[u][g] = __builtin_amdgcn_exp2f(S[u][g]); acc += S[u][g]; }
        lsum += acc;
        bf16x8 p0, p1; pack_p(S[u], p0, p1);
        PIN4(vf[0][0], vf[0][1], vf[1][0], vf[1][1]);
#pragma unroll
        for (int dt = 0; dt < 2; ++dt) { o[dt] = MFMA32(vf[dt][0], p0, o[dt]); o[dt] = MFMA32(vf[dt][1], p1, o[dt]); } }
}
__device__ __forceinline__ void fox_unit(Ctx& F, int l, int h, int qb, int seg) {
    constexpr int KS = 144, VS = 192, BUFB = 128 * KS, BUFV = 128 * VS;
    unsigned char* KT = F.lds; unsigned char* VT = F.lds + 2 * BUFB; float* CS = (float*)(F.lds + 2 * BUFB + 2 * BUFV);
    const float* PEX = (const float*)(F.lds + P3_EXT) + h * 64;
    const int r = F.lane & 31, hh = F.lane >> 5, w = F.wave, t0 = 256 * qb, NT = 2 * qb + 2;
    const int kfirst = __builtin_amdgcn_readfirstlane(((const int*)(F.lds + P3_EXT + 2048))[h * 32 + qb]);
    const int nuse = (NT - kfirst + 15) >> 4;
    if (seg >= nuse) return;
    const int kt0 = kfirst + 16 * seg, te = (kt0 + 16 < NT) ? kt0 + 16 : NT;
    const float mb2 = ((const float*)(F.lds + P3_EXT + 3072))[1];
    const int tq = t0 + 32 * w + r; const float pq0 = PEX[t0 >> 7];
    const float ctq = ((PEX[tq >> 7] - pq0) + F.cl[tq * 8 + h]) * LOG2E - mb2;
    bf16x8 qf[4];
#pragma unroll
    for (int s = 0; s < 4; ++s) qf[s] = *(const bf16x8*)(F.proj + (size_t)tq * PW + C_BQ + h * 64 + 16 * s + 8 * hh);
    f32x16 o[2]; o[0] = f32x16{}; o[1] = f32x16{}; float lsum = 0.f;
    const int lrow = F.tid >> 3, lch = F.tid & 7;
    u32x4 kreg[2], vreg[2]; float creg = 0.f;
    if (kt0 < te) {
#pragma unroll
        for (int i = 0; i < 2; ++i) { const size_t g = (size_t)(128 * kt0 + 64 * i + lrow) * PW + h * 64 + lch * 8; kreg[i] = *(const u32x4*)(F.proj + g + C_BK); vreg[i] = *(const u32x4*)(F.proj + g + C_BV); }
        if (F.tid < 128) creg = ((PEX[kt0] - pq0) + F.cl[(128 * kt0 + F.tid) * 8 + h]) * LOG2E; }
    for (int kt = kt0; kt < te; ++kt) { const int buf = (kt - kt0) & 1;
#pragma unroll
        for (int i = 0; i < 2; ++i) { *(u32x4*)(KT + buf * BUFB + (64 * i + lrow) * KS + lch * 16) = kreg[i]; *(u32x4*)(VT + buf * BUFV + (64 * i + lrow) * VS + lch * 16) = vreg[i]; }
        if (F.tid < 128) CS[buf * 128 + F.tid] = creg;
        __syncthreads();
        if (kt + 1 < te) {
#pragma unroll
            for (int i = 0; i < 2; ++i) { const size_t g = (size_t)(128 * (kt + 1) + 64 * i + lrow) * PW + h * 64 + lch * 8; kreg[i] = *(const u32x4*)(F.proj + g + C_BK); vreg[i] = *(const u32x4*)(F.proj + g + C_BV); }
            if (F.tid < 128) creg = ((PEX[kt + 1] - pq0) + F.cl[(128 * (kt + 1) + F.tid) * 8 + h]) * LOG2E; }
        const unsigned char* Kb = KT + buf * BUFB; const unsigned char* Vb = VT + buf * BUFV; const float* Cb = CS + buf * 128;
        if (kt < 2 * qb) {
#pragma unroll
            for (int hf = 0; hf < 2; ++hf) { f32x16 S[2]; f32x4 c4[2][4];
#pragma unroll
                for (int u = 0; u < 2; ++u)
#pragma unroll
                    for (int i = 0; i < 4; ++i) c4[u][i] = *(const f32x4*)(Cb + 64 * hf + 32 * u + 8 * i + 4 * hh);
                PIN4(c4[0][0], c4[0][1], c4[0][2], c4[0][3]); PIN4(c4[1][0], c4[1][1], c4[1][2], c4[1][3]);
#pragma unroll
                for (int u = 0; u < 2; ++u)
#pragma unroll
                    for (int i = 0; i < 4; ++i) { S[u][4 * i] = ctq - c4[u][i].x; S[u][4 * i + 1] = ctq - c4[u][i].y; S[u][4 * i + 2] = ctq - c4[u][i].z; S[u][4 * i + 3] = ctq - c4[u][i].w; }
                attn_multi<2, KS, VS>(Kb, Vb, 64 * hf, qf, S, o, lsum, F.lane); }
        } else {
            const int qlo = t0 + 32 * w;
#pragma unroll
            for (int sub = 0; sub < 4; ++sub) { const int key0 = 128 * kt + 32 * sub;
                if (key0 <= qlo + 31) {
                    f32x16 S;
#pragma unroll
                    for (int i = 0; i < 4; ++i) { const f32x4 c4 = *(const f32x4*)(Cb + 32 * sub + 8 * i + 4 * hh); S[4 * i] = ctq - c4.x; S[4 * i + 1] = ctq - c4.y; S[4 * i + 2] = ctq - c4.z; S[4 * i + 3] = ctq - c4.w; }
                    attn_sub<KS, VS>(Kb, Vb, 32 * sub, qf, S, o, lsum, F.lane, key0 + 31 > qlo, 0, tq - key0); } }
        }
    }
    lsum += __shfl_xor(lsum, 32);
    float* ob = F.ob + ((size_t)seg * SEQ + tq) * 512 + h * 64 + 4 * hh;
#pragma unroll
    for (int dt = 0; dt < 2; ++dt)
#pragma unroll
        for (int i = 0; i < 4; ++i) *(f32x4*)(ob + 32 * dt + 8 * i) = (f32x4){o[dt][4 * i], o[dt][4 * i + 1], o[dt][4 * i + 2], o[dt][4 * i + 3]};
    if (hh == 0) F.lb[((size_t)seg * SEQ + tq) * 8 + h] = lsum;
    __syncthreads();
}
__device__ __forceinline__ void a_unit(Ctx& F, int l, int a, int n, int rres, int b2) {
    constexpr int KS = 144, VS = 192;
    unsigned char* KA = F.lds; unsigned char* VA = F.lds + 384 * KS;
    const int r = F.lane & 31, hh = F.lane >> 5, w = F.wave, d = (n == 0) ? 1 : (n == 1) ? 4 : 16, i0 = 256 * b2;
    for (int e = F.tid; e < 3072; e += 512) { const int j = e >> 3, ch = e & 7, idx = i0 - 128 + j; u32x4 kv = {0u, 0u, 0u, 0u}, vv = {0u, 0u, 0u, 0u};
        if (idx >= 0) { const size_t g = (size_t)(rres + d * idx) * PW + a * 64 + ch * 8; kv = *(const u32x4*)(F.proj + g + C_AK); vv = *(const u32x4*)(F.proj + g + C_AV); }
        *(u32x4*)(KA + j * KS + ch * 16) = kv; *(u32x4*)(VA + j * VS + ch * 16) = vv; }
    const int tokq = rres + d * (i0 + 32 * w + r);
    bf16x8 qf[4];
#pragma unroll
    for (int s = 0; s < 4; ++s) qf[s] = *(const bf16x8*)(F.proj + (size_t)tokq * PW + C_AQ + a * 64 + 16 * s + 8 * hh);
    const float mb2 = ((const float*)(F.lds + P3_EXT + 3072))[0];
    __syncthreads();
    f32x16 o[2]; o[0] = f32x16{}; o[1] = f32x16{}; float lsum = 0.f;
    const int qj = 32 * w + r + 128;
    if (i0 != 0) {
        { f32x16 S;
#pragma unroll
          for (int g = 0; g < 16; ++g) S[g] = -mb2;
          attn_sub<KS, VS>(KA, VA, 32 * w, qf, S, o, lsum, F.lane, true, qj - 128 - 32 * w, 31); }
        { f32x16 S[3];
#pragma unroll
          for (int u = 0; u < 3; ++u)
#pragma unroll
              for (int g = 0; g < 16; ++g) S[u][g] = -mb2;
          attn_multi<3, KS, VS>(KA, VA, 32 * (w + 1), qf, S, o, lsum, F.lane); }
        { f32x16 S;
#pragma unroll
          for (int g = 0; g < 16; ++g) S[g] = -mb2;
          attn_sub<KS, VS>(KA, VA, 32 * (w + 4), qf, S, o, lsum, F.lane, true, 0, qj - 32 * (w + 4)); }
    } else
    for (int jt = w; jt < w + 5; ++jt) { const int j0 = 32 * jt;
        if (j0 + 31 < 128) continue;
        f32x16 S;
#pragma unroll
        for (int g = 0; g < 16; ++g) S[g] = -mb2;
        int lo = qj - 128 - j0; const int hi_ = qj - j0; if (128 - j0 > lo) lo = 128 - j0;
        attn_sub<KS, VS>(KA, VA, j0, qf, S, o, lsum, F.lane, true, lo, hi_); }
    lsum += __shfl_xor(lsum, 32);
    bf16* oa = F.oa + ((size_t)n * SEQ + tokq) * 768 + a * 64 + 4 * hh;
#pragma unroll
    for (int dt = 0; dt < 2; ++dt)
#pragma unroll
        for (int i = 0; i < 4; ++i) { u32x2 wv; wv.x = pk2(o[dt][4 * i], o[dt][4 * i + 1]); wv.y = pk2(o[dt][4 * i + 2], o[dt][4 * i + 3]); *(u32x2*)(oa + 32 * dt + 8 * i) = wv; }
    if (hh == 0) F.la[((size_t)n * SEQ + tokq) * 12 + a] = lsum;
    __syncthreads();
}
__device__ __forceinline__ void phase3(Ctx& F, int l) {
    volatile unsigned* slot = (volatile unsigned*)(F.lds + QSLOT_OFF);
    { float* PEXA = (float*)(F.lds + P3_EXT); int* KFT = (int*)(F.lds + P3_EXT + 2048); float* MB = (float*)(F.lds + P3_EXT + 3072);
      { const float v = F.bt[F.lane * 8 + F.wave]; float sc = v;
#pragma unroll
        for (int o = 1; o < 64; o <<= 1) { const float y = __shfl_up(sc, o); if (F.lane >= o) sc += y; }
        PEXA[F.wave * 64 + F.lane] = sc - v; }
      if (F.tid == 0) { MB[0] = softmax_ref2(F.aqg + l * 64, F.akg + l * 64); MB[1] = softmax_ref2(F.bqg + l * 64, F.bkg + l * 64); }
      __syncthreads();
      if (F.tid < 256) { const int h = F.tid >> 5, qb = F.tid & 31; const float thr = -(26.f + 2.f * MB[1] * (1.f / LOG2E)), pq0 = PEXA[h * 64 + 2 * qb];
          int kt = 0; while (kt < 2 * qb && (pq0 - PEXA[h * 64 + kt + 1]) < thr) ++kt;
          KFT[F.tid] = kt; if (F.bid == 0) F.ctl[8192 + F.tid] = (unsigned)kt; }
      __syncthreads(); }
    for (;;) {
        if (F.tid == 0) *slot = atomicAdd(F.ctl + l, 1u);
        __syncthreads();
        const int item = __builtin_amdgcn_readfirstlane((int)*slot);
        __syncthreads();
        if (item >= N_ITEMS) break;
        if (item < N_SCAN) scan_item(F, item);
        else if (item < N_SCAN + N_FOX) { int f = item - N_SCAN, ns, qhi;
            if (f < 256) { ns = 4; qhi = 31; } else if (f < 448) { f -= 256; ns = 3; qhi = 23; } else if (f < 576) { f -= 448; ns = 2; qhi = 15; } else { f -= 576; ns = 1; qhi = 7; }
            const int per = ns * 8, qb = qhi - f / per, rem = f % per;
            fox_unit(F, l, rem & 7, qb, rem >> 3); }
        else { const int au = item - N_SCAN - N_FOX, n = au / 384, rest = au % 384, a = rest >> 5, u = rest & 31;
            const int per = (n == 0) ? 32 : (n == 1) ? 8 : 2;
            a_unit(F, l, a, n, u / per, u % per); }
    }
}
__device__ __forceinline__ void phase4(Ctx& F, int l) {
    unsigned char* VV = F.lds;
    float* SSQ = (float*)(F.lds + 51200);
    const int r = F.lane & 31, hh = F.lane >> 5, w = F.wave, ui = w >> 2, th = (w >> 1) & 1, vh = w & 1;
    const float* gain = F.out_gain + l * 192;
    for (int pu = F.bid; pu < 256; pu += F.G) {
        for (int e = F.tid; e < 3072; e += 512) { const int uu = e / 1536, e2 = e % 1536, row = e2 / 24, ch = e2 % 24, u = 2 * pu + uu, h = u & 3, n = u >> 2;
            *(u32x4*)(VV + uu * 25600 + row * 400 + ch * 16) = *(const u32x4*)(F.proj + (size_t)(n * 64 + row) * PW + C_CV + h * 192 + ch * 8); }
        __syncthreads();
        const int u = 2 * pu + ui, h = u & 3, n = u >> 2, t0 = n * 64, tq = th * 32 + r;
        bf16x8 qf[6];
#pragma unroll
        for (int kd = 0; kd < 6; ++kd) qf[kd] = *(const bf16x8*)(F.proj + (size_t)(t0 + tq) * PW + C_CQ + h * 96 + 16 * kd + 8 * hh);
        bf16x8 pf[2][2];
#pragma unroll
        for (int si = 0; si < 2; ++si) if (si <= th) { f32x16 X = {};
#pragma unroll
            for (int kd = 0; kd < 6; ++kd) { const bf16x8 kf = *(const bf16x8*)(F.proj + (size_t)(t0 + 32 * si + r) * PW + C_CK + h * 96 + 16 * kd + 8 * hh); X = MFMA32(kf, qf[kd], X); }
            if (si == th) {
#pragma unroll
                for (int g = 0; g < 16; ++g) if (rowidx(g, hh) > r) X[g] = 0.f; }
            pack_p(X, pf[si][0], pf[si][1]); }
        f32x16 O[3]; float sq = 0.f;
#pragma unroll
        for (int vt = 0; vt < 3; ++vt) { const int vtile = vh * 3 + vt; f32x16 acc = {};
#pragma unroll
            for (int si = 0; si < 2; ++si) if (si <= th) {
#pragma unroll
                for (int s2 = 0; s2 < 2; ++s2) { const bf16x8 vf = frag_tr((lds_cptr)(VV + ui * 25600), 400, 32 * si + 16 * s2, 32 * vtile, F.lane); acc = MFMA32(vf, pf[si][s2], acc); } }
#pragma unroll
            for (int kd = 0; kd < 6; ++kd) { const bf16x8 sf = *(const bf16x8*)(F.st + ((size_t)(n * 4 + h) * 192 + 32 * vtile + r) * 96 + 16 * kd + 8 * hh); acc = MFMA32(sf, qf[kd], acc); }
#pragma unroll
            for (int g = 0; g < 16; ++g) sq += acc[g] * acc[g];
            O[vt] = acc; }
        sq += __shfl_xor(sq, 32);
        if (hh == 0) SSQ[(ui * 2 + vh) * 64 + tq] = sq;
        __syncthreads();
        const float rs = rsqrtf((SSQ[(ui * 2) * 64 + tq] + SSQ[(ui * 2 + 1) * 64 + tq]) * (1.f / 192.f) + EPS);
#pragma unroll
        for (int vt = 0; vt < 3; ++vt)
#pragma unroll
            for (int i = 0; i < 4; ++i) { const int v = 32 * (vh * 3 + vt) + 8 * i + 4 * hh;
                const u32x2 zw = *(const u32x2*)(F.proj + (size_t)(t0 + tq) * PW + C_CZ + h * 192 + v); const f32x4 gg = *(const f32x4*)(gain + v);
                const float y0 = O[vt][4 * i] * rs * gg.x * silu(blo(zw.x)), y1 = O[vt][4 * i + 1] * rs * gg.y * silu(bhi(zw.x)), y2 = O[vt][4 * i + 2] * rs * gg.z * silu(blo(zw.y)), y3 = O[vt][4 * i + 3] * rs * gg.w * silu(bhi(zw.y));
                u32x2 ov; ov.x = pk2(y0, y1); ov.y = pk2(y2, y3); *(u32x2*)(F.mixed + (size_t)(t0 + tq) * DM + 1280 + h * 192 + v) = ov; }
        __syncthreads();
    }
    const int NT = F.G * 512, gt = F.bid * 512 + F.tid;
    for (int idx = gt; idx < SEQ * 96; idx += NT) { const int t = idx / 96, c = (idx % 96) * 8, a = c >> 6;
        float o[8] = {0.f, 0.f, 0.f, 0.f, 0.f, 0.f, 0.f, 0.f}; float lsum = 0.f;
#pragma unroll
        for (int n = 0; n < 3; ++n) { const u32x4 wv = *(const u32x4*)(F.oa + ((size_t)n * SEQ + t) * 768 + c); lsum += F.la[((size_t)n * SEQ + t) * 12 + a];
            o[0] += blo(wv.x); o[1] += bhi(wv.x); o[2] += blo(wv.y); o[3] += bhi(wv.y); o[4] += blo(wv.z); o[5] += bhi(wv.z); o[6] += blo(wv.w); o[7] += bhi(wv.w); }
        const float il = 1.f / lsum; const u32x4 zw = *(const u32x4*)(F.proj + (size_t)t * PW + C_AZ + c);
        u32x4 ov; ov.x = pk2(o[0] * il * silu(blo(zw.x)), o[1] * il * silu(bhi(zw.x))); ov.y = pk2(o[2] * il * silu(blo(zw.y)), o[3] * il * silu(bhi(zw.y)));
        ov.z = pk2(o[4] * il * silu(blo(zw.z)), o[5] * il * silu(bhi(zw.z))); ov.w = pk2(o[6] * il * silu(blo(zw.w)), o[7] * il * silu(bhi(zw.w)));
        *(u32x4*)(F.mixed + (size_t)t * DM + c) = ov; }
    for (int idx = gt; idx < SEQ * 64; idx += NT) { const int t = idx / 64, c = (idx % 64) * 8, h = c >> 6, nseg = (2 * (t >> 8) + 2 - (int)F.ctl[8192 + h * 32 + (t >> 8)] + 15) >> 4;
        f32x4 o0 = {0.f, 0.f, 0.f, 0.f}, o1 = {0.f, 0.f, 0.f, 0.f}; float lsum = 0.f;
        for (int s = 0; s < nseg; ++s) { const float* p = F.ob + ((size_t)s * SEQ + t) * 512 + c; o0 += *(const f32x4*)p; o1 += *(const f32x4*)(p + 4); lsum += F.lb[((size_t)s * SEQ + t) * 8 + h]; }
        const float il = 1.f / lsum; const u32x4 zw = *(const u32x4*)(F.proj + (size_t)t * PW + C_BZ + c);
        u32x4 ov; ov.x = pk2(o0.x * il * silu(blo(zw.x)), o0.y * il * silu(bhi(zw.x))); ov.y = pk2(o0.z * il * silu(blo(zw.y)), o0.w * il * silu(bhi(zw.y)));
        ov.z = pk2(o1.x * il * silu(blo(zw.z)), o1.y * il * silu(bhi(zw.z))); ov.w = pk2(o1.z * il * silu(blo(zw.w)), o1.w * il * silu(bhi(zw.w)));
        *(u32x4*)(F.mixed + (size_t)t * DM + 768 + c) = ov; }
}

#define LAS __attribute__((address_space(3)))
#define XB_TMO      128
#define XB_XCNT(j)  (256  + 64 * (j))
#define XB_XSUB(j)  (1280 + 64 * (j))
#define XB_XGEN(j)  (2304 + 64 * (j))
#define XB_TOP      3328
#define XB_TOPGEN   3392
#define XCD_BAR_WORDS 3456
#define XB_SPIN_CAP (1u << 18)

__device__ __forceinline__ unsigned xb_ld(unsigned* p)              { return __hip_atomic_load(p, __ATOMIC_RELAXED, __HIP_MEMORY_SCOPE_AGENT); }
__device__ __forceinline__ unsigned xb_add(unsigned* p, unsigned v) { return __hip_atomic_fetch_add(p, v, __ATOMIC_RELAXED, __HIP_MEMORY_SCOPE_AGENT); }
__device__ __forceinline__ unsigned xb_xcc_id() { return (unsigned)__builtin_amdgcn_s_getreg((3 << 11) | 20) & 0xFu; }
#define XB_SPIN(cond, bar) do { unsigned _sp = 0; while (cond) { __builtin_amdgcn_s_sleep(1); \
    if ((++_sp & 255u) == 0u) { if (xb_ld(&(bar)[XB_TMO])) break; if (_sp > XB_SPIN_CAP) { atomicAdd(&(bar)[XB_TMO], 1u); break; } } } } while (0)

struct XcdBarrier {
    unsigned* bar; unsigned x;
    volatile LAS unsigned* st;
};

__device__ __forceinline__ XcdBarrier xcd_barrier_post(unsigned* bar, volatile LAS unsigned* st) {
    XcdBarrier b; b.bar = bar; b.x = xb_xcc_id(); b.st = st;
    if (threadIdx.x == 0) (void)xb_add(&bar[XB_XCNT(b.x)], 1u);
    return b;
}
__device__ __forceinline__ void xcd_barrier_complete(unsigned* bar, unsigned x, unsigned& nloc, unsigned& nx) {
    const unsigned G = gridDim.x * gridDim.y * gridDim.z;
    unsigned sum, cnt, mine, sp = 0u;
    for (;;) {
        sum = 0u; cnt = 0u; mine = 0u;
#pragma unroll
        for (unsigned j = 0; j < 16; ++j) { const unsigned c = xb_ld(&bar[XB_XCNT(j)]); sum += c; cnt += (c > 0u) ? 1u : 0u; mine = (j == x) ? c : mine; }
        if (sum == G) break;
        __builtin_amdgcn_s_sleep(1);
        if ((++sp & 255u) == 0u) { if (xb_ld(&bar[XB_TMO])) break; if (sp > XB_SPIN_CAP) { atomicAdd(&bar[XB_TMO], 1u); break; } }
    }
    nloc = mine > 0u ? mine : 1u; nx = cnt > 0u ? cnt : 1u;
}

__device__ __forceinline__ void xcd_barrier(const XcdBarrier& b) {
    asm volatile("s_waitcnt vmcnt(0)" ::: "memory");
    __syncthreads();
    if (threadIdx.x == 0) {
        unsigned* bar = b.bar;
        __builtin_amdgcn_s_waitcnt(0);
        unsigned nloc = b.st[0], nx = b.st[1];
        if (nloc == 0u) { xcd_barrier_complete(bar, b.x, nloc, nx); b.st[0] = nloc; b.st[1] = nx; }
        const unsigned old = xb_add(&bar[XB_XSUB(b.x)], 1u);
        const unsigned gen = old / nloc;
        if (old + 1u == (gen + 1u) * nloc) {
            __builtin_amdgcn_fence(__ATOMIC_RELEASE, "agent");
            asm volatile("s_waitcnt vmcnt(0)" ::: "memory");
            const unsigned og = xb_add(&bar[XB_TOP], 1u);
            const unsigned tg = og / nx;
            if (og + 1u == (tg + 1u) * nx) xb_add(&bar[XB_TOPGEN], 1u);
            else XB_SPIN(xb_ld(&bar[XB_TOPGEN]) == tg, bar);
            __builtin_amdgcn_fence(__ATOMIC_ACQUIRE, "agent");
            xb_add(&bar[XB_XGEN(b.x)], 1u);
            asm volatile("s_waitcnt vmcnt(0)" ::: "memory");
        } else {
            XB_SPIN(xb_ld(&bar[XB_XGEN(b.x)]) == gen, bar);
            __builtin_amdgcn_fence(__ATOMIC_ACQUIRE, "agent");
            asm volatile("s_waitcnt vmcnt(0)" ::: "memory");
        }
    }
    __syncthreads();
}

struct Args { const float* in[12]; float* out; unsigned char* ws; int ph_lo, ph_hi; };
constexpr int N_PHASES = 1 + 5 * NLAYER;
__global__ void __launch_bounds__(512, 2) mega_fwd(Args args) {
    extern __shared__ __attribute__((aligned(16))) unsigned char lds[];
    Ctx F;
#define BUILD() do { const Args* ap_ = &args; \
    F.x = ap_->in[0]; F.norm_g = ap_->in[1]; F.w_in = ap_->in[2]; F.aqg = ap_->in[3]; F.akg = ap_->in[4]; F.bqg = ap_->in[5]; F.bkg = ap_->in[6]; \
    F.fox_bias = ap_->in[7]; F.gate_up = ap_->in[8]; F.gate_bias = ap_->in[9]; F.out_gain = ap_->in[10]; F.w_out = ap_->in[11]; \
    F.out = ap_->out; unsigned char* ws = ap_->ws; F.ws = ws; \
    F.ctl = (unsigned*)(ws + WS_CTL); F.ss = (unsigned long long*)(ws + WS_SS); F.wtin = (bf16*)(ws + WS_WTIN); F.wtout = (bf16*)(ws + WS_WTOUT); F.xb = (bf16*)(ws + WS_XB); \
    F.proj = (bf16*)(ws + WS_PROJ); F.small = (float*)(ws + WS_SMALL); F.mixed = (bf16*)(ws + WS_MIXED); F.oa = (bf16*)(ws + WS_OA); F.la = (float*)(ws + WS_LA); \
    F.ob = (float*)(ws + WS_OB); F.lb = (float*)(ws + WS_LB); F.cl = (float*)(ws + WS_CL); F.bt = (float*)(ws + WS_BT); F.ds = (float*)(ws + WS_DS); F.st = (bf16*)(ws + WS_ST); F.dec = (float*)(ws + WS_DEC); \
    F.lds = lds; F.G = gridDim.x; F.bid = blockIdx.x; \
    int t_ = threadIdx.x; asm volatile("" : "+v"(t_)); F.tid = t_; F.lane = t_ & 63; F.wave = __builtin_amdgcn_readfirstlane(t_ >> 6); } while (0)
    BUILD();
    cg::grid_group grid = cg::this_grid();
    if (threadIdx.x < 8) ((volatile LAS unsigned*)((LAS unsigned char*)lds + MISC_OFF))[threadIdx.x] = 0u;
    __syncthreads();
    XcdBarrier bar = xcd_barrier_post((unsigned*)(F.ws + WS_CTL) + 4096, (volatile LAS unsigned*)((LAS unsigned char*)lds + MISC_OFF));
    const int lo = args.ph_lo, hi = args.ph_hi;
#define IN(k) (lo <= (k) && (k) < hi)
#define RELAUNDER() do { int t_ = threadIdx.x; asm volatile("" : "+v"(t_)); F.tid = t_; F.lane = t_ & 63; F.wave = __builtin_amdgcn_readfirstlane(t_ >> 6); } while (0)
#define SEAM(k) do { if (IN(k) && IN((k) + 1)) { if ((k) == 0) grid.sync(); else xcd_barrier(bar); } } while (0)
    if (IN(0)) { BUILD(); phase0(F); }
    SEAM(0);
    for (int l = 0; l < NLAYER; ++l) { const int pb = 1 + 5 * l;
        if (IN(pb)) { BUILD(); pg8::Gemm g{F.xb, F.wtin + (size_t)l * NPAD * DM, SEQ, NPAD, DM}; pg8::StaticOrder S; S.init(SEQ, NPAD, F.G, F.bid);
            pg8::EpiProj E{F.proj, F.small, F.ss + l * SEQ, (float*)(lds + RING_BYTES + 1024), F.aqg + l * 64, F.akg + l * 64, F.bqg + l * 64, F.bkg + l * 64};
            pg8::gemm_phase<pg8::EpiProj, pg8::StaticOrder, true, true>((PG8_LAS unsigned char*)lds, g, S, E); __syncthreads(); }
        SEAM(pb);
        if (IN(pb + 1)) { BUILD(); phase2(F, l); }
        SEAM(pb + 1);
        if (IN(pb + 2)) { BUILD(); phase3(F, l); }
        SEAM(pb + 2);
        if (IN(pb + 3)) { BUILD(); phase4(F, l); }
        SEAM(pb + 3);
        if (IN(pb + 4)) { BUILD(); pg8::Gemm g{F.mixed, F.wtout + (size_t)l * DM * DM, SEQ, DM, DM}; pg8::StaticOrder S; S.init(SEQ, DM, F.G, F.bid);
            const bool last = (l == NLAYER - 1);
            pg8::EpiOut E{l == 0 ? F.x : F.out, F.out, last ? nullptr : F.xb, last ? nullptr : F.ss + (l + 1) * SEQ};
            pg8::gemm_phase<pg8::EpiOut, pg8::StaticOrder, true, true>((PG8_LAS unsigned char*)lds, g, S, E); __syncthreads(); }
        SEAM(pb + 4);
    }
#undef IN
#undef SEAM
}

#ifndef MK_ONE_LAUNCH
#define MK_ONE_LAUNCH 1
#endif
extern "C" void kernel_launch(void* const* d_in, const int* in_sizes, int n_in, void* d_out, int out_size, void* d_ws, size_t ws_size, hipStream_t stream) {
    static int grid = 0;
    if (grid == 0) {
        int dev = 0, cus = 0, per_cu = 0;
        hipGetDevice(&dev); hipDeviceGetAttribute(&cus, hipDeviceAttributeMultiprocessorCount, dev);
        hipFuncSetAttribute((const void*)mega_fwd, hipFuncAttributeMaxDynamicSharedMemorySize, LDS_BYTES);
        hipOccupancyMaxActiveBlocksPerMultiprocessor(&per_cu, mega_fwd, 512, LDS_BYTES);
        grid = cus * per_cu; if (grid <= 0) grid = 256;
        if (ws_size < WS_END) { fprintf(stderr, "workspace too small: %zu < %zu\n", ws_size, (size_t)WS_END); }
    }
    Args a{}; for (int i = 0; i < 12; ++i) a.in[i] = (const float*)d_in[i]; a.out = (float*)d_out; a.ws = (unsigned char*)d_ws;
#if MK_ONE_LAUNCH
    a.ph_lo = 0; a.ph_hi = N_PHASES; void* kargs[] = {&a};
    (void)hipMemsetAsync(d_ws, 0, 65536, stream);
    hipError_t e = hipLaunchCooperativeKernel((const void*)mega_fwd, dim3(grid), dim3(512), kargs, LDS_BYTES, stream);
    if (e != hipSuccess) fprintf(stderr, "cooperative launch failed: %s (grid %d)\n", hipGetErrorString(e), grid);
#else
    for (int p = 0; p < N_PHASES; ++p) { a.ph_lo = p; a.ph_hi = p + 1; hipLaunchKernelGGL(mega_fwd, dim3(grid), dim3(512), LDS_BYTES, stream, a); }
#endif
}
```

```cpp
#include <hip/hip_runtime.h>
#include <hip/hip_cooperative_groups.h>
#include <cstdio>
#include <cstdint>
namespace cg = cooperative_groups;
namespace pg8 {
#define PG8_LAS __attribute__((address_space(3)))
typedef unsigned short bf16_t;
typedef short bf16x8 __attribute__((ext_vector_type(8)));
typedef float f32x4 __attribute__((ext_vector_type(4)));
typedef unsigned u32x4 __attribute__((ext_vector_type(4)));
constexpr int BM = 256, BK = 64, HALF = 128, HTB = HALF * BK * 2  , STAGE_BYTES = 8 * HTB, NXCD = 8, WGM = 8;

__host__ __device__ __forceinline__ int lds_byte(int r, int c) { const int st = (r >> 4) * 2 + (c >> 5), rr = r & 15, cc = c & 31, ob = rr * 64 + cc * 2; return st * 1024 + (ob ^ (((ob >> 9) & 1) << 5)); }
__host__ __device__ __forceinline__ void stage_rc(int b, int& R, int& C) { const int st = b / 1024, sb = b % 1024, swz = sb ^ (((sb >> 9) & 1) << 5); R = (st >> 1) * 16 + swz / 64; C = (st & 1) * 32 + (swz % 64) / 2; }
__host__ __device__ __forceinline__ int perm32(int rho) { const int n = rho >> 4, i = rho & 15; return 8 * (i >> 2) + 4 * n + (i & 3); }

struct Unit { int pm, pn; };
struct Gemm { const bf16_t* A; const bf16_t* Bt; int M, N, K; };

struct StaticOrder {
    int nM, nN, nwg, G, c;
    __host__ __device__ void init(int M, int N, int G_, int c_) { nM = M / BM; nN = N / BM; nwg = nM * nN; G = G_; c = c_; }
    __host__ __device__ bool next(int i, Unit& u) const {
        const long L = (long)i * G + c; if (L >= nwg) return false;
        int wgid = (int)L; { const int q = nwg / NXCD, r = nwg % NXCD, xcd = wgid % NXCD, off = wgid / NXCD; wgid = (xcd < r ? xcd * (q + 1) : r * (q + 1) + (xcd - r) * q) + off; }
        const int nig = WGM * nN, gid = wgid / nig, fm = gid * WGM, gsz = (nM - fm) < WGM ? (nM - fm) : WGM;
        u.pm = fm + ((wgid % nig) % gsz); u.pn = (wgid % nig) / gsz; return true;
    }
    __device__ __forceinline__ void a_ready(const Unit&) const {}
    __device__ __forceinline__ void done(const Unit&) const {}
};

__device__ __forceinline__ unsigned cvt_pk_bf16(float lo, float hi) { unsigned r; asm volatile("v_cvt_pk_bf16_f32 %0, %1, %2" : "=v"(r) : "v"(lo), "v"(hi)); return r; }
typedef float f32x2 __attribute__((ext_vector_type(2)));
constexpr int PROJ_W = 7424;
struct EpiProj {
    static constexpr bool PERM = true, AFTER_DRAIN = false;
    bf16_t* O; float* small; const unsigned long long* ss; float* xch; const float* gaq; const float* gak; const float* gbq; const float* gbk;
    __device__ __forceinline__ void operator()(const f32x4 (&acc)[2][2][4][2], const Unit& u, int wr, int wc, int fr, int fq) const {
        const int row0 = u.pm * BM + wr * 64 + fr;
        if (u.pn < 29) {
            const int col0 = u.pn * BM + wc * 32 + 8 * fq;
            const bool isA = u.pn < 6, isB = (u.pn >= 12 && u.pn < 16);
            if (isA || isB) {
#pragma unroll
                for (int ai = 0; ai < 2; ++ai)
#pragma unroll
                    for (int m = 0; m < 4; ++m) { const int row = row0 + ai * HALF + m * 16; const float rs = rsqrtf((float)ss[row] * (1.0f / 1048576.0f / 2048.0f) + 1e-6f);
#pragma unroll
                        for (int bj = 0; bj < 2; ++bj) { const f32x4 v0 = acc[ai][bj][m][0] * rs, v1 = acc[ai][bj][m][1] * rs;
                            float sq = (v0[0] * v0[0] + v0[1] * v0[1]) + (v0[2] * v0[2] + v0[3] * v0[3]) + (v1[0] * v1[0] + v1[1] * v1[1]) + (v1[2] * v1[2] + v1[3] * v1[3]);
                            sq += __shfl_xor(sq, 16); sq += __shfl_xor(sq, 32);
                            if (fq == 0) xch[((ai * HALF + wr * 64 + m * 16 + fr) * 2 + bj) * 4 + wc] = sq; } }
                asm volatile("s_waitcnt lgkmcnt(0)" ::: "memory"); __builtin_amdgcn_s_barrier(); asm volatile("" ::: "memory");
                const bool isq = (u.pn < 3) || (u.pn == 12) || (u.pn == 13);
                const float* ga0 = gaq; const float* ga1 = gak; const float* gb0 = gbq; const float* gb1 = gbk;
                const float* gsel = isA ? ga0 : gb0; { const float* gk = isA ? ga1 : gb1; if (!isq) gsel = gk; }
                const float* g = gsel + 32 * (wc & 1) + 8 * fq;
                const float sc = isq ? 0.18033688011112042f : 1.0f;
                const f32x4 g0 = *(const f32x4*)g * sc, g1 = *(const f32x4*)(g + 4) * sc;
#pragma unroll
                for (int ai = 0; ai < 2; ++ai)
#pragma unroll
                    for (int m = 0; m < 4; ++m) { const int row = row0 + ai * HALF + m * 16; bf16_t* rowp = O + (size_t)row * PROJ_W + col0;
                        const float rs = rsqrtf((float)ss[row] * (1.0f / 1048576.0f / 2048.0f) + 1e-6f);
#pragma unroll
                        for (int bj = 0; bj < 2; ++bj) { const float* xp = xch + ((ai * HALF + wr * 64 + m * 16 + fr) * 2 + bj) * 4 + (wc & 2); const float tot = xp[0] + xp[1];
                            const float r2 = rsqrtf(tot * (1.0f / 64.0f) + 1e-6f) * rs;
                            const f32x4 v0 = acc[ai][bj][m][0] * r2 * g0, v1 = acc[ai][bj][m][1] * r2 * g1;
                            u32x4 w; w.x = cvt_pk_bf16(v0[0], v0[1]); w.y = cvt_pk_bf16(v0[2], v0[3]); w.z = cvt_pk_bf16(v1[0], v1[1]); w.w = cvt_pk_bf16(v1[2], v1[3]);
                            *(u32x4*)(rowp + bj * HALF) = w; } }
            } else {
#pragma unroll
            for (int ai = 0; ai < 2; ++ai)
#pragma unroll
                for (int m = 0; m < 4; ++m) { const int row = row0 + ai * HALF + m * 16; const float rs = rsqrtf((float)ss[row] * (1.0f / 1048576.0f / 2048.0f) + 1e-6f);
                    bf16_t* rowp = O + (size_t)row * PROJ_W + col0;
#pragma unroll
                    for (int bj = 0; bj < 2; ++bj) { const f32x4 v0 = acc[ai][bj][m][0] * rs, v1 = acc[ai][bj][m][1] * rs;
                        u32x4 w; w.x = cvt_pk_bf16(v0[0], v0[1]); w.y = cvt_pk_bf16(v0[2], v0[3]); w.z = cvt_pk_bf16(v1[0], v1[1]); w.w = cvt_pk_bf16(v1[2], v1[3]);
                        *(u32x4*)(rowp + bj * HALF) = w; } }
            }
        } else if (wc == 0) {
#pragma unroll
            for (int ai = 0; ai < 2; ++ai)
#pragma unroll
                for (int m = 0; m < 4; ++m) { const int row = row0 + ai * HALF + m * 16; const float rs = rsqrtf((float)ss[row] * (1.0f / 1048576.0f / 2048.0f) + 1e-6f);
                    float* p = small + (size_t)row * 32 + 8 * fq;
                    *(f32x4*)p = acc[ai][0][m][0] * rs; *(f32x4*)(p + 4) = acc[ai][0][m][1] * rs; }
        }
    }
};
struct EpiOut {
    static constexpr bool PERM = true, AFTER_DRAIN = false;
    const float* xin; float* out; bf16_t* xb; unsigned long long* ssn;
    __device__ __forceinline__ void operator()(const f32x4 (&acc)[2][2][4][2], const Unit& u, int wr, int wc, int fr, int fq) const {
        const int row0 = u.pm * BM + wr * 64 + fr, col0 = u.pn * BM + wc * 32 + 8 * fq;
#pragma unroll
        for (int ai = 0; ai < 2; ++ai) {
            f32x4 xo[4][2][2];
#pragma unroll
            for (int m = 0; m < 4; ++m)
#pragma unroll
                for (int bj = 0; bj < 2; ++bj) { const size_t p = (size_t)(row0 + ai * HALF + m * 16) * 2048 + col0 + bj * HALF; xo[m][bj][0] = *(const f32x4*)(xin + p); xo[m][bj][1] = *(const f32x4*)(xin + p + 4); }
#pragma unroll
            for (int m = 0; m < 4; ++m) asm volatile("" : "+v"(xo[m][0][0]), "+v"(xo[m][0][1]), "+v"(xo[m][1][0]), "+v"(xo[m][1][1]));
#pragma unroll
            for (int m = 0; m < 4; ++m) { const int row = row0 + ai * HALF + m * 16; float sq = 0.f;
#pragma unroll
                for (int bj = 0; bj < 2; ++bj) { const size_t p = (size_t)row * 2048 + col0 + bj * HALF;
                    const f32x4 a = xo[m][bj][0] + acc[ai][bj][m][0], b = xo[m][bj][1] + acc[ai][bj][m][1];
                    *(f32x4*)(out + p) = a; *(f32x4*)(out + p + 4) = b;
                    if (xb) { u32x4 w; w.x = cvt_pk_bf16(a[0], a[1]); w.y = cvt_pk_bf16(a[2], a[3]); w.z = cvt_pk_bf16(b[0], b[1]); w.w = cvt_pk_bf16(b[2], b[3]); *(u32x4*)(xb + p) = w; }
                    sq += (a[0] * a[0] + a[1] * a[1]) + (a[2] * a[2] + a[3] * a[3]) + (b[0] * b[0] + b[1] * b[1]) + (b[2] * b[2] + b[3] * b[3]); }
                sq += __shfl_xor(sq, 16); sq += __shfl_xor(sq, 32);
                if (fq == 0 && ssn) atomicAdd(ssn + row, (unsigned long long)(sq * 1048576.0f + 0.5f)); } }
    }
};

template <class Epi, class Sched, bool ALIGN_EPI = false, bool SP2 = false>
__device__ __forceinline__ void gemm_phase(PG8_LAS unsigned char* lds, const Gemm g, const Sched& S, const Epi& E) {
    int tid_ = threadIdx.x; asm volatile("" : "+v"(tid_)); const int tid = tid_, wid = __builtin_amdgcn_readfirstlane(tid >> 6), lane = tid & 63, wr = wid >> 2, wc = wid & 3, fr = lane & 15, fq = lane >> 4;
    const int K = g.K, nt = K / BK;
    unsigned voffA[2], voffB[2];
#pragma unroll
    for (int i = 0; i < 2; ++i) { int R, C; stage_rc(tid * 16 + i * 8192, R, C); const int Rb = Epi::PERM ? ((R & ~31) + perm32(R & 31)) : R;
        voffA[i] = (unsigned)(R * K + C) * 2u; voffB[i] = (unsigned)(Rb * K + C) * 2u; }
    const size_t kstep = (size_t)(BK * 2);
    const size_t hstep = (size_t)HALF * K * 2;
    const size_t tstep = 2 * hstep;
    const unsigned ldsw = (unsigned)wid * 1024u;
    const int aoff = lds_byte(wr * 64 + fr, fq * 8), boff = lds_byte(wc * 32 + fr, fq * 8);
#define PG8_SA(b, h) (((b) * 2 + (h)) * HTB)
#define PG8_SB(b, h) ((4 + (b) * 2 + (h)) * HTB)
#define PG8_STAGE(bufoff, gbase, voff) do { _Pragma("unroll") for (int _i = 0; _i < 2; ++_i) \
        __builtin_amdgcn_global_load_lds((const unsigned*)((const char*)(gbase) + (voff)[_i]), (PG8_LAS unsigned*)(lds + (bufoff) + ldsw + _i * 8192), 16, 0, 0); } while (0)
#define PG8_LDA(dst, b, h) do { _Pragma("unroll") for (int m = 0; m < 4; ++m) _Pragma("unroll") for (int k = 0; k < 2; ++k) dst[m][k] = *(const PG8_LAS bf16x8*)(lds + PG8_SA(b, h) + aoff + m * 2048 + k * 1024); } while (0)
#define PG8_LDB(dst, b, h) do { _Pragma("unroll") for (int n = 0; n < 2; ++n) _Pragma("unroll") for (int k = 0; k < 2; ++k) dst[n][k] = *(const PG8_LAS bf16x8*)(lds + PG8_SB(b, h) + boff + n * 2048 + k * 1024); } while (0)
#define PG8_MMA(ai, bj, At, Bt) do { __builtin_amdgcn_s_setprio(1); _Pragma("unroll") for (int m = 0; m < 4; ++m) _Pragma("unroll") for (int n = 0; n < 2; ++n) _Pragma("unroll") for (int k = 0; k < 2; ++k) \
        acc[ai][bj][m][n] = __builtin_amdgcn_mfma_f32_16x16x32_bf16(Bt[n][k], At[m][k], acc[ai][bj][m][n], 0, 0, 0); __builtin_amdgcn_s_setprio(0); } while (0)
#define PG8_WAIT_V(n) asm volatile("s_waitcnt vmcnt(" #n ")" ::: "memory")
#define PG8_WAIT_L(n) asm volatile("s_waitcnt lgkmcnt(" #n ")" ::: "memory")
#define PG8_BAR __builtin_amdgcn_s_barrier()
#define PG8_SCHED __builtin_amdgcn_sched_barrier(0)
    Unit cur, nxt; int ui = 0;
    if (!S.next(0, cur)) return;
    f32x4 acc[2][2][4][2];
#pragma unroll
    for (int a = 0; a < 2; ++a)
#pragma unroll
        for (int b = 0; b < 2; ++b)
#pragma unroll
            for (int m = 0; m < 4; ++m)
#pragma unroll
                for (int n = 0; n < 2; ++n) acc[a][b][m][n] = (f32x4){0.f, 0.f, 0.f, 0.f};
    bf16x8 At[4][2], B0[2][2], B1[2][2];
    const char* cA = (const char*)g.A + (size_t)cur.pm * tstep; const char* cB = (const char*)g.Bt + (size_t)cur.pn * tstep;
    S.a_ready(cur);
    if constexpr (SP2) {
        PG8_STAGE(PG8_SB(0, 0), cB, voffB); PG8_STAGE(PG8_SB(0, 1), cB + hstep, voffB); PG8_STAGE(PG8_SA(0, 0), cA, voffA); PG8_STAGE(PG8_SA(0, 1), cA + hstep, voffA);
        if (wr == 1) PG8_BAR;
        PG8_WAIT_V(2); PG8_BAR;
        PG8_STAGE(PG8_SB(1, 0), cB + kstep, voffB); PG8_STAGE(PG8_SA(1, 0), cA + kstep, voffA); PG8_STAGE(PG8_SB(1, 1), cB + hstep + kstep, voffB);
        PG8_WAIT_V(6); PG8_BAR;
    } else {
        PG8_STAGE(PG8_SB(0, 0), cB, voffB); PG8_STAGE(PG8_SA(0, 0), cA, voffA); PG8_STAGE(PG8_SB(0, 1), cB + hstep, voffB); PG8_STAGE(PG8_SA(0, 1), cA + hstep, voffA);
        if (wr == 1) PG8_BAR;
        PG8_WAIT_V(4); PG8_BAR;
        PG8_STAGE(PG8_SB(1, 0), cB + kstep, voffB); PG8_STAGE(PG8_SA(1, 0), cA + kstep, voffA); PG8_STAGE(PG8_SB(1, 1), cB + hstep + kstep, voffB);
        PG8_WAIT_V(6); PG8_BAR;
    }
    for (;;) {
        const bool has_next = S.next(ui + 1, nxt);
        const char* nA = has_next ? (const char*)g.A + (size_t)nxt.pm * tstep : cA; const char* nB = has_next ? (const char*)g.Bt + (size_t)nxt.pn * tstep : cB;
        for (int t = 0; t < nt; t += 2) {
            const bool last = (t == nt - 2);
            const char* a1 = cA + (size_t)(t + 1) * kstep;
            const char* a2 = last ? nA : cA + (size_t)(t + 2) * kstep; const char* b2 = last ? nB : cB + (size_t)(t + 2) * kstep;
            const char* a3 = a2 + kstep; const char* b3 = b2 + kstep;
            if (last && has_next) S.a_ready(nxt);
            if constexpr (SP2) {
            PG8_LDB(B0, 0, 0); PG8_LDB(B1, 0, 1); PG8_SCHED; PG8_LDA(At, 0, 0); PG8_STAGE(PG8_SA(1, 1), a1 + hstep, voffA);
            PG8_WAIT_V(8); PG8_WAIT_L(0); PG8_BAR; PG8_MMA(0, 0, At, B0); PG8_MMA(0, 1, At, B1); PG8_BAR; PG8_SCHED;
            PG8_LDA(At, 0, 1); PG8_STAGE(PG8_SB(0, 0), b2, voffB); PG8_STAGE(PG8_SB(0, 1), b2 + hstep, voffB); PG8_STAGE(PG8_SA(0, 0), a2, voffA);
            PG8_WAIT_V(8); PG8_WAIT_L(0); PG8_BAR; PG8_MMA(1, 0, At, B0); PG8_MMA(1, 1, At, B1); PG8_BAR; PG8_SCHED;
            PG8_LDB(B0, 1, 0); PG8_LDB(B1, 1, 1); PG8_SCHED; PG8_LDA(At, 1, 0); PG8_STAGE(PG8_SA(0, 1), a2 + hstep, voffA);
            PG8_WAIT_V(8); PG8_WAIT_L(0); PG8_BAR; PG8_MMA(0, 0, At, B0); PG8_MMA(0, 1, At, B1); PG8_BAR; PG8_SCHED;
            PG8_LDA(At, 1, 1); PG8_STAGE(PG8_SB(1, 0), b3, voffB); PG8_STAGE(PG8_SB(1, 1), b3 + hstep, voffB); PG8_STAGE(PG8_SA(1, 0), a3, voffA);
            PG8_WAIT_V(8); PG8_WAIT_L(0); PG8_BAR; PG8_MMA(1, 0, At, B0); PG8_MMA(1, 1, At, B1); PG8_BAR; PG8_SCHED;
            } else {
            PG8_LDB(B0, 0, 0); PG8_SCHED; PG8_LDA(At, 0, 0); PG8_STAGE(PG8_SA(1, 1), a1 + hstep, voffA);
            PG8_WAIT_L(8); PG8_BAR; PG8_WAIT_L(0); PG8_MMA(0, 0, At, B0); PG8_BAR; PG8_SCHED;
            PG8_LDB(B1, 0, 1); PG8_STAGE(PG8_SB(0, 0), b2, voffB);
            PG8_BAR; PG8_WAIT_L(0); PG8_MMA(0, 1, At, B1); PG8_BAR;
            PG8_LDA(At, 0, 1); PG8_STAGE(PG8_SA(0, 0), a2, voffA);
            PG8_BAR; PG8_WAIT_L(0); PG8_MMA(1, 0, At, B0); PG8_BAR; PG8_SCHED;
            PG8_STAGE(PG8_SB(0, 1), b2 + hstep, voffB);
            PG8_WAIT_V(6); PG8_BAR; PG8_MMA(1, 1, At, B1); PG8_BAR;
            PG8_LDB(B0, 1, 0); PG8_SCHED; PG8_LDA(At, 1, 0); PG8_STAGE(PG8_SA(0, 1), a2 + hstep, voffA);
            PG8_WAIT_L(8); PG8_BAR; PG8_WAIT_L(0); PG8_MMA(0, 0, At, B0); PG8_BAR; PG8_SCHED;
            PG8_LDB(B1, 1, 1); PG8_STAGE(PG8_SB(1, 0), b3, voffB);
            PG8_BAR; PG8_WAIT_L(0); PG8_MMA(0, 1, At, B1); PG8_BAR;
            PG8_LDA(At, 1, 1); PG8_STAGE(PG8_SA(1, 0), a3, voffA);
            PG8_BAR; PG8_WAIT_L(0); PG8_MMA(1, 0, At, B0); PG8_BAR; PG8_SCHED;
            PG8_STAGE(PG8_SB(1, 1), b3 + hstep, voffB);
            PG8_WAIT_V(6); PG8_BAR; PG8_MMA(1, 1, At, B1); PG8_BAR;
            }
        }
        if constexpr (ALIGN_EPI) { if (wr == 0) PG8_BAR; }
        if constexpr (!Epi::AFTER_DRAIN) { E(acc, cur, wr, wc, fr, fq); S.done(cur); }
        if (!has_next) break;
#pragma unroll
        for (int a = 0; a < 2; ++a)
#pragma unroll
            for (int b = 0; b < 2; ++b)
#pragma unroll
                for (int m = 0; m < 4; ++m)
#pragma unroll
                    for (int n = 0; n < 2; ++n) acc[a][b][m][n] = (f32x4){0.f, 0.f, 0.f, 0.f};
        cur = nxt; cA = nA; cB = nB; ++ui;
        if constexpr (ALIGN_EPI) { if (wr == 1) PG8_BAR; }
    }
    PG8_WAIT_V(0);
    if constexpr (!ALIGN_EPI) { if (wr == 0) PG8_BAR; }
    PG8_BAR;
    if constexpr (Epi::AFTER_DRAIN) { E.fused(acc, cur, wr, wc, fr, fq, lds, wid, lane); S.done(cur); }
#undef PG8_SA
#undef PG8_SB
#undef PG8_STAGE
#undef PG8_LDA
#undef PG8_LDB
#undef PG8_MMA
#undef PG8_WAIT_V
#undef PG8_WAIT_L
#undef PG8_BAR
#undef PG8_SCHED
}
}
constexpr int SEQ = 8192, DM = 2048, NLAYER = 4, INW = 7448, NPAD = 7680, PW = pg8::PROJ_W;
constexpr int C_AQ = 0, C_AK = 768, C_AV = 1536, C_AZ = 2304, C_BQ = 3072, C_BK = 3584, C_BV = 4096, C_BZ = 4608, C_CQ = 5120, C_CK = 5504, C_CV = 5888, C_CZ = 6656;
constexpr float LOG2E = 1.4426950408889634f, QSCALE = 0.125f * 1.4426950408889634f, EPS = 1e-6f;
constexpr size_t MiB = 1u << 20;
constexpr size_t WS_CTL = 0, WS_SS = 1 * MiB, WS_WTIN = 2 * MiB, WS_WTOUT = 122 * MiB, WS_XB = 154 * MiB, WS_PROJ = 186 * MiB, WS_SMALL = 302 * MiB,
                 WS_MIXED = 304 * MiB, WS_OA = 336 * MiB, WS_LA = 372 * MiB, WS_OB = 374 * MiB, WS_LB = 438 * MiB, WS_CL = 439 * MiB, WS_BT = WS_CL + 512 * 1024,
                 WS_DS = 440 * MiB, WS_ST = 476 * MiB, WS_DEC = 494 * MiB, WS_END = 496 * MiB;
constexpr int RING_BYTES = 131072, LDS_BYTES = 147456, QSLOT_OFF = RING_BYTES + 64, MISC_OFF = RING_BYTES + 256;
constexpr int P3_EXT = RING_BYTES + 1024;
constexpr int N_SCAN = 72, N_FOX = 640, N_AU = 1152, N_ITEMS = N_SCAN + N_FOX + N_AU;

typedef unsigned short bf16;
typedef short bf16x8 __attribute__((ext_vector_type(8)));
typedef short s16x4 __attribute__((ext_vector_type(4)));
typedef float f32x4 __attribute__((ext_vector_type(4)));
typedef float f32x2 __attribute__((ext_vector_type(2)));
typedef float f32x16 __attribute__((ext_vector_type(16)));
typedef unsigned u32x4 __attribute__((ext_vector_type(4)));
typedef unsigned u32x2 __attribute__((ext_vector_type(2)));
typedef __attribute__((address_space(3))) const char* lds_cptr;
#define LAS3 __attribute__((address_space(3)))

__device__ __forceinline__ float bf2f(unsigned b) { return __uint_as_float(b << 16); }
__device__ __forceinline__ unsigned pk2(float lo, float hi) { return pg8::cvt_pk_bf16(lo, hi); }
__device__ __forceinline__ float blo(unsigned w) { return __uint_as_float(w << 16); }
__device__ __forceinline__ float bhi(unsigned w) { return __uint_as_float(w & 0xffff0000u); }
__device__ __forceinline__ float logsig(float x) { return fminf(x, 0.f) - log1pf(expf(-fabsf(x))); }
__device__ __forceinline__ float silu(float x) { return x / (1.f + __expf(-x)); }
__device__ __forceinline__ s16x4 vtr(lds_cptr p) { return __builtin_bit_cast(s16x4, __builtin_amdgcn_ds_read_tr16_b64_v4i16((LAS3 s16x4*)p)); }
__device__ __forceinline__ bf16x8 frag_tr(lds_cptr img, int stride, int kbase, int m0, int lane) {
    const int i = lane & 15, g = lane >> 4;
    lds_cptr p = img + (kbase + 4 * (g >> 1) + (i >> 2)) * stride + (m0 + 16 * (g & 1) + 4 * (i & 3)) * 2;
    const s16x4 a = vtr(p), b = vtr(p + 8 * stride);
    return (bf16x8){a[0], a[1], a[2], a[3], b[0], b[1], b[2], b[3]};
}
__device__ __forceinline__ int rowidx(int reg, int hh) { return (reg & 3) + 8 * (reg >> 2) + 4 * hh; }
__device__ __forceinline__ void pack_p(const f32x16& p, bf16x8& f0, bf16x8& f1) {
    u32x4 a, b; a.x = pk2(p[0], p[1]); a.y = pk2(p[2], p[3]); a.z = pk2(p[4], p[5]); a.w = pk2(p[6], p[7]);
    b.x = pk2(p[8], p[9]); b.y = pk2(p[10], p[11]); b.z = pk2(p[12], p[13]); b.w = pk2(p[14], p[15]);
    f0 = __builtin_bit_cast(bf16x8, a); f1 = __builtin_bit_cast(bf16x8, b);
}
#define MFMA32(a, b, c) __builtin_amdgcn_mfma_f32_32x32x16_bf16((a), (b), (c), 0, 0, 0)

struct Ctx {
    const float *x, *norm_g, *w_in, *aqg, *akg, *bqg, *bkg, *fox_bias, *gate_up, *gate_bias, *out_gain, *w_out;
    float* out; unsigned char* ws;
    unsigned* ctl; unsigned long long* ss; bf16* wtin; bf16* wtout; bf16* xb; bf16* proj; float* small; bf16* mixed; bf16* oa; float* la; float* ob; float* lb; float* cl; float* bt;
    float* ds; bf16* st; float* dec;
    unsigned char* lds; int tid, lane, wave, G, bid;
};

__device__ __forceinline__ int orig_col(int np) { if (np < 5120) return np; if (np < 7424) return np + 8; if (np < 7432) return 5120 + (np - 7424); if (np < 7448) return np; return -1; }
__device__ __forceinline__ void p0_item(const float* W, int N, bf16* WT, const float* g, int mode, float* scr, int kb, int nb, int lane) {
    const int k0 = 64 * kb, n0 = 32 * nb, c4 = 4 * (lane & 7), np = n0 + c4;
    const int oc = mode ? orig_col(np) : np;
    const float cs = (mode && np >= C_CQ && np < C_CK) ? 0.10206207261596577f : 1.0f;
    f32x4 v[8];
#pragma unroll
    for (int i = 0; i < 8; ++i) { const int kk = 8 * i + (lane >> 3); v[i] = (f32x4){0.f, 0.f, 0.f, 0.f};
        if (oc >= 0) { v[i] = *(const f32x4*)(W + (size_t)(k0 + kk) * N + oc); const float sc = mode ? cs * g[k0 + kk] : 1.0f; v[i] = v[i] * sc; } }
#pragma unroll
    for (int i = 0; i < 8; ++i) { const int kk = 8 * i + (lane >> 3); float* d = scr + kk * 33 + c4; d[0] = v[i].x; d[1] = v[i].y; d[2] = v[i].z; d[3] = v[i].w; }
    __builtin_amdgcn_s_waitcnt(0); asm volatile("" ::: "memory");
    const int c = lane & 7;
#pragma unroll
    for (int j = 0; j < 4; ++j) { const int n = (lane >> 3) + 8 * j; const float* s = scr + (8 * c) * 33 + n;
        u32x4 o; o.x = pk2(s[0 * 33], s[1 * 33]); o.y = pk2(s[2 * 33], s[3 * 33]); o.z = pk2(s[4 * 33], s[5 * 33]); o.w = pk2(s[6 * 33], s[7 * 33]);
        *(u32x4*)(WT + (size_t)(n0 + n) * 2048 + k0 + 8 * c) = o; }
    __builtin_amdgcn_s_waitcnt(0); asm volatile("" ::: "memory");
}
__device__ __forceinline__ void phase0(Ctx& F) {
    float* scr = (float*)(F.lds + F.wave * 16384);
    const int gw = F.bid * 8 + F.wave, NGW = F.G * 8;
    if (F.bid == 0 && F.tid < 64) F.ctl[F.tid] = 0u;
    for (int i = F.bid * 512 + F.tid; i < 3 * SEQ; i += F.G * 512) F.ss[SEQ + i] = 0ull;
    constexpr int I_IN = 32 * 233, I_OUT = 32 * 64, I_L = I_IN + I_OUT;
    for (int it = gw; it < NLAYER * I_L; it += NGW) {
        const int l = it / I_L; int r = it % I_L;
        if (r < I_IN) p0_item(F.w_in + (size_t)l * DM * INW, INW, F.wtin + (size_t)l * NPAD * DM, F.norm_g + l * DM, 1, scr, r / 233, r % 233, F.lane);
        else { r -= I_IN; p0_item(F.w_out + (size_t)l * DM * DM, DM, F.wtout + (size_t)l * DM * DM, nullptr, 0, scr, r / 64, r % 64, F.lane); }
    }
    for (int m = gw; m < SEQ; m += NGW) {
        const f32x4* xr = (const f32x4*)(F.x + (size_t)m * DM) + F.lane; float s = 0.f; u32x2* o8 = (u32x2*)(F.xb + (size_t)m * DM) + F.lane;
#pragma unroll
        for (int j = 0; j < 8; ++j) { const f32x4 v = xr[64 * j]; s += (v.x * v.x + v.y * v.y) + (v.z * v.z + v.w * v.w); u32x2 w; w.x = pk2(v.x, v.y); w.y = pk2(v.z, v.w); o8[64 * j] = w; }
#pragma unroll
        for (int o = 1; o < 64; o <<= 1) s += __shfl_xor(s, o);
        if (F.lane == 0) F.ss[m] = (unsigned long long)(s * 1048576.0f + 0.5f);
    }
}

__device__ __forceinline__ void phase2(Ctx& F, int l) {
    { const int gw = F.bid * 8 + F.wave, NGW = F.G * 8;
      for (int wi = gw; wi < 512; wi += NGW) { const int blk = wi >> 3, h = wi & 7, t = blk * 128 + 2 * F.lane; const float fb = F.fox_bias[l * 8 + h];
        const float l0 = logsig(F.small[(size_t)t * 32 + h] + fb), l1 = logsig(F.small[(size_t)(t + 1) * 32 + h] + fb);
        float s = l0 + l1;
#pragma unroll
        for (int o = 1; o < 64; o <<= 1) { const float y = __shfl_up(s, o); if (F.lane >= o) s += y; }
        const float ex = s - (l0 + l1); F.cl[t * 8 + h] = ex + l0; F.cl[(t + 1) * 8 + h] = s; if (F.lane == 63) F.bt[blk * 8 + h] = s; } }
    { float* CR = (float*)F.lds;
      float* GT = (float*)(F.lds + 4096);
      unsigned char* KH = F.lds + 8192;
      unsigned char* VV = F.lds + 8192 + 13312;
      const float* gup = F.gate_up + (size_t)l * 16 * 384; const float* gbs = F.gate_bias + l * 384;
      for (int u = F.bid; u < 512; u += F.G) { const int h = u & 3, n = u >> 2, t0 = n * 64;
        if (F.tid < 256) *(f32x4*)(CR + F.tid * 4) = *(const f32x4*)(F.small + (size_t)(t0 + (F.tid >> 2)) * 32 + 8 + 4 * (F.tid & 3));
        { u32x4 vv[3];
#pragma unroll
          for (int i = 0; i < 3; ++i) { const int e = F.tid + 512 * i, row = e / 24, ch = e % 24; vv[i] = *(const u32x4*)(F.proj + (size_t)(t0 + row) * PW + C_CV + h * 192 + ch * 8); }
          asm volatile("" : "+v"(vv[0]), "+v"(vv[1]), "+v"(vv[2]));
#pragma unroll
          for (int i = 0; i < 3; ++i) { const int e = F.tid + 512 * i, row = e / 24, ch = e % 24; *(u32x4*)(VV + row * 400 + ch * 16) = vv[i]; } }
        __syncthreads();
        const int d = F.tid % 96, tg = F.tid / 96;
        float bc[16];
        if (F.tid < 384) { float g[16];
#pragma unroll
            for (int r = 0; r < 16; ++r) g[r] = gup[r * 384 + h * 96 + d];
            const float gb = gbs[h * 96 + d]; float run = 0.f;
#pragma unroll
            for (int i = 0; i < 16; ++i) { const float* cr = CR + (16 * tg + i) * 16; float a = gb;
#pragma unroll
                for (int r4 = 0; r4 < 4; ++r4) { const f32x4 c = *(const f32x4*)(cr + 4 * r4); a += c.x * g[4 * r4] + c.y * g[4 * r4 + 1] + c.z * g[4 * r4 + 2] + c.w * g[4 * r4 + 3]; }
                const float ls = fminf(a, 0.f) - __logf(1.f + __expf(-fabsf(a)));
                run += ls * (1.f / 16.f); bc[i] = run; }
            GT[tg * 96 + d] = run; }
        __syncthreads();
        if (F.tid < 384) { const float g0 = GT[d], g1 = GT[96 + d], g2 = GT[192 + d], g3 = GT[288 + d];
            const float pre = (tg > 0 ? g0 : 0.f) + (tg > 1 ? g1 : 0.f) + (tg > 2 ? g2 : 0.f);
            const float bm = g0 + g1, bl = (g0 + g1) + (g2 + g3);
            bf16* qp = F.proj + (size_t)(t0 + 16 * tg) * PW + C_CQ + h * 96 + d; bf16* kp = F.proj + (size_t)(t0 + 16 * tg) * PW + C_CK + h * 96 + d;
            float qv[16], kv[16];
#pragma unroll
            for (int i = 0; i < 16; ++i) { qv[i] = bf2f(qp[(size_t)i * PW]); kv[i] = bf2f(kp[(size_t)i * PW]); }
#pragma unroll
            for (int i = 0; i < 16; ++i) { const float b = bc[i] + pre; const float eq = __expf(b - bm), ek = __expf(bm - b), eh = __expf(bl - b);
                qp[(size_t)i * PW] = (bf16)(pk2(qv[i] * eq, 0.f) & 0xffffu); kp[(size_t)i * PW] = (bf16)(pk2(kv[i] * ek, 0.f) & 0xffffu);
                *(bf16*)(KH + (16 * tg + i) * 208 + d * 2) = (bf16)(pk2(kv[i] * eh, 0.f) & 0xffffu); }
            if (tg == 0) { F.dec[(n * 4 + h) * 96 + d] = __expf(bl); F.dec[49152 + (n * 4 + h) * 96 + d] = __expf(bm); } }
        __syncthreads();
        for (int id = F.wave; id < 18; id += 8) { const int vt = id / 3, dt = id % 3; f32x16 acc = {};
#pragma unroll
            for (int s = 0; s < 4; ++s) { const bf16x8 a = frag_tr((lds_cptr)VV, 400, 16 * s, 32 * vt, F.lane), b = frag_tr((lds_cptr)KH, 208, 16 * s, 32 * dt, F.lane); acc = MFMA32(a, b, acc); }
            float* dst = F.ds + ((size_t)(n * 4 + h) * 192 + 32 * vt) * 96 + 32 * dt + (F.lane & 31);
#pragma unroll
            for (int r = 0; r < 16; ++r) dst[(size_t)rowidx(r, F.lane >> 5) * 96] = acc[r]; }
        __syncthreads(); } }
}
__device__ __forceinline__ float softmax_ref2(const float* gq, const float* gk) {
    float mq = 0.f, mk = 0.f;
    for (int i = 0; i < 64; ++i) { mq = fmaxf(mq, fabsf(gq[i])); mk = fmaxf(mk, fabsf(gk[i])); }
    return 8.25f * mq * mk * LOG2E;
}
__device__ __forceinline__ void scan_item(Ctx& F, int si) {
    const int p = si * 512 + F.tid, d = 2 * (p % 48), v = (p / 48) % 192, h = p / (48 * 192);
    float s0 = 0.f, s1 = 0.f;
    for (int nb = 0; nb < 128; nb += 8) { f32x2 dd[8], a[8], em[8];
#pragma unroll
        for (int j = 0; j < 8; ++j) { const int n = nb + j; const size_t idx = ((size_t)(n * 4 + h) * 192 + v) * 96 + d; const int di = (n * 4 + h) * 96 + d;
            dd[j] = *(const f32x2*)(F.ds + idx); a[j] = *(const f32x2*)(F.dec + di); em[j] = *(const f32x2*)(F.dec + 49152 + di); }
#pragma unroll
        for (int j = 0; j < 8; j += 4) { asm volatile("" : "+v"(dd[j]), "+v"(dd[j + 1]), "+v"(dd[j + 2]), "+v"(dd[j + 3])); asm volatile("" : "+v"(a[j]), "+v"(a[j + 1]), "+v"(a[j + 2]), "+v"(a[j + 3])); asm volatile("" : "+v"(em[j]), "+v"(em[j + 1]), "+v"(em[j + 2]), "+v"(em[j + 3])); }
#pragma unroll
        for (int j = 0; j < 8; ++j) { const int n = nb + j; const size_t idx = ((size_t)(n * 4 + h) * 192 + v) * 96 + d;
            *(unsigned*)(F.st + idx) = pk2(em[j].x * s0, em[j].y * s1);
            s0 = a[j].x * s0 + dd[j].x; s1 = a[j].y * s1 + dd[j].y; } }
}
#define PIN4(a, b, c, d) asm volatile("" : "+v"(a), "+v"(b), "+v"(c), "+v"(d))
#define SBAR0() __builtin_amdgcn_sched_barrier(0)
template <int KSTR, int VSTR>
__device__ __forceinline__ void attn_sub(const unsigned char* Kt, const unsigned char* Vt, int key_row0, const bf16x8 (&qf)[4], f32x16 S, f32x16 (&o)[2], float& lsum, int lane,
                                         bool use_mask, int lo, int hi_) {
    const int r = lane & 31, hh = lane >> 5;
    bf16x8 kf[4];
#pragma unroll
    for (int s = 0; s < 4; ++s) kf[s] = *(const bf16x8*)(Kt + (key_row0 + r) * KSTR + (16 * s + 8 * hh) * 2);
    bf16x8 vf[2][2];
#pragma unroll
    for (int dt = 0; dt < 2; ++dt) { vf[dt][0] = frag_tr((lds_cptr)Vt, VSTR, key_row0, 32 * dt, lane); vf[dt][1] = frag_tr((lds_cptr)Vt, VSTR, key_row0 + 16, 32 * dt, lane); }
    PIN4(kf[0], kf[1], kf[2], kf[3]);
#pragma unroll
    for (int s = 0; s < 4; ++s) S = MFMA32(kf[s], qf[s], S);
    if (use_mask) {
#pragma unroll
        for (int g = 0; g < 16; ++g) { const int k = rowidx(g, hh); if (k < lo || k > hi_) S[g] = -INFINITY; } }
    float acc = 0.f;
#pragma unroll
    for (int g = 0; g < 16; ++g) { S[g] = __builtin_amdgcn_exp2f(S[g]); acc += S[g]; }
    lsum += acc;
    bf16x8 p0, p1; pack_p(S, p0, p1);
    PIN4(vf[0][0], vf[0][1], vf[1][0], vf[1][1]);
#pragma unroll
    for (int dt = 0; dt < 2; ++dt) { o[dt] = MFMA32(vf[dt][0], p0, o[dt]); o[dt] = MFMA32(vf[dt][1], p1, o[dt]); }
}
template <int NSUB, int KSTR, int VSTR>
__device__ __forceinline__ void attn_multi(const unsigned char* Kt, const unsigned char* Vt, int key_row0, const bf16x8 (&qf)[4], f32x16 (&S)[NSUB], f32x16 (&o)[2], float& lsum, int lane) {
    const int r = lane & 31, hh = lane >> 5;
    bf16x8 kf[NSUB][4];
#pragma unroll
    for (int u = 0; u < NSUB; ++u)
#pragma unroll
        for (int s = 0; s < 4; ++s) kf[u][s] = *(const bf16x8*)(Kt + (key_row0 + 32 * u + r) * KSTR + (16 * s + 8 * hh) * 2);
#pragma unroll
    for (int u = 0; u < NSUB; ++u) PIN4(kf[u][0], kf[u][1], kf[u][2], kf[u][3]);
#pragma unroll
    for (int s = 0; s < 4; ++s)
#pragma unroll
        for (int u = 0; u < NSUB; ++u) S[u] = MFMA32(kf[u][s], qf[s], S[u]);
#pragma unroll
    for (int u = 0; u < NSUB; ++u) {
        bf16x8 vf[2][2];
#pragma unroll
        for (int dt = 0; dt < 2; ++dt) { vf[dt][0] = frag_tr((lds_cptr)Vt, VSTR, key_row0 + 32 * u, 32 * dt, lane); vf[dt][1] = frag_tr((lds_cptr)Vt, VSTR, key_row0 + 32 * u + 16, 32 * dt, lane); }
        SBAR0();
        float acc = 0.f;
#pragma unroll
        for (int g = 0; g < 16; ++g) { S[u][g] = __builtin_amdgcn_exp2f(S[u][g]); acc += S[u][g]; }
        lsum += acc;
        bf16x8 p0, p1; pack_p(S[u], p0, p1);
        PIN4(vf[0][0], vf[0][1], vf[1][0], vf[1][1]);
#pragma unroll
        for (int dt = 0; dt < 2; ++dt) { o[dt] = MFMA32(vf[dt][0], p0, o[dt]); o[dt] = MFMA32(vf[dt][1], p1, o[dt]); } }
}
__device__ __forceinline__ void fox_unit(Ctx& F, int l, int h, int qb, int seg) {
    constexpr int KS = 144, VS = 192, BUFB = 128 * KS, BUFV = 128 * VS;
    unsigned char* KT = F.lds; unsigned char* VT = F.lds + 2 * BUFB; float* CS = (float*)(F.lds + 2 * BUFB + 2 * BUFV);
    const float* PEX = (const float*)(F.lds + P3_EXT) + h * 64;
    const int r = F.lane & 31, hh = F.lane >> 5, w = F.wave, t0 = 256 * qb, NT = 2 * qb + 2;
    const int kfirst = __builtin_amdgcn_readfirstlane(((const int*)(F.lds + P3_EXT + 2048))[h * 32 + qb]);
    const int nuse = (NT - kfirst + 15) >> 4;
    if (seg >= nuse) return;
    const int kt0 = kfirst + 16 * seg, te = (kt0 + 16 < NT) ? kt0 + 16 : NT;
    const float mb2 = ((const float*)(F.lds + P3_EXT + 3072))[1];
    const int tq = t0 + 32 * w + r; const float pq0 = PEX[t0 >> 7];
    const float ctq = ((PEX[tq >> 7] - pq0) + F.cl[tq * 8 + h]) * LOG2E - mb2;
    bf16x8 qf[4];
#pragma unroll
    for (int s = 0; s < 4; ++s) qf[s] = *(const bf16x8*)(F.proj + (size_t)tq * PW + C_BQ + h * 64 + 16 * s + 8 * hh);
    f32x16 o[2]; o[0] = f32x16{}; o[1] = f32x16{}; float lsum = 0.f;
    const int lrow = F.tid >> 3, lch = F.tid & 7;
    u32x4 kreg[2], vreg[2]; float creg = 0.f;
    if (kt0 < te) {
#pragma unroll
        for (int i = 0; i < 2; ++i) { const size_t g = (size_t)(128 * kt0 + 64 * i + lrow) * PW + h * 64 + lch * 8; kreg[i] = *(const u32x4*)(F.proj + g + C_BK); vreg[i] = *(const u32x4*)(F.proj + g + C_BV); }
        if (F.tid < 128) creg = ((PEX[kt0] - pq0) + F.cl[(128 * kt0 + F.tid) * 8 + h]) * LOG2E; }
    for (int kt = kt0; kt < te; ++kt) { const int buf = (kt - kt0) & 1;
#pragma unroll
        for (int i = 0; i < 2; ++i) { *(u32x4*)(KT + buf * BUFB + (64 * i + lrow) * KS + lch * 16) = kreg[i]; *(u32x4*)(VT + buf * BUFV + (64 * i + lrow) * VS + lch * 16) = vreg[i]; }
        if (F.tid < 128) CS[buf * 128 + F.tid] = creg;
        __syncthreads();
        if (kt + 1 < te) {
#pragma unroll
            for (int i = 0; i < 2; ++i) { const size_t g = (size_t)(128 * (kt + 1) + 64 * i + lrow) * PW + h * 64 + lch * 8; kreg[i] = *(const u32x4*)(F.proj + g + C_BK); vreg[i] = *(const u32x4*)(F.proj + g + C_BV); }
            if (F.tid < 128) creg = ((PEX[kt + 1] - pq0) + F.cl[(128 * (kt + 1) + F.tid) * 8 + h]) * LOG2E; }
        const unsigned char* Kb = KT + buf * BUFB; const unsigned char* Vb = VT + buf * BUFV; const float* Cb = CS + buf * 128;
        if (kt < 2 * qb) {
#pragma unroll
            for (int hf = 0; hf < 2; ++hf) { f32x16 S[2]; f32x4 c4[2][4];
#pragma unroll
                for (int u = 0; u < 2; ++u)
#pragma unroll
                    for (int i = 0; i < 4; ++i) c4[u][i] = *(const f32x4*)(Cb + 64 * hf + 32 * u + 8 * i + 4 * hh);
                PIN4(c4[0][0], c4[0][1], c4[0][2], c4[0][3]); PIN4(c4[1][0], c4[1][1], c4[1][2], c4[1][3]);
#pragma unroll
                for (int u = 0; u < 2; ++u)
#pragma unroll
                    for (int i = 0; i < 4; ++i) { S[u][4 * i] = ctq - c4[u][i].x; S[u][4 * i + 1] = ctq - c4[u][i].y; S[u][4 * i + 2] = ctq - c4[u][i].z; S[u][4 * i + 3] = ctq - c4[u][i].w; }
                attn_multi<2, KS, VS>(Kb, Vb, 64 * hf, qf, S, o, lsum, F.lane); }
        } else {
            const int qlo = t0 + 32 * w;
#pragma unroll
            for (int sub = 0; sub < 4; ++sub) { const int key0 = 128 * kt + 32 * sub;
                if (key0 <= qlo + 31) {
                    f32x16 S;
#pragma unroll
                    for (int i = 0; i < 4; ++i) { const f32x4 c4 = *(const f32x4*)(Cb + 32 * sub + 8 * i + 4 * hh); S[4 * i] = ctq - c4.x; S[4 * i + 1] = ctq - c4.y; S[4 * i + 2] = ctq - c4.z; S[4 * i + 3] = ctq - c4.w; }
                    attn_sub<KS, VS>(Kb, Vb, 32 * sub, qf, S, o, lsum, F.lane, key0 + 31 > qlo, 0, tq - key0); } }
        }
    }
    lsum += __shfl_xor(lsum, 32);
    float* ob = F.ob + ((size_t)seg * SEQ + tq) * 512 + h * 64 + 4 * hh;
#pragma unroll
    for (int dt = 0; dt < 2; ++dt)
#pragma unroll
        for (int i = 0; i < 4; ++i) *(f32x4*)(ob + 32 * dt + 8 * i) = (f32x4){o[dt][4 * i], o[dt][4 * i + 1], o[dt][4 * i + 2], o[dt][4 * i + 3]};
    if (hh == 0) F.lb[((size_t)seg * SEQ + tq) * 8 + h] = lsum;
    __syncthreads();
}
__device__ __forceinline__ void a_unit(Ctx& F, int l, int a, int n, int rres, int b2) {
    constexpr int KS = 144, VS = 192;
    unsigned char* KA = F.lds; unsigned char* VA = F.lds + 384 * KS;
    const int r = F.lane & 31, hh = F.lane >> 5, w = F.wave, d = (n == 0) ? 1 : (n == 1) ? 4 : 16, i0 = 256 * b2;
    { u32x4 kv[6], vv[6]; const int ch = F.tid & 7;
#pragma unroll
      for (int i = 0; i < 6; ++i) { const int j = (F.tid >> 3) + 64 * i, idx = i0 - 128 + j; kv[i] = (u32x4){0u, 0u, 0u, 0u}; vv[i] = (u32x4){0u, 0u, 0u, 0u};
          if (idx >= 0) { const size_t g = (size_t)(rres + d * idx) * PW + a * 64 + ch * 8; kv[i] = *(const u32x4*)(F.proj + g + C_AK); vv[i] = *(const u32x4*)(F.proj + g + C_AV); } }
      asm volatile("" : "+v"(kv[0]), "+v"(kv[1]), "+v"(kv[2]), "+v"(kv[3]), "+v"(kv[4]), "+v"(kv[5]));
      asm volatile("" : "+v"(vv[0]), "+v"(vv[1]), "+v"(vv[2]), "+v"(vv[3]), "+v"(vv[4]), "+v"(vv[5]));
#pragma unroll
      for (int i = 0; i < 6; ++i) { const int j = (F.tid >> 3) + 64 * i; *(u32x4*)(KA + j * KS + ch * 16) = kv[i]; *(u32x4*)(VA + j * VS + ch * 16) = vv[i]; } }
    const int tokq = rres + d * (i0 + 32 * w + r);
    bf16x8 qf[4];
#pragma unroll
    for (int s = 0; s < 4; ++s) qf[s] = *(const bf16x8*)(F.proj + (size_t)tokq * PW + C_AQ + a * 64 + 16 * s + 8 * hh);
    const float mb2 = ((const float*)(F.lds + P3_EXT + 3072))[0];
    __syncthreads();
    f32x16 o[2]; o[0] = f32x16{}; o[1] = f32x16{}; float lsum = 0.f;
    const int qj = 32 * w + r + 128;
    if (i0 != 0) {
        { f32x16 S;
#pragma unroll
          for (int g = 0; g < 16; ++g) S[g] = -mb2;
          attn_sub<KS, VS>(KA, VA, 32 * w, qf, S, o, lsum, F.lane, true, qj - 128 - 32 * w, 31); }
        { f32x16 S[3];
#pragma unroll
          for (int u = 0; u < 3; ++u)
#pragma unroll
              for (int g = 0; g < 16; ++g) S[u][g] = -mb2;
          attn_multi<3, KS, VS>(KA, VA, 32 * (w + 1), qf, S, o, lsum, F.lane); }
        { f32x16 S;
#pragma unroll
          for (int g = 0; g < 16; ++g) S[g] = -mb2;
          attn_sub<KS, VS>(KA, VA, 32 * (w + 4), qf, S, o, lsum, F.lane, true, 0, qj - 32 * (w + 4)); }
    } else
    for (int jt = w; jt < w + 5; ++jt) { const int j0 = 32 * jt;
        if (j0 + 31 < 128) continue;
        f32x16 S;
#pragma unroll
        for (int g = 0; g < 16; ++g) S[g] = -mb2;
        int lo = qj - 128 - j0; const int hi_ = qj - j0; if (128 - j0 > lo) lo = 128 - j0;
        attn_sub<KS, VS>(KA, VA, j0, qf, S, o, lsum, F.lane, true, lo, hi_); }
    lsum += __shfl_xor(lsum, 32);
    bf16* oa = F.oa + ((size_t)n * SEQ + tokq) * 768 + a * 64 + 4 * hh;
#pragma unroll
    for (int dt = 0; dt < 2; ++dt)
#pragma unroll
        for (int i = 0; i < 4; ++i) { u32x2 wv; wv.x = pk2(o[dt][4 * i], o[dt][4 * i + 1]); wv.y = pk2(o[dt][4 * i + 2], o[dt][4 * i + 3]); *(u32x2*)(oa + 32 * dt + 8 * i) = wv; }
    if (hh == 0) F.la[((size_t)n * SEQ + tokq) * 12 + a] = lsum;
    __syncthreads();
}
__device__ __forceinline__ void phase3(Ctx& F, int l) {
    volatile unsigned* slot = (volatile unsigned*)(F.lds + QSLOT_OFF);
    { float* PEXA = (float*)(F.lds + P3_EXT); int* KFT = (int*)(F.lds + P3_EXT + 2048); float* MB = (float*)(F.lds + P3_EXT + 3072);
      { const float v = F.bt[F.lane * 8 + F.wave]; float sc = v;
#pragma unroll
        for (int o = 1; o < 64; o <<= 1) { const float y = __shfl_up(sc, o); if (F.lane >= o) sc += y; }
        PEXA[F.wave * 64 + F.lane] = sc - v; }
      if (F.tid == 0) { MB[0] = softmax_ref2(F.aqg + l * 64, F.akg + l * 64); MB[1] = softmax_ref2(F.bqg + l * 64, F.bkg + l * 64); }
      __syncthreads();
      if (F.tid < 256) { const int h = F.tid >> 5, qb = F.tid & 31; const float thr = -(26.f + 2.f * MB[1] * (1.f / LOG2E)), pq0 = PEXA[h * 64 + 2 * qb];
          int kt = 0; while (kt < 2 * qb && (pq0 - PEXA[h * 64 + kt + 1]) < thr) ++kt;
          KFT[F.tid] = kt; if (F.bid == 0) F.ctl[8192 + F.tid] = (unsigned)kt; }
      __syncthreads(); }
    for (;;) {
        if (F.tid == 0) *slot = atomicAdd(F.ctl + l, 1u);
        __syncthreads();
        const int item = __builtin_amdgcn_readfirstlane((int)*slot);
        __syncthreads();
        if (item >= N_ITEMS) break;
        if (item < N_SCAN) scan_item(F, item);
        else if (item < N_SCAN + N_FOX) { int f = item - N_SCAN, ns, qhi;
            if (f < 256) { ns = 4; qhi = 31; } else if (f < 448) { f -= 256; ns = 3; qhi = 23; } else if (f < 576) { f -= 448; ns = 2; qhi = 15; } else { f -= 576; ns = 1; qhi = 7; }
            const int per = ns * 8, qb = qhi - f / per, rem = f % per;
            fox_unit(F, l, rem & 7, qb, rem >> 3); }
        else { const int au = item - N_SCAN - N_FOX, n = au / 384, rest = au % 384, a = rest >> 5, u = rest & 31;
            const int per = (n == 0) ? 32 : (n == 1) ? 8 : 2;
            a_unit(F, l, a, n, u / per, u % per); }
    }
}
#define PIN6(a) asm volatile("" : "+v"(a[0]), "+v"(a[1]), "+v"(a[2]), "+v"(a[3]), "+v"(a[4]), "+v"(a[5]))
__device__ __forceinline__ void phase4(Ctx& F, int l) {
    unsigned char* VV = F.lds;
    float* SSQ = (float*)(F.lds + 51200);
    const int r = F.lane & 31, hh = F.lane >> 5, w = F.wave, ui = w >> 2, th = (w >> 1) & 1, vh = w & 1;
    const float* gain = F.out_gain + l * 192;
    for (int pu = F.bid; pu < 256; pu += F.G) {
        const int u = 2 * pu + ui, h = u & 3, n = u >> 2, t0 = n * 64, tq = th * 32 + r;
        bf16x8 qf[6], kf0[6], kf1[6], sfa[6], sfb[6];
        const bf16* stb = F.st + ((size_t)(n * 4 + h) * 192 + 32 * (vh * 3) + r) * 96 + 8 * hh;
#pragma unroll
        for (int kd = 0; kd < 6; ++kd) { qf[kd] = *(const bf16x8*)(F.proj + (size_t)(t0 + tq) * PW + C_CQ + h * 96 + 16 * kd + 8 * hh);
            kf0[kd] = *(const bf16x8*)(F.proj + (size_t)(t0 + r) * PW + C_CK + h * 96 + 16 * kd + 8 * hh);
            kf1[kd] = *(const bf16x8*)(F.proj + (size_t)(t0 + 32 + r) * PW + C_CK + h * 96 + 16 * kd + 8 * hh);
            sfa[kd] = *(const bf16x8*)(stb + 16 * kd); }
        { u32x4 vv[6];
#pragma unroll
          for (int i = 0; i < 6; ++i) { const int e = F.tid + 512 * i, uu = e / 1536, e2 = e % 1536, row = e2 / 24, ch = e2 % 24, u2 = 2 * pu + uu, h2 = u2 & 3, n2 = u2 >> 2;
              vv[i] = *(const u32x4*)(F.proj + (size_t)(n2 * 64 + row) * PW + C_CV + h2 * 192 + ch * 8); }
          asm volatile("" : "+v"(vv[0]), "+v"(vv[1]), "+v"(vv[2]), "+v"(vv[3]), "+v"(vv[4]), "+v"(vv[5]));
#pragma unroll
          for (int i = 0; i < 6; ++i) { const int e = F.tid + 512 * i, uu = e / 1536, e2 = e % 1536, row = e2 / 24, ch = e2 % 24; *(u32x4*)(VV + uu * 25600 + row * 400 + ch * 16) = vv[i]; } }
        __syncthreads();
        PIN6(qf); PIN6(kf0); PIN6(kf1);
        bf16x8 pf[2][2];
        { f32x16 X = {};
#pragma unroll
          for (int kd = 0; kd < 6; ++kd) X = MFMA32(kf0[kd], qf[kd], X);
          if (th == 0) {
#pragma unroll
              for (int g = 0; g < 16; ++g) if (rowidx(g, hh) > r) X[g] = 0.f; }
          pack_p(X, pf[0][0], pf[0][1]); }
        if (th == 1) { f32x16 X = {};
#pragma unroll
          for (int kd = 0; kd < 6; ++kd) X = MFMA32(kf1[kd], qf[kd], X);
#pragma unroll
          for (int g = 0; g < 16; ++g) if (rowidx(g, hh) > r) X[g] = 0.f;
          pack_p(X, pf[1][0], pf[1][1]); }
        f32x16 O[3]; float sq = 0.f;
#pragma unroll
        for (int vt = 0; vt < 3; ++vt) { const int vtile = vh * 3 + vt; f32x16 acc = {};
            if (vt == 0) {
#pragma unroll
                for (int kd = 0; kd < 6; ++kd) sfb[kd] = *(const bf16x8*)(stb + (size_t)32 * 96 + 16 * kd); }
            if (vt == 1) {
#pragma unroll
                for (int kd = 0; kd < 6; ++kd) sfa[kd] = *(const bf16x8*)(stb + (size_t)64 * 96 + 16 * kd); }
#pragma unroll
            for (int si = 0; si < 2; ++si) if (si <= th) {
#pragma unroll
                for (int s2 = 0; s2 < 2; ++s2) { const bf16x8 vf = frag_tr((lds_cptr)(VV + ui * 25600), 400, 32 * si + 16 * s2, 32 * vtile, F.lane); acc = MFMA32(vf, pf[si][s2], acc); } }
            if (vt == 1) { PIN6(sfb);
#pragma unroll
                for (int kd = 0; kd < 6; ++kd) acc = MFMA32(sfb[kd], qf[kd], acc); }
            else { PIN6(sfa);
#pragma unroll
                for (int kd = 0; kd < 6; ++kd) acc = MFMA32(sfa[kd], qf[kd], acc); }
#pragma unroll
            for (int g = 0; g < 16; ++g) sq += acc[g] * acc[g];
            O[vt] = acc; }
        u32x2 zw[3][4]; f32x4 gg[3][4];
#pragma unroll
        for (int vt = 0; vt < 3; ++vt)
#pragma unroll
            for (int i = 0; i < 4; ++i) { const int v = 32 * (vh * 3 + vt) + 8 * i + 4 * hh;
                zw[vt][i] = *(const u32x2*)(F.proj + (size_t)(t0 + tq) * PW + C_CZ + h * 192 + v); gg[vt][i] = *(const f32x4*)(gain + v); }
        sq += __shfl_xor(sq, 32);
        if (hh == 0) SSQ[(ui * 2 + vh) * 64 + tq] = sq;
        __syncthreads();
        const float rs = rsqrtf((SSQ[(ui * 2) * 64 + tq] + SSQ[(ui * 2 + 1) * 64 + tq]) * (1.f / 192.f) + EPS);
#pragma unroll
        for (int vt = 0; vt < 3; ++vt) { PIN4(zw[vt][0], zw[vt][1], zw[vt][2], zw[vt][3]);
#pragma unroll
            for (int i = 0; i < 4; ++i) { const int v = 32 * (vh * 3 + vt) + 8 * i + 4 * hh; const u32x2 z = zw[vt][i]; const f32x4 g4 = gg[vt][i];
                const float y0 = O[vt][4 * i] * rs * g4.x * silu(blo(z.x)), y1 = O[vt][4 * i + 1] * rs * g4.y * silu(bhi(z.x)), y2 = O[vt][4 * i + 2] * rs * g4.z * silu(blo(z.y)), y3 = O[vt][4 * i + 3] * rs * g4.w * silu(bhi(z.y));
                u32x2 ov; ov.x = pk2(y0, y1); ov.y = pk2(y2, y3); *(u32x2*)(F.mixed + (size_t)(t0 + tq) * DM + 1280 + h * 192 + v) = ov; } }
        __syncthreads();
    }
    const int NT = F.G * 512, gt = F.bid * 512 + F.tid;
    for (int idx0 = gt; idx0 < SEQ * 96; idx0 += 2 * NT) {
        u32x4 wv[2][3], zw[2]; float la[2][3]; int tt[2], cc[2]; bool ok[2];
#pragma unroll
        for (int j = 0; j < 2; ++j) { const int idx = idx0 + j * NT; ok[j] = idx < SEQ * 96; const int id2 = ok[j] ? idx : gt; const int t = id2 / 96, c = (id2 % 96) * 8, a = c >> 6; tt[j] = t; cc[j] = c;
#pragma unroll
            for (int n = 0; n < 3; ++n) { wv[j][n] = *(const u32x4*)(F.oa + ((size_t)n * SEQ + t) * 768 + c); la[j][n] = F.la[((size_t)n * SEQ + t) * 12 + a]; }
            zw[j] = *(const u32x4*)(F.proj + (size_t)t * PW + C_AZ + c); }
        PIN4(wv[0][0], wv[0][1], wv[0][2], zw[0]); PIN4(wv[1][0], wv[1][1], wv[1][2], zw[1]);
#pragma unroll
        for (int j = 0; j < 2; ++j) { float o[8] = {0.f, 0.f, 0.f, 0.f, 0.f, 0.f, 0.f, 0.f};
#pragma unroll
            for (int n = 0; n < 3; ++n) { const u32x4 x = wv[j][n]; o[0] += blo(x.x); o[1] += bhi(x.x); o[2] += blo(x.y); o[3] += bhi(x.y); o[4] += blo(x.z); o[5] += bhi(x.z); o[6] += blo(x.w); o[7] += bhi(x.w); }
            const float il = 1.f / ((la[j][0] + la[j][1]) + la[j][2]); const u32x4 z = zw[j];
            u32x4 ov; ov.x = pk2(o[0] * il * silu(blo(z.x)), o[1] * il * silu(bhi(z.x))); ov.y = pk2(o[2] * il * silu(blo(z.y)), o[3] * il * silu(bhi(z.y)));
            ov.z = pk2(o[4] * il * silu(blo(z.z)), o[5] * il * silu(bhi(z.z))); ov.w = pk2(o[6] * il * silu(blo(z.w)), o[7] * il * silu(bhi(z.w)));
            if (ok[j]) *(u32x4*)(F.mixed + (size_t)tt[j] * DM + cc[j]) = ov; } }
    for (int idx0 = gt; idx0 < SEQ * 64; idx0 += 2 * NT) {
        f32x4 a0[2][4], a1[2][4]; float lv[2][4]; u32x4 zw[2]; int tt[2], cc[2], ns[2]; bool ok[2];
#pragma unroll
        for (int j = 0; j < 2; ++j) { const int idx = idx0 + j * NT; ok[j] = idx < SEQ * 64; const int id2 = ok[j] ? idx : gt; const int t = id2 / 64, c = (id2 % 64) * 8, h = c >> 6; tt[j] = t; cc[j] = c;
            ns[j] = (2 * (t >> 8) + 2 - (int)F.ctl[8192 + h * 32 + (t >> 8)] + 15) >> 4;
#pragma unroll
            for (int sg = 0; sg < 4; ++sg) { a0[j][sg] = (f32x4){0.f, 0.f, 0.f, 0.f}; a1[j][sg] = (f32x4){0.f, 0.f, 0.f, 0.f}; lv[j][sg] = 0.f;
                if (sg < ns[j]) { const float* p = F.ob + ((size_t)sg * SEQ + t) * 512 + c; a0[j][sg] = *(const f32x4*)p; a1[j][sg] = *(const f32x4*)(p + 4); lv[j][sg] = F.lb[((size_t)sg * SEQ + t) * 8 + h]; } }
            zw[j] = *(const u32x4*)(F.proj + (size_t)t * PW + C_BZ + c); }
#pragma unroll
        for (int j = 0; j < 2; ++j) { const f32x4 o0 = (a0[j][0] + a0[j][1]) + (a0[j][2] + a0[j][3]), o1 = (a1[j][0] + a1[j][1]) + (a1[j][2] + a1[j][3]);
            const float il = 1.f / ((lv[j][0] + lv[j][1]) + (lv[j][2] + lv[j][3])); const u32x4 z = zw[j];
            u32x4 ov; ov.x = pk2(o0.x * il * silu(blo(z.x)), o0.y * il * silu(bhi(z.x))); ov.y = pk2(o0.z * il * silu(blo(z.y)), o0.w * il * silu(bhi(z.y)));
            ov.z = pk2(o1.x * il * silu(blo(z.z)), o1.y * il * silu(bhi(z.z))); ov.w = pk2(o1.z * il * silu(blo(z.w)), o1.w * il * silu(bhi(z.w)));
            if (ok[j]) *(u32x4*)(F.mixed + (size_t)tt[j] * DM + 768 + cc[j]) = ov; } }
}

#define LAS __attribute__((address_space(3)))
#define XB_TMO      128
#define XB_XCNT(j)  (256  + 64 * (j))
#define XB_XSUB(j)  (1280 + 64 * (j))
#define XB_XGEN(j)  (2304 + 64 * (j))
#define XB_TOP      3328
#define XB_TOPGEN   3392
#define XCD_BAR_WORDS 3456
#define XB_SPIN_CAP (1u << 18)

__device__ __forceinline__ unsigned xb_ld(unsigned* p)              { return __hip_atomic_load(p, __ATOMIC_RELAXED, __HIP_MEMORY_SCOPE_AGENT); }
__device__ __forceinline__ unsigned xb_add(unsigned* p, unsigned v) { return __hip_atomic_fetch_add(p, v, __ATOMIC_RELAXED, __HIP_MEMORY_SCOPE_AGENT); }
__device__ __forceinline__ unsigned xb_xcc_id() { return (unsigned)__builtin_amdgcn_s_getreg((3 << 11) | 20) & 0xFu; }
#define XB_SPIN(cond, bar) do { unsigned _sp = 0; while (cond) { __builtin_amdgcn_s_sleep(1); \
    if ((++_sp & 255u) == 0u) { if (xb_ld(&(bar)[XB_TMO])) break; if (_sp > XB_SPIN_CAP) { atomicAdd(&(bar)[XB_TMO], 1u); break; } } } } while (0)

struct XcdBarrier {
    unsigned* bar; unsigned x;
    volatile LAS unsigned* st;
};

__device__ __forceinline__ XcdBarrier xcd_barrier_post(unsigned* bar, volatile LAS unsigned* st) {
    XcdBarrier b; b.bar = bar; b.x = xb_xcc_id(); b.st = st;
    if (threadIdx.x == 0) (void)xb_add(&bar[XB_XCNT(b.x)], 1u);
    return b;
}
__device__ __forceinline__ void xcd_barrier_complete(unsigned* bar, unsigned x, unsigned& nloc, unsigned& nx) {
    const unsigned G = gridDim.x * gridDim.y * gridDim.z;
    unsigned sum, cnt, mine, sp = 0u;
    for (;;) {
        sum = 0u; cnt = 0u; mine = 0u;
#pragma unroll
        for (unsigned j = 0; j < 16; ++j) { const unsigned c = xb_ld(&bar[XB_XCNT(j)]); sum += c; cnt += (c > 0u) ? 1u : 0u; mine = (j == x) ? c : mine; }
        if (sum == G) break;
        __builtin_amdgcn_s_sleep(1);
        if ((++sp & 255u) == 0u) { if (xb_ld(&bar[XB_TMO])) break; if (sp > XB_SPIN_CAP) { atomicAdd(&bar[XB_TMO], 1u); break; } }
    }
    nloc = mine > 0u ? mine : 1u; nx = cnt > 0u ? cnt : 1u;
}

__device__ __forceinline__ void xcd_barrier(const XcdBarrier& b) {
    asm volatile("s_waitcnt vmcnt(0)" ::: "memory");
    __syncthreads();
    if (threadIdx.x == 0) {
        unsigned* bar = b.bar;
        __builtin_amdgcn_s_waitcnt(0);
        unsigned nloc = b.st[0], nx = b.st[1];
        if (nloc == 0u) { xcd_barrier_complete(bar, b.x, nloc, nx); b.st[0] = nloc; b.st[1] = nx; }
        const unsigned old = xb_add(&bar[XB_XSUB(b.x)], 1u);
        const unsigned gen = old / nloc;
        if (old + 1u == (gen + 1u) * nloc) {
            __builtin_amdgcn_fence(__ATOMIC_RELEASE, "agent");
            asm volatile("s_waitcnt vmcnt(0)" ::: "memory");
            const unsigned og = xb_add(&bar[XB_TOP], 1u);
            const unsigned tg = og / nx;
            if (og + 1u == (tg + 1u) * nx) xb_add(&bar[XB_TOPGEN], 1u);
            else XB_SPIN(xb_ld(&bar[XB_TOPGEN]) == tg, bar);
            __builtin_amdgcn_fence(__ATOMIC_ACQUIRE, "agent");
            xb_add(&bar[XB_XGEN(b.x)], 1u);
            asm volatile("s_waitcnt vmcnt(0)" ::: "memory");
        } else {
            XB_SPIN(xb_ld(&bar[XB_XGEN(b.x)]) == gen, bar);
            __builtin_amdgcn_fence(__ATOMIC_ACQUIRE, "agent");
            asm volatile("s_waitcnt vmcnt(0)" ::: "memory");
        }
    }
    __syncthreads();
}

struct Args { const float* in[12]; float* out; unsigned char* ws; int ph_lo, ph_hi; };
constexpr int N_PHASES = 1 + 5 * NLAYER;
__global__ void __launch_bounds__(512, 2) mega_fwd(Args args) {
    extern __shared__ __attribute__((aligned(16))) unsigned char lds[];
    Ctx F;
#define BUILD() do { const Args* ap_ = &args; \
    F.x = ap_->in[0]; F.norm_g = ap_->in[1]; F.w_in = ap_->in[2]; F.aqg = ap_->in[3]; F.akg = ap_->in[4]; F.bqg = ap_->in[5]; F.bkg = ap_->in[6]; \
    F.fox_bias = ap_->in[7]; F.gate_up = ap_->in[8]; F.gate_bias = ap_->in[9]; F.out_gain = ap_->in[10]; F.w_out = ap_->in[11]; \
    F.out = ap_->out; unsigned char* ws = ap_->ws; F.ws = ws; \
    F.ctl = (unsigned*)(ws + WS_CTL); F.ss = (unsigned long long*)(ws + WS_SS); F.wtin = (bf16*)(ws + WS_WTIN); F.wtout = (bf16*)(ws + WS_WTOUT); F.xb = (bf16*)(ws + WS_XB); \
    F.proj = (bf16*)(ws + WS_PROJ); F.small = (float*)(ws + WS_SMALL); F.mixed = (bf16*)(ws + WS_MIXED); F.oa = (bf16*)(ws + WS_OA); F.la = (float*)(ws + WS_LA); \
    F.ob = (float*)(ws + WS_OB); F.lb = (float*)(ws + WS_LB); F.cl = (float*)(ws + WS_CL); F.bt = (float*)(ws + WS_BT); F.ds = (float*)(ws + WS_DS); F.st = (bf16*)(ws + WS_ST); F.dec = (float*)(ws + WS_DEC); \
    F.lds = lds; F.G = gridDim.x; F.bid = blockIdx.x; \
    int t_ = threadIdx.x; asm volatile("" : "+v"(t_)); F.tid = t_; F.lane = t_ & 63; F.wave = __builtin_amdgcn_readfirstlane(t_ >> 6); } while (0)
    BUILD();
    cg::grid_group grid = cg::this_grid();
    if (threadIdx.x < 8) ((volatile LAS unsigned*)((LAS unsigned char*)lds + MISC_OFF))[threadIdx.x] = 0u;
    __syncthreads();
    XcdBarrier bar = xcd_barrier_post((unsigned*)(F.ws + WS_CTL) + 4096, (volatile LAS unsigned*)((LAS unsigned char*)lds + MISC_OFF));
    const int lo = args.ph_lo, hi = args.ph_hi;
#define IN(k) (lo <= (k) && (k) < hi)
#define RELAUNDER() do { int t_ = threadIdx.x; asm volatile("" : "+v"(t_)); F.tid = t_; F.lane = t_ & 63; F.wave = __builtin_amdgcn_readfirstlane(t_ >> 6); } while (0)
#define SEAM(k) do { if (IN(k) && IN((k) + 1)) { if ((k) == 0) grid.sync(); else xcd_barrier(bar); } } while (0)
    if (IN(0)) { BUILD(); phase0(F); }
    SEAM(0);
    for (int l = 0; l < NLAYER; ++l) { const int pb = 1 + 5 * l;
        if (IN(pb)) { BUILD(); pg8::Gemm g{F.xb, F.wtin + (size_t)l * NPAD * DM, SEQ, NPAD, DM}; pg8::StaticOrder S; S.init(SEQ, NPAD, F.G, F.bid);
            pg8::EpiProj E{F.proj, F.small, F.ss + l * SEQ, (float*)(lds + RING_BYTES + 1024), F.aqg + l * 64, F.akg + l * 64, F.bqg + l * 64, F.bkg + l * 64};
            pg8::gemm_phase<pg8::EpiProj, pg8::StaticOrder, true, true>((PG8_LAS unsigned char*)lds, g, S, E); __syncthreads(); }
        SEAM(pb);
        if (IN(pb + 1)) { BUILD(); phase2(F, l); }
        SEAM(pb + 1);
        if (IN(pb + 2)) { BUILD(); phase3(F, l); }
        SEAM(pb + 2);
        if (IN(pb + 3)) { BUILD(); phase4(F, l); }
        SEAM(pb + 3);
        if (IN(pb + 4)) { BUILD(); pg8::Gemm g{F.mixed, F.wtout + (size_t)l * DM * DM, SEQ, DM, DM}; pg8::StaticOrder S; S.init(SEQ, DM, F.G, F.bid);
            const bool last = (l == NLAYER - 1);
            pg8::EpiOut E{l == 0 ? F.x : F.out, F.out, last ? nullptr : F.xb, last ? nullptr : F.ss + (l + 1) * SEQ};
            pg8::gemm_phase<pg8::EpiOut, pg8::StaticOrder, true, true>((PG8_LAS unsigned char*)lds, g, S, E); __syncthreads(); }
        SEAM(pb + 4);
    }
#undef IN
#undef SEAM
}

#ifndef MK_ONE_LAUNCH
#define MK_ONE_LAUNCH 1
#endif
extern "C" void kernel_launch(void* const* d_in, const int* in_sizes, int n_in, void* d_out, int out_size, void* d_ws, size_t ws_size, hipStream_t stream) {
    static int grid = 0;
    if (grid == 0) {
        int dev = 0, cus = 0, per_cu = 0;
        hipGetDevice(&dev); hipDeviceGetAttribute(&cus, hipDeviceAttributeMultiprocessorCount, dev);
        hipFuncSetAttribute((const void*)mega_fwd, hipFuncAttributeMaxDynamicSharedMemorySize, LDS_BYTES);
        hipOccupancyMaxActiveBlocksPerMultiprocessor(&per_cu, mega_fwd, 512, LDS_BYTES);
        grid = cus * per_cu; if (grid <= 0) grid = 256;
        if (ws_size < WS_END) { fprintf(stderr, "workspace too small: %zu < %zu\n", ws_size, (size_t)WS_END); }
    }
    Args a{}; for (int i = 0; i < 12; ++i) a.in[i] = (const float*)d_in[i]; a.out = (float*)d_out; a.ws = (unsigned char*)d_ws;
#if MK_ONE_LAUNCH
    a.ph_lo = 0; a.ph_hi = N_PHASES; void* kargs[] = {&a};
    (void)hipMemsetAsync(d_ws, 0, 65536, stream);
    hipError_t e = hipLaunchCooperativeKernel((const void*)mega_fwd, dim3(grid), dim3(512), kargs, LDS_BYTES, stream);
    if (e != hipSuccess) fprintf(stderr, "cooperative launch failed: %s (grid %d)\n", hipGetErrorString(e), grid);
#else
    for (int p = 0; p < N_PHASES; ++p) { a.ph_lo = p; a.ph_hi = p + 1; hipLaunchKernelGGL(mega_fwd, dim3(grid), dim3(512), LDS_BYTES, stream, a); }
#endif
}
```

```cpp
#include <hip/hip_runtime.h>
#include <hip/hip_cooperative_groups.h>
#include <cstdio>
#include <cstdint>
namespace cg = cooperative_groups;
namespace pg8 {
#define PG8_LAS __attribute__((address_space(3)))
typedef unsigned short bf16_t;
typedef short bf16x8 __attribute__((ext_vector_type(8)));
typedef float f32x4 __attribute__((ext_vector_type(4)));
typedef unsigned u32x4 __attribute__((ext_vector_type(4)));
constexpr int BM = 256, BK = 64, HALF = 128, HTB = HALF * BK * 2  , STAGE_BYTES = 8 * HTB, NXCD = 8, WGM = 8;

__host__ __device__ __forceinline__ int lds_byte(int r, int c) { const int st = (r >> 4) * 2 + (c >> 5), rr = r & 15, cc = c & 31, ob = rr * 64 + cc * 2; return st * 1024 + (ob ^ (((ob >> 9) & 1) << 5)); }
__host__ __device__ __forceinline__ void stage_rc(int b, int& R, int& C) { const int st = b / 1024, sb = b % 1024, swz = sb ^ (((sb >> 9) & 1) << 5); R = (st >> 1) * 16 + swz / 64; C = (st & 1) * 32 + (swz % 64) / 2; }
__host__ __device__ __forceinline__ int perm32(int rho) { const int n = rho >> 4, i = rho & 15; return 8 * (i >> 2) + 4 * n + (i & 3); }

struct Unit { int pm, pn; };
struct Gemm { const bf16_t* A; const bf16_t* Bt; int M, N, K; };

struct StaticOrder {
    int nM, nN, nwg, G, c;
    __host__ __device__ void init(int M, int N, int G_, int c_) { nM = M / BM; nN = N / BM; nwg = nM * nN; G = G_; c = c_; }
    __host__ __device__ bool next(int i, Unit& u) const {
        const long L = (long)i * G + c; if (L >= nwg) return false;
        int wgid = (int)L; { const int q = nwg / NXCD, r = nwg % NXCD, xcd = wgid % NXCD, off = wgid / NXCD; wgid = (xcd < r ? xcd * (q + 1) : r * (q + 1) + (xcd - r) * q) + off; }
        const int nig = WGM * nN, gid = wgid / nig, fm = gid * WGM, gsz = (nM - fm) < WGM ? (nM - fm) : WGM;
        u.pm = fm + ((wgid % nig) % gsz); u.pn = (wgid % nig) / gsz; return true;
    }
    __device__ __forceinline__ void a_ready(const Unit&) const {}
    __device__ __forceinline__ void done(const Unit&) const {}
};

__device__ __forceinline__ unsigned cvt_pk_bf16(float lo, float hi) { unsigned r; asm volatile("v_cvt_pk_bf16_f32 %0, %1, %2" : "=v"(r) : "v"(lo), "v"(hi)); return r; }
typedef float f32x2 __attribute__((ext_vector_type(2)));
constexpr int PROJ_W = 7424;
struct EpiProj {
    static constexpr bool PERM = true, AFTER_DRAIN = false;
    bf16_t* O; float* small; const unsigned long long* ss; float* xch; const float* gaq; const float* gak; const float* gbq; const float* gbk;
    __device__ __forceinline__ void operator()(const f32x4 (&acc)[2][2][4][2], const Unit& u, int wr, int wc, int fr, int fq) const {
        const int row0 = u.pm * BM + wr * 64 + fr;
        float rsv[2][4];
        { unsigned long long sv[2][4];
#pragma unroll
          for (int ai = 0; ai < 2; ++ai)
#pragma unroll
              for (int m = 0; m < 4; ++m) sv[ai][m] = ss[row0 + ai * HALF + m * 16];
          asm volatile("" : "+v"(sv[0][0]), "+v"(sv[0][1]), "+v"(sv[0][2]), "+v"(sv[0][3])); asm volatile("" : "+v"(sv[1][0]), "+v"(sv[1][1]), "+v"(sv[1][2]), "+v"(sv[1][3]));
#pragma unroll
          for (int ai = 0; ai < 2; ++ai)
#pragma unroll
              for (int m = 0; m < 4; ++m) rsv[ai][m] = rsqrtf((float)sv[ai][m] * (1.0f / 1048576.0f / 2048.0f) + 1e-6f); }
        if (u.pn < 29) {
            const int col0 = u.pn * BM + wc * 32 + 8 * fq;
            const bool isA = u.pn < 6, isB = (u.pn >= 12 && u.pn < 16);
            if (isA || isB) {
#pragma unroll
                for (int ai = 0; ai < 2; ++ai)
#pragma unroll
                    for (int m = 0; m < 4; ++m) { const int row = row0 + ai * HALF + m * 16; const float rs = rsv[ai][m];
#pragma unroll
                        for (int bj = 0; bj < 2; ++bj) { const f32x4 v0 = acc[ai][bj][m][0] * rs, v1 = acc[ai][bj][m][1] * rs;
                            float sq = (v0[0] * v0[0] + v0[1] * v0[1]) + (v0[2] * v0[2] + v0[3] * v0[3]) + (v1[0] * v1[0] + v1[1] * v1[1]) + (v1[2] * v1[2] + v1[3] * v1[3]);
                            sq += __shfl_xor(sq, 16); sq += __shfl_xor(sq, 32);
                            if (fq == 0) xch[((ai * HALF + wr * 64 + m * 16 + fr) * 2 + bj) * 4 + wc] = sq; } }
                asm volatile("s_waitcnt lgkmcnt(0)" ::: "memory"); __builtin_amdgcn_s_barrier(); asm volatile("" ::: "memory");
                const bool isq = (u.pn < 3) || (u.pn == 12) || (u.pn == 13);
                const float* ga0 = gaq; const float* ga1 = gak; const float* gb0 = gbq; const float* gb1 = gbk;
                const float* gsel = isA ? ga0 : gb0; { const float* gk = isA ? ga1 : gb1; if (!isq) gsel = gk; }
                const float* g = gsel + 32 * (wc & 1) + 8 * fq;
                const float sc = isq ? 0.18033688011112042f : 1.0f;
                const f32x4 g0 = *(const f32x4*)g * sc, g1 = *(const f32x4*)(g + 4) * sc;
#pragma unroll
                for (int ai = 0; ai < 2; ++ai)
#pragma unroll
                    for (int m = 0; m < 4; ++m) { const int row = row0 + ai * HALF + m * 16; bf16_t* rowp = O + (size_t)row * PROJ_W + col0;
                        const float rs = rsv[ai][m];
#pragma unroll
                        for (int bj = 0; bj < 2; ++bj) { const float* xp = xch + ((ai * HALF + wr * 64 + m * 16 + fr) * 2 + bj) * 4 + (wc & 2); const float tot = xp[0] + xp[1];
                            const float r2 = rsqrtf(tot * (1.0f / 64.0f) + 1e-6f) * rs;
                            const f32x4 v0 = acc[ai][bj][m][0] * r2 * g0, v1 = acc[ai][bj][m][1] * r2 * g1;
                            u32x4 w; w.x = cvt_pk_bf16(v0[0], v0[1]); w.y = cvt_pk_bf16(v0[2], v0[3]); w.z = cvt_pk_bf16(v1[0], v1[1]); w.w = cvt_pk_bf16(v1[2], v1[3]);
                            *(u32x4*)(rowp + bj * HALF) = w; } }
            } else {
#pragma unroll
            for (int ai = 0; ai < 2; ++ai)
#pragma unroll
                for (int m = 0; m < 4; ++m) { const int row = row0 + ai * HALF + m * 16; const float rs = rsv[ai][m];
                    bf16_t* rowp = O + (size_t)row * PROJ_W + col0;
#pragma unroll
                    for (int bj = 0; bj < 2; ++bj) { const f32x4 v0 = acc[ai][bj][m][0] * rs, v1 = acc[ai][bj][m][1] * rs;
                        u32x4 w; w.x = cvt_pk_bf16(v0[0], v0[1]); w.y = cvt_pk_bf16(v0[2], v0[3]); w.z = cvt_pk_bf16(v1[0], v1[1]); w.w = cvt_pk_bf16(v1[2], v1[3]);
                        *(u32x4*)(rowp + bj * HALF) = w; } }
            }
        } else if (wc == 0) {
#pragma unroll
            for (int ai = 0; ai < 2; ++ai)
#pragma unroll
                for (int m = 0; m < 4; ++m) { const int row = row0 + ai * HALF + m * 16; const float rs = rsv[ai][m];
                    float* p = small + (size_t)row * 32 + 8 * fq;
                    *(f32x4*)p = acc[ai][0][m][0] * rs; *(f32x4*)(p + 4) = acc[ai][0][m][1] * rs; }
        }
    }
};
struct EpiOut {
    static constexpr bool PERM = true, AFTER_DRAIN = false;
    const float* xin; float* out; bf16_t* xb; unsigned long long* ssn;
    __device__ __forceinline__ void operator()(const f32x4 (&acc)[2][2][4][2], const Unit& u, int wr, int wc, int fr, int fq) const {
        const int row0 = u.pm * BM + wr * 64 + fr, col0 = u.pn * BM + wc * 32 + 8 * fq;
#pragma unroll
        for (int ai = 0; ai < 2; ++ai) {
            f32x4 xo[4][2][2];
#pragma unroll
            for (int m = 0; m < 4; ++m)
#pragma unroll
                for (int bj = 0; bj < 2; ++bj) { const size_t p = (size_t)(row0 + ai * HALF + m * 16) * 2048 + col0 + bj * HALF; xo[m][bj][0] = *(const f32x4*)(xin + p); xo[m][bj][1] = *(const f32x4*)(xin + p + 4); }
#pragma unroll
            for (int m = 0; m < 4; ++m) asm volatile("" : "+v"(xo[m][0][0]), "+v"(xo[m][0][1]), "+v"(xo[m][1][0]), "+v"(xo[m][1][1]));
#pragma unroll
            for (int m = 0; m < 4; ++m) { const int row = row0 + ai * HALF + m * 16; float sq = 0.f;
#pragma unroll
                for (int bj = 0; bj < 2; ++bj) { const size_t p = (size_t)row * 2048 + col0 + bj * HALF;
                    const f32x4 a = xo[m][bj][0] + acc[ai][bj][m][0], b = xo[m][bj][1] + acc[ai][bj][m][1];
                    *(f32x4*)(out + p) = a; *(f32x4*)(out + p + 4) = b;
                    if (xb) { u32x4 w; w.x = cvt_pk_bf16(a[0], a[1]); w.y = cvt_pk_bf16(a[2], a[3]); w.z = cvt_pk_bf16(b[0], b[1]); w.w = cvt_pk_bf16(b[2], b[3]); *(u32x4*)(xb + p) = w; }
                    sq += (a[0] * a[0] + a[1] * a[1]) + (a[2] * a[2] + a[3] * a[3]) + (b[0] * b[0] + b[1] * b[1]) + (b[2] * b[2] + b[3] * b[3]); }
                sq += __shfl_xor(sq, 16); sq += __shfl_xor(sq, 32);
                if (fq == 0 && ssn) atomicAdd(ssn + row, (unsigned long long)(sq * 1048576.0f + 0.5f)); } }
    }
};

template <class Epi, class Sched, bool ALIGN_EPI = false, bool SP2 = false>
__device__ __forceinline__ void gemm_phase(PG8_LAS unsigned char* lds, const Gemm g, const Sched& S, const Epi& E) {
    int tid_ = threadIdx.x; asm volatile("" : "+v"(tid_)); const int tid = tid_, wid = __builtin_amdgcn_readfirstlane(tid >> 6), lane = tid & 63, wr = wid >> 2, wc = wid & 3, fr = lane & 15, fq = lane >> 4;
    const int K = g.K, nt = K / BK;
    unsigned voffA[2], voffB[2];
#pragma unroll
    for (int i = 0; i < 2; ++i) { int R, C; stage_rc(tid * 16 + i * 8192, R, C); const int Rb = Epi::PERM ? ((R & ~31) + perm32(R & 31)) : R;
        voffA[i] = (unsigned)(R * K + C) * 2u; voffB[i] = (unsigned)(Rb * K + C) * 2u; }
    const size_t kstep = (size_t)(BK * 2);
    const size_t hstep = (size_t)HALF * K * 2;
    const size_t tstep = 2 * hstep;
    const unsigned ldsw = (unsigned)wid * 1024u;
    const int aoff = lds_byte(wr * 64 + fr, fq * 8), boff = lds_byte(wc * 32 + fr, fq * 8);
#define PG8_SA(b, h) (((b) * 2 + (h)) * HTB)
#define PG8_SB(b, h) ((4 + (b) * 2 + (h)) * HTB)
#define PG8_STAGE(bufoff, gbase, voff) do { _Pragma("unroll") for (int _i = 0; _i < 2; ++_i) \
        __builtin_amdgcn_global_load_lds((const unsigned*)((const char*)(gbase) + (voff)[_i]), (PG8_LAS unsigned*)(lds + (bufoff) + ldsw + _i * 8192), 16, 0, 0); } while (0)
#define PG8_LDA(dst, b, h) do { _Pragma("unroll") for (int m = 0; m < 4; ++m) _Pragma("unroll") for (int k = 0; k < 2; ++k) dst[m][k] = *(const PG8_LAS bf16x8*)(lds + PG8_SA(b, h) + aoff + m * 2048 + k * 1024); } while (0)
#define PG8_LDB(dst, b, h) do { _Pragma("unroll") for (int n = 0; n < 2; ++n) _Pragma("unroll") for (int k = 0; k < 2; ++k) dst[n][k] = *(const PG8_LAS bf16x8*)(lds + PG8_SB(b, h) + boff + n * 2048 + k * 1024); } while (0)
#define PG8_MMA(ai, bj, At, Bt) do { __builtin_amdgcn_s_setprio(1); _Pragma("unroll") for (int m = 0; m < 4; ++m) _Pragma("unroll") for (int n = 0; n < 2; ++n) _Pragma("unroll") for (int k = 0; k < 2; ++k) \
        acc[ai][bj][m][n] = __builtin_amdgcn_mfma_f32_16x16x32_bf16(Bt[n][k], At[m][k], acc[ai][bj][m][n], 0, 0, 0); __builtin_amdgcn_s_setprio(0); } while (0)
#define PG8_WAIT_V(n) asm volatile("s_waitcnt vmcnt(" #n ")" ::: "memory")
#define PG8_WAIT_L(n) asm volatile("s_waitcnt lgkmcnt(" #n ")" ::: "memory")
#define PG8_BAR __builtin_amdgcn_s_barrier()
#define PG8_SCHED __builtin_amdgcn_sched_barrier(0)
    Unit cur, nxt; int ui = 0;
    if (!S.next(0, cur)) return;
    f32x4 acc[2][2][4][2];
#pragma unroll
    for (int a = 0; a < 2; ++a)
#pragma unroll
        for (int b = 0; b < 2; ++b)
#pragma unroll
            for (int m = 0; m < 4; ++m)
#pragma unroll
                for (int n = 0; n < 2; ++n) acc[a][b][m][n] = (f32x4){0.f, 0.f, 0.f, 0.f};
    bf16x8 At[4][2], B0[2][2], B1[2][2];
    const char* cA = (const char*)g.A + (size_t)cur.pm * tstep; const char* cB = (const char*)g.Bt + (size_t)cur.pn * tstep;
    S.a_ready(cur);
    if constexpr (SP2) {
        PG8_STAGE(PG8_SB(0, 0), cB, voffB); PG8_STAGE(PG8_SB(0, 1), cB + hstep, voffB); PG8_STAGE(PG8_SA(0, 0), cA, voffA); PG8_STAGE(PG8_SA(0, 1), cA + hstep, voffA);
        if (wr == 1) PG8_BAR;
        PG8_WAIT_V(2); PG8_BAR;
        PG8_STAGE(PG8_SB(1, 0), cB + kstep, voffB); PG8_STAGE(PG8_SA(1, 0), cA + kstep, voffA); PG8_STAGE(PG8_SB(1, 1), cB + hstep + kstep, voffB);
        PG8_WAIT_V(6); PG8_BAR;
    } else {
        PG8_STAGE(PG8_SB(0, 0), cB, voffB); PG8_STAGE(PG8_SA(0, 0), cA, voffA); PG8_STAGE(PG8_SB(0, 1), cB + hstep, voffB); PG8_STAGE(PG8_SA(0, 1), cA + hstep, voffA);
        if (wr == 1) PG8_BAR;
        PG8_WAIT_V(4); PG8_BAR;
        PG8_STAGE(PG8_SB(1, 0), cB + kstep, voffB); PG8_STAGE(PG8_SA(1, 0), cA + kstep, voffA); PG8_STAGE(PG8_SB(1, 1), cB + hstep + kstep, voffB);
        PG8_WAIT_V(6); PG8_BAR;
    }
    for (;;) {
        const bool has_next = S.next(ui + 1, nxt);
        const char* nA = has_next ? (const char*)g.A + (size_t)nxt.pm * tstep : cA; const char* nB = has_next ? (const char*)g.Bt + (size_t)nxt.pn * tstep : cB;
        for (int t = 0; t < nt; t += 2) {
            const bool last = (t == nt - 2);
            const char* a1 = cA + (size_t)(t + 1) * kstep;
            const char* a2 = last ? nA : cA + (size_t)(t + 2) * kstep; const char* b2 = last ? nB : cB + (size_t)(t + 2) * kstep;
            const char* a3 = a2 + kstep; const char* b3 = b2 + kstep;
            if (last && has_next) S.a_ready(nxt);
            if constexpr (SP2) {
            PG8_LDB(B0, 0, 0); PG8_LDB(B1, 0, 1); PG8_SCHED; PG8_LDA(At, 0, 0); PG8_STAGE(PG8_SA(1, 1), a1 + hstep, voffA);
            PG8_WAIT_V(8); PG8_WAIT_L(0); PG8_BAR; PG8_MMA(0, 0, At, B0); PG8_MMA(0, 1, At, B1); PG8_BAR; PG8_SCHED;
            PG8_LDA(At, 0, 1); PG8_STAGE(PG8_SB(0, 0), b2, voffB); PG8_STAGE(PG8_SB(0, 1), b2 + hstep, voffB); PG8_STAGE(PG8_SA(0, 0), a2, voffA);
            PG8_WAIT_V(8); PG8_WAIT_L(0); PG8_BAR; PG8_MMA(1, 0, At, B0); PG8_MMA(1, 1, At, B1); PG8_BAR; PG8_SCHED;
            PG8_LDB(B0, 1, 0); PG8_LDB(B1, 1, 1); PG8_SCHED; PG8_LDA(At, 1, 0); PG8_STAGE(PG8_SA(0, 1), a2 + hstep, voffA);
            PG8_WAIT_V(8); PG8_WAIT_L(0); PG8_BAR; PG8_MMA(0, 0, At, B0); PG8_MMA(0, 1, At, B1); PG8_BAR; PG8_SCHED;
            PG8_LDA(At, 1, 1); PG8_STAGE(PG8_SB(1, 0), b3, voffB); PG8_STAGE(PG8_SB(1, 1), b3 + hstep, voffB); PG8_STAGE(PG8_SA(1, 0), a3, voffA);
            PG8_WAIT_V(8); PG8_WAIT_L(0); PG8_BAR; PG8_MMA(1, 0, At, B0); PG8_MMA(1, 1, At, B1); PG8_BAR; PG8_SCHED;
            } else {
            PG8_LDB(B0, 0, 0); PG8_SCHED; PG8_LDA(At, 0, 0); PG8_STAGE(PG8_SA(1, 1), a1 + hstep, voffA);
            PG8_WAIT_L(8); PG8_BAR; PG8_WAIT_L(0); PG8_MMA(0, 0, At, B0); PG8_BAR; PG8_SCHED;
            PG8_LDB(B1, 0, 1); PG8_STAGE(PG8_SB(0, 0), b2, voffB);
            PG8_BAR; PG8_WAIT_L(0); PG8_MMA(0, 1, At, B1); PG8_BAR;
            PG8_LDA(At, 0, 1); PG8_STAGE(PG8_SA(0, 0), a2, voffA);
            PG8_BAR; PG8_WAIT_L(0); PG8_MMA(1, 0, At, B0); PG8_BAR; PG8_SCHED;
            PG8_STAGE(PG8_SB(0, 1), b2 + hstep, voffB);
            PG8_WAIT_V(6); PG8_BAR; PG8_MMA(1, 1, At, B1); PG8_BAR;
            PG8_LDB(B0, 1, 0); PG8_SCHED; PG8_LDA(At, 1, 0); PG8_STAGE(PG8_SA(0, 1), a2 + hstep, voffA);
            PG8_WAIT_L(8); PG8_BAR; PG8_WAIT_L(0); PG8_MMA(0, 0, At, B0); PG8_BAR; PG8_SCHED;
            PG8_LDB(B1, 1, 1); PG8_STAGE(PG8_SB(1, 0), b3, voffB);
            PG8_BAR; PG8_WAIT_L(0); PG8_MMA(0, 1, At, B1); PG8_BAR;
            PG8_LDA(At, 1, 1); PG8_STAGE(PG8_SA(1, 0), a3, voffA);
            PG8_BAR; PG8_WAIT_L(0); PG8_MMA(1, 0, At, B0); PG8_BAR; PG8_SCHED;
            PG8_STAGE(PG8_SB(1, 1), b3 + hstep, voffB);
            PG8_WAIT_V(6); PG8_BAR; PG8_MMA(1, 1, At, B1); PG8_BAR;
            }
        }
        if constexpr (ALIGN_EPI) { if (wr == 0) PG8_BAR; }
        if constexpr (!Epi::AFTER_DRAIN) { E(acc, cur, wr, wc, fr, fq); S.done(cur); }
        if (!has_next) break;
#pragma unroll
        for (int a = 0; a < 2; ++a)
#pragma unroll
            for (int b = 0; b < 2; ++b)
#pragma unroll
                for (int m = 0; m < 4; ++m)
#pragma unroll
                    for (int n = 0; n < 2; ++n) acc[a][b][m][n] = (f32x4){0.f, 0.f, 0.f, 0.f};
        cur = nxt; cA = nA; cB = nB; ++ui;
        if constexpr (ALIGN_EPI) { if (wr == 1) PG8_BAR; }
    }
    PG8_WAIT_V(0);
    if constexpr (!ALIGN_EPI) { if (wr == 0) PG8_BAR; }
    PG8_BAR;
    if constexpr (Epi::AFTER_DRAIN) { E.fused(acc, cur, wr, wc, fr, fq, lds, wid, lane); S.done(cur); }
#undef PG8_SA
#undef PG8_SB
#undef PG8_STAGE
#undef PG8_LDA
#undef PG8_LDB
#undef PG8_MMA
#undef PG8_WAIT_V
#undef PG8_WAIT_L
#undef PG8_BAR
#undef PG8_SCHED
}
}
constexpr int SEQ = 8192, DM = 2048, NLAYER = 4, INW = 7448, NPAD = 7680, PW = pg8::PROJ_W;
constexpr int C_AQ = 0, C_AK = 768, C_AV = 1536, C_AZ = 2304, C_BQ = 3072, C_BK = 3584, C_BV = 4096, C_BZ = 4608, C_CQ = 5120, C_CK = 5504, C_CV = 5888, C_CZ = 6656;
constexpr float LOG2E = 1.4426950408889634f, QSCALE = 0.125f * 1.4426950408889634f, EPS = 1e-6f;
constexpr size_t MiB = 1u << 20;
constexpr size_t WS_CTL = 0, WS_SS = 1 * MiB, WS_WTIN = 2 * MiB, WS_WTOUT = 122 * MiB, WS_XB = 154 * MiB, WS_PROJ = 186 * MiB, WS_SMALL = 302 * MiB,
                 WS_MIXED = 304 * MiB, WS_OA = 336 * MiB, WS_LA = 372 * MiB, WS_OB = 374 * MiB, WS_LB = 438 * MiB, WS_CL = 439 * MiB, WS_BT = WS_CL + 512 * 1024,
                 WS_DS = 440 * MiB, WS_ST = 476 * MiB, WS_DEC = 494 * MiB, WS_END = 496 * MiB;
constexpr int RING_BYTES = 131072, LDS_BYTES = 147456, QSLOT_OFF = RING_BYTES + 64, MISC_OFF = RING_BYTES + 256;
constexpr int P3_EXT = RING_BYTES + 1024;
constexpr int N_SCAN = 72, N_FOX = 640, N_AU = 1152, N_ITEMS = N_SCAN + N_FOX + N_AU;

typedef unsigned short bf16;
typedef short bf16x8 __attribute__((ext_vector_type(8)));
typedef short s16x4 __attribute__((ext_vector_type(4)));
typedef float f32x4 __attribute__((ext_vector_type(4)));
typedef float f32x2 __attribute__((ext_vector_type(2)));
typedef float f32x16 __attribute__((ext_vector_type(16)));
typedef unsigned u32x4 __attribute__((ext_vector_type(4)));
typedef unsigned u32x2 __attribute__((ext_vector_type(2)));
typedef __attribute__((address_space(3))) const char* lds_cptr;
#define LAS3 __attribute__((address_space(3)))

__device__ __forceinline__ float bf2f(unsigned b) { return __uint_as_float(b << 16); }
__device__ __forceinline__ unsigned pk2(float lo, float hi) { return pg8::cvt_pk_bf16(lo, hi); }
__device__ __forceinline__ float blo(unsigned w) { return __uint_as_float(w << 16); }
__device__ __forceinline__ float bhi(unsigned w) { return __uint_as_float(w & 0xffff0000u); }
__device__ __forceinline__ float logsig(float x) { return fminf(x, 0.f) - log1pf(expf(-fabsf(x))); }
__device__ __forceinline__ float silu(float x) { return x / (1.f + __expf(-x)); }
__device__ __forceinline__ s16x4 vtr(lds_cptr p) { return __builtin_bit_cast(s16x4, __builtin_amdgcn_ds_read_tr16_b64_v4i16((LAS3 s16x4*)p)); }
__device__ __forceinline__ bf16x8 frag_tr(lds_cptr img, int stride, int kbase, int m0, int lane) {
    const int i = lane & 15, g = lane >> 4;
    lds_cptr p = img + (kbase + 4 * (g >> 1) + (i >> 2)) * stride + (m0 + 16 * (g & 1) + 4 * (i & 3)) * 2;
    const s16x4 a = vtr(p), b = vtr(p + 8 * stride);
    return (bf16x8){a[0], a[1], a[2], a[3], b[0], b[1], b[2], b[3]};
}
__device__ __forceinline__ int rowidx(int reg, int hh) { return (reg & 3) + 8 * (reg >> 2) + 4 * hh; }
__device__ __forceinline__ void pack_p(const f32x16& p, bf16x8& f0, bf16x8& f1) {
    u32x4 a, b; a.x = pk2(p[0], p[1]); a.y = pk2(p[2], p[3]); a.z = pk2(p[4], p[5]); a.w = pk2(p[6], p[7]);
    b.x = pk2(p[8], p[9]); b.y = pk2(p[10], p[11]); b.z = pk2(p[12], p[13]); b.w = pk2(p[14], p[15]);
    f0 = __builtin_bit_cast(bf16x8, a); f1 = __builtin_bit_cast(bf16x8, b);
}
#define MFMA32(a, b, c) __builtin_amdgcn_mfma_f32_32x32x16_bf16((a), (b), (c), 0, 0, 0)

struct Ctx {
    const float *x, *norm_g, *w_in, *aqg, *akg, *bqg, *bkg, *fox_bias, *gate_up, *gate_bias, *out_gain, *w_out;
    float* out; unsigned char* ws;
    unsigned* ctl; unsigned long long* ss; bf16* wtin; bf16* wtout; bf16* xb; bf16* proj; float* small; bf16* mixed; bf16* oa; float* la; float* ob; float* lb; float* cl; float* bt;
    float* ds; bf16* st; float* dec;
    unsigned char* lds; int tid, lane, wave, G, bid;
};

__device__ __forceinline__ int orig_col(int np) { if (np < 5120) return np; if (np < 7424) return np + 8; if (np < 7432) return 5120 + (np - 7424); if (np < 7448) return np; return -1; }
__device__ __forceinline__ void p0_item(const float* W, int N, bf16* WT, const float* g, int mode, float* scr, int kb, int nb, int lane) {
    const int k0 = 64 * kb, n0 = 32 * nb, c4 = 4 * (lane & 7), np = n0 + c4;
    const int oc = mode ? orig_col(np) : np;
    const float cs = (mode && np >= C_CQ && np < C_CK) ? 0.10206207261596577f : 1.0f;
    f32x4 v[8];
#pragma unroll
    for (int i = 0; i < 8; ++i) { const int kk = 8 * i + (lane >> 3); v[i] = (f32x4){0.f, 0.f, 0.f, 0.f};
        if (oc >= 0) { v[i] = *(const f32x4*)(W + (size_t)(k0 + kk) * N + oc); const float sc = mode ? cs * g[k0 + kk] : 1.0f; v[i] = v[i] * sc; } }
#pragma unroll
    for (int i = 0; i < 8; ++i) { const int kk = 8 * i + (lane >> 3); float* d = scr + kk * 33 + c4; d[0] = v[i].x; d[1] = v[i].y; d[2] = v[i].z; d[3] = v[i].w; }
    __builtin_amdgcn_s_waitcnt(0); asm volatile("" ::: "memory");
    const int c = lane & 7;
#pragma unroll
    for (int j = 0; j < 4; ++j) { const int n = (lane >> 3) + 8 * j; const float* s = scr + (8 * c) * 33 + n;
        u32x4 o; o.x = pk2(s[0 * 33], s[1 * 33]); o.y = pk2(s[2 * 33], s[3 * 33]); o.z = pk2(s[4 * 33], s[5 * 33]); o.w = pk2(s[6 * 33], s[7 * 33]);
        *(u32x4*)(WT + (size_t)(n0 + n) * 2048 + k0 + 8 * c) = o; }
    __builtin_amdgcn_s_waitcnt(0); asm volatile("" ::: "memory");
}
__device__ __forceinline__ void phase0(Ctx& F) {
    float* scr = (float*)(F.lds + F.wave * 16384);
    const int gw = F.bid * 8 + F.wave, NGW = F.G * 8;
    if (F.bid == 0 && F.tid < 64) F.ctl[F.tid] = 0u;
    for (int i = F.bid * 512 + F.tid; i < 3 * SEQ; i += F.G * 512) F.ss[SEQ + i] = 0ull;
    constexpr int I_IN = 32 * 233, I_OUT = 32 * 64, I_L = I_IN + I_OUT;
    for (int it = gw; it < NLAYER * I_L; it += NGW) {
        const int l = it / I_L; int r = it % I_L;
        if (r < I_IN) p0_item(F.w_in + (size_t)l * DM * INW, INW, F.wtin + (size_t)l * NPAD * DM, F.norm_g + l * DM, 1, scr, r / 233, r % 233, F.lane);
        else { r -= I_IN; p0_item(F.w_out + (size_t)l * DM * DM, DM, F.wtout + (size_t)l * DM * DM, nullptr, 0, scr, r / 64, r % 64, F.lane); }
    }
    for (int m = gw; m < SEQ; m += NGW) {
        const f32x4* xr = (const f32x4*)(F.x + (size_t)m * DM) + F.lane; float s = 0.f; u32x2* o8 = (u32x2*)(F.xb + (size_t)m * DM) + F.lane;
#pragma unroll
        for (int j = 0; j < 8; ++j) { const f32x4 v = xr[64 * j]; s += (v.x * v.x + v.y * v.y) + (v.z * v.z + v.w * v.w); u32x2 w; w.x = pk2(v.x, v.y); w.y = pk2(v.z, v.w); o8[64 * j] = w; }
#pragma unroll
        for (int o = 1; o < 64; o <<= 1) s += __shfl_xor(s, o);
        if (F.lane == 0) F.ss[m] = (unsigned long long)(s * 1048576.0f + 0.5f);
    }
}

__device__ __forceinline__ void phase2(Ctx& F, int l) {
    { const int gw = F.bid * 8 + F.wave, NGW = F.G * 8;
      for (int wi = gw; wi < 512; wi += NGW) { const int blk = wi >> 3, h = wi & 7, t = blk * 128 + 2 * F.lane; const float fb = F.fox_bias[l * 8 + h];
        const float l0 = logsig(F.small[(size_t)t * 32 + h] + fb), l1 = logsig(F.small[(size_t)(t + 1) * 32 + h] + fb);
        float s = l0 + l1;
#pragma unroll
        for (int o = 1; o < 64; o <<= 1) { const float y = __shfl_up(s, o); if (F.lane >= o) s += y; }
        const float ex = s - (l0 + l1); F.cl[t * 8 + h] = ex + l0; F.cl[(t + 1) * 8 + h] = s; if (F.lane == 63) F.bt[blk * 8 + h] = s; } }
    { float* CR = (float*)F.lds;
      float* GT = (float*)(F.lds + 4096);
      unsigned char* KH = F.lds + 8192;
      unsigned char* VV = F.lds + 8192 + 13312;
      const float* gup = F.gate_up + (size_t)l * 16 * 384; const float* gbs = F.gate_bias + l * 384;
      for (int u = F.bid; u < 512; u += F.G) { const int h = u & 3, n = u >> 2, t0 = n * 64;
        if (F.tid < 256) *(f32x4*)(CR + F.tid * 4) = *(const f32x4*)(F.small + (size_t)(t0 + (F.tid >> 2)) * 32 + 8 + 4 * (F.tid & 3));
        { u32x4 vv[3];
#pragma unroll
          for (int i = 0; i < 3; ++i) { const int e = F.tid + 512 * i, row = e / 24, ch = e % 24; vv[i] = *(const u32x4*)(F.proj + (size_t)(t0 + row) * PW + C_CV + h * 192 + ch * 8); }
          asm volatile("" : "+v"(vv[0]), "+v"(vv[1]), "+v"(vv[2]));
#pragma unroll
          for (int i = 0; i < 3; ++i) { const int e = F.tid + 512 * i, row = e / 24, ch = e % 24; *(u32x4*)(VV + row * 400 + ch * 16) = vv[i]; } }
        __syncthreads();
        const int d = F.tid % 96, tg = F.tid / 96;
        float bc[16];
        if (F.tid < 384) { float g[16];
#pragma unroll
            for (int r = 0; r < 16; ++r) g[r] = gup[r * 384 + h * 96 + d];
            const float gb = gbs[h * 96 + d]; float run = 0.f;
#pragma unroll
            for (int i = 0; i < 16; ++i) { const float* cr = CR + (16 * tg + i) * 16; float a = gb;
#pragma unroll
                for (int r4 = 0; r4 < 4; ++r4) { const f32x4 c = *(const f32x4*)(cr + 4 * r4); a += c.x * g[4 * r4] + c.y * g[4 * r4 + 1] + c.z * g[4 * r4 + 2] + c.w * g[4 * r4 + 3]; }
                const float ls = fminf(a, 0.f) - __logf(1.f + __expf(-fabsf(a)));
                run += ls * (1.f / 16.f); bc[i] = run; }
            GT[tg * 96 + d] = run; }
        __syncthreads();
        if (F.tid < 384) { const float g0 = GT[d], g1 = GT[96 + d], g2 = GT[192 + d], g3 = GT[288 + d];
            const float pre = (tg > 0 ? g0 : 0.f) + (tg > 1 ? g1 : 0.f) + (tg > 2 ? g2 : 0.f);
            const float bm = g0 + g1, bl = (g0 + g1) + (g2 + g3);
            bf16* qp = F.proj + (size_t)(t0 + 16 * tg) * PW + C_CQ + h * 96 + d; bf16* kp = F.proj + (size_t)(t0 + 16 * tg) * PW + C_CK + h * 96 + d;
            float qv[16], kv[16]; unsigned qr[16], kr[16];
#pragma unroll
            for (int i = 0; i < 16; ++i) { qr[i] = qp[(size_t)i * PW]; kr[i] = kp[(size_t)i * PW]; }
#pragma unroll
            for (int i = 0; i < 16; i += 4) { asm volatile("" : "+v"(qr[i]), "+v"(qr[i + 1]), "+v"(qr[i + 2]), "+v"(qr[i + 3])); asm volatile("" : "+v"(kr[i]), "+v"(kr[i + 1]), "+v"(kr[i + 2]), "+v"(kr[i + 3])); }
#pragma unroll
            for (int i = 0; i < 16; ++i) { qv[i] = bf2f(qr[i]); kv[i] = bf2f(kr[i]); }
#pragma unroll
            for (int i = 0; i < 16; ++i) { const float b = bc[i] + pre; const float eq = __expf(b - bm), ek = __expf(bm - b), eh = __expf(bl - b);
                qp[(size_t)i * PW] = (bf16)(pk2(qv[i] * eq, 0.f) & 0xffffu); kp[(size_t)i * PW] = (bf16)(pk2(kv[i] * ek, 0.f) & 0xffffu);
                *(bf16*)(KH + (16 * tg + i) * 208 + d * 2) = (bf16)(pk2(kv[i] * eh, 0.f) & 0xffffu); }
            if (tg == 0) { F.dec[(n * 4 + h) * 96 + d] = __expf(bl); F.dec[49152 + (n * 4 + h) * 96 + d] = __expf(bm); } }
        __syncthreads();
        for (int id = F.wave; id < 18; id += 8) { const int vt = id / 3, dt = id % 3; f32x16 acc = {};
#pragma unroll
            for (int s = 0; s < 4; ++s) { const bf16x8 a = frag_tr((lds_cptr)VV, 400, 16 * s, 32 * vt, F.lane), b = frag_tr((lds_cptr)KH, 208, 16 * s, 32 * dt, F.lane); acc = MFMA32(a, b, acc); }
            float* dst = F.ds + ((size_t)(n * 4 + h) * 192 + 32 * vt) * 96 + 32 * dt + (F.lane & 31);
#pragma unroll
            for (int r = 0; r < 16; ++r) dst[(size_t)rowidx(r, F.lane >> 5) * 96] = acc[r]; }
        __syncthreads(); } }
}
__device__ __forceinline__ float softmax_ref2(const float* gq, const float* gk) {
    float mq = 0.f, mk = 0.f;
    for (int i = 0; i < 64; ++i) { mq = fmaxf(mq, fabsf(gq[i])); mk = fmaxf(mk, fabsf(gk[i])); }
    return 8.25f * mq * mk * LOG2E;
}
__device__ __forceinline__ void scan_item(Ctx& F, int si) {
    const int p = si * 512 + F.tid, d = 2 * (p % 48), v = (p / 48) % 192, h = p / (48 * 192);
    float s0 = 0.f, s1 = 0.f;
    for (int nb = 0; nb < 128; nb += 8) { f32x2 dd[8], a[8], em[8];
#pragma unroll
        for (int j = 0; j < 8; ++j) { const int n = nb + j; const size_t idx = ((size_t)(n * 4 + h) * 192 + v) * 96 + d; const int di = (n * 4 + h) * 96 + d;
            dd[j] = *(const f32x2*)(F.ds + idx); a[j] = *(const f32x2*)(F.dec + di); em[j] = *(const f32x2*)(F.dec + 49152 + di); }
#pragma unroll
        for (int j = 0; j < 8; j += 4) { asm volatile("" : "+v"(dd[j]), "+v"(dd[j + 1]), "+v"(dd[j + 2]), "+v"(dd[j + 3])); asm volatile("" : "+v"(a[j]), "+v"(a[j + 1]), "+v"(a[j + 2]), "+v"(a[j + 3])); asm volatile("" : "+v"(em[j]), "+v"(em[j + 1]), "+v"(em[j + 2]), "+v"(em[j + 3])); }
#pragma unroll
        for (int j = 0; j < 8; ++j) { const int n = nb + j; const size_t idx = ((size_t)(n * 4 + h) * 192 + v) * 96 + d;
            *(unsigned*)(F.st + idx) = pk2(em[j].x * s0, em[j].y * s1);
            s0 = a[j].x * s0 + dd[j].x; s1 = a[j].y * s1 + dd[j].y; } }
}
#define PIN4(a, b, c, d) asm volatile("" : "+v"(a), "+v"(b), "+v"(c), "+v"(d))
#define SBAR0() __builtin_amdgcn_sched_barrier(0)
template <int KSTR, int VSTR>
__device__ __forceinline__ void attn_sub(const unsigned char* Kt, const unsigned char* Vt, int key_row0, const bf16x8 (&qf)[4], f32x16 S, f32x16 (&o)[2], float& lsum, int lane,
                                         bool use_mask, int lo, int hi_) {
    const int r = lane & 31, hh = lane >> 5;
    bf16x8 kf[4];
#pragma unroll
    for (int s = 0; s < 4; ++s) kf[s] = *(const bf16x8*)(Kt + (key_row0 + r) * KSTR + (16 * s + 8 * hh) * 2);
    bf16x8 vf[2][2];
#pragma unroll
    for (int dt = 0; dt < 2; ++dt) { vf[dt][0] = frag_tr((lds_cptr)Vt, VSTR, key_row0, 32 * dt, lane); vf[dt][1] = frag_tr((lds_cptr)Vt, VSTR, key_row0 + 16, 32 * dt, lane); }
    PIN4(kf[0], kf[1], kf[2], kf[3]);
#pragma unroll
    for (int s = 0; s < 4; ++s) S = MFMA32(kf[s], qf[s], S);
    if (use_mask) {
#pragma unroll
        for (int g = 0; g < 16; ++g) { const int k = rowidx(g, hh); if (k < lo || k > hi_) S[g] = -INFINITY; } }
    float acc = 0.f;
#pragma unroll
    for (int g = 0; g < 16; ++g) { S[g] = __builtin_amdgcn_exp2f(S[g]); acc += S[g]; }
    lsum += acc;
    bf16x8 p0, p1; pack_p(S, p0, p1);
    PIN4(vf[0][0], vf[0][1], vf[1][0], vf[1][1]);
#pragma unroll
    for (int dt = 0; dt < 2; ++dt) { o[dt] = MFMA32(vf[dt][0], p0, o[dt]); o[dt] = MFMA32(vf[dt][1], p1, o[dt]); }
}
template <int NSUB, int KSTR, int VSTR>
__device__ __forceinline__ void attn_multi(const unsigned char* Kt, const unsigned char* Vt, int key_row0, const bf16x8 (&qf)[4], f32x16 (&S)[NSUB], f32x16 (&o)[2], float& lsum, int lane) {
    const int r = lane & 31, hh = lane >> 5;
    bf16x8 kf[NSUB][4];
#pragma unroll
    for (int u = 0; u < NSUB; ++u)
#pragma unroll
        for (int s = 0; s < 4; ++s) kf[u][s] = *(const bf16x8*)(Kt + (key_row0 + 32 * u + r) * KSTR + (16 * s + 8 * hh) * 2);
#pragma unroll
    for (int u = 0; u < NSUB; ++u) PIN4(kf[u][0], kf[u][1], kf[u][2], kf[u][3]);
#pragma unroll
    for (int s = 0; s < 4; ++s)
#pragma unroll
        for (int u = 0; u < NSUB; ++u) S[u] = MFMA32(kf[u][s], qf[s], S[u]);
#pragma unroll
    for (int u = 0; u < NSUB; ++u) {
        bf16x8 vf[2][2];
#pragma unroll
        for (int dt = 0; dt < 2; ++dt) { vf[dt][0] = frag_tr((lds_cptr)Vt, VSTR, key_row0 + 32 * u, 32 * dt, lane); vf[dt][1] = frag_tr((lds_cptr)Vt, VSTR, key_row0 + 32 * u + 16, 32 * dt, lane); }
        SBAR0();
        float acc = 0.f;
#pragma unroll
        for (int g = 0; g < 16; ++g) { S[u][g] = __builtin_amdgcn_exp2f(S[u][g]); acc += S[u][g]; }
        lsum += acc;
        bf16x8 p0, p1; pack_p(S[u], p0, p1);
        PIN4(vf[0][0], vf[0][1], vf[1][0], vf[1][1]);
#pragma unroll
        for (int dt = 0; dt < 2; ++dt) { o[dt] = MFMA32(vf[dt][0], p0, o[dt]); o[dt] = MFMA32(vf[dt][1], p1, o[dt]); } }
}
__device__ __forceinline__ void fox_unit(Ctx& F, int l, int h, int qb, int seg) {
    constexpr int KS = 144, VS = 192, BUFB = 128 * KS, BUFV = 128 * VS;
    unsigned char* KT = F.lds; unsigned char* VT = F.lds + 2 * BUFB; float* CS = (float*)(F.lds + 2 * BUFB + 2 * BUFV);
    const float* PEX = (const float*)(F.lds + P3_EXT) + h * 64;
    const int r = F.lane & 31, hh = F.lane >> 5, w = F.wave, t0 = 256 * qb, NT = 2 * qb + 2;
    const int kfirst = __builtin_amdgcn_readfirstlane(((const int*)(F.lds + P3_EXT + 2048))[h * 32 + qb]);
    const int nuse = (NT - kfirst + 15) >> 4;
    if (seg >= nuse) return;
    const int kt0 = kfirst + 16 * seg, te = (kt0 + 16 < NT) ? kt0 + 16 : NT;
    const float mb2 = ((const float*)(F.lds + P3_EXT + 3072))[1];
    const int tq = t0 + 32 * w + r; const float pq0 = PEX[t0 >> 7];
    const float ctq = ((PEX[tq >> 7] - pq0) + F.cl[tq * 8 + h]) * LOG2E - mb2;
    bf16x8 qf[4];
#pragma unroll
    for (int s = 0; s < 4; ++s) qf[s] = *(const bf16x8*)(F.proj + (size_t)tq * PW + C_BQ + h * 64 + 16 * s + 8 * hh);
    f32x16 o[2]; o[0] = f32x16{}; o[1] = f32x16{}; float lsum = 0.f;
    const int lrow = F.tid >> 3, lch = F.tid & 7;
    u32x4 kreg[2], vreg[2]; float creg = 0.f;
    if (kt0 < te) {
#pragma unroll
        for (int i = 0; i < 2; ++i) { const size_t g = (size_t)(128 * kt0 + 64 * i + lrow) * PW + h * 64 + lch * 8; kreg[i] = *(const u32x4*)(F.proj + g + C_BK); vreg[i] = *(const u32x4*)(F.proj + g + C_BV); }
        if (F.tid < 128) creg = ((PEX[kt0] - pq0) + F.cl[(128 * kt0 + F.tid) * 8 + h]) * LOG2E; }
    for (int kt = kt0; kt < te; ++kt) { const int buf = (kt - kt0) & 1;
#pragma unroll
        for (int i = 0; i < 2; ++i) { *(u32x4*)(KT + buf * BUFB + (64 * i + lrow) * KS + lch * 16) = kreg[i]; *(u32x4*)(VT + buf * BUFV + (64 * i + lrow) * VS + lch * 16) = vreg[i]; }
        if (F.tid < 128) CS[buf * 128 + F.tid] = creg;
        __syncthreads();
        if (kt + 1 < te) {
#pragma unroll
            for (int i = 0; i < 2; ++i) { const size_t g = (size_t)(128 * (kt + 1) + 64 * i + lrow) * PW + h * 64 + lch * 8; kreg[i] = *(const u32x4*)(F.proj + g + C_BK); vreg[i] = *(const u32x4*)(F.proj + g + C_BV); }
            if (F.tid < 128) creg = ((PEX[kt + 1] - pq0) + F.cl[(128 * (kt + 1) + F.tid) * 8 + h]) * LOG2E; }
        const unsigned char* Kb = KT + buf * BUFB; const unsigned char* Vb = VT + buf * BUFV; const float* Cb = CS + buf * 128;
        if (kt < 2 * qb) {
#pragma unroll
            for (int hf = 0; hf < 2; ++hf) { f32x16 S[2]; f32x4 c4[2][4];
#pragma unroll
                for (int u = 0; u < 2; ++u)
#pragma unroll
                    for (int i = 0; i < 4; ++i) c4[u][i] = *(const f32x4*)(Cb + 64 * hf + 32 * u + 8 * i + 4 * hh);
                PIN4(c4[0][0], c4[0][1], c4[0][2], c4[0][3]); PIN4(c4[1][0], c4[1][1], c4[1][2], c4[1][3]);
#pragma unroll
                for (int u = 0; u < 2; ++u)
#pragma unroll
                    for (int i = 0; i < 4; ++i) { S[u][4 * i] = ctq - c4[u][i].x; S[u][4 * i + 1] = ctq - c4[u][i].y; S[u][4 * i + 2] = ctq - c4[u][i].z; S[u][4 * i + 3] = ctq - c4[u][i].w; }
                attn_multi<2, KS, VS>(Kb, Vb, 64 * hf, qf, S, o, lsum, F.lane); }
        } else {
            const int qlo = t0 + 32 * w;
#pragma unroll
            for (int sub = 0; sub < 4; ++sub) { const int key0 = 128 * kt + 32 * sub;
                if (key0 <= qlo + 31) {
                    f32x16 S;
#pragma unroll
                    for (int i = 0; i < 4; ++i) { const f32x4 c4 = *(const f32x4*)(Cb + 32 * sub + 8 * i + 4 * hh); S[4 * i] = ctq - c4.x; S[4 * i + 1] = ctq - c4.y; S[4 * i + 2] = ctq - c4.z; S[4 * i + 3] = ctq - c4.w; }
                    attn_sub<KS, VS>(Kb, Vb, 32 * sub, qf, S, o, lsum, F.lane, key0 + 31 > qlo, 0, tq - key0); } }
        }
    }
    lsum += __shfl_xor(lsum, 32);
    float* ob = F.ob + ((size_t)seg * SEQ + tq) * 512 + h * 64 + 4 * hh;
#pragma unroll
    for (int dt = 0; dt < 2; ++dt)
#pragma unroll
        for (int i = 0; i < 4; ++i) *(f32x4*)(ob + 32 * dt + 8 * i) = (f32x4){o[dt][4 * i], o[dt][4 * i + 1], o[dt][4 * i + 2], o[dt][4 * i + 3]};
    if (hh == 0) F.lb[((size_t)seg * SEQ + tq) * 8 + h] = lsum;
    __syncthreads();
}
__device__ __forceinline__ void a_unit(Ctx& F, int l, int a, int n, int rres, int b2) {
    constexpr int KS = 144, VS = 192;
    unsigned char* KA = F.lds; unsigned char* VA = F.lds + 384 * KS;
    const int r = F.lane & 31, hh = F.lane >> 5, w = F.wave, d = (n == 0) ? 1 : (n == 1) ? 4 : 16, i0 = 256 * b2;
    { u32x4 kv[6], vv[6]; const int ch = F.tid & 7;
#pragma unroll
      for (int i = 0; i < 6; ++i) { const int j = (F.tid >> 3) + 64 * i, idx = i0 - 128 + j; kv[i] = (u32x4){0u, 0u, 0u, 0u}; vv[i] = (u32x4){0u, 0u, 0u, 0u};
          if (idx >= 0) { const size_t g = (size_t)(rres + d * idx) * PW + a * 64 + ch * 8; kv[i] = *(const u32x4*)(F.proj + g + C_AK); vv[i] = *(const u32x4*)(F.proj + g + C_AV); } }
      asm volatile("" : "+v"(kv[0]), "+v"(kv[1]), "+v"(kv[2]), "+v"(kv[3]), "+v"(kv[4]), "+v"(kv[5]));
      asm volatile("" : "+v"(vv[0]), "+v"(vv[1]), "+v"(vv[2]), "+v"(vv[3]), "+v"(vv[4]), "+v"(vv[5]));
#pragma unroll
      for (int i = 0; i < 6; ++i) { const int j = (F.tid >> 3) + 64 * i; *(u32x4*)(KA + j * KS + ch * 16) = kv[i]; *(u32x4*)(VA + j * VS + ch * 16) = vv[i]; } }
    const int tokq = rres + d * (i0 + 32 * w + r);
    bf16x8 qf[4];
#pragma unroll
    for (int s = 0; s < 4; ++s) qf[s] = *(const bf16x8*)(F.proj + (size_t)tokq * PW + C_AQ + a * 64 + 16 * s + 8 * hh);
    const float mb2 = ((const float*)(F.lds + P3_EXT + 3072))[0];
    __syncthreads();
    f32x16 o[2]; o[0] = f32x16{}; o[1] = f32x16{}; float lsum = 0.f;
    const int qj = 32 * w + r + 128;
    if (i0 != 0) {
        { f32x16 S;
#pragma unroll
          for (int g = 0; g < 16; ++g) S[g] = -mb2;
          attn_sub<KS, VS>(KA, VA, 32 * w, qf, S, o, lsum, F.lane, true, qj - 128 - 32 * w, 31); }
        { f32x16 S[3];
#pragma unroll
          for (int u = 0; u < 3; ++u)
#pragma unroll
              for (int g = 0; g < 16; ++g) S[u][g] = -mb2;
          attn_multi<3, KS, VS>(KA, VA, 32 * (w + 1), qf, S, o, lsum, F.lane); }
        { f32x16 S;
#pragma unroll
          for (int g = 0; g < 16; ++g) S[g] = -mb2;
          attn_sub<KS, VS>(KA, VA, 32 * (w + 4), qf, S, o, lsum, F.lane, true, 0, qj - 32 * (w + 4)); }
    } else
    for (int jt = w; jt < w + 5; ++jt) { const int j0 = 32 * jt;
        if (j0 + 31 < 128) continue;
        f32x16 S;
#pragma unroll
        for (int g = 0; g < 16; ++g) S[g] = -mb2;
        int lo = qj - 128 - j0; const int hi_ = qj - j0; if (128 - j0 > lo) lo = 128 - j0;
        attn_sub<KS, VS>(KA, VA, j0, qf, S, o, lsum, F.lane, true, lo, hi_); }
    lsum += __shfl_xor(lsum, 32);
    bf16* oa = F.oa + ((size_t)n * SEQ + tokq) * 768 + a * 64 + 4 * hh;
#pragma unroll
    for (int dt = 0; dt < 2; ++dt)
#pragma unroll
        for (int i = 0; i < 4; ++i) { u32x2 wv; wv.x = pk2(o[dt][4 * i], o[dt][4 * i + 1]); wv.y = pk2(o[dt][4 * i + 2], o[dt][4 * i + 3]); *(u32x2*)(oa + 32 * dt + 8 * i) = wv; }
    if (hh == 0) F.la[((size_t)n * SEQ + tokq) * 12 + a] = lsum;
    __syncthreads();
}
__device__ __forceinline__ void phase3(Ctx& F, int l) {
    volatile unsigned* slot = (volatile unsigned*)(F.lds + QSLOT_OFF);
    { float* PEXA = (float*)(F.lds + P3_EXT); int* KFT = (int*)(F.lds + P3_EXT + 2048); float* MB = (float*)(F.lds + P3_EXT + 3072);
      { const float v = F.bt[F.lane * 8 + F.wave]; float sc = v;
#pragma unroll
        for (int o = 1; o < 64; o <<= 1) { const float y = __shfl_up(sc, o); if (F.lane >= o) sc += y; }
        PEXA[F.wave * 64 + F.lane] = sc - v; }
      if (F.tid == 0) { MB[0] = softmax_ref2(F.aqg + l * 64, F.akg + l * 64); MB[1] = softmax_ref2(F.bqg + l * 64, F.bkg + l * 64); }
      __syncthreads();
      if (F.tid < 256) { const int h = F.tid >> 5, qb = F.tid & 31; const float thr = -(26.f + 2.f * MB[1] * (1.f / LOG2E)), pq0 = PEXA[h * 64 + 2 * qb];
          int kt = 0; while (kt < 2 * qb && (pq0 - PEXA[h * 64 + kt + 1]) < thr) ++kt;
          KFT[F.tid] = kt; if (F.bid == 0) F.ctl[8192 + F.tid] = (unsigned)kt; }
      __syncthreads(); }
    for (;;) {
        if (F.tid == 0) *slot = atomicAdd(F.ctl + l, 1u);
        __syncthreads();
        const int item = __builtin_amdgcn_readfirstlane((int)*slot);
        __syncthreads();
        if (item >= N_ITEMS) break;
        if (item < N_SCAN) scan_item(F, item);
        else if (item < N_SCAN + N_FOX) { int f = item - N_SCAN, ns, qhi;
            if (f < 256) { ns = 4; qhi = 31; } else if (f < 448) { f -= 256; ns = 3; qhi = 23; } else if (f < 576) { f -= 448; ns = 2; qhi = 15; } else { f -= 576; ns = 1; qhi = 7; }
            const int per = ns * 8, qb = qhi - f / per, rem = f % per;
            fox_unit(F, l, rem & 7, qb, rem >> 3); }
        else { const int au = item - N_SCAN - N_FOX, n = au / 384, rest = au % 384, a = rest >> 5, u = rest & 31;
            const int per = (n == 0) ? 32 : (n == 1) ? 8 : 2;
            a_unit(F, l, a, n, u / per, u % per); }
    }
}
#define PIN6(a) asm volatile("" : "+v"(a[0]), "+v"(a[1]), "+v"(a[2]), "+v"(a[3]), "+v"(a[4]), "+v"(a[5]))
__device__ __forceinline__ void phase4(Ctx& F, int l) {
    unsigned char* VV = F.lds;
    float* SSQ = (float*)(F.lds + 51200);
    const int r = F.lane & 31, hh = F.lane >> 5, w = F.wave, ui = w >> 2, th = (w >> 1) & 1, vh = w & 1;
    const float* gain = F.out_gain + l * 192;
    for (int pu = F.bid; pu < 256; pu += F.G) {
        const int u = 2 * pu + ui, h = u & 3, n = u >> 2, t0 = n * 64, tq = th * 32 + r;
        bf16x8 qf[6], kf0[6], kf1[6], sfa[6], sfb[6];
        const bf16* stb = F.st + ((size_t)(n * 4 + h) * 192 + 32 * (vh * 3) + r) * 96 + 8 * hh;
#pragma unroll
        for (int kd = 0; kd < 6; ++kd) { qf[kd] = *(const bf16x8*)(F.proj + (size_t)(t0 + tq) * PW + C_CQ + h * 96 + 16 * kd + 8 * hh);
            kf0[kd] = *(const bf16x8*)(F.proj + (size_t)(t0 + r) * PW + C_CK + h * 96 + 16 * kd + 8 * hh);
            kf1[kd] = *(const bf16x8*)(F.proj + (size_t)(t0 + 32 + r) * PW + C_CK + h * 96 + 16 * kd + 8 * hh);
            sfa[kd] = *(const bf16x8*)(stb + 16 * kd); }
        { u32x4 vv[6];
#pragma unroll
          for (int i = 0; i < 6; ++i) { const int e = F.tid + 512 * i, uu = e / 1536, e2 = e % 1536, row = e2 / 24, ch = e2 % 24, u2 = 2 * pu + uu, h2 = u2 & 3, n2 = u2 >> 2;
              vv[i] = *(const u32x4*)(F.proj + (size_t)(n2 * 64 + row) * PW + C_CV + h2 * 192 + ch * 8); }
          asm volatile("" : "+v"(vv[0]), "+v"(vv[1]), "+v"(vv[2]), "+v"(vv[3]), "+v"(vv[4]), "+v"(vv[5]));
#pragma unroll
          for (int i = 0; i < 6; ++i) { const int e = F.tid + 512 * i, uu = e / 1536, e2 = e % 1536, row = e2 / 24, ch = e2 % 24; *(u32x4*)(VV + uu * 25600 + row * 400 + ch * 16) = vv[i]; } }
        __syncthreads();
        PIN6(qf); PIN6(kf0); PIN6(kf1);
        bf16x8 pf[2][2];
        { f32x16 X = {};
#pragma unroll
          for (int kd = 0; kd < 6; ++kd) X = MFMA32(kf0[kd], qf[kd], X);
          if (th == 0) {
#pragma unroll
              for (int g = 0; g < 16; ++g) if (rowidx(g, hh) > r) X[g] = 0.f; }
          pack_p(X, pf[0][0], pf[0][1]); }
        if (th == 1) { f32x16 X = {};
#pragma unroll
          for (int kd = 0; kd < 6; ++kd) X = MFMA32(kf1[kd], qf[kd], X);
#pragma unroll
          for (int g = 0; g < 16; ++g) if (rowidx(g, hh) > r) X[g] = 0.f;
          pack_p(X, pf[1][0], pf[1][1]); }
        f32x16 O[3]; float sq = 0.f;
#pragma unroll
        for (int vt = 0; vt < 3; ++vt) { const int vtile = vh * 3 + vt; f32x16 acc = {};
            if (vt == 0) {
#pragma unroll
                for (int kd = 0; kd < 6; ++kd) sfb[kd] = *(const bf16x8*)(stb + (size_t)32 * 96 + 16 * kd); }
            if (vt == 1) {
#pragma unroll
                for (int kd = 0; kd < 6; ++kd) sfa[kd] = *(const bf16x8*)(stb + (size_t)64 * 96 + 16 * kd); }
#pragma unroll
            for (int si = 0; si < 2; ++si) if (si <= th) {
#pragma unroll
                for (int s2 = 0; s2 < 2; ++s2) { const bf16x8 vf = frag_tr((lds_cptr)(VV + ui * 25600), 400, 32 * si + 16 * s2, 32 * vtile, F.lane); acc = MFMA32(vf, pf[si][s2], acc); } }
            if (vt == 1) { PIN6(sfb);
#pragma unroll
                for (int kd = 0; kd < 6; ++kd) acc = MFMA32(sfb[kd], qf[kd], acc); }
            else { PIN6(sfa);
#pragma unroll
                for (int kd = 0; kd < 6; ++kd) acc = MFMA32(sfa[kd], qf[kd], acc); }
#pragma unroll
            for (int g = 0; g < 16; ++g) sq += acc[g] * acc[g];
            O[vt] = acc; }
        u32x2 zw[3][4]; f32x4 gg[3][4];
#pragma unroll
        for (int vt = 0; vt < 3; ++vt)
#pragma unroll
            for (int i = 0; i < 4; ++i) { const int v = 32 * (vh * 3 + vt) + 8 * i + 4 * hh;
                zw[vt][i] = *(const u32x2*)(F.proj + (size_t)(t0 + tq) * PW + C_CZ + h * 192 + v); gg[vt][i] = *(const f32x4*)(gain + v); }
        sq += __shfl_xor(sq, 32);
        if (hh == 0) SSQ[(ui * 2 + vh) * 64 + tq] = sq;
        __syncthreads();
        const float rs = rsqrtf((SSQ[(ui * 2) * 64 + tq] + SSQ[(ui * 2 + 1) * 64 + tq]) * (1.f / 192.f) + EPS);
#pragma unroll
        for (int vt = 0; vt < 3; ++vt) { PIN4(zw[vt][0], zw[vt][1], zw[vt][2], zw[vt][3]);
#pragma unroll
            for (int i = 0; i < 4; ++i) { const int v = 32 * (vh * 3 + vt) + 8 * i + 4 * hh; const u32x2 z = zw[vt][i]; const f32x4 g4 = gg[vt][i];
                const float y0 = O[vt][4 * i] * rs * g4.x * silu(blo(z.x)), y1 = O[vt][4 * i + 1] * rs * g4.y * silu(bhi(z.x)), y2 = O[vt][4 * i + 2] * rs * g4.z * silu(blo(z.y)), y3 = O[vt][4 * i + 3] * rs * g4.w * silu(bhi(z.y));
                u32x2 ov; ov.x = pk2(y0, y1); ov.y = pk2(y2, y3); *(u32x2*)(F.mixed + (size_t)(t0 + tq) * DM + 1280 + h * 192 + v) = ov; } }
        __syncthreads();
    }
    const int NT = F.G * 512, gt = F.bid * 512 + F.tid;
    for (int idx0 = gt; idx0 < SEQ * 96; idx0 += 2 * NT) {
        u32x4 wv[2][3], zw[2]; float la[2][3]; int tt[2], cc[2]; bool ok[2];
#pragma unroll
        for (int j = 0; j < 2; ++j) { const int idx = idx0 + j * NT; ok[j] = idx < SEQ * 96; const int id2 = ok[j] ? idx : gt; const int t = id2 / 96, c = (id2 % 96) * 8, a = c >> 6; tt[j] = t; cc[j] = c;
#pragma unroll
            for (int n = 0; n < 3; ++n) { wv[j][n] = *(const u32x4*)(F.oa + ((size_t)n * SEQ + t) * 768 + c); la[j][n] = F.la[((size_t)n * SEQ + t) * 12 + a]; }
            zw[j] = *(const u32x4*)(F.proj + (size_t)t * PW + C_AZ + c); }
        PIN4(wv[0][0], wv[0][1], wv[0][2], zw[0]); PIN4(wv[1][0], wv[1][1], wv[1][2], zw[1]);
#pragma unroll
        for (int j = 0; j < 2; ++j) { float o[8] = {0.f, 0.f, 0.f, 0.f, 0.f, 0.f, 0.f, 0.f};
#pragma unroll
            for (int n = 0; n < 3; ++n) { const u32x4 x = wv[j][n]; o[0] += blo(x.x); o[1] += bhi(x.x); o[2] += blo(x.y); o[3] += bhi(x.y); o[4] += blo(x.z); o[5] += bhi(x.z); o[6] += blo(x.w); o[7] += bhi(x.w); }
            const float il = 1.f / ((la[j][0] + la[j][1]) + la[j][2]); const u32x4 z = zw[j];
            u32x4 ov; ov.x = pk2(o[0] * il * silu(blo(z.x)), o[1] * il * silu(bhi(z.x))); ov.y = pk2(o[2] * il * silu(blo(z.y)), o[3] * il * silu(bhi(z.y)));
            ov.z = pk2(o[4] * il * silu(blo(z.z)), o[5] * il * silu(bhi(z.z))); ov.w = pk2(o[6] * il * silu(blo(z.w)), o[7] * il * silu(bhi(z.w)));
            if (ok[j]) *(u32x4*)(F.mixed + (size_t)tt[j] * DM + cc[j]) = ov; } }
    for (int idx0 = gt; idx0 < SEQ * 64; idx0 += 2 * NT) {
        f32x4 a0[2][4], a1[2][4]; float lv[2][4]; u32x4 zw[2]; int tt[2], cc[2], ns[2]; bool ok[2];
#pragma unroll
        for (int j = 0; j < 2; ++j) { const int idx = idx0 + j * NT; ok[j] = idx < SEQ * 64; const int id2 = ok[j] ? idx : gt; const int t = id2 / 64, c = (id2 % 64) * 8, h = c >> 6; tt[j] = t; cc[j] = c;
            ns[j] = (2 * (t >> 8) + 2 - (int)F.ctl[8192 + h * 32 + (t >> 8)] + 15) >> 4;
#pragma unroll
            for (int sg = 0; sg < 4; ++sg) { a0[j][sg] = (f32x4){0.f, 0.f, 0.f, 0.f}; a1[j][sg] = (f32x4){0.f, 0.f, 0.f, 0.f}; lv[j][sg] = 0.f;
                if (sg < ns[j]) { const float* p = F.ob + ((size_t)sg * SEQ + t) * 512 + c; a0[j][sg] = *(const f32x4*)p; a1[j][sg] = *(const f32x4*)(p + 4); lv[j][sg] = F.lb[((size_t)sg * SEQ + t) * 8 + h]; } }
            zw[j] = *(const u32x4*)(F.proj + (size_t)t * PW + C_BZ + c); }
#pragma unroll
        for (int j = 0; j < 2; ++j) { const f32x4 o0 = (a0[j][0] + a0[j][1]) + (a0[j][2] + a0[j][3]), o1 = (a1[j][0] + a1[j][1]) + (a1[j][2] + a1[j][3]);
            const float il = 1.f / ((lv[j][0] + lv[j][1]) + (lv[j][2] + lv[j][3])); const u32x4 z = zw[j];
            u32x4 ov; ov.x = pk2(o0.x * il * silu(blo(z.x)), o0.y * il * silu(bhi(z.x))); ov.y = pk2(o0.z * il * silu(blo(z.y)), o0.w * il * silu(bhi(z.y)));
            ov.z = pk2(o1.x * il * silu(blo(z.z)), o1.y * il * silu(bhi(z.z))); ov.w = pk2(o1.z * il * silu(blo(z.w)), o1.w * il * silu(bhi(z.w)));
            if (ok[j]) *(u32x4*)(F.mixed + (size_t)tt[j] * DM + 768 + cc[j]) = ov; } }
}

#define LAS __attribute__((address_space(3)))
#define XB_TMO      128
#define XB_XCNT(j)  (256  + 64 * (j))
#define XB_XSUB(j)  (1280 + 64 * (j))
#define XB_XGEN(j)  (2304 + 64 * (j))
#define XB_TOP      3328
#define XB_TOPGEN   3392
#define XCD_BAR_WORDS 3456
#define XB_SPIN_CAP (1u << 18)

__device__ __forceinline__ unsigned xb_ld(unsigned* p)              { return __hip_atomic_load(p, __ATOMIC_RELAXED, __HIP_MEMORY_SCOPE_AGENT); }
__device__ __forceinline__ unsigned xb_add(unsigned* p, unsigned v) { return __hip_atomic_fetch_add(p, v, __ATOMIC_RELAXED, __HIP_MEMORY_SCOPE_AGENT); }
__device__ __forceinline__ unsigned xb_xcc_id() { return (unsigned)__builtin_amdgcn_s_getreg((3 << 11) | 20) & 0xFu; }
#define XB_SPIN(cond, bar) do { unsigned _sp = 0; while (cond) { __builtin_amdgcn_s_sleep(1); \
    if ((++_sp & 255u) == 0u) { if (xb_ld(&(bar)[XB_TMO])) break; if (_sp > XB_SPIN_CAP) { atomicAdd(&(bar)[XB_TMO], 1u); break; } } } } while (0)

struct XcdBarrier {
    unsigned* bar; unsigned x;
    volatile LAS unsigned* st;
};

__device__ __forceinline__ XcdBarrier xcd_barrier_post(unsigned* bar, volatile LAS unsigned* st) {
    XcdBarrier b; b.bar = bar; b.x = xb_xcc_id(); b.st = st;
    if (threadIdx.x == 0) (void)xb_add(&bar[XB_XCNT(b.x)], 1u);
    return b;
}
__device__ __forceinline__ void xcd_barrier_complete(unsigned* bar, unsigned x, unsigned& nloc, unsigned& nx) {
    const unsigned G = gridDim.x * gridDim.y * gridDim.z;
    unsigned sum, cnt, mine, sp = 0u;
    for (;;) {
        sum = 0u; cnt = 0u; mine = 0u;
#pragma unroll
        for (unsigned j = 0; j < 16; ++j) { const unsigned c = xb_ld(&bar[XB_XCNT(j)]); sum += c; cnt += (c > 0u) ? 1u : 0u; mine = (j == x) ? c : mine; }
        if (sum == G) break;
        __builtin_amdgcn_s_sleep(1);
        if ((++sp & 255u) == 0u) { if (xb_ld(&bar[XB_TMO])) break; if (sp > XB_SPIN_CAP) { atomicAdd(&bar[XB_TMO], 1u); break; } }
    }
    nloc = mine > 0u ? mine : 1u; nx = cnt > 0u ? cnt : 1u;
}

__device__ __forceinline__ void xcd_barrier(const XcdBarrier& b) {
    asm volatile("s_waitcnt vmcnt(0)" ::: "memory");
    __syncthreads();
    if (threadIdx.x == 0) {
        unsigned* bar = b.bar;
        __builtin_amdgcn_s_waitcnt(0);
        unsigned nloc = b.st[0], nx = b.st[1];
        if (nloc == 0u) { xcd_barrier_complete(bar, b.x, nloc, nx); b.st[0] = nloc; b.st[1] = nx; }
        const unsigned old = xb_add(&bar[XB_XSUB(b.x)], 1u);
        const unsigned gen = old / nloc;
        if (old + 1u == (gen + 1u) * nloc) {
            __builtin_amdgcn_fence(__ATOMIC_RELEASE, "agent");
            asm volatile("s_waitcnt vmcnt(0)" ::: "memory");
            const unsigned og = xb_add(&bar[XB_TOP], 1u);
            const unsigned tg = og / nx;
            if (og + 1u == (tg + 1u) * nx) xb_add(&bar[XB_TOPGEN], 1u);
            else XB_SPIN(xb_ld(&bar[XB_TOPGEN]) == tg, bar);
            __builtin_amdgcn_fence(__ATOMIC_ACQUIRE, "agent");
            xb_add(&bar[XB_XGEN(b.x)], 1u);
            asm volatile("s_waitcnt vmcnt(0)" ::: "memory");
        } else {
            XB_SPIN(xb_ld(&bar[XB_XGEN(b.x)]) == gen, bar);
            __builtin_amdgcn_fence(__ATOMIC_ACQUIRE, "agent");
            asm volatile("s_waitcnt vmcnt(0)" ::: "memory");
        }
    }
    __syncthreads();
}

struct Args { const float* in[12]; float* out; unsigned char* ws; int ph_lo, ph_hi; };
constexpr int N_PHASES = 1 + 5 * NLAYER;
__global__ void __launch_bounds__(512, 2) mega_fwd(Args args) {
    extern __shared__ __attribute__((aligned(16))) unsigned char lds[];
    Ctx F;
#define BUILD() do { const Args* ap_ = &args; \
    F.x = ap_->in[0]; F.norm_g = ap_->in[1]; F.w_in = ap_->in[2]; F.aqg = ap_->in[3]; F.akg = ap_->in[4]; F.bqg = ap_->in[5]; F.bkg = ap_->in[6]; \
    F.fox_bias = ap_->in[7]; F.gate_up = ap_->in[8]; F.gate_bias = ap_->in[9]; F.out_gain = ap_->in[10]; F.w_out = ap_->in[11]; \
    F.out = ap_->out; unsigned char* ws = ap_->ws; F.ws = ws; \
    F.ctl = (unsigned*)(ws + WS_CTL); F.ss = (unsigned long long*)(ws + WS_SS); F.wtin = (bf16*)(ws + WS_WTIN); F.wtout = (bf16*)(ws + WS_WTOUT); F.xb = (bf16*)(ws + WS_XB); \
    F.proj = (bf16*)(ws + WS_PROJ); F.small = (float*)(ws + WS_SMALL); F.mixed = (bf16*)(ws + WS_MIXED); F.oa = (bf16*)(ws + WS_OA); F.la = (float*)(ws + WS_LA); \
    F.ob = (float*)(ws + WS_OB); F.lb = (float*)(ws + WS_LB); F.cl = (float*)(ws + WS_CL); F.bt = (float*)(ws + WS_BT); F.ds = (float*)(ws + WS_DS); F.st = (bf16*)(ws + WS_ST); F.dec = (float*)(ws + WS_DEC); \
    F.lds = lds; F.G = gridDim.x; F.bid = blockIdx.x; \
    int t_ = threadIdx.x; asm volatile("" : "+v"(t_)); F.tid = t_; F.lane = t_ & 63; F.wave = __builtin_amdgcn_readfirstlane(t_ >> 6); } while (0)
    BUILD();
    cg::grid_group grid = cg::this_grid();
    if (threadIdx.x < 8) ((volatile LAS unsigned*)((LAS unsigned char*)lds + MISC_OFF))[threadIdx.x] = 0u;
    __syncthreads();
    XcdBarrier bar = xcd_barrier_post((unsigned*)(F.ws + WS_CTL) + 4096, (volatile LAS unsigned*)((LAS unsigned char*)lds + MISC_OFF));
    const int lo = args.ph_lo, hi = args.ph_hi;
#define IN(k) (lo <= (k) && (k) < hi)
#define RELAUNDER() do { int t_ = threadIdx.x; asm volatile("" : "+v"(t_)); F.tid = t_; F.lane = t_ & 63; F.wave = __builtin_amdgcn_readfirstlane(t_ >> 6); } while (0)
#define SEAM(k) do { if (IN(k) && IN((k) + 1)) { if ((k) == 0) grid.sync(); else xcd_barrier(bar); } } while (0)
    if (IN(0)) { BUILD(); phase0(F); }
    SEAM(0);
    for (int l = 0; l < NLAYER; ++l) { const int pb = 1 + 5 * l;
        if (IN(pb)) { BUILD(); pg8::Gemm g{F.xb, F.wtin + (size_t)l * NPAD * DM, SEQ, NPAD, DM}; pg8::StaticOrder S; S.init(SEQ, NPAD, F.G, F.bid);
            pg8::EpiProj E{F.proj, F.small, F.ss + l * SEQ, (float*)(lds + RING_BYTES + 1024), F.aqg + l * 64, F.akg + l * 64, F.bqg + l * 64, F.bkg + l * 64};
            pg8::gemm_phase<pg8::EpiProj, pg8::StaticOrder, true, true>((PG8_LAS unsigned char*)lds, g, S, E); __syncthreads(); }
        SEAM(pb);
        if (IN(pb + 1)) { BUILD(); phase2(F, l); }
        SEAM(pb + 1);
        if (IN(pb + 2)) { BUILD(); phase3(F, l); }
        SEAM(pb + 2);
        if (IN(pb + 3)) { BUILD(); phase4(F, l); }
        SEAM(pb + 3);
        if (IN(pb + 4)) { BUILD(); pg8::Gemm g{F.mixed, F.wtout + (size_t)l * DM * DM, SEQ, DM, DM}; pg8::StaticOrder S; S.init(SEQ, DM, F.G, F.bid);
            const bool last = (l == NLAYER - 1);
            pg8::EpiOut E{l == 0 ? F.x : F.out, F.out, last ? nullptr : F.xb, last ? nullptr : F.ss + (l + 1) * SEQ};
            pg8::gemm_phase<pg8::EpiOut, pg8::StaticOrder, true, true>((PG8_LAS unsigned char*)lds, g, S, E); __syncthreads(); }
        SEAM(pb + 4);
    }
#undef IN
#undef SEAM
}

#ifndef MK_ONE_LAUNCH
#define MK_ONE_LAUNCH 1
#endif
extern "C" void kernel_launch(void* const* d_in, const int* in_sizes, int n_in, void* d_out, int out_size, void* d_ws, size_t ws_size, hipStream_t stream) {
    static int grid = 0;
    if (grid == 0) {
        int dev = 0, cus = 0, per_cu = 0;
        hipGetDevice(&dev); hipDeviceGetAttribute(&cus, hipDeviceAttributeMultiprocessorCount, dev);
        hipFuncSetAttribute((const void*)mega_fwd, hipFuncAttributeMaxDynamicSharedMemorySize, LDS_BYTES);
        hipOccupancyMaxActiveBlocksPerMultiprocessor(&per_cu, mega_fwd, 512, LDS_BYTES);
        grid = cus * per_cu; if (grid <= 0) grid = 256;
        if (ws_size < WS_END) { fprintf(stderr, "workspace too small: %zu < %zu\n", ws_size, (size_t)WS_END); }
    }
    Args a{}; for (int i = 0; i < 12; ++i) a.in[i] = (const float*)d_in[i]; a.out = (float*)d_out; a.ws = (unsigned char*)d_ws;
#if MK_ONE_LAUNCH
    a.ph_lo = 0; a.ph_hi = N_PHASES; void* kargs[] = {&a};
    (void)hipMemsetAsync(d_ws, 0, 65536, stream);
    hipError_t e = hipLaunchCooperativeKernel((const void*)mega_fwd, dim3(grid), dim3(512), kargs, LDS_BYTES, stream);
    if (e != hipSuccess) fprintf(stderr, "cooperative launch failed: %s (grid %d)\n", hipGetErrorString(e), grid);
#else
    for (int p = 0; p < N_PHASES; ++p) { a.ph_lo = p; a.ph_hi = p + 1; hipLaunchKernelGGL(mega_fwd, dim3(grid), dim3(512), LDS_BYTES, stream, a); }
#endif
}
```

```cpp
#include <hip/hip_runtime.h>
#include <hip/hip_cooperative_groups.h>
#include <cstdio>
#include <cstdint>
namespace cg = cooperative_groups;
namespace pg8 {
#define PG8_LAS __attribute__((address_space(3)))
typedef unsigned short bf16_t;
typedef short bf16x8 __attribute__((ext_vector_type(8)));
typedef float f32x4 __attribute__((ext_vector_type(4)));
typedef unsigned u32x4 __attribute__((ext_vector_type(4)));
constexpr int BM = 256, BK = 64, HALF = 128, HTB = HALF * BK * 2  , STAGE_BYTES = 8 * HTB, NXCD = 8, WGM = 8;

__host__ __device__ __forceinline__ int lds_byte(int r, int c) { const int st = (r >> 4) * 2 + (c >> 5), rr = r & 15, cc = c & 31, ob = rr * 64 + cc * 2; return st * 1024 + (ob ^ (((ob >> 9) & 1) << 5)); }
__host__ __device__ __forceinline__ void stage_rc(int b, int& R, int& C) { const int st = b / 1024, sb = b % 1024, swz = sb ^ (((sb >> 9) & 1) << 5); R = (st >> 1) * 16 + swz / 64; C = (st & 1) * 32 + (swz % 64) / 2; }
__host__ __device__ __forceinline__ int perm32(int rho) { const int n = rho >> 4, i = rho & 15; return 8 * (i >> 2) + 4 * n + (i & 3); }

struct Unit { int pm, pn; };
struct Gemm { const bf16_t* A; const bf16_t* Bt; int M, N, K; };

struct StaticOrder {
    int nM, nN, nwg, G, c;
    __host__ __device__ void init(int M, int N, int G_, int c_) { nM = M / BM; nN = N / BM; nwg = nM * nN; G = G_; c = c_; }
    __host__ __device__ bool next(int i, Unit& u) const {
        const long L = (long)i * G + c; if (L >= nwg) return false;
        int wgid = (int)L; { const int q = nwg / NXCD, r = nwg % NXCD, xcd = wgid % NXCD, off = wgid / NXCD; wgid = (xcd < r ? xcd * (q + 1) : r * (q + 1) + (xcd - r) * q) + off; }
        const int nig = WGM * nN, gid = wgid / nig, fm = gid * WGM, gsz = (nM - fm) < WGM ? (nM - fm) : WGM;
        u.pm = fm + ((wgid % nig) % gsz); u.pn = (wgid % nig) / gsz; return true;
    }
    __device__ __forceinline__ void a_ready(const Unit&) const {}
    __device__ __forceinline__ void done(const Unit&) const {}
};

__device__ __forceinline__ unsigned cvt_pk_bf16(float lo, float hi) { unsigned r; asm volatile("v_cvt_pk_bf16_f32 %0, %1, %2" : "=v"(r) : "v"(lo), "v"(hi)); return r; }
typedef float f32x2 __attribute__((ext_vector_type(2)));
constexpr int PROJ_W = 7424;
struct EpiProj {
    static constexpr bool PERM = true, AFTER_DRAIN = false;
    bf16_t* O; float* small; const unsigned long long* ss; float* xch; const float* gaq; const float* gak; const float* gbq; const float* gbk;
    __device__ __forceinline__ void operator()(const f32x4 (&acc)[2][2][4][2], const Unit& u, int wr, int wc, int fr, int fq) const {
        const int row0 = u.pm * BM + wr * 64 + fr;
        float rsv[2][4];
        { unsigned long long sv[2][4];
#pragma unroll
          for (int ai = 0; ai < 2; ++ai)
#pragma unroll
              for (int m = 0; m < 4; ++m) sv[ai][m] = ss[row0 + ai * HALF + m * 16];
          asm volatile("" : "+v"(sv[0][0]), "+v"(sv[0][1]), "+v"(sv[0][2]), "+v"(sv[0][3])); asm volatile("" : "+v"(sv[1][0]), "+v"(sv[1][1]), "+v"(sv[1][2]), "+v"(sv[1][3]));
#pragma unroll
          for (int ai = 0; ai < 2; ++ai)
#pragma unroll
              for (int m = 0; m < 4; ++m) rsv[ai][m] = rsqrtf((float)sv[ai][m] * (1.0f / 1048576.0f / 2048.0f) + 1e-6f); }
        if (u.pn < 29) {
            const int col0 = u.pn * BM + wc * 32 + 8 * fq;
            const bool isA = u.pn < 6, isB = (u.pn >= 12 && u.pn < 16);
            if (isA || isB) {
#pragma unroll
                for (int ai = 0; ai < 2; ++ai)
#pragma unroll
                    for (int m = 0; m < 4; ++m) { const int row = row0 + ai * HALF + m * 16; const float rs = rsv[ai][m];
#pragma unroll
                        for (int bj = 0; bj < 2; ++bj) { const f32x4 v0 = acc[ai][bj][m][0] * rs, v1 = acc[ai][bj][m][1] * rs;
                            float sq = (v0[0] * v0[0] + v0[1] * v0[1]) + (v0[2] * v0[2] + v0[3] * v0[3]) + (v1[0] * v1[0] + v1[1] * v1[1]) + (v1[2] * v1[2] + v1[3] * v1[3]);
                            sq += __shfl_xor(sq, 16); sq += __shfl_xor(sq, 32);
                            if (fq == 0) xch[((ai * HALF + wr * 64 + m * 16 + fr) * 2 + bj) * 4 + wc] = sq; } }
                asm volatile("s_waitcnt lgkmcnt(0)" ::: "memory"); __builtin_amdgcn_s_barrier(); asm volatile("" ::: "memory");
                const bool isq = (u.pn < 3) || (u.pn == 12) || (u.pn == 13);
                const float* ga0 = gaq; const float* ga1 = gak; const float* gb0 = gbq; const float* gb1 = gbk;
                const float* gsel = isA ? ga0 : gb0; { const float* gk = isA ? ga1 : gb1; if (!isq) gsel = gk; }
                const float* g = gsel + 32 * (wc & 1) + 8 * fq;
                const float sc = isq ? 0.18033688011112042f : 1.0f;
                const f32x4 g0 = *(const f32x4*)g * sc, g1 = *(const f32x4*)(g + 4) * sc;
#pragma unroll
                for (int ai = 0; ai < 2; ++ai)
#pragma unroll
                    for (int m = 0; m < 4; ++m) { const int row = row0 + ai * HALF + m * 16; bf16_t* rowp = O + (size_t)row * PROJ_W + col0;
                        const float rs = rsv[ai][m];
#pragma unroll
                        for (int bj = 0; bj < 2; ++bj) { const float* xp = xch + ((ai * HALF + wr * 64 + m * 16 + fr) * 2 + bj) * 4 + (wc & 2); const float tot = xp[0] + xp[1];
                            const float r2 = rsqrtf(tot * (1.0f / 64.0f) + 1e-6f) * rs;
                            const f32x4 v0 = acc[ai][bj][m][0] * r2 * g0, v1 = acc[ai][bj][m][1] * r2 * g1;
                            u32x4 w; w.x = cvt_pk_bf16(v0[0], v0[1]); w.y = cvt_pk_bf16(v0[2], v0[3]); w.z = cvt_pk_bf16(v1[0], v1[1]); w.w = cvt_pk_bf16(v1[2], v1[3]);
                            *(u32x4*)(rowp + bj * HALF) = w; } }
            } else {
#pragma unroll
            for (int ai = 0; ai < 2; ++ai)
#pragma unroll
                for (int m = 0; m < 4; ++m) { const int row = row0 + ai * HALF + m * 16; const float rs = rsv[ai][m];
                    bf16_t* rowp = O + (size_t)row * PROJ_W + col0;
#pragma unroll
                    for (int bj = 0; bj < 2; ++bj) { const f32x4 v0 = acc[ai][bj][m][0] * rs, v1 = acc[ai][bj][m][1] * rs;
                        u32x4 w; w.x = cvt_pk_bf16(v0[0], v0[1]); w.y = cvt_pk_bf16(v0[2], v0[3]); w.z = cvt_pk_bf16(v1[0], v1[1]); w.w = cvt_pk_bf16(v1[2], v1[3]);
                        *(u32x4*)(rowp + bj * HALF) = w; } }
            }
        } else if (wc == 0) {
#pragma unroll
            for (int ai = 0; ai < 2; ++ai)
#pragma unroll
                for (int m = 0; m < 4; ++m) { const int row = row0 + ai * HALF + m * 16; const float rs = rsv[ai][m];
                    float* p = small + (size_t)row * 32 + 8 * fq;
                    *(f32x4*)p = acc[ai][0][m][0] * rs; *(f32x4*)(p + 4) = acc[ai][0][m][1] * rs; }
        }
    }
};
struct EpiOut {
    static constexpr bool PERM = true, AFTER_DRAIN = false;
    const float* xin; float* out; bf16_t* xb; unsigned long long* ssn;
    __device__ __forceinline__ void operator()(const f32x4 (&acc)[2][2][4][2], const Unit& u, int wr, int wc, int fr, int fq) const {
        const int row0 = u.pm * BM + wr * 64 + fr, col0 = u.pn * BM + wc * 32 + 8 * fq;
#pragma unroll
        for (int ai = 0; ai < 2; ++ai) {
            f32x4 xo[4][2][2];
#pragma unroll
            for (int m = 0; m < 4; ++m)
#pragma unroll
                for (int bj = 0; bj < 2; ++bj) { const size_t p = (size_t)(row0 + ai * HALF + m * 16) * 2048 + col0 + bj * HALF; xo[m][bj][0] = *(const f32x4*)(xin + p); xo[m][bj][1] = *(const f32x4*)(xin + p + 4); }
#pragma unroll
            for (int m = 0; m < 4; ++m) asm volatile("" : "+v"(xo[m][0][0]), "+v"(xo[m][0][1]), "+v"(xo[m][1][0]), "+v"(xo[m][1][1]));
#pragma unroll
            for (int m = 0; m < 4; ++m) { const int row = row0 + ai * HALF + m * 16; float sq = 0.f;
#pragma unroll
                for (int bj = 0; bj < 2; ++bj) { const size_t p = (size_t)row * 2048 + col0 + bj * HALF;
                    const f32x4 a = xo[m][bj][0] + acc[ai][bj][m][0], b = xo[m][bj][1] + acc[ai][bj][m][1];
                    *(f32x4*)(out + p) = a; *(f32x4*)(out + p + 4) = b;
                    if (xb) { u32x4 w; w.x = cvt_pk_bf16(a[0], a[1]); w.y = cvt_pk_bf16(a[2], a[3]); w.z = cvt_pk_bf16(b[0], b[1]); w.w = cvt_pk_bf16(b[2], b[3]); *(u32x4*)(xb + p) = w; }
                    sq += (a[0] * a[0] + a[1] * a[1]) + (a[2] * a[2] + a[3] * a[3]) + (b[0] * b[0] + b[1] * b[1]) + (b[2] * b[2] + b[3] * b[3]); }
                sq += __shfl_xor(sq, 16); sq += __shfl_xor(sq, 32);
                if (fq == 0 && ssn) atomicAdd(ssn + row, (unsigned long long)(sq * 1048576.0f + 0.5f)); } }
    }
};

template <class Epi, class Sched, bool ALIGN_EPI = false, bool SP2 = false>
__device__ __forceinline__ void gemm_phase(PG8_LAS unsigned char* lds, const Gemm g, const Sched& S, const Epi& E) {
    int tid_ = threadIdx.x; asm volatile("" : "+v"(tid_)); const int tid = tid_, wid = __builtin_amdgcn_readfirstlane(tid >> 6), lane = tid & 63, wr = wid >> 2, wc = wid & 3, fr = lane & 15, fq = lane >> 4;
    const int K = g.K, nt = K / BK;
    unsigned voffA[2], voffB[2];
#pragma unroll
    for (int i = 0; i < 2; ++i) { int R, C; stage_rc(tid * 16 + i * 8192, R, C); const int Rb = Epi::PERM ? ((R & ~31) + perm32(R & 31)) : R;
        voffA[i] = (unsigned)(R * K + C) * 2u; voffB[i] = (unsigned)(Rb * K + C) * 2u; }
    const size_t kstep = (size_t)(BK * 2);
    const size_t hstep = (size_t)HALF * K * 2;
    const size_t tstep = 2 * hstep;
    const unsigned ldsw = (unsigned)wid * 1024u;
    const int aoff = lds_byte(wr * 64 + fr, fq * 8), boff = lds_byte(wc * 32 + fr, fq * 8);
#define PG8_SA(b, h) (((b) * 2 + (h)) * HTB)
#define PG8_SB(b, h) ((4 + (b) * 2 + (h)) * HTB)
#define PG8_STAGE(bufoff, gbase, voff) do { _Pragma("unroll") for (int _i = 0; _i < 2; ++_i) \
        __builtin_amdgcn_global_load_lds((const unsigned*)((const char*)(gbase) + (voff)[_i]), (PG8_LAS unsigned*)(lds + (bufoff) + ldsw + _i * 8192), 16, 0, 0); } while (0)
#define PG8_LDA(dst, b, h) do { _Pragma("unroll") for (int m = 0; m < 4; ++m) _Pragma("unroll") for (int k = 0; k < 2; ++k) dst[m][k] = *(const PG8_LAS bf16x8*)(lds + PG8_SA(b, h) + aoff + m * 2048 + k * 1024); } while (0)
#define PG8_LDB(dst, b, h) do { _Pragma("unroll") for (int n = 0; n < 2; ++n) _Pragma("unroll") for (int k = 0; k < 2; ++k) dst[n][k] = *(const PG8_LAS bf16x8*)(lds + PG8_SB(b, h) + boff + n * 2048 + k * 1024); } while (0)
#define PG8_MMA(ai, bj, At, Bt) do { __builtin_amdgcn_s_setprio(1); _Pragma("unroll") for (int m = 0; m < 4; ++m) _Pragma("unroll") for (int n = 0; n < 2; ++n) _Pragma("unroll") for (int k = 0; k < 2; ++k) \
        acc[ai][bj][m][n] = __builtin_amdgcn_mfma_f32_16x16x32_bf16(Bt[n][k], At[m][k], acc[ai][bj][m][n], 0, 0, 0); __builtin_amdgcn_s_setprio(0); } while (0)
#define PG8_WAIT_V(n) asm volatile("s_waitcnt vmcnt(" #n ")" ::: "memory")
#define PG8_WAIT_L(n) asm volatile("s_waitcnt lgkmcnt(" #n ")" ::: "memory")
#define PG8_BAR __builtin_amdgcn_s_barrier()
#define PG8_SCHED __builtin_amdgcn_sched_barrier(0)
    Unit cur, nxt; int ui = 0;
    if (!S.next(0, cur)) return;
    f32x4 acc[2][2][4][2];
#pragma unroll
    for (int a = 0; a < 2; ++a)
#pragma unroll
        for (int b = 0; b < 2; ++b)
#pragma unroll
            for (int m = 0; m < 4; ++m)
#pragma unroll
                for (int n = 0; n < 2; ++n) acc[a][b][m][n] = (f32x4){0.f, 0.f, 0.f, 0.f};
    bf16x8 At[4][2], B0[2][2], B1[2][2];
    const char* cA = (const char*)g.A + (size_t)cur.pm * tstep; const char* cB = (const char*)g.Bt + (size_t)cur.pn * tstep;
    S.a_ready(cur);
    if constexpr (SP2) {
        PG8_STAGE(PG8_SB(0, 0), cB, voffB); PG8_STAGE(PG8_SB(0, 1), cB + hstep, voffB); PG8_STAGE(PG8_SA(0, 0), cA, voffA); PG8_STAGE(PG8_SA(0, 1), cA + hstep, voffA);
        if (wr == 1) PG8_BAR;
        PG8_WAIT_V(2); PG8_BAR;
        PG8_STAGE(PG8_SB(1, 0), cB + kstep, voffB); PG8_STAGE(PG8_SA(1, 0), cA + kstep, voffA); PG8_STAGE(PG8_SB(1, 1), cB + hstep + kstep, voffB);
        PG8_WAIT_V(6); PG8_BAR;
    } else {
        PG8_STAGE(PG8_SB(0, 0), cB, voffB); PG8_STAGE(PG8_SA(0, 0), cA, voffA); PG8_STAGE(PG8_SB(0, 1), cB + hstep, voffB); PG8_STAGE(PG8_SA(0, 1), cA + hstep, voffA);
        if (wr == 1) PG8_BAR;
        PG8_WAIT_V(4); PG8_BAR;
        PG8_STAGE(PG8_SB(1, 0), cB + kstep, voffB); PG8_STAGE(PG8_SA(1, 0), cA + kstep, voffA); PG8_STAGE(PG8_SB(1, 1), cB + hstep + kstep, voffB);
        PG8_WAIT_V(6); PG8_BAR;
    }
    for (;;) {
        const bool has_next = S.next(ui + 1, nxt);
        const char* nA = has_next ? (const char*)g.A + (size_t)nxt.pm * tstep : cA; const char* nB = has_next ? (const char*)g.Bt + (size_t)nxt.pn * tstep : cB;
        for (int t = 0; t < nt; t += 2) {
            const bool last = (t == nt - 2);
            const char* a1 = cA + (size_t)(t + 1) * kstep;
            const char* a2 = last ? nA : cA + (size_t)(t + 2) * kstep; const char* b2 = last ? nB : cB + (size_t)(t + 2) * kstep;
            const char* a3 = a2 + kstep; const char* b3 = b2 + kstep;
            if (last && has_next) S.a_ready(nxt);
            if constexpr (SP2) {
            PG8_LDB(B0, 0, 0); PG8_LDB(B1, 0, 1); PG8_SCHED; PG8_LDA(At, 0, 0); PG8_STAGE(PG8_SA(1, 1), a1 + hstep, voffA);
            PG8_WAIT_V(8); PG8_WAIT_L(0); PG8_BAR; PG8_MMA(0, 0, At, B0); PG8_MMA(0, 1, At, B1); PG8_BAR; PG8_SCHED;
            PG8_LDA(At, 0, 1); PG8_STAGE(PG8_SB(0, 0), b2, voffB); PG8_STAGE(PG8_SB(0, 1), b2 + hstep, voffB); PG8_STAGE(PG8_SA(0, 0), a2, voffA);
            PG8_WAIT_V(8); PG8_WAIT_L(0); PG8_BAR; PG8_MMA(1, 0, At, B0); PG8_MMA(1, 1, At, B1); PG8_BAR; PG8_SCHED;
            PG8_LDB(B0, 1, 0); PG8_LDB(B1, 1, 1); PG8_SCHED; PG8_LDA(At, 1, 0); PG8_STAGE(PG8_SA(0, 1), a2 + hstep, voffA);
            PG8_WAIT_V(8); PG8_WAIT_L(0); PG8_BAR; PG8_MMA(0, 0, At, B0); PG8_MMA(0, 1, At, B1); PG8_BAR; PG8_SCHED;
            PG8_LDA(At, 1, 1); PG8_STAGE(PG8_SB(1, 0), b3, voffB); PG8_STAGE(PG8_SB(1, 1), b3 + hstep, voffB); PG8_STAGE(PG8_SA(1, 0), a3, voffA);
            PG8_WAIT_V(8); PG8_WAIT_L(0); PG8_BAR; PG8_MMA(1, 0, At, B0); PG8_MMA(1, 1, At, B1); PG8_BAR; PG8_SCHED;
            } else {
            PG8_LDB(B0, 0, 0); PG8_SCHED; PG8_LDA(At, 0, 0); PG8_STAGE(PG8_SA(1, 1), a1 + hstep, voffA);
            PG8_WAIT_L(8); PG8_BAR; PG8_WAIT_L(0); PG8_MMA(0, 0, At, B0); PG8_BAR; PG8_SCHED;
            PG8_LDB(B1, 0, 1); PG8_STAGE(PG8_SB(0, 0), b2, voffB);
            PG8_BAR; PG8_WAIT_L(0); PG8_MMA(0, 1, At, B1); PG8_BAR;
            PG8_LDA(At, 0, 1); PG8_STAGE(PG8_SA(0, 0), a2, voffA);
            PG8_BAR; PG8_WAIT_L(0); PG8_MMA(1, 0, At, B0); PG8_BAR; PG8_SCHED;
            PG8_STAGE(PG8_SB(0, 1), b2 + hstep, voffB);
            PG8_WAIT_V(6); PG8_BAR; PG8_MMA(1, 1, At, B1); PG8_BAR;
            PG8_LDB(B0, 1, 0); PG8_SCHED; PG8_LDA(At, 1, 0); PG8_STAGE(PG8_SA(0, 1), a2 + hstep, voffA);
            PG8_WAIT_L(8); PG8_BAR; PG8_WAIT_L(0); PG8_MMA(0, 0, At, B0); PG8_BAR; PG8_SCHED;
            PG8_LDB(B1, 1, 1); PG8_STAGE(PG8_SB(1, 0), b3, voffB);
            PG8_BAR; PG8_WAIT_L(0); PG8_MMA(0, 1, At, B1); PG8_BAR;
            PG8_LDA(At, 1, 1); PG8_STAGE(PG8_SA(1, 0), a3, voffA);
            PG8_BAR; PG8_WAIT_L(0); PG8_MMA(1, 0, At, B0); PG8_BAR; PG8_SCHED;
            PG8_STAGE(PG8_SB(1, 1), b3 + hstep, voffB);
            PG8_WAIT_V(6); PG8_BAR; PG8_MMA(1, 1, At, B1); PG8_BAR;
            }
        }
        if constexpr (ALIGN_EPI) { if (wr == 0) PG8_BAR; }
        if constexpr (!Epi::AFTER_DRAIN) { E(acc, cur, wr, wc, fr, fq); S.done(cur); }
        if (!has_next) break;
#pragma unroll
        for (int a = 0; a < 2; ++a)
#pragma unroll
            for (int b = 0; b < 2; ++b)
#pragma unroll
                for (int m = 0; m < 4; ++m)
#pragma unroll
                    for (int n = 0; n < 2; ++n) acc[a][b][m][n] = (f32x4){0.f, 0.f, 0.f, 0.f};
        cur = nxt; cA = nA; cB = nB; ++ui;
        if constexpr (ALIGN_EPI) { if (wr == 1) PG8_BAR; }
    }
    PG8_WAIT_V(0);
    if constexpr (!ALIGN_EPI) { if (wr == 0) PG8_BAR; }
    PG8_BAR;
    if constexpr (Epi::AFTER_DRAIN) { E.fused(acc, cur, wr, wc, fr, fq, lds, wid, lane); S.done(cur); }
#undef PG8_SA
#undef PG8_SB
#undef PG8_STAGE
#undef PG8_LDA
#undef PG8_LDB
#undef PG8_MMA
#undef PG8_WAIT_V
#undef PG8_WAIT_L
#undef PG8_BAR
#undef PG8_SCHED
}
}
constexpr int SEQ = 8192, DM = 2048, NLAYER = 4, INW = 7448, NPAD = 7680, PW = pg8::PROJ_W;
constexpr int C_AQ = 0, C_AK = 768, C_AV = 1536, C_AZ = 2304, C_BQ = 3072, C_BK = 3584, C_BV = 4096, C_BZ = 4608, C_CQ = 5120, C_CK = 5504, C_CV = 5888, C_CZ = 6656;
constexpr float LOG2E = 1.4426950408889634f, QSCALE = 0.125f * 1.4426950408889634f, EPS = 1e-6f;
constexpr size_t MiB = 1u << 20;
constexpr size_t WS_CTL = 0, WS_SS = 1 * MiB, WS_WTIN = 2 * MiB, WS_WTOUT = 122 * MiB, WS_XB = 154 * MiB, WS_PROJ = 186 * MiB, WS_SMALL = 302 * MiB,
                 WS_MIXED = 304 * MiB, WS_OA = 336 * MiB, WS_LA = 372 * MiB, WS_OB = 374 * MiB, WS_LB = 438 * MiB, WS_CL = 439 * MiB, WS_BT = WS_CL + 512 * 1024,
                 WS_DS = 440 * MiB, WS_ST = 476 * MiB, WS_DEC = 494 * MiB, WS_END = 496 * MiB;
constexpr int RING_BYTES = 131072, LDS_BYTES = 147456, QSLOT_OFF = RING_BYTES + 64, MISC_OFF = RING_BYTES + 256;
constexpr int P3_EXT = RING_BYTES + 1024;
constexpr int N_SCAN = 72, N_FOX = 640, N_AU = 1152, N_ITEMS = N_SCAN + N_FOX + N_AU;

typedef unsigned short bf16;
typedef short bf16x8 __attribute__((ext_vector_type(8)));
typedef short s16x4 __attribute__((ext_vector_type(4)));
typedef float f32x4 __attribute__((ext_vector_type(4)));
typedef float f32x2 __attribute__((ext_vector_type(2)));
typedef float f32x16 __attribute__((ext_vector_type(16)));
typedef unsigned u32x4 __attribute__((ext_vector_type(4)));
typedef unsigned u32x2 __attribute__((ext_vector_type(2)));
typedef __attribute__((address_space(3))) const char* lds_cptr;
#define LAS3 __attribute__((address_space(3)))

__device__ __forceinline__ float bf2f(unsigned b) { return __uint_as_float(b << 16); }
__device__ __forceinline__ unsigned pk2(float lo, float hi) { return pg8::cvt_pk_bf16(lo, hi); }
__device__ __forceinline__ float blo(unsigned w) { return __uint_as_float(w << 16); }
__device__ __forceinline__ float bhi(unsigned w) { return __uint_as_float(w & 0xffff0000u); }
__device__ __forceinline__ float logsig(float x) { return fminf(x, 0.f) - log1pf(expf(-fabsf(x))); }
__device__ __forceinline__ float silu(float x) { return x / (1.f + __expf(-x)); }
__device__ __forceinline__ s16x4 vtr(lds_cptr p) { return __builtin_bit_cast(s16x4, __builtin_amdgcn_ds_read_tr16_b64_v4i16((LAS3 s16x4*)p)); }
__device__ __forceinline__ bf16x8 frag_tr(lds_cptr img, int stride, int kbase, int m0, int lane) {
    const int i = lane & 15, g = lane >> 4;
    lds_cptr p = img + (kbase + 4 * (g >> 1) + (i >> 2)) * stride + (m0 + 16 * (g & 1) + 4 * (i & 3)) * 2;
    const s16x4 a = vtr(p), b = vtr(p + 8 * stride);
    return (bf16x8){a[0], a[1], a[2], a[3], b[0], b[1], b[2], b[3]};
}
__device__ __forceinline__ int rowidx(int reg, int hh) { return (reg & 3) + 8 * (reg >> 2) + 4 * hh; }
__device__ __forceinline__ void pack_p(const f32x16& p, bf16x8& f0, bf16x8& f1) {
    u32x4 a, b; a.x = pk2(p[0], p[1]); a.y = pk2(p[2], p[3]); a.z = pk2(p[4], p[5]); a.w = pk2(p[6], p[7]);
    b.x = pk2(p[8], p[9]); b.y = pk2(p[10], p[11]); b.z = pk2(p[12], p[13]); b.w = pk2(p[14], p[15]);
    f0 = __builtin_bit_cast(bf16x8, a); f1 = __builtin_bit_cast(bf16x8, b);
}
#define MFMA32(a, b, c) __builtin_amdgcn_mfma_f32_32x32x16_bf16((a), (b), (c), 0, 0, 0)

struct Ctx {
    const float *x, *norm_g, *w_in, *aqg, *akg, *bqg, *bkg, *fox_bias, *gate_up, *gate_bias, *out_gain, *w_out;
    float* out; unsigned char* ws;
    unsigned* ctl; unsigned long long* ss; bf16* wtin; bf16* wtout; bf16* xb; bf16* proj; float* small; bf16* mixed; bf16* oa; float* la; float* ob; float* lb; float* cl; float* bt;
    float* ds; bf16* st; float* dec;
    unsigned char* lds; int tid, lane, wave, G, bid;
};

__device__ __forceinline__ int orig_col(int np) { if (np < 5120) return np; if (np < 7424) return np + 8; if (np < 7432) return 5120 + (np - 7424); if (np < 7448) return np; return -1; }
__device__ __forceinline__ void p0_load(const float* W, int N, const float* g, int mode, int kb, int nb, int lane, f32x4 (&v)[8], float (&gs)[8]) {
    const int k0 = 64 * kb, np = 32 * nb + 4 * (lane & 7);
    const int oc = mode ? orig_col(np) : np;
#pragma unroll
    for (int i = 0; i < 8; ++i) { const int kk = 8 * i + (lane >> 3); v[i] = (f32x4){0.f, 0.f, 0.f, 0.f}; gs[i] = 1.0f;
        if (oc >= 0) { v[i] = *(const f32x4*)(W + (size_t)(k0 + kk) * N + oc); if (mode) gs[i] = g[k0 + kk]; } }
}
__device__ __forceinline__ void p0_finish(bf16* WT, int mode, int kb, int nb, int lane, float* scr, const f32x4 (&v)[8], const float (&gs)[8]) {
    const int k0 = 64 * kb, n0 = 32 * nb, c4 = 4 * (lane & 7), np = n0 + c4;
    const float cs = (mode && np >= C_CQ && np < C_CK) ? 0.10206207261596577f : 1.0f;
#pragma unroll
    for (int i = 0; i < 8; ++i) { const int kk = 8 * i + (lane >> 3); float* d = scr + kk * 33 + c4; const float sc = cs * gs[i]; d[0] = v[i].x * sc; d[1] = v[i].y * sc; d[2] = v[i].z * sc; d[3] = v[i].w * sc; }
    asm volatile("s_waitcnt lgkmcnt(0)" ::: "memory");
    const int c = lane & 7;
#pragma unroll
    for (int j = 0; j < 4; ++j) { const int n = (lane >> 3) + 8 * j; const float* s = scr + (8 * c) * 33 + n;
        u32x4 o; o.x = pk2(s[0 * 33], s[1 * 33]); o.y = pk2(s[2 * 33], s[3 * 33]); o.z = pk2(s[4 * 33], s[5 * 33]); o.w = pk2(s[6 * 33], s[7 * 33]);
        *(u32x4*)(WT + (size_t)(n0 + n) * 2048 + k0 + 8 * c) = o; }
    asm volatile("s_waitcnt lgkmcnt(0)" ::: "memory");
}
__device__ __forceinline__ void phase0(Ctx& F) {
    float* scr = (float*)(F.lds + F.wave * 16384);
    const int gw = F.bid * 8 + F.wave, NGW = F.G * 8;
    if (F.bid == 0 && F.tid < 64) F.ctl[F.tid] = 0u;
    for (int i = F.bid * 512 + F.tid; i < 3 * SEQ; i += F.G * 512) F.ss[SEQ + i] = 0ull;
    constexpr int I_IN = 32 * 233, I_OUT = 32 * 64, I_L = I_IN + I_OUT, I_ALL = NLAYER * I_L;
#define P0_DECODE(it_, W_, N_, WT_, g_, mode_, kb_, nb_) do { const int l_ = (it_) / I_L; int r_ = (it_) % I_L; \
        if (r_ < I_IN) { W_ = F.w_in + (size_t)l_ * DM * INW; N_ = INW; WT_ = F.wtin + (size_t)l_ * NPAD * DM; g_ = F.norm_g + l_ * DM; mode_ = 1; kb_ = r_ / 233; nb_ = r_ % 233; } \
        else { r_ -= I_IN; W_ = F.w_out + (size_t)l_ * DM * DM; N_ = DM; WT_ = F.wtout + (size_t)l_ * DM * DM; g_ = F.norm_g; mode_ = 0; kb_ = r_ / 64; nb_ = r_ % 64; } } while (0)
    { f32x4 va[8], vb[8]; float ga[8], gb[8];
      const float* W = nullptr; const float* g = nullptr; bf16* WT = nullptr; int N = 0, mode = 0, kb = 0, nb = 0;
      int it = gw;
      if (it < I_ALL) { P0_DECODE(it, W, N, WT, g, mode, kb, nb); p0_load(W, N, g, mode, kb, nb, F.lane, va, ga); }
      while (it < I_ALL) { const int nit = it + NGW;
          const float* W2 = nullptr; const float* g2 = nullptr; bf16* WT2 = nullptr; int N2 = 0, mode2 = 0, kb2 = 0, nb2 = 0;
          if (nit < I_ALL) { P0_DECODE(nit, W2, N2, WT2, g2, mode2, kb2, nb2); p0_load(W2, N2, g2, mode2, kb2, nb2, F.lane, vb, gb); }
          p0_finish(WT, mode, kb, nb, F.lane, scr, va, ga);
#pragma unroll
          for (int i = 0; i < 8; ++i) { va[i] = vb[i]; ga[i] = gb[i]; }
          it = nit; WT = WT2; mode = mode2; kb = kb2; nb = nb2; } }
#undef P0_DECODE
    for (int m = gw; m < SEQ; m += NGW) {
        const f32x4* xr = (const f32x4*)(F.x + (size_t)m * DM) + F.lane; float s = 0.f; u32x2* o8 = (u32x2*)(F.xb + (size_t)m * DM) + F.lane;
#pragma unroll
        for (int j = 0; j < 8; ++j) { const f32x4 v = xr[64 * j]; s += (v.x * v.x + v.y * v.y) + (v.z * v.z + v.w * v.w); u32x2 w; w.x = pk2(v.x, v.y); w.y = pk2(v.z, v.w); o8[64 * j] = w; }
#pragma unroll
        for (int o = 1; o < 64; o <<= 1) s += __shfl_xor(s, o);
        if (F.lane == 0) F.ss[m] = (unsigned long long)(s * 1048576.0f + 0.5f);
    }
}

__device__ __forceinline__ void phase2(Ctx& F, int l) {
    { const int gw = F.bid * 8 + F.wave, NGW = F.G * 8;
      for (int wi = gw; wi < 512; wi += NGW) { const int blk = wi >> 3, h = wi & 7, t = blk * 128 + 2 * F.lane; const float fb = F.fox_bias[l * 8 + h];
        const float l0 = logsig(F.small[(size_t)t * 32 + h] + fb), l1 = logsig(F.small[(size_t)(t + 1) * 32 + h] + fb);
        float s = l0 + l1;
#pragma unroll
        for (int o = 1; o < 64; o <<= 1) { const float y = __shfl_up(s, o); if (F.lane >= o) s += y; }
        const float ex = s - (l0 + l1); F.cl[t * 8 + h] = ex + l0; F.cl[(t + 1) * 8 + h] = s; if (F.lane == 63) F.bt[blk * 8 + h] = s; } }
    { float* CR = (float*)F.lds;
      float* GT = (float*)(F.lds + 4096);
      unsigned char* KH = F.lds + 8192;
      unsigned char* VV = F.lds + 8192 + 13312;
      const float* gup = F.gate_up + (size_t)l * 16 * 384; const float* gbs = F.gate_bias + l * 384;
      for (int u = F.bid; u < 512; u += F.G) { const int h = u & 3, n = u >> 2, t0 = n * 64;
        if (F.tid < 256) *(f32x4*)(CR + F.tid * 4) = *(const f32x4*)(F.small + (size_t)(t0 + (F.tid >> 2)) * 32 + 8 + 4 * (F.tid & 3));
        { u32x4 vv[3];
#pragma unroll
          for (int i = 0; i < 3; ++i) { const int e = F.tid + 512 * i, row = e / 24, ch = e % 24; vv[i] = *(const u32x4*)(F.proj + (size_t)(t0 + row) * PW + C_CV + h * 192 + ch * 8); }
          asm volatile("" : "+v"(vv[0]), "+v"(vv[1]), "+v"(vv[2]));
#pragma unroll
          for (int i = 0; i < 3; ++i) { const int e = F.tid + 512 * i, row = e / 24, ch = e % 24; *(u32x4*)(VV + row * 400 + ch * 16) = vv[i]; } }
        __syncthreads();
        const int d = F.tid % 96, tg = F.tid / 96;
        float bc[16];
        if (F.tid < 384) { float g[16];
#pragma unroll
            for (int r = 0; r < 16; ++r) g[r] = gup[r * 384 + h * 96 + d];
            const float gb = gbs[h * 96 + d]; float run = 0.f;
#pragma unroll
            for (int i = 0; i < 16; ++i) { const float* cr = CR + (16 * tg + i) * 16; float a = gb;
#pragma unroll
                for (int r4 = 0; r4 < 4; ++r4) { const f32x4 c = *(const f32x4*)(cr + 4 * r4); a += c.x * g[4 * r4] + c.y * g[4 * r4 + 1] + c.z * g[4 * r4 + 2] + c.w * g[4 * r4 + 3]; }
                const float ls = fminf(a, 0.f) - __logf(1.f + __expf(-fabsf(a)));
                run += ls * (1.f / 16.f); bc[i] = run; }
            GT[tg * 96 + d] = run; }
        __syncthreads();
        if (F.tid < 384) { const float g0 = GT[d], g1 = GT[96 + d], g2 = GT[192 + d], g3 = GT[288 + d];
            const float pre = (tg > 0 ? g0 : 0.f) + (tg > 1 ? g1 : 0.f) + (tg > 2 ? g2 : 0.f);
            const float bm = g0 + g1, bl = (g0 + g1) + (g2 + g3);
            bf16* qp = F.proj + (size_t)(t0 + 16 * tg) * PW + C_CQ + h * 96 + d; bf16* kp = F.proj + (size_t)(t0 + 16 * tg) * PW + C_CK + h * 96 + d;
            float qv[16], kv[16]; unsigned qr[16], kr[16];
#pragma unroll
            for (int i = 0; i < 16; ++i) { qr[i] = qp[(size_t)i * PW]; kr[i] = kp[(size_t)i * PW]; }
#pragma unroll
            for (int i = 0; i < 16; i += 4) { asm volatile("" : "+v"(qr[i]), "+v"(qr[i + 1]), "+v"(qr[i + 2]), "+v"(qr[i + 3])); asm volatile("" : "+v"(kr[i]), "+v"(kr[i + 1]), "+v"(kr[i + 2]), "+v"(kr[i + 3])); }
#pragma unroll
            for (int i = 0; i < 16; ++i) { qv[i] = bf2f(qr[i]); kv[i] = bf2f(kr[i]); }
#pragma unroll
            for (int i = 0; i < 16; ++i) { const float b = bc[i] + pre; const float eq = __expf(b - bm), ek = __expf(bm - b), eh = __expf(bl - b);
                qp[(size_t)i * PW] = (bf16)(pk2(qv[i] * eq, 0.f) & 0xffffu); kp[(size_t)i * PW] = (bf16)(pk2(kv[i] * ek, 0.f) & 0xffffu);
                *(bf16*)(KH + (16 * tg + i) * 208 + d * 2) = (bf16)(pk2(kv[i] * eh, 0.f) & 0xffffu); }
            if (tg == 0) { F.dec[(n * 4 + h) * 96 + d] = __expf(bl); F.dec[49152 + (n * 4 + h) * 96 + d] = __expf(bm); } }
        __syncthreads();
        for (int id = F.wave; id < 18; id += 8) { const int vt = id / 3, dt = id % 3; f32x16 acc = {};
#pragma unroll
            for (int s = 0; s < 4; ++s) { const bf16x8 a = frag_tr((lds_cptr)VV, 400, 16 * s, 32 * vt, F.lane), b = frag_tr((lds_cptr)KH, 208, 16 * s, 32 * dt, F.lane); acc = MFMA32(a, b, acc); }
            float* dst = F.ds + ((size_t)(n * 4 + h) * 192 + 32 * vt) * 96 + 32 * dt + (F.lane & 31);
#pragma unroll
            for (int r = 0; r < 16; ++r) dst[(size_t)rowidx(r, F.lane >> 5) * 96] = acc[r]; }
        __syncthreads(); } }
}
__device__ __forceinline__ float softmax_ref2(const float* gq, const float* gk) {
    float mq = 0.f, mk = 0.f;
    for (int i = 0; i < 64; ++i) { mq = fmaxf(mq, fabsf(gq[i])); mk = fmaxf(mk, fabsf(gk[i])); }
    return 8.25f * mq * mk * LOG2E;
}
__device__ __forceinline__ void scan_item(Ctx& F, int si) {
    const int p = si * 512 + F.tid, d = 2 * (p % 48), v = (p / 48) % 192, h = p / (48 * 192);
    float s0 = 0.f, s1 = 0.f;
    for (int nb = 0; nb < 128; nb += 8) { f32x2 dd[8], a[8], em[8];
#pragma unroll
        for (int j = 0; j < 8; ++j) { const int n = nb + j; const size_t idx = ((size_t)(n * 4 + h) * 192 + v) * 96 + d; const int di = (n * 4 + h) * 96 + d;
            dd[j] = *(const f32x2*)(F.ds + idx); a[j] = *(const f32x2*)(F.dec + di); em[j] = *(const f32x2*)(F.dec + 49152 + di); }
#pragma unroll
        for (int j = 0; j < 8; j += 4) { asm volatile("" : "+v"(dd[j]), "+v"(dd[j + 1]), "+v"(dd[j + 2]), "+v"(dd[j + 3])); asm volatile("" : "+v"(a[j]), "+v"(a[j + 1]), "+v"(a[j + 2]), "+v"(a[j + 3])); asm volatile("" : "+v"(em[j]), "+v"(em[j + 1]), "+v"(em[j + 2]), "+v"(em[j + 3])); }
#pragma unroll
        for (int j = 0; j < 8; ++j) { const int n = nb + j; const size_t idx = ((size_t)(n * 4 + h) * 192 + v) * 96 + d;
            *(unsigned*)(F.st + idx) = pk2(em[j].x * s0, em[j].y * s1);
            s0 = a[j].x * s0 + dd[j].x; s1 = a[j].y * s1 + dd[j].y; } }
}
#define PIN4(a, b, c, d) asm volatile("" : "+v"(a), "+v"(b), "+v"(c), "+v"(d))
#define SBAR0() __builtin_amdgcn_sched_barrier(0)
template <int KSTR, int VSTR>
__device__ __forceinline__ void attn_sub(const unsigned char* Kt, const unsigned char* Vt, int key_row0, const bf16x8 (&qf)[4], f32x16 S, f32x16 (&o)[2], float& lsum, int lane,
                                         bool use_mask, int lo, int hi_) {
    const int r = lane & 31, hh = lane >> 5;
    bf16x8 kf[4];
#pragma unroll
    for (int s = 0; s < 4; ++s) kf[s] = *(const bf16x8*)(Kt + (key_row0 + r) * KSTR + (16 * s + 8 * hh) * 2);
    bf16x8 vf[2][2];
#pragma unroll
    for (int dt = 0; dt < 2; ++dt) { vf[dt][0] = frag_tr((lds_cptr)Vt, VSTR, key_row0, 32 * dt, lane); vf[dt][1] = frag_tr((lds_cptr)Vt, VSTR, key_row0 + 16, 32 * dt, lane); }
    PIN4(kf[0], kf[1], kf[2], kf[3]);
#pragma unroll
    for (int s = 0; s < 4; ++s) S = MFMA32(kf[s], qf[s], S);
    if (use_mask) {
#pragma unroll
        for (int g = 0; g < 16; ++g) { const int k = rowidx(g, hh); if (k < lo || k > hi_) S[g] = -INFINITY; } }
    float acc = 0.f;
#pragma unroll
    for (int g = 0; g < 16; ++g) { S[g] = __builtin_amdgcn_exp2f(S[g]); acc += S[g]; }
    lsum += acc;
    bf16x8 p0, p1; pack_p(S, p0, p1);
    PIN4(vf[0][0], vf[0][1], vf[1][0], vf[1][1]);
#pragma unroll
    for (int dt = 0; dt < 2; ++dt) { o[dt] = MFMA32(vf[dt][0], p0, o[dt]); o[dt] = MFMA32(vf[dt][1], p1, o[dt]); }
}
template <int NSUB, int KSTR, int VSTR>
__device__ __forceinline__ void attn_multi(const unsigned char* Kt, const unsigned char* Vt, int key_row0, const bf16x8 (&qf)[4], f32x16 (&S)[NSUB], f32x16 (&o)[2], float& lsum, int lane) {
    const int r = lane & 31, hh = lane >> 5;
    bf16x8 kf[NSUB][4];
#pragma unroll
    for (int u = 0; u < NSUB; ++u)
#pragma unroll
        for (int s = 0; s < 4; ++s) kf[u][s] = *(const bf16x8*)(Kt + (key_row0 + 32 * u + r) * KSTR + (16 * s + 8 * hh) * 2);
#pragma unroll
    for (int u = 0; u < NSUB; ++u) PIN4(kf[u][0], kf[u][1], kf[u][2], kf[u][3]);
#pragma unroll
    for (int s = 0; s < 4; ++s)
#pragma unroll
        for (int u = 0; u < NSUB; ++u) S[u] = MFMA32(kf[u][s], qf[s], S[u]);
#pragma unroll
    for (int u = 0; u < NSUB; ++u) {
        bf16x8 vf[2][2];
#pragma unroll
        for (int dt = 0; dt < 2; ++dt) { vf[dt][0] = frag_tr((lds_cptr)Vt, VSTR, key_row0 + 32 * u, 32 * dt, lane); vf[dt][1] = frag_tr((lds_cptr)Vt, VSTR, key_row0 + 32 * u + 16, 32 * dt, lane); }
        SBAR0();
        float acc = 0.f;
#pragma unroll
        for (int g = 0; g < 16; ++g) { S[u][g] = __builtin_amdgcn_exp2f(S[u][g]); acc += S[u][g]; }
        lsum += acc;
        bf16x8 p0, p1; pack_p(S[u], p0, p1);
        PIN4(vf[0][0], vf[0][1], vf[1][0], vf[1][1]);
#pragma unroll
        for (int dt = 0; dt < 2; ++dt) { o[dt] = MFMA32(vf[dt][0], p0, o[dt]); o[dt] = MFMA32(vf[dt][1], p1, o[dt]); } }
}
__device__ __forceinline__ void fox_unit(Ctx& F, int l, int h, int qb, int seg) {
    constexpr int KS = 144, VS = 192, BUFB = 128 * KS, BUFV = 128 * VS;
    unsigned char* KT = F.lds; unsigned char* VT = F.lds + 2 * BUFB; float* CS = (float*)(F.lds + 2 * BUFB + 2 * BUFV);
    const float* PEX = (const float*)(F.lds + P3_EXT) + h * 64;
    const int r = F.lane & 31, hh = F.lane >> 5, w = F.wave, t0 = 256 * qb, NT = 2 * qb + 2;
    const int kfirst = __builtin_amdgcn_readfirstlane(((const int*)(F.lds + P3_EXT + 2048))[h * 32 + qb]);
    const int nuse = (NT - kfirst + 15) >> 4;
    if (seg >= nuse) return;
    const int kt0 = kfirst + 16 * seg, te = (kt0 + 16 < NT) ? kt0 + 16 : NT;
    const float mb2 = ((const float*)(F.lds + P3_EXT + 3072))[1];
    const int tq = t0 + 32 * w + r; const float pq0 = PEX[t0 >> 7];
    const float ctq = ((PEX[tq >> 7] - pq0) + F.cl[tq * 8 + h]) * LOG2E - mb2;
    bf16x8 qf[4];
#pragma unroll
    for (int s = 0; s < 4; ++s) qf[s] = *(const bf16x8*)(F.proj + (size_t)tq * PW + C_BQ + h * 64 + 16 * s + 8 * hh);
    f32x16 o[2]; o[0] = f32x16{}; o[1] = f32x16{}; float lsum = 0.f;
    const int lrow = F.tid >> 3, lch = F.tid & 7;
    u32x4 kreg[2], vreg[2]; float creg = 0.f;
    if (kt0 < te) {
#pragma unroll
        for (int i = 0; i < 2; ++i) { const size_t g = (size_t)(128 * kt0 + 64 * i + lrow) * PW + h * 64 + lch * 8; kreg[i] = *(const u32x4*)(F.proj + g + C_BK); vreg[i] = *(const u32x4*)(F.proj + g + C_BV); }
        if (F.tid < 128) creg = ((PEX[kt0] - pq0) + F.cl[(128 * kt0 + F.tid) * 8 + h]) * LOG2E; }
    for (int kt = kt0; kt < te; ++kt) { const int buf = (kt - kt0) & 1;
#pragma unroll
        for (int i = 0; i < 2; ++i) { *(u32x4*)(KT + buf * BUFB + (64 * i + lrow) * KS + lch * 16) = kreg[i]; *(u32x4*)(VT + buf * BUFV + (64 * i + lrow) * VS + lch * 16) = vreg[i]; }
        if (F.tid < 128) CS[buf * 128 + F.tid] = creg;
        __syncthreads();
        if (kt + 1 < te) {
#pragma unroll
            for (int i = 0; i < 2; ++i) { const size_t g = (size_t)(128 * (kt + 1) + 64 * i + lrow) * PW + h * 64 + lch * 8; kreg[i] = *(const u32x4*)(F.proj + g + C_BK); vreg[i] = *(const u32x4*)(F.proj + g + C_BV); }
            if (F.tid < 128) creg = ((PEX[kt + 1] - pq0) + F.cl[(128 * (kt + 1) + F.tid) * 8 + h]) * LOG2E; }
        const unsigned char* Kb = KT + buf * BUFB; const unsigned char* Vb = VT + buf * BUFV; const float* Cb = CS + buf * 128;
        if (kt < 2 * qb) {
#pragma unroll
            for (int hf = 0; hf < 2; ++hf) { f32x16 S[2]; f32x4 c4[2][4];
#pragma unroll
                for (int u = 0; u < 2; ++u)
#pragma unroll
                    for (int i = 0; i < 4; ++i) c4[u][i] = *(const f32x4*)(Cb + 64 * hf + 32 * u + 8 * i + 4 * hh);
                PIN4(c4[0][0], c4[0][1], c4[0][2], c4[0][3]); PIN4(c4[1][0], c4[1][1], c4[1][2], c4[1][3]);
#pragma unroll
                for (int u = 0; u < 2; ++u)
#pragma unroll
                    for (int i = 0; i < 4; ++i) { S[u][4 * i] = ctq - c4[u][i].x; S[u][4 * i + 1] = ctq - c4[u][i].y; S[u][4 * i + 2] = ctq - c4[u][i].z; S[u][4 * i + 3] = ctq - c4[u][i].w; }
                attn_multi<2, KS, VS>(Kb, Vb, 64 * hf, qf, S, o, lsum, F.lane); }
        } else {
            const int qlo = t0 + 32 * w;
#pragma unroll
            for (int sub = 0; sub < 4; ++sub) { const int key0 = 128 * kt + 32 * sub;
                if (key0 <= qlo + 31) {
                    f32x16 S;
#pragma unroll
                    for (int i = 0; i < 4; ++i) { const f32x4 c4 = *(const f32x4*)(Cb + 32 * sub + 8 * i + 4 * hh); S[4 * i] = ctq - c4.x; S[4 * i + 1] = ctq - c4.y; S[4 * i + 2] = ctq - c4.z; S[4 * i + 3] = ctq - c4.w; }
                    attn_sub<KS, VS>(Kb, Vb, 32 * sub, qf, S, o, lsum, F.lane, key0 + 31 > qlo, 0, tq - key0); } }
        }
    }
    lsum += __shfl_xor(lsum, 32);
    float* ob = F.ob + ((size_t)seg * SEQ + tq) * 512 + h * 64 + 4 * hh;
#pragma unroll
    for (int dt = 0; dt < 2; ++dt)
#pragma unroll
        for (int i = 0; i < 4; ++i) *(f32x4*)(ob + 32 * dt + 8 * i) = (f32x4){o[dt][4 * i], o[dt][4 * i + 1], o[dt][4 * i + 2], o[dt][4 * i + 3]};
    if (hh == 0) F.lb[((size_t)seg * SEQ + tq) * 8 + h] = lsum;
    __syncthreads();
}
__device__ __forceinline__ void a_unit(Ctx& F, int l, int a, int n, int rres, int b2) {
    constexpr int KS = 144, VS = 192;
    unsigned char* KA = F.lds; unsigned char* VA = F.lds + 384 * KS;
    const int r = F.lane & 31, hh = F.lane >> 5, w = F.wave, d = (n == 0) ? 1 : (n == 1) ? 4 : 16, i0 = 256 * b2;
    { u32x4 kv[6], vv[6]; const int ch = F.tid & 7;
#pragma unroll
      for (int i = 0; i < 6; ++i) { const int j = (F.tid >> 3) + 64 * i, idx = i0 - 128 + j; kv[i] = (u32x4){0u, 0u, 0u, 0u}; vv[i] = (u32x4){0u, 0u, 0u, 0u};
          if (idx >= 0) { const size_t g = (size_t)(rres + d * idx) * PW + a * 64 + ch * 8; kv[i] = *(const u32x4*)(F.proj + g + C_AK); vv[i] = *(const u32x4*)(F.proj + g + C_AV); } }
      asm volatile("" : "+v"(kv[0]), "+v"(kv[1]), "+v"(kv[2]), "+v"(kv[3]), "+v"(kv[4]), "+v"(kv[5]));
      asm volatile("" : "+v"(vv[0]), "+v"(vv[1]), "+v"(vv[2]), "+v"(vv[3]), "+v"(vv[4]), "+v"(vv[5]));
#pragma unroll
      for (int i = 0; i < 6; ++i) { const int j = (F.tid >> 3) + 64 * i; *(u32x4*)(KA + j * KS + ch * 16) = kv[i]; *(u32x4*)(VA + j * VS + ch * 16) = vv[i]; } }
    const int tokq = rres + d * (i0 + 32 * w + r);
    bf16x8 qf[4];
#pragma unroll
    for (int s = 0; s < 4; ++s) qf[s] = *(const bf16x8*)(F.proj + (size_t)tokq * PW + C_AQ + a * 64 + 16 * s + 8 * hh);
    const float mb2 = ((const float*)(F.lds + P3_EXT + 3072))[0];
    __syncthreads();
    f32x16 o[2]; o[0] = f32x16{}; o[1] = f32x16{}; float lsum = 0.f;
    const int qj = 32 * w + r + 128;
    if (i0 != 0) {
        { f32x16 S;
#pragma unroll
          for (int g = 0; g < 16; ++g) S[g] = -mb2;
          attn_sub<KS, VS>(KA, VA, 32 * w, qf, S, o, lsum, F.lane, true, qj - 128 - 32 * w, 31); }
        { f32x16 S[3];
#pragma unroll
          for (int u = 0; u < 3; ++u)
#pragma unroll
              for (int g = 0; g < 16; ++g) S[u][g] = -mb2;
          attn_multi<3, KS, VS>(KA, VA, 32 * (w + 1), qf, S, o, lsum, F.lane); }
        { f32x16 S;
#pragma unroll
          for (int g = 0; g < 16; ++g) S[g] = -mb2;
          attn_sub<KS, VS>(KA, VA, 32 * (w + 4), qf, S, o, lsum, F.lane, true, 0, qj - 32 * (w + 4)); }
    } else
    for (int jt = w; jt < w + 5; ++jt) { const int j0 = 32 * jt;
        if (j0 + 31 < 128) continue;
        f32x16 S;
#pragma unroll
        for (int g = 0; g < 16; ++g) S[g] = -mb2;
        int lo = qj - 128 - j0; const int hi_ = qj - j0; if (128 - j0 > lo) lo = 128 - j0;
        attn_sub<KS, VS>(KA, VA, j0, qf, S, o, lsum, F.lane, true, lo, hi_); }
    lsum += __shfl_xor(lsum, 32);
    bf16* oa = F.oa + ((size_t)n * SEQ + tokq) * 768 + a * 64 + 4 * hh;
#pragma unroll
    for (int dt = 0; dt < 2; ++dt)
#pragma unroll
        for (int i = 0; i < 4; ++i) { u32x2 wv; wv.x = pk2(o[dt][4 * i], o[dt][4 * i + 1]); wv.y = pk2(o[dt][4 * i + 2], o[dt][4 * i + 3]); *(u32x2*)(oa + 32 * dt + 8 * i) = wv; }
    if (hh == 0) F.la[((size_t)n * SEQ + tokq) * 12 + a] = lsum;
    __syncthreads();
}
__device__ __forceinline__ void phase3(Ctx& F, int l) {
    volatile unsigned* slot = (volatile unsigned*)(F.lds + QSLOT_OFF);
    { float* PEXA = (float*)(F.lds + P3_EXT); int* KFT = (int*)(F.lds + P3_EXT + 2048); float* MB = (float*)(F.lds + P3_EXT + 3072);
      { const float v = F.bt[F.lane * 8 + F.wave]; float sc = v;
#pragma unroll
        for (int o = 1; o < 64; o <<= 1) { const float y = __shfl_up(sc, o); if (F.lane >= o) sc += y; }
        PEXA[F.wave * 64 + F.lane] = sc - v; }
      if (F.tid == 0) { MB[0] = softmax_ref2(F.aqg + l * 64, F.akg + l * 64); MB[1] = softmax_ref2(F.bqg + l * 64, F.bkg + l * 64); }
      __syncthreads();
      if (F.tid < 256) { const int h = F.tid >> 5, qb = F.tid & 31; const float thr = -(26.f + 2.f * MB[1] * (1.f / LOG2E)), pq0 = PEXA[h * 64 + 2 * qb];
          int kt = 0; while (kt < 2 * qb && (pq0 - PEXA[h * 64 + kt + 1]) < thr) ++kt;
          KFT[F.tid] = kt; if (F.bid == 0) F.ctl[8192 + F.tid] = (unsigned)kt; }
      __syncthreads(); }
    for (;;) {
        if (F.tid == 0) *slot = atomicAdd(F.ctl + l, 1u);
        __syncthreads();
        const int item = __builtin_amdgcn_readfirstlane((int)*slot);
        __syncthreads();
        if (item >= N_ITEMS) break;
        if (item < N_SCAN) scan_item(F, item);
        else if (item < N_SCAN + N_FOX) { int f = item - N_SCAN, ns, qhi;
            if (f < 256) { ns = 4; qhi = 31; } else if (f < 448) { f -= 256; ns = 3; qhi = 23; } else if (f < 576) { f -= 448; ns = 2; qhi = 15; } else { f -= 576; ns = 1; qhi = 7; }
            const int per = ns * 8, qb = qhi - f / per, rem = f % per;
            fox_unit(F, l, rem & 7, qb, rem >> 3); }
        else { const int au = item - N_SCAN - N_FOX, n = au / 384, rest = au % 384, a = rest >> 5, u = rest & 31;
            const int per = (n == 0) ? 32 : (n == 1) ? 8 : 2;
            a_unit(F, l, a, n, u / per, u % per); }
    }
}
#define PIN6(a) asm volatile("" : "+v"(a[0]), "+v"(a[1]), "+v"(a[2]), "+v"(a[3]), "+v"(a[4]), "+v"(a[5]))
__device__ __forceinline__ void phase4(Ctx& F, int l) {
    unsigned char* VV = F.lds;
    float* SSQ = (float*)(F.lds + 51200);
    const int r = F.lane & 31, hh = F.lane >> 5, w = F.wave, ui = w >> 2, th = (w >> 1) & 1, vh = w & 1;
    const float* gain = F.out_gain + l * 192;
    for (int pu = F.bid; pu < 256; pu += F.G) {
        const int u = 2 * pu + ui, h = u & 3, n = u >> 2, t0 = n * 64, tq = th * 32 + r;
        bf16x8 qf[6], kf0[6], kf1[6], sfa[6], sfb[6];
        const bf16* stb = F.st + ((size_t)(n * 4 + h) * 192 + 32 * (vh * 3) + r) * 96 + 8 * hh;
#pragma unroll
        for (int kd = 0; kd < 6; ++kd) { qf[kd] = *(const bf16x8*)(F.proj + (size_t)(t0 + tq) * PW + C_CQ + h * 96 + 16 * kd + 8 * hh);
            kf0[kd] = *(const bf16x8*)(F.proj + (size_t)(t0 + r) * PW + C_CK + h * 96 + 16 * kd + 8 * hh);
            kf1[kd] = *(const bf16x8*)(F.proj + (size_t)(t0 + 32 + r) * PW + C_CK + h * 96 + 16 * kd + 8 * hh);
            sfa[kd] = *(const bf16x8*)(stb + 16 * kd); }
        { u32x4 vv[6];
#pragma unroll
          for (int i = 0; i < 6; ++i) { const int e = F.tid + 512 * i, uu = e / 1536, e2 = e % 1536, row = e2 / 24, ch = e2 % 24, u2 = 2 * pu + uu, h2 = u2 & 3, n2 = u2 >> 2;
              vv[i] = *(const u32x4*)(F.proj + (size_t)(n2 * 64 + row) * PW + C_CV + h2 * 192 + ch * 8); }
          asm volatile("" : "+v"(vv[0]), "+v"(vv[1]), "+v"(vv[2]), "+v"(vv[3]), "+v"(vv[4]), "+v"(vv[5]));
#pragma unroll
          for (int i = 0; i < 6; ++i) { const int e = F.tid + 512 * i, uu = e / 1536, e2 = e % 1536, row = e2 / 24, ch = e2 % 24; *(u32x4*)(VV + uu * 25600 + row * 400 + ch * 16) = vv[i]; } }
        __syncthreads();
        PIN6(qf); PIN6(kf0); PIN6(kf1);
        bf16x8 pf[2][2];
        { f32x16 X = {};
#pragma unroll
          for (int kd = 0; kd < 6; ++kd) X = MFMA32(kf0[kd], qf[kd], X);
          if (th == 0) {
#pragma unroll
              for (int g = 0; g < 16; ++g) if (rowidx(g, hh) > r) X[g] = 0.f; }
          pack_p(X, pf[0][0], pf[0][1]); }
        if (th == 1) { f32x16 X = {};
#pragma unroll
          for (int kd = 0; kd < 6; ++kd) X = MFMA32(kf1[kd], qf[kd], X);
#pragma unroll
          for (int g = 0; g < 16; ++g) if (rowidx(g, hh) > r) X[g] = 0.f;
          pack_p(X, pf[1][0], pf[1][1]); }
        f32x16 O[3]; float sq = 0.f;
#pragma unroll
        for (int vt = 0; vt < 3; ++vt) { const int vtile = vh * 3 + vt; f32x16 acc = {};
            if (vt == 0) {
#pragma unroll
                for (int kd = 0; kd < 6; ++kd) sfb[kd] = *(const bf16x8*)(stb + (size_t)32 * 96 + 16 * kd); }
            if (vt == 1) {
#pragma unroll
                for (int kd = 0; kd < 6; ++kd) sfa[kd] = *(const bf16x8*)(stb + (size_t)64 * 96 + 16 * kd); }
#pragma unroll
            for (int si = 0; si < 2; ++si) if (si <= th) {
#pragma unroll
                for (int s2 = 0; s2 < 2; ++s2) { const bf16x8 vf = frag_tr((lds_cptr)(VV + ui * 25600), 400, 32 * si + 16 * s2, 32 * vtile, F.lane); acc = MFMA32(vf, pf[si][s2], acc); } }
            if (vt == 1) { PIN6(sfb);
#pragma unroll
                for (int kd = 0; kd < 6; ++kd) acc = MFMA32(sfb[kd], qf[kd], acc); }
            else { PIN6(sfa);
#pragma unroll
                for (int kd = 0; kd < 6; ++kd) acc = MFMA32(sfa[kd], qf[kd], acc); }
#pragma unroll
            for (int g = 0; g < 16; ++g) sq += acc[g] * acc[g];
            O[vt] = acc; }
        u32x2 zw[3][4]; f32x4 gg[3][4];
#pragma unroll
        for (int vt = 0; vt < 3; ++vt)
#pragma unroll
            for (int i = 0; i < 4; ++i) { const int v = 32 * (vh * 3 + vt) + 8 * i + 4 * hh;
                zw[vt][i] = *(const u32x2*)(F.proj + (size_t)(t0 + tq) * PW + C_CZ + h * 192 + v); gg[vt][i] = *(const f32x4*)(gain + v); }
        sq += __shfl_xor(sq, 32);
        if (hh == 0) SSQ[(ui * 2 + vh) * 64 + tq] = sq;
        __syncthreads();
        const float rs = rsqrtf((SSQ[(ui * 2) * 64 + tq] + SSQ[(ui * 2 + 1) * 64 + tq]) * (1.f / 192.f) + EPS);
#pragma unroll
        for (int vt = 0; vt < 3; ++vt) { PIN4(zw[vt][0], zw[vt][1], zw[vt][2], zw[vt][3]);
#pragma unroll
            for (int i = 0; i < 4; ++i) { const int v = 32 * (vh * 3 + vt) + 8 * i + 4 * hh; const u32x2 z = zw[vt][i]; const f32x4 g4 = gg[vt][i];
                const float y0 = O[vt][4 * i] * rs * g4.x * silu(blo(z.x)), y1 = O[vt][4 * i + 1] * rs * g4.y * silu(bhi(z.x)), y2 = O[vt][4 * i + 2] * rs * g4.z * silu(blo(z.y)), y3 = O[vt][4 * i + 3] * rs * g4.w * silu(bhi(z.y));
                u32x2 ov; ov.x = pk2(y0, y1); ov.y = pk2(y2, y3); *(u32x2*)(F.mixed + (size_t)(t0 + tq) * DM + 1280 + h * 192 + v) = ov; } }
        __syncthreads();
    }
    const int NT = F.G * 512, gt = F.bid * 512 + F.tid;
    for (int idx0 = gt; idx0 < SEQ * 96; idx0 += 2 * NT) {
        u32x4 wv[2][3], zw[2]; float la[2][3]; int tt[2], cc[2]; bool ok[2];
#pragma unroll
        for (int j = 0; j < 2; ++j) { const int idx = idx0 + j * NT; ok[j] = idx < SEQ * 96; const int id2 = ok[j] ? idx : gt; const int t = id2 / 96, c = (id2 % 96) * 8, a = c >> 6; tt[j] = t; cc[j] = c;
#pragma unroll
            for (int n = 0; n < 3; ++n) { wv[j][n] = *(const u32x4*)(F.oa + ((size_t)n * SEQ + t) * 768 + c); la[j][n] = F.la[((size_t)n * SEQ + t) * 12 + a]; }
            zw[j] = *(const u32x4*)(F.proj + (size_t)t * PW + C_AZ + c); }
        PIN4(wv[0][0], wv[0][1], wv[0][2], zw[0]); PIN4(wv[1][0], wv[1][1], wv[1][2], zw[1]);
#pragma unroll
        for (int j = 0; j < 2; ++j) { float o[8] = {0.f, 0.f, 0.f, 0.f, 0.f, 0.f, 0.f, 0.f};
#pragma unroll
            for (int n = 0; n < 3; ++n) { const u32x4 x = wv[j][n]; o[0] += blo(x.x); o[1] += bhi(x.x); o[2] += blo(x.y); o[3] += bhi(x.y); o[4] += blo(x.z); o[5] += bhi(x.z); o[6] += blo(x.w); o[7] += bhi(x.w); }
            const float il = 1.f / ((la[j][0] + la[j][1]) + la[j][2]); const u32x4 z = zw[j];
            u32x4 ov; ov.x = pk2(o[0] * il * silu(blo(z.x)), o[1] * il * silu(bhi(z.x))); ov.y = pk2(o[2] * il * silu(blo(z.y)), o[3] * il * silu(bhi(z.y)));
            ov.z = pk2(o[4] * il * silu(blo(z.z)), o[5] * il * silu(bhi(z.z))); ov.w = pk2(o[6] * il * silu(blo(z.w)), o[7] * il * silu(bhi(z.w)));
            if (ok[j]) *(u32x4*)(F.mixed + (size_t)tt[j] * DM + cc[j]) = ov; } }
    for (int idx0 = gt; idx0 < SEQ * 64; idx0 += 2 * NT) {
        f32x4 a0[2][4], a1[2][4]; float lv[2][4]; u32x4 zw[2]; int tt[2], cc[2], ns[2]; bool ok[2];
#pragma unroll
        for (int j = 0; j < 2; ++j) { const int idx = idx0 + j * NT; ok[j] = idx < SEQ * 64; const int id2 = ok[j] ? idx : gt; const int t = id2 / 64, c = (id2 % 64) * 8, h = c >> 6; tt[j] = t; cc[j] = c;
            ns[j] = (2 * (t >> 8) + 2 - (int)F.ctl[8192 + h * 32 + (t >> 8)] + 15) >> 4;
#pragma unroll
            for (int sg = 0; sg < 4; ++sg) { a0[j][sg] = (f32x4){0.f, 0.f, 0.f, 0.f}; a1[j][sg] = (f32x4){0.f, 0.f, 0.f, 0.f}; lv[j][sg] = 0.f;
                if (sg < ns[j]) { const float* p = F.ob + ((size_t)sg * SEQ + t) * 512 + c; a0[j][sg] = *(const f32x4*)p; a1[j][sg] = *(const f32x4*)(p + 4); lv[j][sg] = F.lb[((size_t)sg * SEQ + t) * 8 + h]; } }
            zw[j] = *(const u32x4*)(F.proj + (size_t)t * PW + C_BZ + c); }
#pragma unroll
        for (int j = 0; j < 2; ++j) { const f32x4 o0 = (a0[j][0] + a0[j][1]) + (a0[j][2] + a0[j][3]), o1 = (a1[j][0] + a1[j][1]) + (a1[j][2] + a1[j][3]);
            const float il = 1.f / ((lv[j][0] + lv[j][1]) + (lv[j][2] + lv[j][3])); const u32x4 z = zw[j];
            u32x4 ov; ov.x = pk2(o0.x * il * silu(blo(z.x)), o0.y * il * silu(bhi(z.x))); ov.y = pk2(o0.z * il * silu(blo(z.y)), o0.w * il * silu(bhi(z.y)));
            ov.z = pk2(o1.x * il * silu(blo(z.z)), o1.y * il * silu(bhi(z.z))); ov.w = pk2(o1.z * il * silu(blo(z.w)), o1.w * il * silu(bhi(z.w)));
            if (ok[j]) *(u32x4*)(F.mixed + (size_t)tt[j] * DM + 768 + cc[j]) = ov; } }
}

#define LAS __attribute__((address_space(3)))
#define XB_TMO      128
#define XB_XCNT(j)  (256  + 64 * (j))
#define XB_XSUB(j)  (1280 + 64 * (j))
#define XB_XGEN(j)  (2304 + 64 * (j))
#define XB_TOP      3328
#define XB_TOPGEN   3392
#define XCD_BAR_WORDS 3456
#define XB_SPIN_CAP (1u << 18)

__device__ __forceinline__ unsigned xb_ld(unsigned* p)              { return __hip_atomic_load(p, __ATOMIC_RELAXED, __HIP_MEMORY_SCOPE_AGENT); }
__device__ __forceinline__ unsigned xb_add(unsigned* p, unsigned v) { return __hip_atomic_fetch_add(p, v, __ATOMIC_RELAXED, __HIP_MEMORY_SCOPE_AGENT); }
__device__ __forceinline__ unsigned xb_xcc_id() { return (unsigned)__builtin_amdgcn_s_getreg((3 << 11) | 20) & 0xFu; }
#define XB_SPIN(cond, bar) do { unsigned _sp = 0; while (cond) { __builtin_amdgcn_s_sleep(1); \
    if ((++_sp & 255u) == 0u) { if (xb_ld(&(bar)[XB_TMO])) break; if (_sp > XB_SPIN_CAP) { atomicAdd(&(bar)[XB_TMO], 1u); break; } } } } while (0)

struct XcdBarrier {
    unsigned* bar; unsigned x;
    volatile LAS unsigned* st;
};

__device__ __forceinline__ XcdBarrier xcd_barrier_post(unsigned* bar, volatile LAS unsigned* st) {
    XcdBarrier b; b.bar = bar; b.x = xb_xcc_id(); b.st = st;
    if (threadIdx.x == 0) (void)xb_add(&bar[XB_XCNT(b.x)], 1u);
    return b;
}
__device__ __forceinline__ void xcd_barrier_complete(unsigned* bar, unsigned x, unsigned& nloc, unsigned& nx) {
    const unsigned G = gridDim.x * gridDim.y * gridDim.z;
    unsigned sum, cnt, mine, sp = 0u;
    for (;;) {
        sum = 0u; cnt = 0u; mine = 0u;
#pragma unroll
        for (unsigned j = 0; j < 16; ++j) { const unsigned c = xb_ld(&bar[XB_XCNT(j)]); sum += c; cnt += (c > 0u) ? 1u : 0u; mine = (j == x) ? c : mine; }
        if (sum == G) break;
        __builtin_amdgcn_s_sleep(1);
        if ((++sp & 255u) == 0u) { if (xb_ld(&bar[XB_TMO])) break; if (sp > XB_SPIN_CAP) { atomicAdd(&bar[XB_TMO], 1u); break; } }
    }
    nloc = mine > 0u ? mine : 1u; nx = cnt > 0u ? cnt : 1u;
}

__device__ __forceinline__ void xcd_barrier(const XcdBarrier& b) {
    asm volatile("s_waitcnt vmcnt(0)" ::: "memory");
    __syncthreads();
    if (threadIdx.x == 0) {
        unsigned* bar = b.bar;
        __builtin_amdgcn_s_waitcnt(0);
        unsigned nloc = b.st[0], nx = b.st[1];
        if (nloc == 0u) { xcd_barrier_complete(bar, b.x, nloc, nx); b.st[0] = nloc; b.st[1] = nx; }
        const unsigned old = xb_add(&bar[XB_XSUB(b.x)], 1u);
        const unsigned gen = old / nloc;
        if (old + 1u == (gen + 1u) * nloc) {
            __builtin_amdgcn_fence(__ATOMIC_RELEASE, "agent");
            asm volatile("s_waitcnt vmcnt(0)" ::: "memory");
            const unsigned og = xb_add(&bar[XB_TOP], 1u);
            const unsigned tg = og / nx;
            if (og + 1u == (tg + 1u) * nx) xb_add(&bar[XB_TOPGEN], 1u);
            else XB_SPIN(xb_ld(&bar[XB_TOPGEN]) == tg, bar);
            __builtin_amdgcn_fence(__ATOMIC_ACQUIRE, "agent");
            xb_add(&bar[XB_XGEN(b.x)], 1u);
            asm volatile("s_waitcnt vmcnt(0)" ::: "memory");
        } else {
            XB_SPIN(xb_ld(&bar[XB_XGEN(b.x)]) == gen, bar);
            __builtin_amdgcn_fence(__ATOMIC_ACQUIRE, "agent");
            asm volatile("s_waitcnt vmcnt(0)" ::: "memory");
        }
    }
    __syncthreads();
}

struct Args { const float* in[12]; float* out; unsigned char* ws; int ph_lo, ph_hi; };
constexpr int N_PHASES = 1 + 5 * NLAYER;
__global__ void __launch_bounds__(512, 2) mega_fwd(Args args) {
    extern __shared__ __attribute__((aligned(16))) unsigned char lds[];
    Ctx F;
#define BUILD() do { const Args* ap_ = &args; \
    F.x = ap_->in[0]; F.norm_g = ap_->in[1]; F.w_in = ap_->in[2]; F.aqg = ap_->in[3]; F.akg = ap_->in[4]; F.bqg = ap_->in[5]; F.bkg = ap_->in[6]; \
    F.fox_bias = ap_->in[7]; F.gate_up = ap_->in[8]; F.gate_bias = ap_->in[9]; F.out_gain = ap_->in[10]; F.w_out = ap_->in[11]; \
    F.out = ap_->out; unsigned char* ws = ap_->ws; F.ws = ws; \
    F.ctl = (unsigned*)(ws + WS_CTL); F.ss = (unsigned long long*)(ws + WS_SS); F.wtin = (bf16*)(ws + WS_WTIN); F.wtout = (bf16*)(ws + WS_WTOUT); F.xb = (bf16*)(ws + WS_XB); \
    F.proj = (bf16*)(ws + WS_PROJ); F.small = (float*)(ws + WS_SMALL); F.mixed = (bf16*)(ws + WS_MIXED); F.oa = (bf16*)(ws + WS_OA); F.la = (float*)(ws + WS_LA); \
    F.ob = (float*)(ws + WS_OB); F.lb = (float*)(ws + WS_LB); F.cl = (float*)(ws + WS_CL); F.bt = (float*)(ws + WS_BT); F.ds = (float*)(ws + WS_DS); F.st = (bf16*)(ws + WS_ST); F.dec = (float*)(ws + WS_DEC); \
    F.lds = lds; F.G = gridDim.x; F.bid = blockIdx.x; \
    int t_ = threadIdx.x; asm volatile("" : "+v"(t_)); F.tid = t_; F.lane = t_ & 63; F.wave = __builtin_amdgcn_readfirstlane(t_ >> 6); } while (0)
    BUILD();
    cg::grid_group grid = cg::this_grid();
    if (threadIdx.x < 8) ((volatile LAS unsigned*)((LAS unsigned char*)lds + MISC_OFF))[threadIdx.x] = 0u;
    __syncthreads();
    XcdBarrier bar = xcd_barrier_post((unsigned*)(F.ws + WS_CTL) + 4096, (volatile LAS unsigned*)((LAS unsigned char*)lds + MISC_OFF));
    const int lo = args.ph_lo, hi = args.ph_hi;
#define IN(k) (lo <= (k) && (k) < hi)
#define RELAUNDER() do { int t_ = threadIdx.x; asm volatile("" : "+v"(t_)); F.tid = t_; F.lane = t_ & 63; F.wave = __builtin_amdgcn_readfirstlane(t_ >> 6); } while (0)
#define SEAM(k) do { if (IN(k) && IN((k) + 1)) { if ((k) == 0) grid.sync(); else xcd_barrier(bar); } } while (0)
    if (IN(0)) { BUILD(); phase0(F); }
    SEAM(0);
    for (int l = 0; l < NLAYER; ++l) { const int pb = 1 + 5 * l;
        if (IN(pb)) { BUILD(); pg8::Gemm g{F.xb, F.wtin + (size_t)l * NPAD * DM, SEQ, NPAD, DM}; pg8::StaticOrder S; S.init(SEQ, NPAD, F.G, F.bid);
            pg8::EpiProj E{F.proj, F.small, F.ss + l * SEQ, (float*)(lds + RING_BYTES + 1024), F.aqg + l * 64, F.akg + l * 64, F.bqg + l * 64, F.bkg + l * 64};
            pg8::gemm_phase<pg8::EpiProj, pg8::StaticOrder, true, true>((PG8_LAS unsigned char*)lds, g, S, E); __syncthreads(); }
        SEAM(pb);
        if (IN(pb + 1)) { BUILD(); phase2(F, l); }
        SEAM(pb + 1);
        if (IN(pb + 2)) { BUILD(); phase3(F, l); }
        SEAM(pb + 2);
        if (IN(pb + 3)) { BUILD(); phase4(F, l); }
        SEAM(pb + 3);
        if (IN(pb + 4)) { BUILD(); pg8::Gemm g{F.mixed, F.wtout + (size_t)l * DM * DM, SEQ, DM, DM}; pg8::StaticOrder S; S.init(SEQ, DM, F.G, F.bid);
            const bool last = (l == NLAYER - 1);
            pg8::EpiOut E{l == 0 ? F.x : F.out, F.out, last ? nullptr : F.xb, last ? nullptr : F.ss + (l + 1) * SEQ};
            pg8::gemm_phase<pg8::EpiOut, pg8::StaticOrder, true, true>((PG8_LAS unsigned char*)lds, g, S, E); __syncthreads(); }
        SEAM(pb + 4);
    }
#undef IN
#undef SEAM
}

#ifndef MK_ONE_LAUNCH
#define MK_ONE_LAUNCH 1
#endif
extern "C" void kernel_launch(void* const* d_in, const int* in_sizes, int n_in, void* d_out, int out_size, void* d_ws, size_t ws_size, hipStream_t stream) {
    static int grid = 0;
    if (grid == 0) {
        int dev = 0, cus = 0, per_cu = 0;
        hipGetDevice(&dev); hipDeviceGetAttribute(&cus, hipDeviceAttributeMultiprocessorCount, dev);
        hipFuncSetAttribute((const void*)mega_fwd, hipFuncAttributeMaxDynamicSharedMemorySize, LDS_BYTES);
        hipOccupancyMaxActiveBlocksPerMultiprocessor(&per_cu, mega_fwd, 512, LDS_BYTES);
        grid = cus * per_cu; if (grid <= 0) grid = 256;
        if (ws_size < WS_END) { fprintf(stderr, "workspace too small: %zu < %zu\n", ws_size, (size_t)WS_END); }
    }
    Args a{}; for (int i = 0; i < 12; ++i) a.in[i] = (const float*)d_in[i]; a.out = (float*)d_out; a.ws = (unsigned char*)d_ws;
#if MK_ONE_LAUNCH
    a.ph_lo = 0; a.ph_hi = N_PHASES; void* kargs[] = {&a};
    (void)hipMemsetAsync(d_ws, 0, 65536, stream);
    hipError_t e = hipLaunchCooperativeKernel((const void*)mega_fwd, dim3(grid), dim3(512), kargs, LDS_BYTES, stream);
    if (e != hipSuccess) fprintf(stderr, "cooperative launch failed: %s (grid %d)\n", hipGetErrorString(e), grid);
#else
    for (int p = 0; p < N_PHASES; ++p) { a.ph_lo = p; a.ph_hi = p + 1; hipLaunchKernelGGL(mega_fwd, dim3(grid), dim3(512), LDS_BYTES, stream, a); }
#endif
}
```

```cpp
#include <hip/hip_runtime.h>
#include <hip/hip_cooperative_groups.h>
#include <cstdio>
#include <cstdint>
namespace cg = cooperative_groups;
namespace pg8 {
#define PG8_LAS __attribute__((address_space(3)))
typedef unsigned short bf16_t;
typedef short bf16x8 __attribute__((ext_vector_type(8)));
typedef float f32x4 __attribute__((ext_vector_type(4)));
typedef unsigned u32x4 __attribute__((ext_vector_type(4)));
constexpr int BM = 256, BK = 64, HALF = 128, HTB = HALF * BK * 2  , STAGE_BYTES = 8 * HTB, NXCD = 8, WGM = 8;

__host__ __device__ __forceinline__ int lds_byte(int r, int c) { const int st = (r >> 4) * 2 + (c >> 5), rr = r & 15, cc = c & 31, ob = rr * 64 + cc * 2; return st * 1024 + (ob ^ (((ob >> 9) & 1) << 5)); }
__host__ __device__ __forceinline__ void stage_rc(int b, int& R, int& C) { const int st = b / 1024, sb = b % 1024, swz = sb ^ (((sb >> 9) & 1) << 5); R = (st >> 1) * 16 + swz / 64; C = (st & 1) * 32 + (swz % 64) / 2; }
__host__ __device__ __forceinline__ int perm32(int rho) { const int n = rho >> 4, i = rho & 15; return 8 * (i >> 2) + 4 * n + (i & 3); }

struct Unit { int pm, pn; };
struct Gemm { const bf16_t* A; const bf16_t* Bt; int M, N, K; };

struct StaticOrder {
    int nM, nN, nwg, G, c;
    __host__ __device__ void init(int M, int N, int G_, int c_) { nM = M / BM; nN = N / BM; nwg = nM * nN; G = G_; c = c_; }
    __host__ __device__ bool next(int i, Unit& u) const {
        const long L = (long)i * G + c; if (L >= nwg) return false;
        int wgid = (int)L; { const int q = nwg / NXCD, r = nwg % NXCD, xcd = wgid % NXCD, off = wgid / NXCD; wgid = (xcd < r ? xcd * (q + 1) : r * (q + 1) + (xcd - r) * q) + off; }
        const int nig = WGM * nN, gid = wgid / nig, fm = gid * WGM, gsz = (nM - fm) < WGM ? (nM - fm) : WGM;
        u.pm = fm + ((wgid % nig) % gsz); u.pn = (wgid % nig) / gsz; return true;
    }
    __device__ __forceinline__ void a_ready(const Unit&) const {}
    __device__ __forceinline__ void done(const Unit&) const {}
};

__device__ __forceinline__ unsigned cvt_pk_bf16(float lo, float hi) { unsigned r; asm volatile("v_cvt_pk_bf16_f32 %0, %1, %2" : "=v"(r) : "v"(lo), "v"(hi)); return r; }
typedef float f32x2 __attribute__((ext_vector_type(2)));
constexpr int PROJ_W = 7424;
struct EpiProj {
    static constexpr bool PERM = true, AFTER_DRAIN = false;
    bf16_t* O; float* small; const unsigned long long* ss; float* xch; const float* gaq; const float* gak; const float* gbq; const float* gbk;
    __device__ __forceinline__ void operator()(const f32x4 (&acc)[2][2][4][2], const Unit& u, int wr, int wc, int fr, int fq) const {
        const int row0 = u.pm * BM + wr * 64 + fr;
        float rsv[2][4];
        { unsigned long long sv[2][4];
#pragma unroll
          for (int ai = 0; ai < 2; ++ai)
#pragma unroll
              for (int m = 0; m < 4; ++m) sv[ai][m] = ss[row0 + ai * HALF + m * 16];
          asm volatile("" : "+v"(sv[0][0]), "+v"(sv[0][1]), "+v"(sv[0][2]), "+v"(sv[0][3])); asm volatile("" : "+v"(sv[1][0]), "+v"(sv[1][1]), "+v"(sv[1][2]), "+v"(sv[1][3]));
#pragma unroll
          for (int ai = 0; ai < 2; ++ai)
#pragma unroll
              for (int m = 0; m < 4; ++m) rsv[ai][m] = rsqrtf((float)sv[ai][m] * (1.0f / 1048576.0f / 2048.0f) + 1e-6f); }
        if (u.pn < 29) {
            const int col0 = u.pn * BM + wc * 32 + 8 * fq;
            const bool isA = u.pn < 6, isB = (u.pn >= 12 && u.pn < 16);
            if (isA || isB) {
#pragma unroll
                for (int ai = 0; ai < 2; ++ai)
#pragma unroll
                    for (int m = 0; m < 4; ++m) { const int row = row0 + ai * HALF + m * 16; const float rs = rsv[ai][m];
#pragma unroll
                        for (int bj = 0; bj < 2; ++bj) { const f32x4 v0 = acc[ai][bj][m][0] * rs, v1 = acc[ai][bj][m][1] * rs;
                            float sq = (v0[0] * v0[0] + v0[1] * v0[1]) + (v0[2] * v0[2] + v0[3] * v0[3]) + (v1[0] * v1[0] + v1[1] * v1[1]) + (v1[2] * v1[2] + v1[3] * v1[3]);
                            sq += __shfl_xor(sq, 16); sq += __shfl_xor(sq, 32);
                            if (fq == 0) xch[((ai * HALF + wr * 64 + m * 16 + fr) * 2 + bj) * 4 + wc] = sq; } }
                asm volatile("s_waitcnt lgkmcnt(0)" ::: "memory"); __builtin_amdgcn_s_barrier(); asm volatile("" ::: "memory");
                const bool isq = (u.pn < 3) || (u.pn == 12) || (u.pn == 13);
                const float* ga0 = gaq; const float* ga1 = gak; const float* gb0 = gbq; const float* gb1 = gbk;
                const float* gsel = isA ? ga0 : gb0; { const float* gk = isA ? ga1 : gb1; if (!isq) gsel = gk; }
                const float* g = gsel + 32 * (wc & 1) + 8 * fq;
                const float sc = isq ? 0.18033688011112042f : 1.0f;
                const f32x4 g0 = *(const f32x4*)g * sc, g1 = *(const f32x4*)(g + 4) * sc;
#pragma unroll
                for (int ai = 0; ai < 2; ++ai)
#pragma unroll
                    for (int m = 0; m < 4; ++m) { const int row = row0 + ai * HALF + m * 16; bf16_t* rowp = O + (size_t)row * PROJ_W + col0;
                        const float rs = rsv[ai][m];
#pragma unroll
                        for (int bj = 0; bj < 2; ++bj) { const float* xp = xch + ((ai * HALF + wr * 64 + m * 16 + fr) * 2 + bj) * 4 + (wc & 2); const float tot = xp[0] + xp[1];
                            const float r2 = rsqrtf(tot * (1.0f / 64.0f) + 1e-6f) * rs;
                            const f32x4 v0 = acc[ai][bj][m][0] * r2 * g0, v1 = acc[ai][bj][m][1] * r2 * g1;
                            u32x4 w; w.x = cvt_pk_bf16(v0[0], v0[1]); w.y = cvt_pk_bf16(v0[2], v0[3]); w.z = cvt_pk_bf16(v1[0], v1[1]); w.w = cvt_pk_bf16(v1[2], v1[3]);
                            *(u32x4*)(rowp + bj * HALF) = w; } }
            } else {
#pragma unroll
            for (int ai = 0; ai < 2; ++ai)
#pragma unroll
                for (int m = 0; m < 4; ++m) { const int row = row0 + ai * HALF + m * 16; const float rs = rsv[ai][m];
                    bf16_t* rowp = O + (size_t)row * PROJ_W + col0;
#pragma unroll
                    for (int bj = 0; bj < 2; ++bj) { const f32x4 v0 = acc[ai][bj][m][0] * rs, v1 = acc[ai][bj][m][1] * rs;
                        u32x4 w; w.x = cvt_pk_bf16(v0[0], v0[1]); w.y = cvt_pk_bf16(v0[2], v0[3]); w.z = cvt_pk_bf16(v1[0], v1[1]); w.w = cvt_pk_bf16(v1[2], v1[3]);
                        *(u32x4*)(rowp + bj * HALF) = w; } }
            }
        } else if (wc == 0) {
#pragma unroll
            for (int ai = 0; ai < 2; ++ai)
#pragma unroll
                for (int m = 0; m < 4; ++m) { const int row = row0 + ai * HALF + m * 16; const float rs = rsv[ai][m];
                    float* p = small + (size_t)row * 32 + 8 * fq;
                    *(f32x4*)p = acc[ai][0][m][0] * rs; *(f32x4*)(p + 4) = acc[ai][0][m][1] * rs; }
        }
    }
};
struct EpiOut {
    static constexpr bool PERM = true, AFTER_DRAIN = false;
    const float* xin; float* out; bf16_t* xb; unsigned long long* ssn;
    __device__ __forceinline__ void operator()(const f32x4 (&acc)[2][2][4][2], const Unit& u, int wr, int wc, int fr, int fq) const {
        const int row0 = u.pm * BM + wr * 64 + fr, col0 = u.pn * BM + wc * 32 + 8 * fq;
#pragma unroll
        for (int ai = 0; ai < 2; ++ai) {
            f32x4 xo[4][2][2];
#pragma unroll
            for (int m = 0; m < 4; ++m)
#pragma unroll
                for (int bj = 0; bj < 2; ++bj) { const size_t p = (size_t)(row0 + ai * HALF + m * 16) * 2048 + col0 + bj * HALF; xo[m][bj][0] = *(const f32x4*)(xin + p); xo[m][bj][1] = *(const f32x4*)(xin + p + 4); }
#pragma unroll
            for (int m = 0; m < 4; ++m) asm volatile("" : "+v"(xo[m][0][0]), "+v"(xo[m][0][1]), "+v"(xo[m][1][0]), "+v"(xo[m][1][1]));
#pragma unroll
            for (int m = 0; m < 4; ++m) { const int row = row0 + ai * HALF + m * 16; float sq = 0.f;
#pragma unroll
                for (int bj = 0; bj < 2; ++bj) { const size_t p = (size_t)row * 2048 + col0 + bj * HALF;
                    const f32x4 a = xo[m][bj][0] + acc[ai][bj][m][0], b = xo[m][bj][1] + acc[ai][bj][m][1];
                    *(f32x4*)(out + p) = a; *(f32x4*)(out + p + 4) = b;
                    if (xb) { u32x4 w; w.x = cvt_pk_bf16(a[0], a[1]); w.y = cvt_pk_bf16(a[2], a[3]); w.z = cvt_pk_bf16(b[0], b[1]); w.w = cvt_pk_bf16(b[2], b[3]); *(u32x4*)(xb + p) = w; }
                    sq += (a[0] * a[0] + a[1] * a[1]) + (a[2] * a[2] + a[3] * a[3]) + (b[0] * b[0] + b[1] * b[1]) + (b[2] * b[2] + b[3] * b[3]); }
                sq += __shfl_xor(sq, 16); sq += __shfl_xor(sq, 32);
                if (fq == 0 && ssn) atomicAdd(ssn + row, (unsigned long long)(sq * 1048576.0f + 0.5f)); } }
    }
};

template <class Epi, class Sched, bool ALIGN_EPI = false, bool SP2 = false>
__device__ __forceinline__ void gemm_phase(PG8_LAS unsigned char* lds, const Gemm g, const Sched& S, const Epi& E) {
    int tid_ = threadIdx.x; asm volatile("" : "+v"(tid_)); const int tid = tid_, wid = __builtin_amdgcn_readfirstlane(tid >> 6), lane = tid & 63, wr = wid >> 2, wc = wid & 3, fr = lane & 15, fq = lane >> 4;
    const int K = g.K, nt = K / BK;
    unsigned voffA[2], voffB[2];
#pragma unroll
    for (int i = 0; i < 2; ++i) { int R, C; stage_rc(tid * 16 + i * 8192, R, C); const int Rb = Epi::PERM ? ((R & ~31) + perm32(R & 31)) : R;
        voffA[i] = (unsigned)(R * K + C) * 2u; voffB[i] = (unsigned)(Rb * K + C) * 2u; }
    const size_t kstep = (size_t)(BK * 2);
    const size_t hstep = (size_t)HALF * K * 2;
    const size_t tstep = 2 * hstep;
    const unsigned ldsw = (unsigned)wid * 1024u;
    const int aoff = lds_byte(wr * 64 + fr, fq * 8), boff = lds_byte(wc * 32 + fr, fq * 8);
#define PG8_SA(b, h) (((b) * 2 + (h)) * HTB)
#define PG8_SB(b, h) ((4 + (b) * 2 + (h)) * HTB)
#define PG8_STAGE(bufoff, gbase, voff) do { _Pragma("unroll") for (int _i = 0; _i < 2; ++_i) \
        __builtin_amdgcn_global_load_lds((const unsigned*)((const char*)(gbase) + (voff)[_i]), (PG8_LAS unsigned*)(lds + (bufoff) + ldsw + _i * 8192), 16, 0, 0); } while (0)
#define PG8_LDA(dst, b, h) do { _Pragma("unroll") for (int m = 0; m < 4; ++m) _Pragma("unroll") for (int k = 0; k < 2; ++k) dst[m][k] = *(const PG8_LAS bf16x8*)(lds + PG8_SA(b, h) + aoff + m * 2048 + k * 1024); } while (0)
#define PG8_LDB(dst, b, h) do { _Pragma("unroll") for (int n = 0; n < 2; ++n) _Pragma("unroll") for (int k = 0; k < 2; ++k) dst[n][k] = *(const PG8_LAS bf16x8*)(lds + PG8_SB(b, h) + boff + n * 2048 + k * 1024); } while (0)
#define PG8_MMA(ai, bj, At, Bt) do { __builtin_amdgcn_s_setprio(1); _Pragma("unroll") for (int m = 0; m < 4; ++m) _Pragma("unroll") for (int n = 0; n < 2; ++n) _Pragma("unroll") for (int k = 0; k < 2; ++k) \
        acc[ai][bj][m][n] = __builtin_amdgcn_mfma_f32_16x16x32_bf16(Bt[n][k], At[m][k], acc[ai][bj][m][n], 0, 0, 0); __builtin_amdgcn_s_setprio(0); } while (0)
#define PG8_WAIT_V(n) asm volatile("s_waitcnt vmcnt(" #n ")" ::: "memory")
#define PG8_WAIT_L(n) asm volatile("s_waitcnt lgkmcnt(" #n ")" ::: "memory")
#define PG8_BAR __builtin_amdgcn_s_barrier()
#define PG8_SCHED __builtin_amdgcn_sched_barrier(0)
    Unit cur, nxt; int ui = 0;
    if (!S.next(0, cur)) return;
    f32x4 acc[2][2][4][2];
#pragma unroll
    for (int a = 0; a < 2; ++a)
#pragma unroll
        for (int b = 0; b < 2; ++b)
#pragma unroll
            for (int m = 0; m < 4; ++m)
#pragma unroll
                for (int n = 0; n < 2; ++n) acc[a][b][m][n] = (f32x4){0.f, 0.f, 0.f, 0.f};
    bf16x8 At[4][2], B0[2][2], B1[2][2];
    const char* cA = (const char*)g.A + (size_t)cur.pm * tstep; const char* cB = (const char*)g.Bt + (size_t)cur.pn * tstep;
    S.a_ready(cur);
    if constexpr (SP2) {
        PG8_STAGE(PG8_SB(0, 0), cB, voffB); PG8_STAGE(PG8_SB(0, 1), cB + hstep, voffB); PG8_STAGE(PG8_SA(0, 0), cA, voffA); PG8_STAGE(PG8_SA(0, 1), cA + hstep, voffA);
        if (wr == 1) PG8_BAR;
        PG8_WAIT_V(2); PG8_BAR;
        PG8_STAGE(PG8_SB(1, 0), cB + kstep, voffB); PG8_STAGE(PG8_SA(1, 0), cA + kstep, voffA); PG8_STAGE(PG8_SB(1, 1), cB + hstep + kstep, voffB);
        PG8_WAIT_V(6); PG8_BAR;
    } else {
        PG8_STAGE(PG8_SB(0, 0), cB, voffB); PG8_STAGE(PG8_SA(0, 0), cA, voffA); PG8_STAGE(PG8_SB(0, 1), cB + hstep, voffB); PG8_STAGE(PG8_SA(0, 1), cA + hstep, voffA);
        if (wr == 1) PG8_BAR;
        PG8_WAIT_V(4); PG8_BAR;
        PG8_STAGE(PG8_SB(1, 0), cB + kstep, voffB); PG8_STAGE(PG8_SA(1, 0), cA + kstep, voffA); PG8_STAGE(PG8_SB(1, 1), cB + hstep + kstep, voffB);
        PG8_WAIT_V(6); PG8_BAR;
    }
    for (;;) {
        const bool has_next = S.next(ui + 1, nxt);
        const char* nA = has_next ? (const char*)g.A + (size_t)nxt.pm * tstep : cA; const char* nB = has_next ? (const char*)g.Bt + (size_t)nxt.pn * tstep : cB;
        for (int t = 0; t < nt; t += 2) {
            const bool last = (t == nt - 2);
            const char* a1 = cA + (size_t)(t + 1) * kstep;
            const char* a2 = last ? nA : cA + (size_t)(t + 2) * kstep; const char* b2 = last ? nB : cB + (size_t)(t + 2) * kstep;
            const char* a3 = a2 + kstep; const char* b3 = b2 + kstep;
            if (last && has_next) S.a_ready(nxt);
            if constexpr (SP2) {
            PG8_LDB(B0, 0, 0); PG8_LDB(B1, 0, 1); PG8_SCHED; PG8_LDA(At, 0, 0); PG8_STAGE(PG8_SA(1, 1), a1 + hstep, voffA);
            PG8_WAIT_V(8); PG8_WAIT_L(0); PG8_BAR; PG8_MMA(0, 0, At, B0); PG8_MMA(0, 1, At, B1); PG8_BAR; PG8_SCHED;
            PG8_LDA(At, 0, 1); PG8_STAGE(PG8_SB(0, 0), b2, voffB); PG8_STAGE(PG8_SB(0, 1), b2 + hstep, voffB); PG8_STAGE(PG8_SA(0, 0), a2, voffA);
            PG8_WAIT_V(8); PG8_WAIT_L(0); PG8_BAR; PG8_MMA(1, 0, At, B0); PG8_MMA(1, 1, At, B1); PG8_BAR; PG8_SCHED;
            PG8_LDB(B0, 1, 0); PG8_LDB(B1, 1, 1); PG8_SCHED; PG8_LDA(At, 1, 0); PG8_STAGE(PG8_SA(0, 1), a2 + hstep, voffA);
            PG8_WAIT_V(8); PG8_WAIT_L(0); PG8_BAR; PG8_MMA(0, 0, At, B0); PG8_MMA(0, 1, At, B1); PG8_BAR; PG8_SCHED;
            PG8_LDA(At, 1, 1); PG8_STAGE(PG8_SB(1, 0), b3, voffB); PG8_STAGE(PG8_SB(1, 1), b3 + hstep, voffB); PG8_STAGE(PG8_SA(1, 0), a3, voffA);
            PG8_WAIT_V(8); PG8_WAIT_L(0); PG8_BAR; PG8_MMA(1, 0, At, B0); PG8_MMA(1, 1, At, B1); PG8_BAR; PG8_SCHED;
            } else {
            PG8_LDB(B0, 0, 0); PG8_SCHED; PG8_LDA(At, 0, 0); PG8_STAGE(PG8_SA(1, 1), a1 + hstep, voffA);
            PG8_WAIT_L(8); PG8_BAR; PG8_WAIT_L(0); PG8_MMA(0, 0, At, B0); PG8_BAR; PG8_SCHED;
            PG8_LDB(B1, 0, 1); PG8_STAGE(PG8_SB(0, 0), b2, voffB);
            PG8_BAR; PG8_WAIT_L(0); PG8_MMA(0, 1, At, B1); PG8_BAR;
            PG8_LDA(At, 0, 1); PG8_STAGE(PG8_SA(0, 0), a2, voffA);
            PG8_BAR; PG8_WAIT_L(0); PG8_MMA(1, 0, At, B0); PG8_BAR; PG8_SCHED;
            PG8_STAGE(PG8_SB(0, 1), b2 + hstep, voffB);
            PG8_WAIT_V(6); PG8_BAR; PG8_MMA(1, 1, At, B1); PG8_BAR;
            PG8_LDB(B0, 1, 0); PG8_SCHED; PG8_LDA(At, 1, 0); PG8_STAGE(PG8_SA(0, 1), a2 + hstep, voffA);
            PG8_WAIT_L(8); PG8_BAR; PG8_WAIT_L(0); PG8_MMA(0, 0, At, B0); PG8_BAR; PG8_SCHED;
            PG8_LDB(B1, 1, 1); PG8_STAGE(PG8_SB(1, 0), b3, voffB);
            PG8_BAR; PG8_WAIT_L(0); PG8_MMA(0, 1, At, B1); PG8_BAR;
            PG8_LDA(At, 1, 1); PG8_STAGE(PG8_SA(1, 0), a3, voffA);
            PG8_BAR; PG8_WAIT_L(0); PG8_MMA(1, 0, At, B0); PG8_BAR; PG8_SCHED;
            PG8_STAGE(PG8_SB(1, 1), b3 + hstep, voffB);
            PG8_WAIT_V(6); PG8_BAR; PG8_MMA(1, 1, At, B1); PG8_BAR;
            }
        }
        if constexpr (ALIGN_EPI) { if (wr == 0) PG8_BAR; }
        if constexpr (!Epi::AFTER_DRAIN) { E(acc, cur, wr, wc, fr, fq); S.done(cur); }
        if (!has_next) break;
#pragma unroll
        for (int a = 0; a < 2; ++a)
#pragma unroll
            for (int b = 0; b < 2; ++b)
#pragma unroll
                for (int m = 0; m < 4; ++m)
#pragma unroll
                    for (int n = 0; n < 2; ++n) acc[a][b][m][n] = (f32x4){0.f, 0.f, 0.f, 0.f};
        cur = nxt; cA = nA; cB = nB; ++ui;
        if constexpr (ALIGN_EPI) { if (wr == 1) PG8_BAR; }
    }
    PG8_WAIT_V(0);
    if constexpr (!ALIGN_EPI) { if (wr == 0) PG8_BAR; }
    PG8_BAR;
    if constexpr (Epi::AFTER_DRAIN) { E.fused(acc, cur, wr, wc, fr, fq, lds, wid, lane); S.done(cur); }
#undef PG8_SA
#undef PG8_SB
#undef PG8_STAGE
#undef PG8_LDA
#undef PG8_LDB
#undef PG8_MMA
#undef PG8_WAIT_V
#undef PG8_WAIT_L
#undef PG8_BAR
#undef PG8_SCHED
}
}
constexpr int SEQ = 8192, DM = 2048, NLAYER = 4, INW = 7448, NPAD = 7680, PW = pg8::PROJ_W;
constexpr int C_AQ = 0, C_AK = 768, C_AV = 1536, C_AZ = 2304, C_BQ = 3072, C_BK = 3584, C_BV = 4096, C_BZ = 4608, C_CQ = 5120, C_CK = 5504, C_CV = 5888, C_CZ = 6656;
constexpr float LOG2E = 1.4426950408889634f, QSCALE = 0.125f * 1.4426950408889634f, EPS = 1e-6f;
constexpr size_t MiB = 1u << 20;
constexpr size_t WS_CTL = 0, WS_SS = 1 * MiB, WS_WTIN = 2 * MiB, WS_WTOUT = 122 * MiB, WS_XB = 154 * MiB, WS_PROJ = 186 * MiB, WS_SMALL = 302 * MiB,
                 WS_MIXED = 304 * MiB, WS_OA = 336 * MiB, WS_LA = 372 * MiB, WS_OB = 374 * MiB, WS_LB = 438 * MiB, WS_CL = 439 * MiB, WS_BT = WS_CL + 512 * 1024,
                 WS_DS = 440 * MiB, WS_ST = 476 * MiB, WS_DEC = 494 * MiB, WS_END = 496 * MiB;
constexpr int RING_BYTES = 131072, LDS_BYTES = 147456, QSLOT_OFF = RING_BYTES + 64, MISC_OFF = RING_BYTES + 256;
constexpr int P3_EXT = RING_BYTES + 1024;
constexpr int N_SCAN = 72, N_FOX = 640, N_AU = 1152, N_ITEMS = N_SCAN + N_FOX + N_AU;

typedef unsigned short bf16;
typedef short bf16x8 __attribute__((ext_vector_type(8)));
typedef short s16x4 __attribute__((ext_vector_type(4)));
typedef float f32x4 __attribute__((ext_vector_type(4)));
typedef float f32x2 __attribute__((ext_vector_type(2)));
typedef float f32x16 __attribute__((ext_vector_type(16)));
typedef unsigned u32x4 __attribute__((ext_vector_type(4)));
typedef unsigned u32x2 __attribute__((ext_vector_type(2)));
typedef __attribute__((address_space(3))) const char* lds_cptr;
#define LAS3 __attribute__((address_space(3)))

__device__ __forceinline__ float bf2f(unsigned b) { return __uint_as_float(b << 16); }
__device__ __forceinline__ unsigned pk2(float lo, float hi) { return pg8::cvt_pk_bf16(lo, hi); }
__device__ __forceinline__ float blo(unsigned w) { return __uint_as_float(w << 16); }
__device__ __forceinline__ float bhi(unsigned w) { return __uint_as_float(w & 0xffff0000u); }
__device__ __forceinline__ float logsig(float x) { return fminf(x, 0.f) - log1pf(expf(-fabsf(x))); }
__device__ __forceinline__ float silu(float x) { return x / (1.f + __expf(-x)); }
__device__ __forceinline__ s16x4 vtr(lds_cptr p) { return __builtin_bit_cast(s16x4, __builtin_amdgcn_ds_read_tr16_b64_v4i16((LAS3 s16x4*)p)); }
__device__ __forceinline__ bf16x8 frag_tr(lds_cptr img, int stride, int kbase, int m0, int lane) {
    const int i = lane & 15, g = lane >> 4;
    lds_cptr p = img + (kbase + 4 * (g >> 1) + (i >> 2)) * stride + (m0 + 16 * (g & 1) + 4 * (i & 3)) * 2;
    const s16x4 a = vtr(p), b = vtr(p + 8 * stride);
    return (bf16x8){a[0], a[1], a[2], a[3], b[0], b[1], b[2], b[3]};
}
__device__ __forceinline__ int rowidx(int reg, int hh) { return (reg & 3) + 8 * (reg >> 2) + 4 * hh; }
__device__ __forceinline__ void pack_p(const f32x16& p, bf16x8& f0, bf16x8& f1) {
    u32x4 a, b; a.x = pk2(p[0], p[1]); a.y = pk2(p[2], p[3]); a.z = pk2(p[4], p[5]); a.w = pk2(p[6], p[7]);
    b.x = pk2(p[8], p[9]); b.y = pk2(p[10], p[11]); b.z = pk2(p[12], p[13]); b.w = pk2(p[14], p[15]);
    f0 = __builtin_bit_cast(bf16x8, a); f1 = __builtin_bit_cast(bf16x8, b);
}
#define MFMA32(a, b, c) __builtin_amdgcn_mfma_f32_32x32x16_bf16((a), (b), (c), 0, 0, 0)

struct Ctx {
    const float *x, *norm_g, *w_in, *aqg, *akg, *bqg, *bkg, *fox_bias, *gate_up, *gate_bias, *out_gain, *w_out;
    float* out; unsigned char* ws;
    unsigned* ctl; unsigned long long* ss; bf16* wtin; bf16* wtout; bf16* xb; bf16* proj; float* small; bf16* mixed; bf16* oa; float* la; float* ob; float* lb; float* cl; float* bt;
    float* ds; bf16* st; float* dec;
    unsigned char* lds; int tid, lane, wave, G, bid;
};

__device__ __forceinline__ int orig_col(int np) { if (np < 5120) return np; if (np < 7424) return np + 8; if (np < 7432) return 5120 + (np - 7424); if (np < 7448) return np; return -1; }
__device__ __forceinline__ void p0_load(const float* W, int N, const float* g, int mode, int kb, int nb, int lane, f32x4 (&v)[8], float (&gs)[8]) {
    const int k0 = 64 * kb, np = 32 * nb + 4 * (lane & 7);
    const int oc = mode ? orig_col(np) : np;
#pragma unroll
    for (int i = 0; i < 8; ++i) { const int kk = 8 * i + (lane >> 3); v[i] = (f32x4){0.f, 0.f, 0.f, 0.f}; gs[i] = 1.0f;
        if (oc >= 0) { v[i] = *(const f32x4*)(W + (size_t)(k0 + kk) * N + oc); if (mode) gs[i] = g[k0 + kk]; } }
}
__device__ __forceinline__ void p0_finish(bf16* WT, int mode, int kb, int nb, int lane, float* scr, const f32x4 (&v)[8], const float (&gs)[8]) {
    const int k0 = 64 * kb, n0 = 32 * nb, c4 = 4 * (lane & 7), np = n0 + c4;
    const float cs = (mode && np >= C_CQ && np < C_CK) ? 0.10206207261596577f : 1.0f;
#pragma unroll
    for (int i = 0; i < 8; ++i) { const int kk = 8 * i + (lane >> 3); float* d = scr + kk * 33 + c4; const float sc = cs * gs[i]; d[0] = v[i].x * sc; d[1] = v[i].y * sc; d[2] = v[i].z * sc; d[3] = v[i].w * sc; }
    asm volatile("s_waitcnt lgkmcnt(0)" ::: "memory");
    const int c = lane & 7;
#pragma unroll
    for (int j = 0; j < 4; ++j) { const int n = (lane >> 3) + 8 * j; const float* s = scr + (8 * c) * 33 + n;
        u32x4 o; o.x = pk2(s[0 * 33], s[1 * 33]); o.y = pk2(s[2 * 33], s[3 * 33]); o.z = pk2(s[4 * 33], s[5 * 33]); o.w = pk2(s[6 * 33], s[7 * 33]);
        *(u32x4*)(WT + (size_t)(n0 + n) * 2048 + k0 + 8 * c) = o; }
    asm volatile("s_waitcnt lgkmcnt(0)" ::: "memory");
}
__device__ __forceinline__ void phase0(Ctx& F) {
    float* scr = (float*)(F.lds + F.wave * 16384);
    const int gw = F.bid * 8 + F.wave, NGW = F.G * 8;
    if (F.bid == 0) for (int i = F.tid; i < 16384; i += 512) F.ctl[i] = 0u;
    for (int i = F.bid * 512 + F.tid; i < 3 * SEQ; i += F.G * 512) F.ss[SEQ + i] = 0ull;
    constexpr int I_IN = 32 * 233, I_OUT = 32 * 64, I_L = I_IN + I_OUT, I_ALL = NLAYER * I_L;
#define P0_DECODE(it_, W_, N_, WT_, g_, mode_, kb_, nb_) do { const int l_ = (it_) / I_L; int r_ = (it_) % I_L; \
        if (r_ < I_IN) { W_ = F.w_in + (size_t)l_ * DM * INW; N_ = INW; WT_ = F.wtin + (size_t)l_ * NPAD * DM; g_ = F.norm_g + l_ * DM; mode_ = 1; kb_ = r_ / 233; nb_ = r_ % 233; } \
        else { r_ -= I_IN; W_ = F.w_out + (size_t)l_ * DM * DM; N_ = DM; WT_ = F.wtout + (size_t)l_ * DM * DM; g_ = F.norm_g; mode_ = 0; kb_ = r_ / 64; nb_ = r_ % 64; } } while (0)
    { f32x4 va[8], vb[8]; float ga[8], gb[8];
      const float* W = nullptr; const float* g = nullptr; bf16* WT = nullptr; int N = 0, mode = 0, kb = 0, nb = 0;
      int it = gw;
      if (it < I_ALL) { P0_DECODE(it, W, N, WT, g, mode, kb, nb); p0_load(W, N, g, mode, kb, nb, F.lane, va, ga); }
      while (it < I_ALL) { const int nit = it + NGW;
          const float* W2 = nullptr; const float* g2 = nullptr; bf16* WT2 = nullptr; int N2 = 0, mode2 = 0, kb2 = 0, nb2 = 0;
          if (nit < I_ALL) { P0_DECODE(nit, W2, N2, WT2, g2, mode2, kb2, nb2); p0_load(W2, N2, g2, mode2, kb2, nb2, F.lane, vb, gb); }
          p0_finish(WT, mode, kb, nb, F.lane, scr, va, ga);
#pragma unroll
          for (int i = 0; i < 8; ++i) { va[i] = vb[i]; ga[i] = gb[i]; }
          it = nit; WT = WT2; mode = mode2; kb = kb2; nb = nb2; } }
#undef P0_DECODE
    for (int m = gw; m < SEQ; m += NGW) {
        const f32x4* xr = (const f32x4*)(F.x + (size_t)m * DM) + F.lane; float s = 0.f; u32x2* o8 = (u32x2*)(F.xb + (size_t)m * DM) + F.lane;
#pragma unroll
        for (int j = 0; j < 8; ++j) { const f32x4 v = xr[64 * j]; s += (v.x * v.x + v.y * v.y) + (v.z * v.z + v.w * v.w); u32x2 w; w.x = pk2(v.x, v.y); w.y = pk2(v.z, v.w); o8[64 * j] = w; }
#pragma unroll
        for (int o = 1; o < 64; o <<= 1) s += __shfl_xor(s, o);
        if (F.lane == 0) F.ss[m] = (unsigned long long)(s * 1048576.0f + 0.5f);
    }
}

__device__ __forceinline__ void phase2(Ctx& F, int l) {
    { const int gw = F.bid * 8 + F.wave, NGW = F.G * 8;
      for (int wi = gw; wi < 512; wi += NGW) { const int blk = wi >> 3, h = wi & 7, t = blk * 128 + 2 * F.lane; const float fb = F.fox_bias[l * 8 + h];
        const float l0 = logsig(F.small[(size_t)t * 32 + h] + fb), l1 = logsig(F.small[(size_t)(t + 1) * 32 + h] + fb);
        float s = l0 + l1;
#pragma unroll
        for (int o = 1; o < 64; o <<= 1) { const float y = __shfl_up(s, o); if (F.lane >= o) s += y; }
        const float ex = s - (l0 + l1); F.cl[t * 8 + h] = ex + l0; F.cl[(t + 1) * 8 + h] = s; if (F.lane == 63) F.bt[blk * 8 + h] = s; } }
    { float* CR = (float*)F.lds;
      float* GT = (float*)(F.lds + 4096);
      unsigned char* KH = F.lds + 8192;
      unsigned char* VV = F.lds + 8192 + 13312;
      const float* gup = F.gate_up + (size_t)l * 16 * 384; const float* gbs = F.gate_bias + l * 384;
      for (int u = F.bid; u < 512; u += F.G) { const int h = u & 3, n = u >> 2, t0 = n * 64;
        if (F.tid < 256) *(f32x4*)(CR + F.tid * 4) = *(const f32x4*)(F.small + (size_t)(t0 + (F.tid >> 2)) * 32 + 8 + 4 * (F.tid & 3));
        { u32x4 vv[3];
#pragma unroll
          for (int i = 0; i < 3; ++i) { const int e = F.tid + 512 * i, row = e / 24, ch = e % 24; vv[i] = *(const u32x4*)(F.proj + (size_t)(t0 + row) * PW + C_CV + h * 192 + ch * 8); }
          asm volatile("" : "+v"(vv[0]), "+v"(vv[1]), "+v"(vv[2]));
#pragma unroll
          for (int i = 0; i < 3; ++i) { const int e = F.tid + 512 * i, row = e / 24, ch = e % 24; *(u32x4*)(VV + row * 400 + ch * 16) = vv[i]; } }
        __syncthreads();
        const int d = F.tid % 96, tg = F.tid / 96;
        float bc[16];
        if (F.tid < 384) { float g[16];
#pragma unroll
            for (int r = 0; r < 16; ++r) g[r] = gup[r * 384 + h * 96 + d];
            const float gb = gbs[h * 96 + d]; float run = 0.f;
#pragma unroll
            for (int i = 0; i < 16; ++i) { const float* cr = CR + (16 * tg + i) * 16; float a = gb;
#pragma unroll
                for (int r4 = 0; r4 < 4; ++r4) { const f32x4 c = *(const f32x4*)(cr + 4 * r4); a += c.x * g[4 * r4] + c.y * g[4 * r4 + 1] + c.z * g[4 * r4 + 2] + c.w * g[4 * r4 + 3]; }
                const float ls = fminf(a, 0.f) - __logf(1.f + __expf(-fabsf(a)));
                run += ls * (1.f / 16.f); bc[i] = run; }
            GT[tg * 96 + d] = run; }
        __syncthreads();
        if (F.tid < 384) { const float g0 = GT[d], g1 = GT[96 + d], g2 = GT[192 + d], g3 = GT[288 + d];
            const float pre = (tg > 0 ? g0 : 0.f) + (tg > 1 ? g1 : 0.f) + (tg > 2 ? g2 : 0.f);
            const float bm = g0 + g1, bl = (g0 + g1) + (g2 + g3);
            bf16* qp = F.proj + (size_t)(t0 + 16 * tg) * PW + C_CQ + h * 96 + d; bf16* kp = F.proj + (size_t)(t0 + 16 * tg) * PW + C_CK + h * 96 + d;
            float qv[16], kv[16]; unsigned qr[16], kr[16];
#pragma unroll
            for (int i = 0; i < 16; ++i) { qr[i] = qp[(size_t)i * PW]; kr[i] = kp[(size_t)i * PW]; }
#pragma unroll
            for (int i = 0; i < 16; i += 4) { asm volatile("" : "+v"(qr[i]), "+v"(qr[i + 1]), "+v"(qr[i + 2]), "+v"(qr[i + 3])); asm volatile("" : "+v"(kr[i]), "+v"(kr[i + 1]), "+v"(kr[i + 2]), "+v"(kr[i + 3])); }
#pragma unroll
            for (int i = 0; i < 16; ++i) { qv[i] = bf2f(qr[i]); kv[i] = bf2f(kr[i]); }
#pragma unroll
            for (int i = 0; i < 16; ++i) { const float b = bc[i] + pre; const float eq = __expf(b - bm), ek = __expf(bm - b), eh = __expf(bl - b);
                qp[(size_t)i * PW] = (bf16)(pk2(qv[i] * eq, 0.f) & 0xffffu); kp[(size_t)i * PW] = (bf16)(pk2(kv[i] * ek, 0.f) & 0xffffu);
                *(bf16*)(KH + (16 * tg + i) * 208 + d * 2) = (bf16)(pk2(kv[i] * eh, 0.f) & 0xffffu); }
            if (tg == 0) { F.dec[(n * 4 + h) * 96 + d] = __expf(bl); F.dec[49152 + (n * 4 + h) * 96 + d] = __expf(bm); } }
        __syncthreads();
        for (int id = F.wave; id < 18; id += 8) { const int vt = id / 3, dt = id % 3; f32x16 acc = {};
#pragma unroll
            for (int s = 0; s < 4; ++s) { const bf16x8 a = frag_tr((lds_cptr)VV, 400, 16 * s, 32 * vt, F.lane), b = frag_tr((lds_cptr)KH, 208, 16 * s, 32 * dt, F.lane); acc = MFMA32(a, b, acc); }
            float* dst = F.ds + ((size_t)(n * 4 + h) * 192 + 32 * vt) * 96 + 32 * dt + (F.lane & 31);
#pragma unroll
            for (int r = 0; r < 16; ++r) dst[(size_t)rowidx(r, F.lane >> 5) * 96] = acc[r]; }
        __syncthreads(); } }
}
__device__ __forceinline__ float softmax_ref2(const float* gq, const float* gk) {
    float mq = 0.f, mk = 0.f;
    for (int i = 0; i < 64; ++i) { mq = fmaxf(mq, fabsf(gq[i])); mk = fmaxf(mk, fabsf(gk[i])); }
    return 8.25f * mq * mk * LOG2E;
}
__device__ __forceinline__ void scan_item(Ctx& F, int si) {
    const int p = si * 512 + F.tid, d = 2 * (p % 48), v = (p / 48) % 192, h = p / (48 * 192);
    float s0 = 0.f, s1 = 0.f;
    for (int nb = 0; nb < 128; nb += 8) { f32x2 dd[8], a[8], em[8];
#pragma unroll
        for (int j = 0; j < 8; ++j) { const int n = nb + j; const size_t idx = ((size_t)(n * 4 + h) * 192 + v) * 96 + d; const int di = (n * 4 + h) * 96 + d;
            dd[j] = *(const f32x2*)(F.ds + idx); a[j] = *(const f32x2*)(F.dec + di); em[j] = *(const f32x2*)(F.dec + 49152 + di); }
#pragma unroll
        for (int j = 0; j < 8; j += 4) { asm volatile("" : "+v"(dd[j]), "+v"(dd[j + 1]), "+v"(dd[j + 2]), "+v"(dd[j + 3])); asm volatile("" : "+v"(a[j]), "+v"(a[j + 1]), "+v"(a[j + 2]), "+v"(a[j + 3])); asm volatile("" : "+v"(em[j]), "+v"(em[j + 1]), "+v"(em[j + 2]), "+v"(em[j + 3])); }
#pragma unroll
        for (int j = 0; j < 8; ++j) { const int n = nb + j; const size_t idx = ((size_t)(n * 4 + h) * 192 + v) * 96 + d;
            *(unsigned*)(F.st + idx) = pk2(em[j].x * s0, em[j].y * s1);
            s0 = a[j].x * s0 + dd[j].x; s1 = a[j].y * s1 + dd[j].y; } }
}
#define PIN4(a, b, c, d) asm volatile("" : "+v"(a), "+v"(b), "+v"(c), "+v"(d))
#define SBAR0() __builtin_amdgcn_sched_barrier(0)
template <int KSTR, int VSTR>
__device__ __forceinline__ void attn_sub(const unsigned char* Kt, const unsigned char* Vt, int key_row0, const bf16x8 (&qf)[4], f32x16 S, f32x16 (&o)[2], float& lsum, int lane,
                                         bool use_mask, int lo, int hi_) {
    const int r = lane & 31, hh = lane >> 5;
    bf16x8 kf[4];
#pragma unroll
    for (int s = 0; s < 4; ++s) kf[s] = *(const bf16x8*)(Kt + (key_row0 + r) * KSTR + (16 * s + 8 * hh) * 2);
    bf16x8 vf[2][2];
#pragma unroll
    for (int dt = 0; dt < 2; ++dt) { vf[dt][0] = frag_tr((lds_cptr)Vt, VSTR, key_row0, 32 * dt, lane); vf[dt][1] = frag_tr((lds_cptr)Vt, VSTR, key_row0 + 16, 32 * dt, lane); }
    PIN4(kf[0], kf[1], kf[2], kf[3]);
#pragma unroll
    for (int s = 0; s < 4; ++s) S = MFMA32(kf[s], qf[s], S);
    if (use_mask) {
#pragma unroll
        for (int g = 0; g < 16; ++g) { const int k = rowidx(g, hh); if (k < lo || k > hi_) S[g] = -INFINITY; } }
    float acc = 0.f;
#pragma unroll
    for (int g = 0; g < 16; ++g) { S[g] = __builtin_amdgcn_exp2f(S[g]); acc += S[g]; }
    lsum += acc;
    bf16x8 p0, p1; pack_p(S, p0, p1);
    PIN4(vf[0][0], vf[0][1], vf[1][0], vf[1][1]);
#pragma unroll
    for (int dt = 0; dt < 2; ++dt) { o[dt] = MFMA32(vf[dt][0], p0, o[dt]); o[dt] = MFMA32(vf[dt][1], p1, o[dt]); }
}
template <int NSUB, int KSTR, int VSTR>
__device__ __forceinline__ void attn_multi(const unsigned char* Kt, const unsigned char* Vt, int key_row0, const bf16x8 (&qf)[4], f32x16 (&S)[NSUB], f32x16 (&o)[2], float& lsum, int lane) {
    const int r = lane & 31, hh = lane >> 5;
    bf16x8 kf[NSUB][4];
#pragma unroll
    for (int u = 0; u < NSUB; ++u)
#pragma unroll
        for (int s = 0; s < 4; ++s) kf[u][s] = *(const bf16x8*)(Kt + (key_row0 + 32 * u + r) * KSTR + (16 * s + 8 * hh) * 2);
#pragma unroll
    for (int u = 0; u < NSUB; ++u) PIN4(kf[u][0], kf[u][1], kf[u][2], kf[u][3]);
#pragma unroll
    for (int s = 0; s < 4; ++s)
#pragma unroll
        for (int u = 0; u < NSUB; ++u) S[u] = MFMA32(kf[u][s], qf[s], S[u]);
#pragma unroll
    for (int u = 0; u < NSUB; ++u) {
        bf16x8 vf[2][2];
#pragma unroll
        for (int dt = 0; dt < 2; ++dt) { vf[dt][0] = frag_tr((lds_cptr)Vt, VSTR, key_row0 + 32 * u, 32 * dt, lane); vf[dt][1] = frag_tr((lds_cptr)Vt, VSTR, key_row0 + 32 * u + 16, 32 * dt, lane); }
        SBAR0();
        float acc = 0.f;
#pragma unroll
        for (int g = 0; g < 16; ++g) { S[u][g] = __builtin_amdgcn_exp2f(S[u][g]); acc += S[u][g]; }
        lsum += acc;
        bf16x8 p0, p1; pack_p(S[u], p0, p1);
        PIN4(vf[0][0], vf[0][1], vf[1][0], vf[1][1]);
#pragma unroll
        for (int dt = 0; dt < 2; ++dt) { o[dt] = MFMA32(vf[dt][0], p0, o[dt]); o[dt] = MFMA32(vf[dt][1], p1, o[dt]); } }
}
__device__ __forceinline__ void fox_unit(Ctx& F, int l, int h, int qb, int seg) {
    constexpr int KS = 144, VS = 192, BUFB = 128 * KS, BUFV = 128 * VS;
    unsigned char* KT = F.lds; unsigned char* VT = F.lds + 2 * BUFB; float* CS = (float*)(F.lds + 2 * BUFB + 2 * BUFV);
    const float* PEX = (const float*)(F.lds + P3_EXT) + h * 64;
    const int r = F.lane & 31, hh = F.lane >> 5, w = F.wave, t0 = 256 * qb, NT = 2 * qb + 2;
    const int kfirst = __builtin_amdgcn_readfirstlane(((const int*)(F.lds + P3_EXT + 2048))[h * 32 + qb]);
    const int nuse = (NT - kfirst + 15) >> 4;
    if (seg >= nuse) return;
    const int kt0 = kfirst + 16 * seg, te = (kt0 + 16 < NT) ? kt0 + 16 : NT;
    const float mb2 = ((const float*)(F.lds + P3_EXT + 3072))[1];
    const int tq = t0 + 32 * w + r; const float pq0 = PEX[t0 >> 7];
    const float ctq = ((PEX[tq >> 7] - pq0) + F.cl[tq * 8 + h]) * LOG2E - mb2;
    bf16x8 qf[4];
#pragma unroll
    for (int s = 0; s < 4; ++s) qf[s] = *(const bf16x8*)(F.proj + (size_t)tq * PW + C_BQ + h * 64 + 16 * s + 8 * hh);
    f32x16 o[2]; o[0] = f32x16{}; o[1] = f32x16{}; float lsum = 0.f;
    const int lrow = F.tid >> 3, lch = F.tid & 7;
    u32x4 kreg[2], vreg[2]; float creg = 0.f;
    if (kt0 < te) {
#pragma unroll
        for (int i = 0; i < 2; ++i) { const size_t g = (size_t)(128 * kt0 + 64 * i + lrow) * PW + h * 64 + lch * 8; kreg[i] = *(const u32x4*)(F.proj + g + C_BK); vreg[i] = *(const u32x4*)(F.proj + g + C_BV); }
        if (F.tid < 128) creg = ((PEX[kt0] - pq0) + F.cl[(128 * kt0 + F.tid) * 8 + h]) * LOG2E; }
    for (int kt = kt0; kt < te; ++kt) { const int buf = (kt - kt0) & 1;
#pragma unroll
        for (int i = 0; i < 2; ++i) { *(u32x4*)(KT + buf * BUFB + (64 * i + lrow) * KS + lch * 16) = kreg[i]; *(u32x4*)(VT + buf * BUFV + (64 * i + lrow) * VS + lch * 16) = vreg[i]; }
        if (F.tid < 128) CS[buf * 128 + F.tid] = creg;
        __syncthreads();
        if (kt + 1 < te) {
#pragma unroll
            for (int i = 0; i < 2; ++i) { const size_t g = (size_t)(128 * (kt + 1) + 64 * i + lrow) * PW + h * 64 + lch * 8; kreg[i] = *(const u32x4*)(F.proj + g + C_BK); vreg[i] = *(const u32x4*)(F.proj + g + C_BV); }
            if (F.tid < 128) creg = ((PEX[kt + 1] - pq0) + F.cl[(128 * (kt + 1) + F.tid) * 8 + h]) * LOG2E; }
        const unsigned char* Kb = KT + buf * BUFB; const unsigned char* Vb = VT + buf * BUFV; const float* Cb = CS + buf * 128;
        if (kt < 2 * qb) {
#pragma unroll
            for (int hf = 0; hf < 2; ++hf) { f32x16 S[2]; f32x4 c4[2][4];
#pragma unroll
                for (int u = 0; u < 2; ++u)
#pragma unroll
                    for (int i = 0; i < 4; ++i) c4[u][i] = *(const f32x4*)(Cb + 64 * hf + 32 * u + 8 * i + 4 * hh);
                PIN4(c4[0][0], c4[0][1], c4[0][2], c4[0][3]); PIN4(c4[1][0], c4[1][1], c4[1][2], c4[1][3]);
#pragma unroll
                for (int u = 0; u < 2; ++u)
#pragma unroll
                    for (int i = 0; i < 4; ++i) { S[u][4 * i] = ctq - c4[u][i].x; S[u][4 * i + 1] = ctq - c4[u][i].y; S[u][4 * i + 2] = ctq - c4[u][i].z; S[u][4 * i + 3] = ctq - c4[u][i].w; }
                attn_multi<2, KS, VS>(Kb, Vb, 64 * hf, qf, S, o, lsum, F.lane); }
        } else {
            const int qlo = t0 + 32 * w;
#pragma unroll
            for (int sub = 0; sub < 4; ++sub) { const int key0 = 128 * kt + 32 * sub;
                if (key0 <= qlo + 31) {
                    f32x16 S;
#pragma unroll
                    for (int i = 0; i < 4; ++i) { const f32x4 c4 = *(const f32x4*)(Cb + 32 * sub + 8 * i + 4 * hh); S[4 * i] = ctq - c4.x; S[4 * i + 1] = ctq - c4.y; S[4 * i + 2] = ctq - c4.z; S[4 * i + 3] = ctq - c4.w; }
                    attn_sub<KS, VS>(Kb, Vb, 32 * sub, qf, S, o, lsum, F.lane, key0 + 31 > qlo, 0, tq - key0); } }
        }
    }
    lsum += __shfl_xor(lsum, 32);
    float* ob = F.ob + ((size_t)seg * SEQ + tq) * 512 + h * 64 + 4 * hh;
#pragma unroll
    for (int dt = 0; dt < 2; ++dt)
#pragma unroll
        for (int i = 0; i < 4; ++i) *(f32x4*)(ob + 32 * dt + 8 * i) = (f32x4){o[dt][4 * i], o[dt][4 * i + 1], o[dt][4 * i + 2], o[dt][4 * i + 3]};
    if (hh == 0) F.lb[((size_t)seg * SEQ + tq) * 8 + h] = lsum;
    __syncthreads();
}
__device__ __forceinline__ void a_unit(Ctx& F, int l, int a, int n, int rres, int b2) {
    constexpr int KS = 144, VS = 192;
    unsigned char* KA = F.lds; unsigned char* VA = F.lds + 384 * KS;
    const int r = F.lane & 31, hh = F.lane >> 5, w = F.wave, d = (n == 0) ? 1 : (n == 1) ? 4 : 16, i0 = 256 * b2;
    { u32x4 kv[6], vv[6]; const int ch = F.tid & 7;
#pragma unroll
      for (int i = 0; i < 6; ++i) { const int j = (F.tid >> 3) + 64 * i, idx = i0 - 128 + j; kv[i] = (u32x4){0u, 0u, 0u, 0u}; vv[i] = (u32x4){0u, 0u, 0u, 0u};
          if (idx >= 0) { const size_t g = (size_t)(rres + d * idx) * PW + a * 64 + ch * 8; kv[i] = *(const u32x4*)(F.proj + g + C_AK); vv[i] = *(const u32x4*)(F.proj + g + C_AV); } }
      asm volatile("" : "+v"(kv[0]), "+v"(kv[1]), "+v"(kv[2]), "+v"(kv[3]), "+v"(kv[4]), "+v"(kv[5]));
      asm volatile("" : "+v"(vv[0]), "+v"(vv[1]), "+v"(vv[2]), "+v"(vv[3]), "+v"(vv[4]), "+v"(vv[5]));
#pragma unroll
      for (int i = 0; i < 6; ++i) { const int j = (F.tid >> 3) + 64 * i; *(u32x4*)(KA + j * KS + ch * 16) = kv[i]; *(u32x4*)(VA + j * VS + ch * 16) = vv[i]; } }
    const int tokq = rres + d * (i0 + 32 * w + r);
    bf16x8 qf[4];
#pragma unroll
    for (int s = 0; s < 4; ++s) qf[s] = *(const bf16x8*)(F.proj + (size_t)tokq * PW + C_AQ + a * 64 + 16 * s + 8 * hh);
    const float mb2 = ((const float*)(F.lds + P3_EXT + 3072))[0];
    __syncthreads();
    f32x16 o[2]; o[0] = f32x16{}; o[1] = f32x16{}; float lsum = 0.f;
    const int qj = 32 * w + r + 128;
    if (i0 != 0) {
        { f32x16 S;
#pragma unroll
          for (int g = 0; g < 16; ++g) S[g] = -mb2;
          attn_sub<KS, VS>(KA, VA, 32 * w, qf, S, o, lsum, F.lane, true, qj - 128 - 32 * w, 31); }
        { f32x16 S[3];
#pragma unroll
          for (int u = 0; u < 3; ++u)
#pragma unroll
              for (int g = 0; g < 16; ++g) S[u][g] = -mb2;
          attn_multi<3, KS, VS>(KA, VA, 32 * (w + 1), qf, S, o, lsum, F.lane); }
        { f32x16 S;
#pragma unroll
          for (int g = 0; g < 16; ++g) S[g] = -mb2;
          attn_sub<KS, VS>(KA, VA, 32 * (w + 4), qf, S, o, lsum, F.lane, true, 0, qj - 32 * (w + 4)); }
    } else
    for (int jt = w; jt < w + 5; ++jt) { const int j0 = 32 * jt;
        if (j0 + 31 < 128) continue;
        f32x16 S;
#pragma unroll
        for (int g = 0; g < 16; ++g) S[g] = -mb2;
        int lo = qj - 128 - j0; const int hi_ = qj - j0; if (128 - j0 > lo) lo = 128 - j0;
        attn_sub<KS, VS>(KA, VA, j0, qf, S, o, lsum, F.lane, true, lo, hi_); }
    lsum += __shfl_xor(lsum, 32);
    bf16* oa = F.oa + ((size_t)n * SEQ + tokq) * 768 + a * 64 + 4 * hh;
#pragma unroll
    for (int dt = 0; dt < 2; ++dt)
#pragma unroll
        for (int i = 0; i < 4; ++i) { u32x2 wv; wv.x = pk2(o[dt][4 * i], o[dt][4 * i + 1]); wv.y = pk2(o[dt][4 * i + 2], o[dt][4 * i + 3]); *(u32x2*)(oa + 32 * dt + 8 * i) = wv; }
    if (hh == 0) F.la[((size_t)n * SEQ + tokq) * 12 + a] = lsum;
    __syncthreads();
}
__device__ __forceinline__ void phase3(Ctx& F, int l) {
    volatile unsigned* slot = (volatile unsigned*)(F.lds + QSLOT_OFF);
    { float* PEXA = (float*)(F.lds + P3_EXT); int* KFT = (int*)(F.lds + P3_EXT + 2048); float* MB = (float*)(F.lds + P3_EXT + 3072);
      { const float v = F.bt[F.lane * 8 + F.wave]; float sc = v;
#pragma unroll
        for (int o = 1; o < 64; o <<= 1) { const float y = __shfl_up(sc, o); if (F.lane >= o) sc += y; }
        PEXA[F.wave * 64 + F.lane] = sc - v; }
      if (F.tid == 0) { MB[0] = softmax_ref2(F.aqg + l * 64, F.akg + l * 64); MB[1] = softmax_ref2(F.bqg + l * 64, F.bkg + l * 64); }
      __syncthreads();
      if (F.tid < 256) { const int h = F.tid >> 5, qb = F.tid & 31; const float thr = -(26.f + 2.f * MB[1] * (1.f / LOG2E)), pq0 = PEXA[h * 64 + 2 * qb];
          int kt = 0; while (kt < 2 * qb && (pq0 - PEXA[h * 64 + kt + 1]) < thr) ++kt;
          KFT[F.tid] = kt; if (F.bid == 0) F.ctl[8192 + F.tid] = (unsigned)kt; }
      __syncthreads(); }
    for (;;) {
        if (F.tid == 0) *slot = atomicAdd(F.ctl + l, 1u);
        __syncthreads();
        const int item = __builtin_amdgcn_readfirstlane((int)*slot);
        __syncthreads();
        if (item >= N_ITEMS) break;
        if (item < N_SCAN) scan_item(F, item);
        else if (item < N_SCAN + N_FOX) { int f = item - N_SCAN, ns, qhi;
            if (f < 256) { ns = 4; qhi = 31; } else if (f < 448) { f -= 256; ns = 3; qhi = 23; } else if (f < 576) { f -= 448; ns = 2; qhi = 15; } else { f -= 576; ns = 1; qhi = 7; }
            const int per = ns * 8, qb = qhi - f / per, rem = f % per;
            fox_unit(F, l, rem & 7, qb, rem >> 3); }
        else { const int au = item - N_SCAN - N_FOX, n = au / 384, rest = au % 384, a = rest >> 5, u = rest & 31;
            const int per = (n == 0) ? 32 : (n == 1) ? 8 : 2;
            a_unit(F, l, a, n, u / per, u % per); }
    }
}
#define PIN6(a) asm volatile("" : "+v"(a[0]), "+v"(a[1]), "+v"(a[2]), "+v"(a[3]), "+v"(a[4]), "+v"(a[5]))
__device__ __forceinline__ void phase4(Ctx& F, int l) {
    unsigned char* VV = F.lds;
    float* SSQ = (float*)(F.lds + 51200);
    const int r = F.lane & 31, hh = F.lane >> 5, w = F.wave, ui = w >> 2, th = (w >> 1) & 1, vh = w & 1;
    const float* gain = F.out_gain + l * 192;
    for (int pu = F.bid; pu < 256; pu += F.G) {
        const int u = 2 * pu + ui, h = u & 3, n = u >> 2, t0 = n * 64, tq = th * 32 + r;
        bf16x8 qf[6], kf0[6], kf1[6], sfa[6], sfb[6];
        const bf16* stb = F.st + ((size_t)(n * 4 + h) * 192 + 32 * (vh * 3) + r) * 96 + 8 * hh;
#pragma unroll
        for (int kd = 0; kd < 6; ++kd) { qf[kd] = *(const bf16x8*)(F.proj + (size_t)(t0 + tq) * PW + C_CQ + h * 96 + 16 * kd + 8 * hh);
            kf0[kd] = *(const bf16x8*)(F.proj + (size_t)(t0 + r) * PW + C_CK + h * 96 + 16 * kd + 8 * hh);
            kf1[kd] = *(const bf16x8*)(F.proj + (size_t)(t0 + 32 + r) * PW + C_CK + h * 96 + 16 * kd + 8 * hh);
            sfa[kd] = *(const bf16x8*)(stb + 16 * kd); }
        { u32x4 vv[6];
#pragma unroll
          for (int i = 0; i < 6; ++i) { const int e = F.tid + 512 * i, uu = e / 1536, e2 = e % 1536, row = e2 / 24, ch = e2 % 24, u2 = 2 * pu + uu, h2 = u2 & 3, n2 = u2 >> 2;
              vv[i] = *(const u32x4*)(F.proj + (size_t)(n2 * 64 + row) * PW + C_CV + h2 * 192 + ch * 8); }
          asm volatile("" : "+v"(vv[0]), "+v"(vv[1]), "+v"(vv[2]), "+v"(vv[3]), "+v"(vv[4]), "+v"(vv[5]));
#pragma unroll
          for (int i = 0; i < 6; ++i) { const int e = F.tid + 512 * i, uu = e / 1536, e2 = e % 1536, row = e2 / 24, ch = e2 % 24; *(u32x4*)(VV + uu * 25600 + row * 400 + ch * 16) = vv[i]; } }
        __syncthreads();
        PIN6(qf); PIN6(kf0); PIN6(kf1);
        bf16x8 pf[2][2];
        { f32x16 X = {};
#pragma unroll
          for (int kd = 0; kd < 6; ++kd) X = MFMA32(kf0[kd], qf[kd], X);
          if (th == 0) {
#pragma unroll
              for (int g = 0; g < 16; ++g) if (rowidx(g, hh) > r) X[g] = 0.f; }
          pack_p(X, pf[0][0], pf[0][1]); }
        if (th == 1) { f32x16 X = {};
#pragma unroll
          for (int kd = 0; kd < 6; ++kd) X = MFMA32(kf1[kd], qf[kd], X);
#pragma unroll
          for (int g = 0; g < 16; ++g) if (rowidx(g, hh) > r) X[g] = 0.f;
          pack_p(X, pf[1][0], pf[1][1]); }
        f32x16 O[3]; float sq = 0.f;
#pragma unroll
        for (int vt = 0; vt < 3; ++vt) { const int vtile = vh * 3 + vt; f32x16 acc = {};
            if (vt == 0) {
#pragma unroll
                for (int kd = 0; kd < 6; ++kd) sfb[kd] = *(const bf16x8*)(stb + (size_t)32 * 96 + 16 * kd); }
            if (vt == 1) {
#pragma unroll
                for (int kd = 0; kd < 6; ++kd) sfa[kd] = *(const bf16x8*)(stb + (size_t)64 * 96 + 16 * kd); }
#pragma unroll
            for (int si = 0; si < 2; ++si) if (si <= th) {
#pragma unroll
                for (int s2 = 0; s2 < 2; ++s2) { const bf16x8 vf = frag_tr((lds_cptr)(VV + ui * 25600), 400, 32 * si + 16 * s2, 32 * vtile, F.lane); acc = MFMA32(vf, pf[si][s2], acc); } }
            if (vt == 1) { PIN6(sfb);
#pragma unroll
                for (int kd = 0; kd < 6; ++kd) acc = MFMA32(sfb[kd], qf[kd], acc); }
            else { PIN6(sfa);
#pragma unroll
                for (int kd = 0; kd < 6; ++kd) acc = MFMA32(sfa[kd], qf[kd], acc); }
#pragma unroll
            for (int g = 0; g < 16; ++g) sq += acc[g] * acc[g];
            O[vt] = acc; }
        u32x2 zw[3][4]; f32x4 gg[3][4];
#pragma unroll
        for (int vt = 0; vt < 3; ++vt)
#pragma unroll
            for (int i = 0; i < 4; ++i) { const int v = 32 * (vh * 3 + vt) + 8 * i + 4 * hh;
                zw[vt][i] = *(const u32x2*)(F.proj + (size_t)(t0 + tq) * PW + C_CZ + h * 192 + v); gg[vt][i] = *(const f32x4*)(gain + v); }
        sq += __shfl_xor(sq, 32);
        if (hh == 0) SSQ[(ui * 2 + vh) * 64 + tq] = sq;
        __syncthreads();
        const float rs = rsqrtf((SSQ[(ui * 2) * 64 + tq] + SSQ[(ui * 2 + 1) * 64 + tq]) * (1.f / 192.f) + EPS);
#pragma unroll
        for (int vt = 0; vt < 3; ++vt) { PIN4(zw[vt][0], zw[vt][1], zw[vt][2], zw[vt][3]);
#pragma unroll
            for (int i = 0; i < 4; ++i) { const int v = 32 * (vh * 3 + vt) + 8 * i + 4 * hh; const u32x2 z = zw[vt][i]; const f32x4 g4 = gg[vt][i];
                const float y0 = O[vt][4 * i] * rs * g4.x * silu(blo(z.x)), y1 = O[vt][4 * i + 1] * rs * g4.y * silu(bhi(z.x)), y2 = O[vt][4 * i + 2] * rs * g4.z * silu(blo(z.y)), y3 = O[vt][4 * i + 3] * rs * g4.w * silu(bhi(z.y));
                u32x2 ov; ov.x = pk2(y0, y1); ov.y = pk2(y2, y3); *(u32x2*)(F.mixed + (size_t)(t0 + tq) * DM + 1280 + h * 192 + v) = ov; } }
        __syncthreads();
    }
    const int NT = F.G * 512, gt = F.bid * 512 + F.tid;
    for (int idx0 = gt; idx0 < SEQ * 96; idx0 += 2 * NT) {
        u32x4 wv[2][3], zw[2]; float la[2][3]; int tt[2], cc[2]; bool ok[2];
#pragma unroll
        for (int j = 0; j < 2; ++j) { const int idx = idx0 + j * NT; ok[j] = idx < SEQ * 96; const int id2 = ok[j] ? idx : gt; const int t = id2 / 96, c = (id2 % 96) * 8, a = c >> 6; tt[j] = t; cc[j] = c;
#pragma unroll
            for (int n = 0; n < 3; ++n) { wv[j][n] = *(const u32x4*)(F.oa + ((size_t)n * SEQ + t) * 768 + c); la[j][n] = F.la[((size_t)n * SEQ + t) * 12 + a]; }
            zw[j] = *(const u32x4*)(F.proj + (size_t)t * PW + C_AZ + c); }
        PIN4(wv[0][0], wv[0][1], wv[0][2], zw[0]); PIN4(wv[1][0], wv[1][1], wv[1][2], zw[1]);
#pragma unroll
        for (int j = 0; j < 2; ++j) { float o[8] = {0.f, 0.f, 0.f, 0.f, 0.f, 0.f, 0.f, 0.f};
#pragma unroll
            for (int n = 0; n < 3; ++n) { const u32x4 x = wv[j][n]; o[0] += blo(x.x); o[1] += bhi(x.x); o[2] += blo(x.y); o[3] += bhi(x.y); o[4] += blo(x.z); o[5] += bhi(x.z); o[6] += blo(x.w); o[7] += bhi(x.w); }
            const float il = 1.f / ((la[j][0] + la[j][1]) + la[j][2]); const u32x4 z = zw[j];
            u32x4 ov; ov.x = pk2(o[0] * il * silu(blo(z.x)), o[1] * il * silu(bhi(z.x))); ov.y = pk2(o[2] * il * silu(blo(z.y)), o[3] * il * silu(bhi(z.y)));
            ov.z = pk2(o[4] * il * silu(blo(z.z)), o[5] * il * silu(bhi(z.z))); ov.w = pk2(o[6] * il * silu(blo(z.w)), o[7] * il * silu(bhi(z.w)));
            if (ok[j]) *(u32x4*)(F.mixed + (size_t)tt[j] * DM + cc[j]) = ov; } }
    for (int idx0 = gt; idx0 < SEQ * 64; idx0 += 2 * NT) {
        f32x4 a0[2][4], a1[2][4]; float lv[2][4]; u32x4 zw[2]; int tt[2], cc[2], ns[2]; bool ok[2];
#pragma unroll
        for (int j = 0; j < 2; ++j) { const int idx = idx0 + j * NT; ok[j] = idx < SEQ * 64; const int id2 = ok[j] ? idx : gt; const int t = id2 / 64, c = (id2 % 64) * 8, h = c >> 6; tt[j] = t; cc[j] = c;
            ns[j] = (2 * (t >> 8) + 2 - (int)F.ctl[8192 + h * 32 + (t >> 8)] + 15) >> 4;
#pragma unroll
            for (int sg = 0; sg < 4; ++sg) { a0[j][sg] = (f32x4){0.f, 0.f, 0.f, 0.f}; a1[j][sg] = (f32x4){0.f, 0.f, 0.f, 0.f}; lv[j][sg] = 0.f;
                if (sg < ns[j]) { const float* p = F.ob + ((size_t)sg * SEQ + t) * 512 + c; a0[j][sg] = *(const f32x4*)p; a1[j][sg] = *(const f32x4*)(p + 4); lv[j][sg] = F.lb[((size_t)sg * SEQ + t) * 8 + h]; } }
            zw[j] = *(const u32x4*)(F.proj + (size_t)t * PW + C_BZ + c); }
#pragma unroll
        for (int j = 0; j < 2; ++j) { const f32x4 o0 = (a0[j][0] + a0[j][1]) + (a0[j][2] + a0[j][3]), o1 = (a1[j][0] + a1[j][1]) + (a1[j][2] + a1[j][3]);
            const float il = 1.f / ((lv[j][0] + lv[j][1]) + (lv[j][2] + lv[j][3])); const u32x4 z = zw[j];
            u32x4 ov; ov.x = pk2(o0.x * il * silu(blo(z.x)), o0.y * il * silu(bhi(z.x))); ov.y = pk2(o0.z * il * silu(blo(z.y)), o0.w * il * silu(bhi(z.y)));
            ov.z = pk2(o1.x * il * silu(blo(z.z)), o1.y * il * silu(bhi(z.z))); ov.w = pk2(o1.z * il * silu(blo(z.w)), o1.w * il * silu(bhi(z.w)));
            if (ok[j]) *(u32x4*)(F.mixed + (size_t)tt[j] * DM + 768 + cc[j]) = ov; } }
}

#define LAS __attribute__((address_space(3)))
#define XB_TMO      128
#define XB_XCNT(j)  (256  + 64 * (j))
#define XB_XSUB(j)  (1280 + 64 * (j))
#define XB_XGEN(j)  (2304 + 64 * (j))
#define XB_TOP      3328
#define XB_TOPGEN   3392
#define XCD_BAR_WORDS 3456
#define XB_SPIN_CAP (1u << 18)

__device__ __forceinline__ unsigned xb_ld(unsigned* p)              { return __hip_atomic_load(p, __ATOMIC_RELAXED, __HIP_MEMORY_SCOPE_AGENT); }
__device__ __forceinline__ unsigned xb_add(unsigned* p, unsigned v) { return __hip_atomic_fetch_add(p, v, __ATOMIC_RELAXED, __HIP_MEMORY_SCOPE_AGENT); }
__device__ __forceinline__ unsigned xb_xcc_id() { return (unsigned)__builtin_amdgcn_s_getreg((3 << 11) | 20) & 0xFu; }
#define XB_SPIN(cond, bar) do { unsigned _sp = 0; while (cond) { __builtin_amdgcn_s_sleep(1); \
    if ((++_sp & 255u) == 0u) { if (xb_ld(&(bar)[XB_TMO])) break; if (_sp > XB_SPIN_CAP) { atomicAdd(&(bar)[XB_TMO], 1u); break; } } } } while (0)

struct XcdBarrier {
    unsigned* bar; unsigned x;
    volatile LAS unsigned* st;
};

__device__ __forceinline__ XcdBarrier xcd_barrier_post(unsigned* bar, volatile LAS unsigned* st) {
    XcdBarrier b; b.bar = bar; b.x = xb_xcc_id(); b.st = st;
    if (threadIdx.x == 0) (void)xb_add(&bar[XB_XCNT(b.x)], 1u);
    return b;
}
__device__ __forceinline__ void xcd_barrier_complete(unsigned* bar, unsigned x, unsigned& nloc, unsigned& nx) {
    const unsigned G = gridDim.x * gridDim.y * gridDim.z;
    unsigned sum, cnt, mine, sp = 0u;
    for (;;) {
        sum = 0u; cnt = 0u; mine = 0u;
#pragma unroll
        for (unsigned j = 0; j < 16; ++j) { const unsigned c = xb_ld(&bar[XB_XCNT(j)]); sum += c; cnt += (c > 0u) ? 1u : 0u; mine = (j == x) ? c : mine; }
        if (sum == G) break;
        __builtin_amdgcn_s_sleep(1);
        if ((++sp & 255u) == 0u) { if (xb_ld(&bar[XB_TMO])) break; if (sp > XB_SPIN_CAP) { atomicAdd(&bar[XB_TMO], 1u); break; } }
    }
    nloc = mine > 0u ? mine : 1u; nx = cnt > 0u ? cnt : 1u;
}

__device__ __forceinline__ void xcd_barrier(const XcdBarrier& b) {
    asm volatile("s_waitcnt vmcnt(0)" ::: "memory");
    __syncthreads();
    if (threadIdx.x == 0) {
        unsigned* bar = b.bar;
        __builtin_amdgcn_s_waitcnt(0);
        unsigned nloc = b.st[0], nx = b.st[1];
        if (nloc == 0u) { xcd_barrier_complete(bar, b.x, nloc, nx); b.st[0] = nloc; b.st[1] = nx; }
        const unsigned old = xb_add(&bar[XB_XSUB(b.x)], 1u);
        const unsigned gen = old / nloc;
        if (old + 1u == (gen + 1u) * nloc) {
            __builtin_amdgcn_fence(__ATOMIC_RELEASE, "agent");
            asm volatile("s_waitcnt vmcnt(0)" ::: "memory");
            const unsigned og = xb_add(&bar[XB_TOP], 1u);
            const unsigned tg = og / nx;
            if (og + 1u == (tg + 1u) * nx) xb_add(&bar[XB_TOPGEN], 1u);
            else XB_SPIN(xb_ld(&bar[XB_TOPGEN]) == tg, bar);
            __builtin_amdgcn_fence(__ATOMIC_ACQUIRE, "agent");
            xb_add(&bar[XB_XGEN(b.x)], 1u);
            asm volatile("s_waitcnt vmcnt(0)" ::: "memory");
        } else {
            XB_SPIN(xb_ld(&bar[XB_XGEN(b.x)]) == gen, bar);
            __builtin_amdgcn_fence(__ATOMIC_ACQUIRE, "agent");
            asm volatile("s_waitcnt vmcnt(0)" ::: "memory");
        }
    }
    __syncthreads();
}

struct Args { const float* in[12]; float* out; unsigned char* ws; int ph_lo, ph_hi; };
constexpr int N_PHASES = 1 + 5 * NLAYER;
__global__ void __launch_bounds__(512, 2) mega_fwd(Args args) {
    extern __shared__ __attribute__((aligned(16))) unsigned char lds[];
    Ctx F;
#define BUILD() do { const Args* ap_ = &args; \
    F.x = ap_->in[0]; F.norm_g = ap_->in[1]; F.w_in = ap_->in[2]; F.aqg = ap_->in[3]; F.akg = ap_->in[4]; F.bqg = ap_->in[5]; F.bkg = ap_->in[6]; \
    F.fox_bias = ap_->in[7]; F.gate_up = ap_->in[8]; F.gate_bias = ap_->in[9]; F.out_gain = ap_->in[10]; F.w_out = ap_->in[11]; \
    F.out = ap_->out; unsigned char* ws = ap_->ws; F.ws = ws; \
    F.ctl = (unsigned*)(ws + WS_CTL); F.ss = (unsigned long long*)(ws + WS_SS); F.wtin = (bf16*)(ws + WS_WTIN); F.wtout = (bf16*)(ws + WS_WTOUT); F.xb = (bf16*)(ws + WS_XB); \
    F.proj = (bf16*)(ws + WS_PROJ); F.small = (float*)(ws + WS_SMALL); F.mixed = (bf16*)(ws + WS_MIXED); F.oa = (bf16*)(ws + WS_OA); F.la = (float*)(ws + WS_LA); \
    F.ob = (float*)(ws + WS_OB); F.lb = (float*)(ws + WS_LB); F.cl = (float*)(ws + WS_CL); F.bt = (float*)(ws + WS_BT); F.ds = (float*)(ws + WS_DS); F.st = (bf16*)(ws + WS_ST); F.dec = (float*)(ws + WS_DEC); \
    F.lds = lds; F.G = gridDim.x; F.bid = blockIdx.x; \
    int t_ = threadIdx.x; asm volatile("" : "+v"(t_)); F.tid = t_; F.lane = t_ & 63; F.wave = __builtin_amdgcn_readfirstlane(t_ >> 6); } while (0)
    BUILD();
    cg::grid_group grid = cg::this_grid();
    if (threadIdx.x < 8) ((volatile LAS unsigned*)((LAS unsigned char*)lds + MISC_OFF))[threadIdx.x] = 0u;
    __syncthreads();
    XcdBarrier bar; bar.bar = (unsigned*)(F.ws + WS_CTL) + 4096; bar.x = 0; bar.st = (volatile LAS unsigned*)((LAS unsigned char*)lds + MISC_OFF);
    const int lo = args.ph_lo, hi = args.ph_hi;
#define IN(k) (lo <= (k) && (k) < hi)
#define RELAUNDER() do { int t_ = threadIdx.x; asm volatile("" : "+v"(t_)); F.tid = t_; F.lane = t_ & 63; F.wave = __builtin_amdgcn_readfirstlane(t_ >> 6); } while (0)
#define SEAM(k) do { if (IN(k) && IN((k) + 1)) { if ((k) == 0) grid.sync(); else xcd_barrier(bar); } } while (0)
    if (IN(0)) { BUILD(); phase0(F); }
    SEAM(0);
    bar = xcd_barrier_post(bar.bar, bar.st);
    for (int l = 0; l < NLAYER; ++l) { const int pb = 1 + 5 * l;
        if (IN(pb)) { BUILD(); pg8::Gemm g{F.xb, F.wtin + (size_t)l * NPAD * DM, SEQ, NPAD, DM}; pg8::StaticOrder S; S.init(SEQ, NPAD, F.G, F.bid);
            pg8::EpiProj E{F.proj, F.small, F.ss + l * SEQ, (float*)(lds + RING_BYTES + 1024), F.aqg + l * 64, F.akg + l * 64, F.bqg + l * 64, F.bkg + l * 64};
            pg8::gemm_phase<pg8::EpiProj, pg8::StaticOrder, true, true>((PG8_LAS unsigned char*)lds, g, S, E); __syncthreads(); }
        SEAM(pb);
        if (IN(pb + 1)) { BUILD(); phase2(F, l); }
        SEAM(pb + 1);
        if (IN(pb + 2)) { BUILD(); phase3(F, l); }
        SEAM(pb + 2);
        if (IN(pb + 3)) { BUILD(); phase4(F, l); }
        SEAM(pb + 3);
        if (IN(pb + 4)) { BUILD(); pg8::Gemm g{F.mixed, F.wtout + (size_t)l * DM * DM, SEQ, DM, DM}; pg8::StaticOrder S; S.init(SEQ, DM, F.G, F.bid);
            const bool last = (l == NLAYER - 1);
            pg8::EpiOut E{l == 0 ? F.x : F.out, F.out, last ? nullptr : F.xb, last ? nullptr : F.ss + (l + 1) * SEQ};
            pg8::gemm_phase<pg8::EpiOut, pg8::StaticOrder, true, true>((PG8_LAS unsigned char*)lds, g, S, E); __syncthreads(); }
        SEAM(pb + 4);
    }
#undef IN
#undef SEAM
}

#ifndef MK_ONE_LAUNCH
#define MK_ONE_LAUNCH 1
#endif
extern "C" void kernel_launch(void* const* d_in, const int* in_sizes, int n_in, void* d_out, int out_size, void* d_ws, size_t ws_size, hipStream_t stream) {
    static int grid = 0;
    if (grid == 0) {
        int dev = 0, cus = 0, per_cu = 0;
        hipGetDevice(&dev); hipDeviceGetAttribute(&cus, hipDeviceAttributeMultiprocessorCount, dev);
        hipFuncSetAttribute((const void*)mega_fwd, hipFuncAttributeMaxDynamicSharedMemorySize, LDS_BYTES);
        hipOccupancyMaxActiveBlocksPerMultiprocessor(&per_cu, mega_fwd, 512, LDS_BYTES);
        grid = cus * per_cu; if (grid <= 0) grid = 256;
        if (ws_size < WS_END) { fprintf(stderr, "workspace too small: %zu < %zu\n", ws_size, (size_t)WS_END); }
    }
    Args a{}; for (int i = 0; i < 12; ++i) a.in[i] = (const float*)d_in[i]; a.out = (float*)d_out; a.ws = (unsigned char*)d_ws;
#if MK_ONE_LAUNCH
    a.ph_lo = 0; a.ph_hi = N_PHASES; void* kargs[] = {&a};
    hipError_t e = hipLaunchCooperativeKernel((const void*)mega_fwd, dim3(grid), dim3(512), kargs, LDS_BYTES, stream);
    if (e != hipSuccess) fprintf(stderr, "cooperative launch failed: %s (grid %d)\n", hipGetErrorString(e), grid);
#else
    for (int p = 0; p < N_PHASES; ++p) { a.ph_lo = p; a.ph_hi = p + 1; hipLaunchKernelGGL(mega_fwd, dim3(grid), dim3(512), LDS_BYTES, stream, a); }
#endif
}
```

```cpp
#include <hip/hip_runtime.h>
#include <hip/hip_cooperative_groups.h>
#include <cstdio>
#include <cstdint>
namespace cg = cooperative_groups;
namespace pg8 {
#define PG8_LAS __attribute__((address_space(3)))
typedef unsigned short bf16_t;
typedef short bf16x8 __attribute__((ext_vector_type(8)));
typedef float f32x4 __attribute__((ext_vector_type(4)));
typedef unsigned u32x4 __attribute__((ext_vector_type(4)));
constexpr int BM = 256, BK = 64, HALF = 128, HTB = HALF * BK * 2  , STAGE_BYTES = 8 * HTB, NXCD = 8, WGM = 8;

__host__ __device__ __forceinline__ int lds_byte(int r, int c) { const int st = (r >> 4) * 2 + (c >> 5), rr = r & 15, cc = c & 31, ob = rr * 64 + cc * 2; return st * 1024 + (ob ^ (((ob >> 9) & 1) << 5)); }
__host__ __device__ __forceinline__ void stage_rc(int b, int& R, int& C) { const int st = b / 1024, sb = b % 1024, swz = sb ^ (((sb >> 9) & 1) << 5); R = (st >> 1) * 16 + swz / 64; C = (st & 1) * 32 + (swz % 64) / 2; }
__host__ __device__ __forceinline__ int perm32(int rho) { const int n = rho >> 4, i = rho & 15; return 8 * (i >> 2) + 4 * n + (i & 3); }

struct Unit { int pm, pn; };
struct Gemm { const bf16_t* A; const bf16_t* Bt; int M, N, K; };

struct StaticOrder {
    int nM, nN, nwg, G, c;
    __host__ __device__ void init(int M, int N, int G_, int c_) { nM = M / BM; nN = N / BM; nwg = nM * nN; G = G_; c = c_; }
    __host__ __device__ bool next(int i, Unit& u) const {
        const long L = (long)i * G + c; if (L >= nwg) return false;
        int wgid = (int)L; { const int q = nwg / NXCD, r = nwg % NXCD, xcd = wgid % NXCD, off = wgid / NXCD; wgid = (xcd < r ? xcd * (q + 1) : r * (q + 1) + (xcd - r) * q) + off; }
        const int nig = WGM * nN, gid = wgid / nig, fm = gid * WGM, gsz = (nM - fm) < WGM ? (nM - fm) : WGM;
        u.pm = fm + ((wgid % nig) % gsz); u.pn = (wgid % nig) / gsz; return true;
    }
    __device__ __forceinline__ void a_ready(const Unit&) const {}
    __device__ __forceinline__ void done(const Unit&) const {}
};

__device__ __forceinline__ unsigned cvt_pk_bf16(float lo, float hi) { unsigned r; asm volatile("v_cvt_pk_bf16_f32 %0, %1, %2" : "=v"(r) : "v"(lo), "v"(hi)); return r; }
typedef float f32x2 __attribute__((ext_vector_type(2)));
constexpr int PROJ_W = 7424;
struct EpiProj {
    static constexpr bool PERM = true, AFTER_DRAIN = false;
    bf16_t* O; float* small; const unsigned long long* ss; float* xch; const float* gaq; const float* gak; const float* gbq; const float* gbk;
    __device__ __forceinline__ void operator()(const f32x4 (&acc)[2][2][4][2], const Unit& u, int wr, int wc, int fr, int fq) const {
        const int row0 = u.pm * BM + wr * 64 + fr;
        float rsv[2][4];
        { unsigned long long sv[2][4];
#pragma unroll
          for (int ai = 0; ai < 2; ++ai)
#pragma unroll
              for (int m = 0; m < 4; ++m) sv[ai][m] = ss[row0 + ai * HALF + m * 16];
          asm volatile("" : "+v"(sv[0][0]), "+v"(sv[0][1]), "+v"(sv[0][2]), "+v"(sv[0][3])); asm volatile("" : "+v"(sv[1][0]), "+v"(sv[1][1]), "+v"(sv[1][2]), "+v"(sv[1][3]));
#pragma unroll
          for (int ai = 0; ai < 2; ++ai)
#pragma unroll
              for (int m = 0; m < 4; ++m) rsv[ai][m] = rsqrtf((float)sv[ai][m] * (1.0f / 1048576.0f / 2048.0f) + 1e-6f); }
        if (u.pn < 29) {
            const int col0 = u.pn * BM + wc * 32 + 8 * fq;
            const bool isA = u.pn < 6, isB = (u.pn >= 12 && u.pn < 16);
            if (isA || isB) {
#pragma unroll
                for (int ai = 0; ai < 2; ++ai)
#pragma unroll
                    for (int m = 0; m < 4; ++m) { const int row = row0 + ai * HALF + m * 16; const float rs = rsv[ai][m];
#pragma unroll
                        for (int bj = 0; bj < 2; ++bj) { const f32x4 v0 = acc[ai][bj][m][0] * rs, v1 = acc[ai][bj][m][1] * rs;
                            float sq = (v0[0] * v0[0] + v0[1] * v0[1]) + (v0[2] * v0[2] + v0[3] * v0[3]) + (v1[0] * v1[0] + v1[1] * v1[1]) + (v1[2] * v1[2] + v1[3] * v1[3]);
                            sq += __shfl_xor(sq, 16); sq += __shfl_xor(sq, 32);
                            if (fq == 0) xch[((ai * HALF + wr * 64 + m * 16 + fr) * 2 + bj) * 4 + wc] = sq; } }
                asm volatile("s_waitcnt lgkmcnt(0)" ::: "memory"); __builtin_amdgcn_s_barrier(); asm volatile("" ::: "memory");
                const bool isq = (u.pn < 3) || (u.pn == 12) || (u.pn == 13);
                const float* ga0 = gaq; const float* ga1 = gak; const float* gb0 = gbq; const float* gb1 = gbk;
                const float* gsel = isA ? ga0 : gb0; { const float* gk = isA ? ga1 : gb1; if (!isq) gsel = gk; }
                const float* g = gsel + 32 * (wc & 1) + 8 * fq;
                const float sc = isq ? 0.18033688011112042f : 1.0f;
                const f32x4 g0 = *(const f32x4*)g * sc, g1 = *(const f32x4*)(g + 4) * sc;
#pragma unroll
                for (int ai = 0; ai < 2; ++ai)
#pragma unroll
                    for (int m = 0; m < 4; ++m) { const int row = row0 + ai * HALF + m * 16; bf16_t* rowp = O + (size_t)row * PROJ_W + col0;
                        const float rs = rsv[ai][m];
#pragma unroll
                        for (int bj = 0; bj < 2; ++bj) { const float* xp = xch + ((ai * HALF + wr * 64 + m * 16 + fr) * 2 + bj) * 4 + (wc & 2); const float tot = xp[0] + xp[1];
                            const float r2 = rsqrtf(tot * (1.0f / 64.0f) + 1e-6f) * rs;
                            const f32x4 v0 = acc[ai][bj][m][0] * r2 * g0, v1 = acc[ai][bj][m][1] * r2 * g1;
                            u32x4 w; w.x = cvt_pk_bf16(v0[0], v0[1]); w.y = cvt_pk_bf16(v0[2], v0[3]); w.z = cvt_pk_bf16(v1[0], v1[1]); w.w = cvt_pk_bf16(v1[2], v1[3]);
                            *(u32x4*)(rowp + bj * HALF) = w; } }
            } else {
#pragma unroll
            for (int ai = 0; ai < 2; ++ai)
#pragma unroll
                for (int m = 0; m < 4; ++m) { const int row = row0 + ai * HALF + m * 16; const float rs = rsv[ai][m];
                    bf16_t* rowp = O + (size_t)row * PROJ_W + col0;
#pragma unroll
                    for (int bj = 0; bj < 2; ++bj) { const f32x4 v0 = acc[ai][bj][m][0] * rs, v1 = acc[ai][bj][m][1] * rs;
                        u32x4 w; w.x = cvt_pk_bf16(v0[0], v0[1]); w.y = cvt_pk_bf16(v0[2], v0[3]); w.z = cvt_pk_bf16(v1[0], v1[1]); w.w = cvt_pk_bf16(v1[2], v1[3]);
                        *(u32x4*)(rowp + bj * HALF) = w; } }
            }
        } else if (wc == 0) {
#pragma unroll
            for (int ai = 0; ai < 2; ++ai)
#pragma unroll
                for (int m = 0; m < 4; ++m) { const int row = row0 + ai * HALF + m * 16; const float rs = rsv[ai][m];
                    float* p = small + (size_t)row * 32 + 8 * fq;
                    *(f32x4*)p = acc[ai][0][m][0] * rs; *(f32x4*)(p + 4) = acc[ai][0][m][1] * rs; }
        }
    }
};
struct EpiOut {
    static constexpr bool PERM = true, AFTER_DRAIN = false;
    const float* xin; float* out; bf16_t* xb; unsigned long long* ssn;
    __device__ __forceinline__ void operator()(const f32x4 (&acc)[2][2][4][2], const Unit& u, int wr, int wc, int fr, int fq) const {
        const int row0 = u.pm * BM + wr * 64 + fr, col0 = u.pn * BM + wc * 32 + 8 * fq;
#pragma unroll
        for (int ai = 0; ai < 2; ++ai) {
            f32x4 xo[4][2][2];
#pragma unroll
            for (int m = 0; m < 4; ++m)
#pragma unroll
                for (int bj = 0; bj < 2; ++bj) { const size_t p = (size_t)(row0 + ai * HALF + m * 16) * 2048 + col0 + bj * HALF; xo[m][bj][0] = *(const f32x4*)(xin + p); xo[m][bj][1] = *(const f32x4*)(xin + p + 4); }
#pragma unroll
            for (int m = 0; m < 4; ++m) asm volatile("" : "+v"(xo[m][0][0]), "+v"(xo[m][0][1]), "+v"(xo[m][1][0]), "+v"(xo[m][1][1]));
#pragma unroll
            for (int m = 0; m < 4; ++m) { const int row = row0 + ai * HALF + m * 16; float sq = 0.f;
#pragma unroll
                for (int bj = 0; bj < 2; ++bj) { const size_t p = (size_t)row * 2048 + col0 + bj * HALF;
                    const f32x4 a = xo[m][bj][0] + acc[ai][bj][m][0], b = xo[m][bj][1] + acc[ai][bj][m][1];
                    *(f32x4*)(out + p) = a; *(f32x4*)(out + p + 4) = b;
                    if (xb) { u32x4 w; w.x = cvt_pk_bf16(a[0], a[1]); w.y = cvt_pk_bf16(a[2], a[3]); w.z = cvt_pk_bf16(b[0], b[1]); w.w = cvt_pk_bf16(b[2], b[3]); *(u32x4*)(xb + p) = w; }
                    sq += (a[0] * a[0] + a[1] * a[1]) + (a[2] * a[2] + a[3] * a[3]) + (b[0] * b[0] + b[1] * b[1]) + (b[2] * b[2] + b[3] * b[3]); }
                sq += __shfl_xor(sq, 16); sq += __shfl_xor(sq, 32);
                if (fq == 0 && ssn) atomicAdd(ssn + row, (unsigned long long)(sq * 1048576.0f + 0.5f)); } }
    }
};

template <class Epi, class Sched, bool ALIGN_EPI = false, bool SP2 = false>
__device__ __forceinline__ void gemm_phase(PG8_LAS unsigned char* lds, const Gemm g, const Sched& S, const Epi& E) {
    int tid_ = threadIdx.x; asm volatile("" : "+v"(tid_)); const int tid = tid_, wid = __builtin_amdgcn_readfirstlane(tid >> 6), lane = tid & 63, wr = wid >> 2, wc = wid & 3, fr = lane & 15, fq = lane >> 4;
    const int K = g.K, nt = K / BK;
    unsigned voffA[2], voffB[2];
#pragma unroll
    for (int i = 0; i < 2; ++i) { int R, C; stage_rc(tid * 16 + i * 8192, R, C); const int Rb = Epi::PERM ? ((R & ~31) + perm32(R & 31)) : R;
        voffA[i] = (unsigned)(R * K + C) * 2u; voffB[i] = (unsigned)(Rb * K + C) * 2u; }
    const size_t kstep = (size_t)(BK * 2);
    const size_t hstep = (size_t)HALF * K * 2;
    const size_t tstep = 2 * hstep;
    const unsigned ldsw = (unsigned)wid * 1024u;
    const int aoff = lds_byte(wr * 64 + fr, fq * 8), boff = lds_byte(wc * 32 + fr, fq * 8);
#define PG8_SA(b, h) (((b) * 2 + (h)) * HTB)
#define PG8_SB(b, h) ((4 + (b) * 2 + (h)) * HTB)
#define PG8_STAGE(bufoff, gbase, voff) do { _Pragma("unroll") for (int _i = 0; _i < 2; ++_i) \
        __builtin_amdgcn_global_load_lds((const unsigned*)((const char*)(gbase) + (voff)[_i]), (PG8_LAS unsigned*)(lds + (bufoff) + ldsw + _i * 8192), 16, 0, 0); } while (0)
#define PG8_LDA(dst, b, h) do { _Pragma("unroll") for (int m = 0; m < 4; ++m) _Pragma("unroll") for (int k = 0; k < 2; ++k) dst[m][k] = *(const PG8_LAS bf16x8*)(lds + PG8_SA(b, h) + aoff + m * 2048 + k * 1024); } while (0)
#define PG8_LDB(dst, b, h) do { _Pragma("unroll") for (int n = 0; n < 2; ++n) _Pragma("unroll") for (int k = 0; k < 2; ++k) dst[n][k] = *(const PG8_LAS bf16x8*)(lds + PG8_SB(b, h) + boff + n * 2048 + k * 1024); } while (0)
#define PG8_MMA(ai, bj, At, Bt) do { __builtin_amdgcn_s_setprio(1); _Pragma("unroll") for (int m = 0; m < 4; ++m) _Pragma("unroll") for (int n = 0; n < 2; ++n) _Pragma("unroll") for (int k = 0; k < 2; ++k) \
        acc[ai][bj][m][n] = __builtin_amdgcn_mfma_f32_16x16x32_bf16(Bt[n][k], At[m][k], acc[ai][bj][m][n], 0, 0, 0); __builtin_amdgcn_s_setprio(0); } while (0)
#define PG8_WAIT_V(n) asm volatile("s_waitcnt vmcnt(" #n ")" ::: "memory")
#define PG8_WAIT_L(n) asm volatile("s_waitcnt lgkmcnt(" #n ")" ::: "memory")
#define PG8_BAR __builtin_amdgcn_s_barrier()
#define PG8_SCHED __builtin_amdgcn_sched_barrier(0)
    Unit cur, nxt; int ui = 0;
    if (!S.next(0, cur)) return;
    f32x4 acc[2][2][4][2];
#pragma unroll
    for (int a = 0; a < 2; ++a)
#pragma unroll
        for (int b = 0; b < 2; ++b)
#pragma unroll
            for (int m = 0; m < 4; ++m)
#pragma unroll
                for (int n = 0; n < 2; ++n) acc[a][b][m][n] = (f32x4){0.f, 0.f, 0.f, 0.f};
    bf16x8 At[4][2], B0[2][2], B1[2][2];
    const char* cA = (const char*)g.A + (size_t)cur.pm * tstep; const char* cB = (const char*)g.Bt + (size_t)cur.pn * tstep;
    S.a_ready(cur);
    if constexpr (SP2) {
        PG8_STAGE(PG8_SB(0, 0), cB, voffB); PG8_STAGE(PG8_SB(0, 1), cB + hstep, voffB); PG8_STAGE(PG8_SA(0, 0), cA, voffA); PG8_STAGE(PG8_SA(0, 1), cA + hstep, voffA);
        if (wr == 1) PG8_BAR;
        PG8_WAIT_V(2); PG8_BAR;
        PG8_STAGE(PG8_SB(1, 0), cB + kstep, voffB); PG8_STAGE(PG8_SA(1, 0), cA + kstep, voffA); PG8_STAGE(PG8_SB(1, 1), cB + hstep + kstep, voffB);
        PG8_WAIT_V(6); PG8_BAR;
    } else {
        PG8_STAGE(PG8_SB(0, 0), cB, voffB); PG8_STAGE(PG8_SA(0, 0), cA, voffA); PG8_STAGE(PG8_SB(0, 1), cB + hstep, voffB); PG8_STAGE(PG8_SA(0, 1), cA + hstep, voffA);
        if (wr == 1) PG8_BAR;
        PG8_WAIT_V(4); PG8_BAR;
        PG8_STAGE(PG8_SB(1, 0), cB + kstep, voffB); PG8_STAGE(PG8_SA(1, 0), cA + kstep, voffA); PG8_STAGE(PG8_SB(1, 1), cB + hstep + kstep, voffB);
        PG8_WAIT_V(6); PG8_BAR;
    }
    for (;;) {
        const bool has_next = S.next(ui + 1, nxt);
        const char* nA = has_next ? (const char*)g.A + (size_t)nxt.pm * tstep : cA; const char* nB = has_next ? (const char*)g.Bt + (size_t)nxt.pn * tstep : cB;
        for (int t = 0; t < nt; t += 2) {
            const bool last = (t == nt - 2);
            const char* a1 = cA + (size_t)(t + 1) * kstep;
            const char* a2 = last ? nA : cA + (size_t)(t + 2) * kstep; const char* b2 = last ? nB : cB + (size_t)(t + 2) * kstep;
            const char* a3 = a2 + kstep; const char* b3 = b2 + kstep;
            if (last && has_next) S.a_ready(nxt);
            if constexpr (SP2) {
            PG8_LDB(B0, 0, 0); PG8_LDB(B1, 0, 1); PG8_SCHED; PG8_LDA(At, 0, 0); PG8_STAGE(PG8_SA(1, 1), a1 + hstep, voffA);
            PG8_WAIT_V(8); PG8_WAIT_L(0); PG8_BAR; PG8_MMA(0, 0, At, B0); PG8_MMA(0, 1, At, B1); PG8_BAR; PG8_SCHED;
            PG8_LDA(At, 0, 1); PG8_STAGE(PG8_SB(0, 0), b2, voffB); PG8_STAGE(PG8_SB(0, 1), b2 + hstep, voffB); PG8_STAGE(PG8_SA(0, 0), a2, voffA);
            PG8_WAIT_V(8); PG8_WAIT_L(0); PG8_BAR; PG8_MMA(1, 0, At, B0); PG8_MMA(1, 1, At, B1); PG8_BAR; PG8_SCHED;
            PG8_LDB(B0, 1, 0); PG8_LDB(B1, 1, 1); PG8_SCHED; PG8_LDA(At, 1, 0); PG8_STAGE(PG8_SA(0, 1), a2 + hstep, voffA);
            PG8_WAIT_V(8); PG8_WAIT_L(0); PG8_BAR; PG8_MMA(0, 0, At, B0); PG8_MMA(0, 1, At, B1); PG8_BAR; PG8_SCHED;
            PG8_LDA(At, 1, 1); PG8_STAGE(PG8_SB(1, 0), b3, voffB); PG8_STAGE(PG8_SB(1, 1), b3 + hstep, voffB); PG8_STAGE(PG8_SA(1, 0), a3, voffA);
            PG8_WAIT_V(8); PG8_WAIT_L(0); PG8_BAR; PG8_MMA(1, 0, At, B0); PG8_MMA(1, 1, At, B1); PG8_BAR; PG8_SCHED;
            } else {
            PG8_LDB(B0, 0, 0); PG8_SCHED; PG8_LDA(At, 0, 0); PG8_STAGE(PG8_SA(1, 1), a1 + hstep, voffA);
            PG8_WAIT_L(8); PG8_BAR; PG8_WAIT_L(0); PG8_MMA(0, 0, At, B0); PG8_BAR; PG8_SCHED;
            PG8_LDB(B1, 0, 1); PG8_STAGE(PG8_SB(0, 0), b2, voffB);
            PG8_BAR; PG8_WAIT_L(0); PG8_MMA(0, 1, At, B1); PG8_BAR;
            PG8_LDA(At, 0, 1); PG8_STAGE(PG8_SA(0, 0), a2, voffA);
            PG8_BAR; PG8_WAIT_L(0); PG8_MMA(1, 0, At, B0); PG8_BAR; PG8_SCHED;
            PG8_STAGE(PG8_SB(0, 1), b2 + hstep, voffB);
            PG8_WAIT_V(6); PG8_BAR; PG8_MMA(1, 1, At, B1); PG8_BAR;
            PG8_LDB(B0, 1, 0); PG8_SCHED; PG8_LDA(At, 1, 0); PG8_STAGE(PG8_SA(0, 1), a2 + hstep, voffA);
            PG8_WAIT_L(8); PG8_BAR; PG8_WAIT_L(0); PG8_MMA(0, 0, At, B0); PG8_BAR; PG8_SCHED;
            PG8_LDB(B1, 1, 1); PG8_STAGE(PG8_SB(1, 0), b3, voffB);
            PG8_BAR; PG8_WAIT_L(0); PG8_MMA(0, 1, At, B1); PG8_BAR;
            PG8_LDA(At, 1, 1); PG8_STAGE(PG8_SA(1, 0), a3, voffA);
            PG8_BAR; PG8_WAIT_L(0); PG8_MMA(1, 0, At, B0); PG8_BAR; PG8_SCHED;
            PG8_STAGE(PG8_SB(1, 1), b3 + hstep, voffB);
            PG8_WAIT_V(6); PG8_BAR; PG8_MMA(1, 1, At, B1); PG8_BAR;
            }
        }
        if constexpr (ALIGN_EPI) { if (wr == 0) PG8_BAR; }
        if constexpr (!Epi::AFTER_DRAIN) { E(acc, cur, wr, wc, fr, fq); S.done(cur); }
        if (!has_next) break;
#pragma unroll
        for (int a = 0; a < 2; ++a)
#pragma unroll
            for (int b = 0; b < 2; ++b)
#pragma unroll
                for (int m = 0; m < 4; ++m)
#pragma unroll
                    for (int n = 0; n < 2; ++n) acc[a][b][m][n] = (f32x4){0.f, 0.f, 0.f, 0.f};
        cur = nxt; cA = nA; cB = nB; ++ui;
        if constexpr (ALIGN_EPI) { if (wr == 1) PG8_BAR; }
    }
    PG8_WAIT_V(0);
    if constexpr (!ALIGN_EPI) { if (wr == 0) PG8_BAR; }
    PG8_BAR;
    if constexpr (Epi::AFTER_DRAIN) { E.fused(acc, cur, wr, wc, fr, fq, lds, wid, lane); S.done(cur); }
#undef PG8_SA
#undef PG8_SB
#undef PG8_STAGE
#undef PG8_LDA
#undef PG8_LDB
#undef PG8_MMA
#undef PG8_WAIT_V
#undef PG8_WAIT_L
#undef PG8_BAR
#undef PG8_SCHED
}
}
constexpr int SEQ = 8192, DM = 2048, NLAYER = 4, INW = 7448, NPAD = 7680, PW = pg8::PROJ_W;
constexpr int C_AQ = 0, C_AK = 768, C_AV = 1536, C_AZ = 2304, C_BQ = 3072, C_BK = 3584, C_BV = 4096, C_BZ = 4608, C_CQ = 5120, C_CK = 5504, C_CV = 5888, C_CZ = 6656;
constexpr float LOG2E = 1.4426950408889634f, QSCALE = 0.125f * 1.4426950408889634f, EPS = 1e-6f;
constexpr size_t MiB = 1u << 20;
constexpr size_t WS_CTL = 0, WS_SS = 1 * MiB, WS_WTIN = 2 * MiB, WS_WTOUT = 122 * MiB, WS_XB = 154 * MiB, WS_PROJ = 186 * MiB, WS_SMALL = 302 * MiB,
                 WS_MIXED = 304 * MiB, WS_OA = 336 * MiB, WS_LA = 372 * MiB, WS_OB = 374 * MiB, WS_LB = 438 * MiB, WS_CL = 439 * MiB, WS_BT = WS_CL + 512 * 1024,
                 WS_DS = 440 * MiB, WS_ST = 476 * MiB, WS_DEC = 494 * MiB, WS_END = 496 * MiB;
constexpr int RING_BYTES = 131072, LDS_BYTES = 147456, QSLOT_OFF = RING_BYTES + 64, MISC_OFF = RING_BYTES + 256;
constexpr int P3_EXT = RING_BYTES + 1024;
constexpr int N_SCAN = 72, N_FOX = 640, N_AU = 1152, N_ITEMS = N_SCAN + N_FOX + N_AU;

typedef unsigned short bf16;
typedef short bf16x8 __attribute__((ext_vector_type(8)));
typedef short s16x4 __attribute__((ext_vector_type(4)));
typedef float f32x4 __attribute__((ext_vector_type(4)));
typedef float f32x2 __attribute__((ext_vector_type(2)));
typedef float f32x16 __attribute__((ext_vector_type(16)));
typedef unsigned u32x4 __attribute__((ext_vector_type(4)));
typedef unsigned u32x2 __attribute__((ext_vector_type(2)));
typedef __attribute__((address_space(3))) const char* lds_cptr;
#define LAS3 __attribute__((address_space(3)))

__device__ __forceinline__ float bf2f(unsigned b) { return __uint_as_float(b << 16); }
__device__ __forceinline__ unsigned pk2(float lo, float hi) { return pg8::cvt_pk_bf16(lo, hi); }
__device__ __forceinline__ float blo(unsigned w) { return __uint_as_float(w << 16); }
__device__ __forceinline__ float bhi(unsigned w) { return __uint_as_float(w & 0xffff0000u); }
__device__ __forceinline__ float logsig(float x) { return fminf(x, 0.f) - log1pf(expf(-fabsf(x))); }
__device__ __forceinline__ float silu(float x) { return x / (1.f + __expf(-x)); }
__device__ __forceinline__ s16x4 vtr(lds_cptr p) { return __builtin_bit_cast(s16x4, __builtin_amdgcn_ds_read_tr16_b64_v4i16((LAS3 s16x4*)p)); }
__device__ __forceinline__ bf16x8 frag_tr(lds_cptr img, int stride, int kbase, int m0, int lane) {
    const int i = lane & 15, g = lane >> 4;
    lds_cptr p = img + (kbase + 4 * (g >> 1) + (i >> 2)) * stride + (m0 + 16 * (g & 1) + 4 * (i & 3)) * 2;
    const s16x4 a = vtr(p), b = vtr(p + 8 * stride);
    return (bf16x8){a[0], a[1], a[2], a[3], b[0], b[1], b[2], b[3]};
}
__device__ __forceinline__ int rowidx(int reg, int hh) { return (reg & 3) + 8 * (reg >> 2) + 4 * hh; }
__device__ __forceinline__ void pack_p(const f32x16& p, bf16x8& f0, bf16x8& f1) {
    u32x4 a, b; a.x = pk2(p[0], p[1]); a.y = pk2(p[2], p[3]); a.z = pk2(p[4], p[5]); a.w = pk2(p[6], p[7]);
    b.x = pk2(p[8], p[9]); b.y = pk2(p[10], p[11]); b.z = pk2(p[12], p[13]); b.w = pk2(p[14], p[15]);
    f0 = __builtin_bit_cast(bf16x8, a); f1 = __builtin_bit_cast(bf16x8, b);
}
#define MFMA32(a, b, c) __builtin_amdgcn_mfma_f32_32x32x16_bf16((a), (b), (c), 0, 0, 0)

struct Ctx {
    const float *x, *norm_g, *w_in, *aqg, *akg, *bqg, *bkg, *fox_bias, *gate_up, *gate_bias, *out_gain, *w_out;
    float* out; unsigned char* ws;
    unsigned* ctl; unsigned long long* ss; bf16* wtin; bf16* wtout; bf16* xb; bf16* proj; float* small; bf16* mixed; bf16* oa; float* la; float* ob; float* lb; float* cl; float* bt;
    float* ds; bf16* st; float* dec;
    unsigned char* lds; int tid, lane, wave, G, bid;
};

__device__ __forceinline__ int orig_col(int np) { if (np < 5120) return np; if (np < 7424) return np + 8; if (np < 7432) return 5120 + (np - 7424); if (np < 7448) return np; return -1; }
__device__ __forceinline__ void p0_load(const float* W, int N, const float* g, int mode, int kb, int nb, int lane, f32x4 (&v)[8], float (&gs)[8]) {
    const int k0 = 64 * kb, np = 32 * nb + 4 * (lane & 7);
    const int oc = mode ? orig_col(np) : np;
#pragma unroll
    for (int i = 0; i < 8; ++i) { const int kk = 8 * i + (lane >> 3); v[i] = (f32x4){0.f, 0.f, 0.f, 0.f}; gs[i] = 1.0f;
        if (oc >= 0) { v[i] = __builtin_nontemporal_load((const f32x4*)(W + (size_t)(k0 + kk) * N + oc)); if (mode) gs[i] = g[k0 + kk]; } }
}
__device__ __forceinline__ void p0_finish(bf16* WT, int mode, int kb, int nb, int lane, float* scr, const f32x4 (&v)[8], const float (&gs)[8]) {
    const int k0 = 64 * kb, n0 = 32 * nb, c4 = 4 * (lane & 7), np = n0 + c4;
    const float cs = (mode && np >= C_CQ && np < C_CK) ? 0.10206207261596577f : 1.0f;
#pragma unroll
    for (int i = 0; i < 8; ++i) { const int kk = 8 * i + (lane >> 3); float* d = scr + kk * 33 + c4; const float sc = cs * gs[i]; d[0] = v[i].x * sc; d[1] = v[i].y * sc; d[2] = v[i].z * sc; d[3] = v[i].w * sc; }
    asm volatile("s_waitcnt lgkmcnt(0)" ::: "memory");
    const int c = lane & 7;
#pragma unroll
    for (int j = 0; j < 4; ++j) { const int n = (lane >> 3) + 8 * j; const float* s = scr + (8 * c) * 33 + n;
        u32x4 o; o.x = pk2(s[0 * 33], s[1 * 33]); o.y = pk2(s[2 * 33], s[3 * 33]); o.z = pk2(s[4 * 33], s[5 * 33]); o.w = pk2(s[6 * 33], s[7 * 33]);
        __builtin_nontemporal_store(o, (u32x4*)(WT + (size_t)(n0 + n) * 2048 + k0 + 8 * c)); }
    asm volatile("s_waitcnt lgkmcnt(0)" ::: "memory");
}
constexpr int P0_I_IN = 32 * 233, P0_I_OUT = 32 * 64, P0_I_L = P0_I_IN + P0_I_OUT, P0_EARLY = P0_I_L;
__device__ __forceinline__ void convert_items(Ctx& F, int it_lo, int it_hi, int gw, int NGW) {
    float* scr = (float*)(F.lds + F.wave * 16384);
#define P0_DECODE(it_, W_, N_, WT_, g_, mode_, kb_, nb_) do { const int l_ = (it_) / P0_I_L; int r_ = (it_) % P0_I_L; \
        if (r_ < P0_I_IN) { W_ = F.w_in + (size_t)l_ * DM * INW; N_ = INW; WT_ = F.wtin + (size_t)l_ * NPAD * DM; g_ = F.norm_g + l_ * DM; mode_ = 1; kb_ = r_ / 233; nb_ = r_ % 233; } \
        else { r_ -= P0_I_IN; W_ = F.w_out + (size_t)l_ * DM * DM; N_ = DM; WT_ = F.wtout + (size_t)l_ * DM * DM; g_ = F.norm_g; mode_ = 0; kb_ = r_ / 64; nb_ = r_ % 64; } } while (0)
    f32x4 va[8], vb[8]; float ga[8], gb[8];
    const float* W = nullptr; const float* g = nullptr; bf16* WT = nullptr; int N = 0, mode = 0, kb = 0, nb = 0;
    int it = it_lo + gw;
    if (it < it_hi) { P0_DECODE(it, W, N, WT, g, mode, kb, nb); p0_load(W, N, g, mode, kb, nb, F.lane, va, ga); }
    while (it < it_hi) { const int nit = it + NGW;
        const float* W2 = nullptr; const float* g2 = nullptr; bf16* WT2 = nullptr; int N2 = 0, mode2 = 0, kb2 = 0, nb2 = 0;
        if (nit < it_hi) { P0_DECODE(nit, W2, N2, WT2, g2, mode2, kb2, nb2); p0_load(W2, N2, g2, mode2, kb2, nb2, F.lane, vb, gb); }
        p0_finish(WT, mode, kb, nb, F.lane, scr, va, ga);
#pragma unroll
        for (int i = 0; i < 8; ++i) { va[i] = vb[i]; ga[i] = gb[i]; }
        it = nit; WT = WT2; mode = mode2; kb = kb2; nb = nb2; }
#undef P0_DECODE
}
__device__ __forceinline__ void phase0(Ctx& F) {
    const int gw = F.bid * 8 + F.wave, NGW = F.G * 8;
    if (F.bid == 0) for (int i = F.tid; i < 16384; i += 512) F.ctl[i] = 0u;
    for (int i = F.bid * 512 + F.tid; i < 3 * SEQ; i += F.G * 512) F.ss[SEQ + i] = 0ull;
    if (F.G == 256) { convert_items(F, 0, P0_I_L, gw, NGW);
#pragma unroll 1
        for (int l2 = 1; l2 < NLAYER; ++l2) convert_items(F, l2 * P0_I_L + P0_EARLY, (l2 + 1) * P0_I_L, gw, NGW); }
    else convert_items(F, 0, NLAYER * P0_I_L, gw, NGW);
    for (int m = gw; m < SEQ; m += NGW) {
        const f32x4* xr = (const f32x4*)(F.x + (size_t)m * DM) + F.lane; float s = 0.f; u32x2* o8 = (u32x2*)(F.xb + (size_t)m * DM) + F.lane;
#pragma unroll
        for (int j = 0; j < 8; ++j) { const f32x4 v = xr[64 * j]; s += (v.x * v.x + v.y * v.y) + (v.z * v.z + v.w * v.w); u32x2 w; w.x = pk2(v.x, v.y); w.y = pk2(v.z, v.w); o8[64 * j] = w; }
#pragma unroll
        for (int o = 1; o < 64; o <<= 1) s += __shfl_xor(s, o);
        if (F.lane == 0) F.ss[m] = (unsigned long long)(s * 1048576.0f + 0.5f);
    }
}

__device__ __forceinline__ void phase2(Ctx& F, int l) {
    { const int gw = F.bid * 8 + F.wave, NGW = F.G * 8;
      for (int wi = gw; wi < 512; wi += NGW) { const int blk = wi >> 3, h = wi & 7, t = blk * 128 + 2 * F.lane; const float fb = F.fox_bias[l * 8 + h];
        const float l0 = logsig(F.small[(size_t)t * 32 + h] + fb), l1 = logsig(F.small[(size_t)(t + 1) * 32 + h] + fb);
        float s = l0 + l1;
#pragma unroll
        for (int o = 1; o < 64; o <<= 1) { const float y = __shfl_up(s, o); if (F.lane >= o) s += y; }
        const float ex = s - (l0 + l1); F.cl[t * 8 + h] = ex + l0; F.cl[(t + 1) * 8 + h] = s; if (F.lane == 63) F.bt[blk * 8 + h] = s; } }
    { float* CR = (float*)F.lds;
      float* GT = (float*)(F.lds + 4096);
      unsigned char* KH = F.lds + 8192;
      unsigned char* VV = F.lds + 8192 + 13312;
      const float* gup = F.gate_up + (size_t)l * 16 * 384; const float* gbs = F.gate_bias + l * 384;
      for (int u = F.bid; u < 512; u += F.G) { const int h = u & 3, n = u >> 2, t0 = n * 64;
        if (F.tid < 256) *(f32x4*)(CR + F.tid * 4) = *(const f32x4*)(F.small + (size_t)(t0 + (F.tid >> 2)) * 32 + 8 + 4 * (F.tid & 3));
        { u32x4 vv[3];
#pragma unroll
          for (int i = 0; i < 3; ++i) { const int e = F.tid + 512 * i, row = e / 24, ch = e % 24; vv[i] = *(const u32x4*)(F.proj + (size_t)(t0 + row) * PW + C_CV + h * 192 + ch * 8); }
          asm volatile("" : "+v"(vv[0]), "+v"(vv[1]), "+v"(vv[2]));
#pragma unroll
          for (int i = 0; i < 3; ++i) { const int e = F.tid + 512 * i, row = e / 24, ch = e % 24; *(u32x4*)(VV + row * 400 + ch * 16) = vv[i]; } }
        __syncthreads();
        const int d = F.tid % 96, tg = F.tid / 96;
        float bc[16];
        if (F.tid < 384) { float g[16];
#pragma unroll
            for (int r = 0; r < 16; ++r) g[r] = gup[r * 384 + h * 96 + d];
            const float gb = gbs[h * 96 + d]; float run = 0.f;
#pragma unroll
            for (int i = 0; i < 16; ++i) { const float* cr = CR + (16 * tg + i) * 16; float a = gb;
#pragma unroll
                for (int r4 = 0; r4 < 4; ++r4) { const f32x4 c = *(const f32x4*)(cr + 4 * r4); a += c.x * g[4 * r4] + c.y * g[4 * r4 + 1] + c.z * g[4 * r4 + 2] + c.w * g[4 * r4 + 3]; }
                const float ls = fminf(a, 0.f) - __logf(1.f + __expf(-fabsf(a)));
                run += ls * (1.f / 16.f); bc[i] = run; }
            GT[tg * 96 + d] = run; }
        __syncthreads();
        if (F.tid < 384) { const float g0 = GT[d], g1 = GT[96 + d], g2 = GT[192 + d], g3 = GT[288 + d];
            const float pre = (tg > 0 ? g0 : 0.f) + (tg > 1 ? g1 : 0.f) + (tg > 2 ? g2 : 0.f);
            const float bm = g0 + g1, bl = (g0 + g1) + (g2 + g3);
            bf16* qp = F.proj + (size_t)(t0 + 16 * tg) * PW + C_CQ + h * 96 + d; bf16* kp = F.proj + (size_t)(t0 + 16 * tg) * PW + C_CK + h * 96 + d;
            float qv[16], kv[16]; unsigned qr[16], kr[16];
#pragma unroll
            for (int i = 0; i < 16; ++i) { qr[i] = qp[(size_t)i * PW]; kr[i] = kp[(size_t)i * PW]; }
#pragma unroll
            for (int i = 0; i < 16; i += 4) { asm volatile("" : "+v"(qr[i]), "+v"(qr[i + 1]), "+v"(qr[i + 2]), "+v"(qr[i + 3])); asm volatile("" : "+v"(kr[i]), "+v"(kr[i + 1]), "+v"(kr[i + 2]), "+v"(kr[i + 3])); }
#pragma unroll
            for (int i = 0; i < 16; ++i) { qv[i] = bf2f(qr[i]); kv[i] = bf2f(kr[i]); }
#pragma unroll
            for (int i = 0; i < 16; ++i) { const float b = bc[i] + pre; const float eq = __expf(b - bm), ek = __expf(bm - b), eh = __expf(bl - b);
                qp[(size_t)i * PW] = (bf16)(pk2(qv[i] * eq, 0.f) & 0xffffu); kp[(size_t)i * PW] = (bf16)(pk2(kv[i] * ek, 0.f) & 0xffffu);
                *(bf16*)(KH + (16 * tg + i) * 208 + d * 2) = (bf16)(pk2(kv[i] * eh, 0.f) & 0xffffu); }
            if (tg == 0) { F.dec[(n * 4 + h) * 96 + d] = __expf(bl); F.dec[49152 + (n * 4 + h) * 96 + d] = __expf(bm); } }
        __syncthreads();
        for (int id = F.wave; id < 18; id += 8) { const int vt = id / 3, dt = id % 3; f32x16 acc = {};
#pragma unroll
            for (int s = 0; s < 4; ++s) { const bf16x8 a = frag_tr((lds_cptr)VV, 400, 16 * s, 32 * vt, F.lane), b = frag_tr((lds_cptr)KH, 208, 16 * s, 32 * dt, F.lane); acc = MFMA32(a, b, acc); }
            float* dst = F.ds + ((size_t)(n * 4 + h) * 192 + 32 * vt) * 96 + 32 * dt + (F.lane & 31);
#pragma unroll
            for (int r = 0; r < 16; ++r) dst[(size_t)rowidx(r, F.lane >> 5) * 96] = acc[r]; }
        __syncthreads(); } }
}
__device__ __forceinline__ float softmax_ref2(const float* gq, const float* gk) {
    float mq = 0.f, mk = 0.f;
    for (int i = 0; i < 64; ++i) { mq = fmaxf(mq, fabsf(gq[i])); mk = fmaxf(mk, fabsf(gk[i])); }
    return 8.25f * mq * mk * LOG2E;
}
__device__ __forceinline__ void scan_item(Ctx& F, int si) {
    const int p = si * 512 + F.tid, d = 2 * (p % 48), v = (p / 48) % 192, h = p / (48 * 192);
    float s0 = 0.f, s1 = 0.f;
    for (int nb = 0; nb < 128; nb += 8) { f32x2 dd[8], a[8], em[8];
#pragma unroll
        for (int j = 0; j < 8; ++j) { const int n = nb + j; const size_t idx = ((size_t)(n * 4 + h) * 192 + v) * 96 + d; const int di = (n * 4 + h) * 96 + d;
            dd[j] = *(const f32x2*)(F.ds + idx); a[j] = *(const f32x2*)(F.dec + di); em[j] = *(const f32x2*)(F.dec + 49152 + di); }
#pragma unroll
        for (int j = 0; j < 8; j += 4) { asm volatile("" : "+v"(dd[j]), "+v"(dd[j + 1]), "+v"(dd[j + 2]), "+v"(dd[j + 3])); asm volatile("" : "+v"(a[j]), "+v"(a[j + 1]), "+v"(a[j + 2]), "+v"(a[j + 3])); asm volatile("" : "+v"(em[j]), "+v"(em[j + 1]), "+v"(em[j + 2]), "+v"(em[j + 3])); }
#pragma unroll
        for (int j = 0; j < 8; ++j) { const int n = nb + j; const size_t idx = ((size_t)(n * 4 + h) * 192 + v) * 96 + d;
            *(unsigned*)(F.st + idx) = pk2(em[j].x * s0, em[j].y * s1);
            s0 = a[j].x * s0 + dd[j].x; s1 = a[j].y * s1 + dd[j].y; } }
}
#define PIN4(a, b, c, d) asm volatile("" : "+v"(a), "+v"(b), "+v"(c), "+v"(d))
#define SBAR0() __builtin_amdgcn_sched_barrier(0)
template <int KSTR, int VSTR>
__device__ __forceinline__ void attn_sub(const unsigned char* Kt, const unsigned char* Vt, int key_row0, const bf16x8 (&qf)[4], f32x16 S, f32x16 (&o)[2], float& lsum, int lane,
                                         bool use_mask, int lo, int hi_) {
    const int r = lane & 31, hh = lane >> 5;
    bf16x8 kf[4];
#pragma unroll
    for (int s = 0; s < 4; ++s) kf[s] = *(const bf16x8*)(Kt + (key_row0 + r) * KSTR + (16 * s + 8 * hh) * 2);
    bf16x8 vf[2][2];
#pragma unroll
    for (int dt = 0; dt < 2; ++dt) { vf[dt][0] = frag_tr((lds_cptr)Vt, VSTR, key_row0, 32 * dt, lane); vf[dt][1] = frag_tr((lds_cptr)Vt, VSTR, key_row0 + 16, 32 * dt, lane); }
    PIN4(kf[0], kf[1], kf[2], kf[3]);
#pragma unroll
    for (int s = 0; s < 4; ++s) S = MFMA32(kf[s], qf[s], S);
    if (use_mask) {
#pragma unroll
        for (int g = 0; g < 16; ++g) { const int k = rowidx(g, hh); if (k < lo || k > hi_) S[g] = -INFINITY; } }
    float acc = 0.f;
#pragma unroll
    for (int g = 0; g < 16; ++g) { S[g] = __builtin_amdgcn_exp2f(S[g]); acc += S[g]; }
    lsum += acc;
    bf16x8 p0, p1; pack_p(S, p0, p1);
    PIN4(vf[0][0], vf[0][1], vf[1][0], vf[1][1]);
#pragma unroll
    for (int dt = 0; dt < 2; ++dt) { o[dt] = MFMA32(vf[dt][0], p0, o[dt]); o[dt] = MFMA32(vf[dt][1], p1, o[dt]); }
}
template <int NSUB, int KSTR, int VSTR>
__device__ __forceinline__ void attn_multi(const unsigned char* Kt, const unsigned char* Vt, int key_row0, const bf16x8 (&qf)[4], f32x16 (&S)[NSUB], f32x16 (&o)[2], float& lsum, int lane) {
    const int r = lane & 31, hh = lane >> 5;
    bf16x8 kf[NSUB][4];
#pragma unroll
    for (int u = 0; u < NSUB; ++u)
#pragma unroll
        for (int s = 0; s < 4; ++s) kf[u][s] = *(const bf16x8*)(Kt + (key_row0 + 32 * u + r) * KSTR + (16 * s + 8 * hh) * 2);
#pragma unroll
    for (int u = 0; u < NSUB; ++u) PIN4(kf[u][0], kf[u][1], kf[u][2], kf[u][3]);
#pragma unroll
    for (int s = 0; s < 4; ++s)
#pragma unroll
        for (int u = 0; u < NSUB; ++u) S[u] = MFMA32(kf[u][s], qf[s], S[u]);
#pragma unroll
    for (int u = 0; u < NSUB; ++u) {
        bf16x8 vf[2][2];
#pragma unroll
        for (int dt = 0; dt < 2; ++dt) { vf[dt][0] = frag_tr((lds_cptr)Vt, VSTR, key_row0 + 32 * u, 32 * dt, lane); vf[dt][1] = frag_tr((lds_cptr)Vt, VSTR, key_row0 + 32 * u + 16, 32 * dt, lane); }
        SBAR0();
        float acc = 0.f;
#pragma unroll
        for (int g = 0; g < 16; ++g) { S[u][g] = __builtin_amdgcn_exp2f(S[u][g]); acc += S[u][g]; }
        lsum += acc;
        bf16x8 p0, p1; pack_p(S[u], p0, p1);
        PIN4(vf[0][0], vf[0][1], vf[1][0], vf[1][1]);
#pragma unroll
        for (int dt = 0; dt < 2; ++dt) { o[dt] = MFMA32(vf[dt][0], p0, o[dt]); o[dt] = MFMA32(vf[dt][1], p1, o[dt]); } }
}
__device__ __forceinline__ void fox_unit(Ctx& F, int l, int h, int qb, int seg) {
    constexpr int KS = 144, VS = 192, BUFB = 128 * KS, BUFV = 128 * VS;
    unsigned char* KT = F.lds; unsigned char* VT = F.lds + 2 * BUFB; float* CS = (float*)(F.lds + 2 * BUFB + 2 * BUFV);
    const float* PEX = (const float*)(F.lds + P3_EXT) + h * 64;
    const int r = F.lane & 31, hh = F.lane >> 5, w = F.wave, t0 = 256 * qb, NT = 2 * qb + 2;
    const int kfirst = __builtin_amdgcn_readfirstlane(((const int*)(F.lds + P3_EXT + 2048))[h * 32 + qb]);
    const int nuse = (NT - kfirst + 15) >> 4;
    if (seg >= nuse) return;
    const int kt0 = kfirst + 16 * seg, te = (kt0 + 16 < NT) ? kt0 + 16 : NT;
    const float mb2 = ((const float*)(F.lds + P3_EXT + 3072))[1];
    const int tq = t0 + 32 * w + r; const float pq0 = PEX[t0 >> 7];
    const float ctq = ((PEX[tq >> 7] - pq0) + F.cl[tq * 8 + h]) * LOG2E - mb2;
    bf16x8 qf[4];
#pragma unroll
    for (int s = 0; s < 4; ++s) qf[s] = *(const bf16x8*)(F.proj + (size_t)tq * PW + C_BQ + h * 64 + 16 * s + 8 * hh);
    f32x16 o[2]; o[0] = f32x16{}; o[1] = f32x16{}; float lsum = 0.f;
    const int lrow = F.tid >> 3, lch = F.tid & 7;
    u32x4 kreg[2], vreg[2]; float creg = 0.f;
    if (kt0 < te) {
#pragma unroll
        for (int i = 0; i < 2; ++i) { const size_t g = (size_t)(128 * kt0 + 64 * i + lrow) * PW + h * 64 + lch * 8; kreg[i] = *(const u32x4*)(F.proj + g + C_BK); vreg[i] = *(const u32x4*)(F.proj + g + C_BV); }
        if (F.tid < 128) creg = ((PEX[kt0] - pq0) + F.cl[(128 * kt0 + F.tid) * 8 + h]) * LOG2E; }
    for (int kt = kt0; kt < te; ++kt) { const int buf = (kt - kt0) & 1;
#pragma unroll
        for (int i = 0; i < 2; ++i) { *(u32x4*)(KT + buf * BUFB + (64 * i + lrow) * KS + lch * 16) = kreg[i]; *(u32x4*)(VT + buf * BUFV + (64 * i + lrow) * VS + lch * 16) = vreg[i]; }
        if (F.tid < 128) CS[buf * 128 + F.tid] = creg;
        __syncthreads();
        if (kt + 1 < te) {
#pragma unroll
            for (int i = 0; i < 2; ++i) { const size_t g = (size_t)(128 * (kt + 1) + 64 * i + lrow) * PW + h * 64 + lch * 8; kreg[i] = *(const u32x4*)(F.proj + g + C_BK); vreg[i] = *(const u32x4*)(F.proj + g + C_BV); }
            if (F.tid < 128) creg = ((PEX[kt + 1] - pq0) + F.cl[(128 * (kt + 1) + F.tid) * 8 + h]) * LOG2E; }
        const unsigned char* Kb = KT + buf * BUFB; const unsigned char* Vb = VT + buf * BUFV; const float* Cb = CS + buf * 128;
        if (kt < 2 * qb) {
#pragma unroll
            for (int hf = 0; hf < 2; ++hf) { f32x16 S[2]; f32x4 c4[2][4];
#pragma unroll
                for (int u = 0; u < 2; ++u)
#pragma unroll
                    for (int i = 0; i < 4; ++i) c4[u][i] = *(const f32x4*)(Cb + 64 * hf + 32 * u + 8 * i + 4 * hh);
                PIN4(c4[0][0], c4[0][1], c4[0][2], c4[0][3]); PIN4(c4[1][0], c4[1][1], c4[1][2], c4[1][3]);
#pragma unroll
                for (int u = 0; u < 2; ++u)
#pragma unroll
                    for (int i = 0; i < 4; ++i) { S[u][4 * i] = ctq - c4[u][i].x; S[u][4 * i + 1] = ctq - c4[u][i].y; S[u][4 * i + 2] = ctq - c4[u][i].z; S[u][4 * i + 3] = ctq - c4[u][i].w; }
                attn_multi<2, KS, VS>(Kb, Vb, 64 * hf, qf, S, o, lsum, F.lane); }
        } else {
            const int qlo = t0 + 32 * w;
#pragma unroll
            for (int sub = 0; sub < 4; ++sub) { const int key0 = 128 * kt + 32 * sub;
                if (key0 <= qlo + 31) {
                    f32x16 S;
#pragma unroll
                    for (int i = 0; i < 4; ++i) { const f32x4 c4 = *(const f32x4*)(Cb + 32 * sub + 8 * i + 4 * hh); S[4 * i] = ctq - c4.x; S[4 * i + 1] = ctq - c4.y; S[4 * i + 2] = ctq - c4.z; S[4 * i + 3] = ctq - c4.w; }
                    attn_sub<KS, VS>(Kb, Vb, 32 * sub, qf, S, o, lsum, F.lane, key0 + 31 > qlo, 0, tq - key0); } }
        }
    }
    lsum += __shfl_xor(lsum, 32);
    float* ob = F.ob + ((size_t)seg * SEQ + tq) * 512 + h * 64 + 4 * hh;
#pragma unroll
    for (int dt = 0; dt < 2; ++dt)
#pragma unroll
        for (int i = 0; i < 4; ++i) *(f32x4*)(ob + 32 * dt + 8 * i) = (f32x4){o[dt][4 * i], o[dt][4 * i + 1], o[dt][4 * i + 2], o[dt][4 * i + 3]};
    if (hh == 0) F.lb[((size_t)seg * SEQ + tq) * 8 + h] = lsum;
    __syncthreads();
}
__device__ __forceinline__ void a_unit(Ctx& F, int l, int a, int n, int rres, int b2) {
    constexpr int KS = 144, VS = 192;
    unsigned char* KA = F.lds; unsigned char* VA = F.lds + 384 * KS;
    const int r = F.lane & 31, hh = F.lane >> 5, w = F.wave, d = (n == 0) ? 1 : (n == 1) ? 4 : 16, i0 = 256 * b2;
    { u32x4 kv[6], vv[6]; const int ch = F.tid & 7;
#pragma unroll
      for (int i = 0; i < 6; ++i) { const int j = (F.tid >> 3) + 64 * i, idx = i0 - 128 + j; kv[i] = (u32x4){0u, 0u, 0u, 0u}; vv[i] = (u32x4){0u, 0u, 0u, 0u};
          if (idx >= 0) { const size_t g = (size_t)(rres + d * idx) * PW + a * 64 + ch * 8; kv[i] = *(const u32x4*)(F.proj + g + C_AK); vv[i] = *(const u32x4*)(F.proj + g + C_AV); } }
      asm volatile("" : "+v"(kv[0]), "+v"(kv[1]), "+v"(kv[2]), "+v"(kv[3]), "+v"(kv[4]), "+v"(kv[5]));
      asm volatile("" : "+v"(vv[0]), "+v"(vv[1]), "+v"(vv[2]), "+v"(vv[3]), "+v"(vv[4]), "+v"(vv[5]));
#pragma unroll
      for (int i = 0; i < 6; ++i) { const int j = (F.tid >> 3) + 64 * i; *(u32x4*)(KA + j * KS + ch * 16) = kv[i]; *(u32x4*)(VA + j * VS + ch * 16) = vv[i]; } }
    const int tokq = rres + d * (i0 + 32 * w + r);
    bf16x8 qf[4];
#pragma unroll
    for (int s = 0; s < 4; ++s) qf[s] = *(const bf16x8*)(F.proj + (size_t)tokq * PW + C_AQ + a * 64 + 16 * s + 8 * hh);
    const float mb2 = ((const float*)(F.lds + P3_EXT + 3072))[0];
    __syncthreads();
    f32x16 o[2]; o[0] = f32x16{}; o[1] = f32x16{}; float lsum = 0.f;
    const int qj = 32 * w + r + 128;
    if (i0 != 0) {
        { f32x16 S;
#pragma unroll
          for (int g = 0; g < 16; ++g) S[g] = -mb2;
          attn_sub<KS, VS>(KA, VA, 32 * w, qf, S, o, lsum, F.lane, true, qj - 128 - 32 * w, 31); }
        { f32x16 S[3];
#pragma unroll
          for (int u = 0; u < 3; ++u)
#pragma unroll
              for (int g = 0; g < 16; ++g) S[u][g] = -mb2;
          attn_multi<3, KS, VS>(KA, VA, 32 * (w + 1), qf, S, o, lsum, F.lane); }
        { f32x16 S;
#pragma unroll
          for (int g = 0; g < 16; ++g) S[g] = -mb2;
          attn_sub<KS, VS>(KA, VA, 32 * (w + 4), qf, S, o, lsum, F.lane, true, 0, qj - 32 * (w + 4)); }
    } else
    for (int jt = w; jt < w + 5; ++jt) { const int j0 = 32 * jt;
        if (j0 + 31 < 128) continue;
        f32x16 S;
#pragma unroll
        for (int g = 0; g < 16; ++g) S[g] = -mb2;
        int lo = qj - 128 - j0; const int hi_ = qj - j0; if (128 - j0 > lo) lo = 128 - j0;
        attn_sub<KS, VS>(KA, VA, j0, qf, S, o, lsum, F.lane, true, lo, hi_); }
    lsum += __shfl_xor(lsum, 32);
    bf16* oa = F.oa + ((size_t)n * SEQ + tokq) * 768 + a * 64 + 4 * hh;
#pragma unroll
    for (int dt = 0; dt < 2; ++dt)
#pragma unroll
        for (int i = 0; i < 4; ++i) { u32x2 wv; wv.x = pk2(o[dt][4 * i], o[dt][4 * i + 1]); wv.y = pk2(o[dt][4 * i + 2], o[dt][4 * i + 3]); *(u32x2*)(oa + 32 * dt + 8 * i) = wv; }
    if (hh == 0) F.la[((size_t)n * SEQ + tokq) * 12 + a] = lsum;
    __syncthreads();
}
__device__ __forceinline__ void phase3(Ctx& F, int l) {
    volatile unsigned* slot = (volatile unsigned*)(F.lds + QSLOT_OFF);
    { float* PEXA = (float*)(F.lds + P3_EXT); int* KFT = (int*)(F.lds + P3_EXT + 2048); float* MB = (float*)(F.lds + P3_EXT + 3072);
      { const float v = F.bt[F.lane * 8 + F.wave]; float sc = v;
#pragma unroll
        for (int o = 1; o < 64; o <<= 1) { const float y = __shfl_up(sc, o); if (F.lane >= o) sc += y; }
        PEXA[F.wave * 64 + F.lane] = sc - v; }
      if (F.tid == 0) { MB[0] = softmax_ref2(F.aqg + l * 64, F.akg + l * 64); MB[1] = softmax_ref2(F.bqg + l * 64, F.bkg + l * 64); }
      __syncthreads();
      if (F.tid < 256) { const int h = F.tid >> 5, qb = F.tid & 31; const float thr = -(26.f + 2.f * MB[1] * (1.f / LOG2E)), pq0 = PEXA[h * 64 + 2 * qb];
          int kt = 0; while (kt < 2 * qb && (pq0 - PEXA[h * 64 + kt + 1]) < thr) ++kt;
          KFT[F.tid] = kt; if (F.bid == 0) F.ctl[8192 + F.tid] = (unsigned)kt; }
      __syncthreads(); }
    for (;;) {
        if (F.tid == 0) *slot = atomicAdd(F.ctl + l, 1u);
        __syncthreads();
        const int item = __builtin_amdgcn_readfirstlane((int)*slot);
        __syncthreads();
        if (item >= N_ITEMS) break;
        if (item < N_SCAN) scan_item(F, item);
        else if (item < N_SCAN + N_FOX) { int f = item - N_SCAN, ns, qhi;
            if (f < 256) { ns = 4; qhi = 31; } else if (f < 448) { f -= 256; ns = 3; qhi = 23; } else if (f < 576) { f -= 448; ns = 2; qhi = 15; } else { f -= 576; ns = 1; qhi = 7; }
            const int per = ns * 8, qb = qhi - f / per, rem = f % per;
            fox_unit(F, l, rem & 7, qb, rem >> 3); }
        else { const int au = item - N_SCAN - N_FOX, n = au / 384, rest = au % 384, a = rest >> 5, u = rest & 31;
            const int per = (n == 0) ? 32 : (n == 1) ? 8 : 2;
            a_unit(F, l, a, n, u / per, u % per); }
    }
}
#define PIN6(a) asm volatile("" : "+v"(a[0]), "+v"(a[1]), "+v"(a[2]), "+v"(a[3]), "+v"(a[4]), "+v"(a[5]))
__device__ __forceinline__ void phase4(Ctx& F, int l) {
    unsigned char* VV = F.lds;
    float* SSQ = (float*)(F.lds + 51200);
    const int r = F.lane & 31, hh = F.lane >> 5, w = F.wave, ui = w >> 2, th = (w >> 1) & 1, vh = w & 1;
    const float* gain = F.out_gain + l * 192;
    for (int pu = F.bid; pu < 256; pu += F.G) {
        const int u = 2 * pu + ui, h = u & 3, n = u >> 2, t0 = n * 64, tq = th * 32 + r;
        bf16x8 qf[6], kf0[6], kf1[6], sfa[6], sfb[6];
        const bf16* stb = F.st + ((size_t)(n * 4 + h) * 192 + 32 * (vh * 3) + r) * 96 + 8 * hh;
#pragma unroll
        for (int kd = 0; kd < 6; ++kd) { qf[kd] = *(const bf16x8*)(F.proj + (size_t)(t0 + tq) * PW + C_CQ + h * 96 + 16 * kd + 8 * hh);
            kf0[kd] = *(const bf16x8*)(F.proj + (size_t)(t0 + r) * PW + C_CK + h * 96 + 16 * kd + 8 * hh);
            kf1[kd] = *(const bf16x8*)(F.proj + (size_t)(t0 + 32 + r) * PW + C_CK + h * 96 + 16 * kd + 8 * hh);
            sfa[kd] = *(const bf16x8*)(stb + 16 * kd); }
        { u32x4 vv[6];
#pragma unroll
          for (int i = 0; i < 6; ++i) { const int e = F.tid + 512 * i, uu = e / 1536, e2 = e % 1536, row = e2 / 24, ch = e2 % 24, u2 = 2 * pu + uu, h2 = u2 & 3, n2 = u2 >> 2;
              vv[i] = *(const u32x4*)(F.proj + (size_t)(n2 * 64 + row) * PW + C_CV + h2 * 192 + ch * 8); }
          asm volatile("" : "+v"(vv[0]), "+v"(vv[1]), "+v"(vv[2]), "+v"(vv[3]), "+v"(vv[4]), "+v"(vv[5]));
#pragma unroll
          for (int i = 0; i < 6; ++i) { const int e = F.tid + 512 * i, uu = e / 1536, e2 = e % 1536, row = e2 / 24, ch = e2 % 24; *(u32x4*)(VV + uu * 25600 + row * 400 + ch * 16) = vv[i]; } }
        __syncthreads();
        PIN6(qf); PIN6(kf0); PIN6(kf1);
        bf16x8 pf[2][2];
        { f32x16 X = {};
#pragma unroll
          for (int kd = 0; kd < 6; ++kd) X = MFMA32(kf0[kd], qf[kd], X);
          if (th == 0) {
#pragma unroll
              for (int g = 0; g < 16; ++g) if (rowidx(g, hh) > r) X[g] = 0.f; }
          pack_p(X, pf[0][0], pf[0][1]); }
        if (th == 1) { f32x16 X = {};
#pragma unroll
          for (int kd = 0; kd < 6; ++kd) X = MFMA32(kf1[kd], qf[kd], X);
#pragma unroll
          for (int g = 0; g < 16; ++g) if (rowidx(g, hh) > r) X[g] = 0.f;
          pack_p(X, pf[1][0], pf[1][1]); }
        f32x16 O[3]; float sq = 0.f;
#pragma unroll
        for (int vt = 0; vt < 3; ++vt) { const int vtile = vh * 3 + vt; f32x16 acc = {};
            if (vt == 0) {
#pragma unroll
                for (int kd = 0; kd < 6; ++kd) sfb[kd] = *(const bf16x8*)(stb + (size_t)32 * 96 + 16 * kd); }
            if (vt == 1) {
#pragma unroll
                for (int kd = 0; kd < 6; ++kd) sfa[kd] = *(const bf16x8*)(stb + (size_t)64 * 96 + 16 * kd); }
#pragma unroll
            for (int si = 0; si < 2; ++si) if (si <= th) {
#pragma unroll
                for (int s2 = 0; s2 < 2; ++s2) { const bf16x8 vf = frag_tr((lds_cptr)(VV + ui * 25600), 400, 32 * si + 16 * s2, 32 * vtile, F.lane); acc = MFMA32(vf, pf[si][s2], acc); } }
            if (vt == 1) { PIN6(sfb);
#pragma unroll
                for (int kd = 0; kd < 6; ++kd) acc = MFMA32(sfb[kd], qf[kd], acc); }
            else { PIN6(sfa);
#pragma unroll
                for (int kd = 0; kd < 6; ++kd) acc = MFMA32(sfa[kd], qf[kd], acc); }
#pragma unroll
            for (int g = 0; g < 16; ++g) sq += acc[g] * acc[g];
            O[vt] = acc; }
        u32x2 zw[3][4]; f32x4 gg[3][4];
#pragma unroll
        for (int vt = 0; vt < 3; ++vt)
#pragma unroll
            for (int i = 0; i < 4; ++i) { const int v = 32 * (vh * 3 + vt) + 8 * i + 4 * hh;
                zw[vt][i] = *(const u32x2*)(F.proj + (size_t)(t0 + tq) * PW + C_CZ + h * 192 + v); gg[vt][i] = *(const f32x4*)(gain + v); }
        sq += __shfl_xor(sq, 32);
        if (hh == 0) SSQ[(ui * 2 + vh) * 64 + tq] = sq;
        __syncthreads();
        const float rs = rsqrtf((SSQ[(ui * 2) * 64 + tq] + SSQ[(ui * 2 + 1) * 64 + tq]) * (1.f / 192.f) + EPS);
#pragma unroll
        for (int vt = 0; vt < 3; ++vt) { PIN4(zw[vt][0], zw[vt][1], zw[vt][2], zw[vt][3]);
#pragma unroll
            for (int i = 0; i < 4; ++i) { const int v = 32 * (vh * 3 + vt) + 8 * i + 4 * hh; const u32x2 z = zw[vt][i]; const f32x4 g4 = gg[vt][i];
                const float y0 = O[vt][4 * i] * rs * g4.x * silu(blo(z.x)), y1 = O[vt][4 * i + 1] * rs * g4.y * silu(bhi(z.x)), y2 = O[vt][4 * i + 2] * rs * g4.z * silu(blo(z.y)), y3 = O[vt][4 * i + 3] * rs * g4.w * silu(bhi(z.y));
                u32x2 ov; ov.x = pk2(y0, y1); ov.y = pk2(y2, y3); *(u32x2*)(F.mixed + (size_t)(t0 + tq) * DM + 1280 + h * 192 + v) = ov; } }
        __syncthreads();
    }
    const int NT = F.G * 512, gt = F.bid * 512 + F.tid;
    for (int idx0 = gt; idx0 < SEQ * 96; idx0 += 2 * NT) {
        u32x4 wv[2][3], zw[2]; float la[2][3]; int tt[2], cc[2]; bool ok[2];
#pragma unroll
        for (int j = 0; j < 2; ++j) { const int idx = idx0 + j * NT; ok[j] = idx < SEQ * 96; const int id2 = ok[j] ? idx : gt; const int t = id2 / 96, c = (id2 % 96) * 8, a = c >> 6; tt[j] = t; cc[j] = c;
#pragma unroll
            for (int n = 0; n < 3; ++n) { wv[j][n] = *(const u32x4*)(F.oa + ((size_t)n * SEQ + t) * 768 + c); la[j][n] = F.la[((size_t)n * SEQ + t) * 12 + a]; }
            zw[j] = *(const u32x4*)(F.proj + (size_t)t * PW + C_AZ + c); }
        PIN4(wv[0][0], wv[0][1], wv[0][2], zw[0]); PIN4(wv[1][0], wv[1][1], wv[1][2], zw[1]);
#pragma unroll
        for (int j = 0; j < 2; ++j) { float o[8] = {0.f, 0.f, 0.f, 0.f, 0.f, 0.f, 0.f, 0.f};
#pragma unroll
            for (int n = 0; n < 3; ++n) { const u32x4 x = wv[j][n]; o[0] += blo(x.x); o[1] += bhi(x.x); o[2] += blo(x.y); o[3] += bhi(x.y); o[4] += blo(x.z); o[5] += bhi(x.z); o[6] += blo(x.w); o[7] += bhi(x.w); }
            const float il = 1.f / ((la[j][0] + la[j][1]) + la[j][2]); const u32x4 z = zw[j];
            u32x4 ov; ov.x = pk2(o[0] * il * silu(blo(z.x)), o[1] * il * silu(bhi(z.x))); ov.y = pk2(o[2] * il * silu(blo(z.y)), o[3] * il * silu(bhi(z.y)));
            ov.z = pk2(o[4] * il * silu(blo(z.z)), o[5] * il * silu(bhi(z.z))); ov.w = pk2(o[6] * il * silu(blo(z.w)), o[7] * il * silu(bhi(z.w)));
            if (ok[j]) *(u32x4*)(F.mixed + (size_t)tt[j] * DM + cc[j]) = ov; } }
    for (int idx0 = gt; idx0 < SEQ * 64; idx0 += 2 * NT) {
        f32x4 a0[2][4], a1[2][4]; float lv[2][4]; u32x4 zw[2]; int tt[2], cc[2], ns[2]; bool ok[2];
#pragma unroll
        for (int j = 0; j < 2; ++j) { const int idx = idx0 + j * NT; ok[j] = idx < SEQ * 64; const int id2 = ok[j] ? idx : gt; const int t = id2 / 64, c = (id2 % 64) * 8, h = c >> 6; tt[j] = t; cc[j] = c;
            ns[j] = (2 * (t >> 8) + 2 - (int)F.ctl[8192 + h * 32 + (t >> 8)] + 15) >> 4;
#pragma unroll
            for (int sg = 0; sg < 4; ++sg) { a0[j][sg] = (f32x4){0.f, 0.f, 0.f, 0.f}; a1[j][sg] = (f32x4){0.f, 0.f, 0.f, 0.f}; lv[j][sg] = 0.f;
                if (sg < ns[j]) { const float* p = F.ob + ((size_t)sg * SEQ + t) * 512 + c; a0[j][sg] = *(const f32x4*)p; a1[j][sg] = *(const f32x4*)(p + 4); lv[j][sg] = F.lb[((size_t)sg * SEQ + t) * 8 + h]; } }
            zw[j] = *(const u32x4*)(F.proj + (size_t)t * PW + C_BZ + c); }
#pragma unroll
        for (int j = 0; j < 2; ++j) { const f32x4 o0 = (a0[j][0] + a0[j][1]) + (a0[j][2] + a0[j][3]), o1 = (a1[j][0] + a1[j][1]) + (a1[j][2] + a1[j][3]);
            const float il = 1.f / ((lv[j][0] + lv[j][1]) + (lv[j][2] + lv[j][3])); const u32x4 z = zw[j];
            u32x4 ov; ov.x = pk2(o0.x * il * silu(blo(z.x)), o0.y * il * silu(bhi(z.x))); ov.y = pk2(o0.z * il * silu(blo(z.y)), o0.w * il * silu(bhi(z.y)));
            ov.z = pk2(o1.x * il * silu(blo(z.z)), o1.y * il * silu(bhi(z.z))); ov.w = pk2(o1.z * il * silu(blo(z.w)), o1.w * il * silu(bhi(z.w)));
            if (ok[j]) *(u32x4*)(F.mixed + (size_t)tt[j] * DM + 768 + cc[j]) = ov; } }
}

#define LAS __attribute__((address_space(3)))
#define XB_TMO      128
#define XB_XCNT(j)  (256  + 64 * (j))
#define XB_XSUB(j)  (1280 + 64 * (j))
#define XB_XGEN(j)  (2304 + 64 * (j))
#define XB_TOP      3328
#define XB_TOPGEN   3392
#define XCD_BAR_WORDS 3456
#define XB_SPIN_CAP (1u << 18)

__device__ __forceinline__ unsigned xb_ld(unsigned* p)              { return __hip_atomic_load(p, __ATOMIC_RELAXED, __HIP_MEMORY_SCOPE_AGENT); }
__device__ __forceinline__ unsigned xb_add(unsigned* p, unsigned v) { return __hip_atomic_fetch_add(p, v, __ATOMIC_RELAXED, __HIP_MEMORY_SCOPE_AGENT); }
__device__ __forceinline__ unsigned xb_xcc_id() { return (unsigned)__builtin_amdgcn_s_getreg((3 << 11) | 20) & 0xFu; }
#define XB_SPIN(cond, bar) do { unsigned _sp = 0; while (cond) { __builtin_amdgcn_s_sleep(1); \
    if ((++_sp & 255u) == 0u) { if (xb_ld(&(bar)[XB_TMO])) break; if (_sp > XB_SPIN_CAP) { atomicAdd(&(bar)[XB_TMO], 1u); break; } } } } while (0)

struct XcdBarrier {
    unsigned* bar; unsigned x;
    volatile LAS unsigned* st;
};

__device__ __forceinline__ XcdBarrier xcd_barrier_post(unsigned* bar, volatile LAS unsigned* st) {
    XcdBarrier b; b.bar = bar; b.x = xb_xcc_id(); b.st = st;
    if (threadIdx.x == 0) (void)xb_add(&bar[XB_XCNT(b.x)], 1u);
    return b;
}
__device__ __forceinline__ void xcd_barrier_complete(unsigned* bar, unsigned x, unsigned& nloc, unsigned& nx) {
    const unsigned G = gridDim.x * gridDim.y * gridDim.z;
    unsigned sum, cnt, mine, sp = 0u;
    for (;;) {
        sum = 0u; cnt = 0u; mine = 0u;
#pragma unroll
        for (unsigned j = 0; j < 16; ++j) { const unsigned c = xb_ld(&bar[XB_XCNT(j)]); sum += c; cnt += (c > 0u) ? 1u : 0u; mine = (j == x) ? c : mine; }
        if (sum == G) break;
        __builtin_amdgcn_s_sleep(1);
        if ((++sp & 255u) == 0u) { if (xb_ld(&bar[XB_TMO])) break; if (sp > XB_SPIN_CAP) { atomicAdd(&bar[XB_TMO], 1u); break; } }
    }
    nloc = mine > 0u ? mine : 1u; nx = cnt > 0u ? cnt : 1u;
}

__device__ __forceinline__ void xcd_barrier(const XcdBarrier& b) {
    asm volatile("s_waitcnt vmcnt(0)" ::: "memory");
    __syncthreads();
    if (threadIdx.x == 0) {
        unsigned* bar = b.bar;
        __builtin_amdgcn_s_waitcnt(0);
        unsigned nloc = b.st[0], nx = b.st[1];
        if (nloc == 0u) { xcd_barrier_complete(bar, b.x, nloc, nx); b.st[0] = nloc; b.st[1] = nx; }
        const unsigned old = xb_add(&bar[XB_XSUB(b.x)], 1u);
        const unsigned gen = old / nloc;
        if (old + 1u == (gen + 1u) * nloc) {
            __builtin_amdgcn_fence(__ATOMIC_RELEASE, "agent");
            asm volatile("s_waitcnt vmcnt(0)" ::: "memory");
            const unsigned og = xb_add(&bar[XB_TOP], 1u);
            const unsigned tg = og / nx;
            if (og + 1u == (tg + 1u) * nx) xb_add(&bar[XB_TOPGEN], 1u);
            else XB_SPIN(xb_ld(&bar[XB_TOPGEN]) == tg, bar);
            __builtin_amdgcn_fence(__ATOMIC_ACQUIRE, "agent");
            xb_add(&bar[XB_XGEN(b.x)], 1u);
            asm volatile("s_waitcnt vmcnt(0)" ::: "memory");
        } else {
            XB_SPIN(xb_ld(&bar[XB_XGEN(b.x)]) == gen, bar);
            __builtin_amdgcn_fence(__ATOMIC_ACQUIRE, "agent");
            asm volatile("s_waitcnt vmcnt(0)" ::: "memory");
        }
    }
    __syncthreads();
}

struct Args { const float* in[12]; float* out; unsigned char* ws; int ph_lo, ph_hi; };
constexpr int N_PHASES = 1 + 5 * NLAYER;
__global__ void __launch_bounds__(512, 2) mega_fwd(Args args) {
    extern __shared__ __attribute__((aligned(16))) unsigned char lds[];
    Ctx F;
#define BUILD() do { const Args* ap_ = &args; \
    F.x = ap_->in[0]; F.norm_g = ap_->in[1]; F.w_in = ap_->in[2]; F.aqg = ap_->in[3]; F.akg = ap_->in[4]; F.bqg = ap_->in[5]; F.bkg = ap_->in[6]; \
    F.fox_bias = ap_->in[7]; F.gate_up = ap_->in[8]; F.gate_bias = ap_->in[9]; F.out_gain = ap_->in[10]; F.w_out = ap_->in[11]; \
    F.out = ap_->out; unsigned char* ws = ap_->ws; F.ws = ws; \
    F.ctl = (unsigned*)(ws + WS_CTL); F.ss = (unsigned long long*)(ws + WS_SS); F.wtin = (bf16*)(ws + WS_WTIN); F.wtout = (bf16*)(ws + WS_WTOUT); F.xb = (bf16*)(ws + WS_XB); \
    F.proj = (bf16*)(ws + WS_PROJ); F.small = (float*)(ws + WS_SMALL); F.mixed = (bf16*)(ws + WS_MIXED); F.oa = (bf16*)(ws + WS_OA); F.la = (float*)(ws + WS_LA); \
    F.ob = (float*)(ws + WS_OB); F.lb = (float*)(ws + WS_LB); F.cl = (float*)(ws + WS_CL); F.bt = (float*)(ws + WS_BT); F.ds = (float*)(ws + WS_DS); F.st = (bf16*)(ws + WS_ST); F.dec = (float*)(ws + WS_DEC); \
    F.lds = lds; F.G = gridDim.x; F.bid = blockIdx.x; \
    int t_ = threadIdx.x; asm volatile("" : "+v"(t_)); F.tid = t_; F.lane = t_ & 63; F.wave = __builtin_amdgcn_readfirstlane(t_ >> 6); } while (0)
    BUILD();
    cg::grid_group grid = cg::this_grid();
    if (threadIdx.x < 8) ((volatile LAS unsigned*)((LAS unsigned char*)lds + MISC_OFF))[threadIdx.x] = 0u;
    __syncthreads();
    XcdBarrier bar; bar.bar = (unsigned*)(F.ws + WS_CTL) + 4096; bar.x = 0; bar.st = (volatile LAS unsigned*)((LAS unsigned char*)lds + MISC_OFF);
    const int lo = args.ph_lo, hi = args.ph_hi;
#define IN(k) (lo <= (k) && (k) < hi)
#define RELAUNDER() do { int t_ = threadIdx.x; asm volatile("" : "+v"(t_)); F.tid = t_; F.lane = t_ & 63; F.wave = __builtin_amdgcn_readfirstlane(t_ >> 6); } while (0)
#define SEAM(k) do { if (IN(k) && IN((k) + 1)) { if ((k) == 0) grid.sync(); else xcd_barrier(bar); } } while (0)
    if (IN(0)) { BUILD(); phase0(F); }
    SEAM(0);
    bar = xcd_barrier_post(bar.bar, bar.st);
    for (int l = 0; l < NLAYER; ++l) { const int pb = 1 + 5 * l;
        if (IN(pb)) { BUILD(); pg8::Gemm g{F.xb, F.wtin + (size_t)l * NPAD * DM, SEQ, NPAD, DM}; pg8::StaticOrder S; S.init(SEQ, NPAD, F.G, F.bid);
            pg8::EpiProj E{F.proj, F.small, F.ss + l * SEQ, (float*)(lds + RING_BYTES + 1024), F.aqg + l * 64, F.akg + l * 64, F.bqg + l * 64, F.bkg + l * 64};
            pg8::gemm_phase<pg8::EpiProj, pg8::StaticOrder, true, true>((PG8_LAS unsigned char*)lds, g, S, E); __syncthreads();
            if (F.G == 256 && F.bid >= 192 && l + 1 < NLAYER) { BUILD(); convert_items(F, (l + 1) * P0_I_L, (l + 1) * P0_I_L + P0_EARLY, (F.bid - 192) * 8 + F.wave, 64 * 8); __syncthreads(); } }
        SEAM(pb);
        if (IN(pb + 1)) { BUILD(); phase2(F, l); }
        SEAM(pb + 1);
        if (IN(pb + 2)) { BUILD(); phase3(F, l); }
        SEAM(pb + 2);
        if (IN(pb + 3)) { BUILD(); phase4(F, l); }
        SEAM(pb + 3);
        if (IN(pb + 4)) { BUILD(); pg8::Gemm g{F.mixed, F.wtout + (size_t)l * DM * DM, SEQ, DM, DM}; pg8::StaticOrder S; S.init(SEQ, DM, F.G, F.bid);
            const bool last = (l == NLAYER - 1);
            pg8::EpiOut E{l == 0 ? F.x : F.out, F.out, last ? nullptr : F.xb, last ? nullptr : F.ss + (l + 1) * SEQ};
            pg8::gemm_phase<pg8::EpiOut, pg8::StaticOrder, true, true>((PG8_LAS unsigned char*)lds, g, S, E); __syncthreads(); }
        SEAM(pb + 4);
    }
#undef IN
#undef SEAM
}

#ifndef MK_ONE_LAUNCH
#define MK_ONE_LAUNCH 1
#endif
extern "C" void kernel_launch(void* const* d_in, const int* in_sizes, int n_in, void* d_out, int out_size, void* d_ws, size_t ws_size, hipStream_t stream) {
    static int grid = 0;
    if (grid == 0) {
        int dev = 0, cus = 0, per_cu = 0;
        hipGetDevice(&dev); hipDeviceGetAttribute(&cus, hipDeviceAttributeMultiprocessorCount, dev);
        hipFuncSetAttribute((const void*)mega_fwd, hipFuncAttributeMaxDynamicSharedMemorySize, LDS_BYTES);
        hipOccupancyMaxActiveBlocksPerMultiprocessor(&per_cu, mega_fwd, 512, LDS_BYTES);
        grid = cus * per_cu; if (grid <= 0) grid = 256;
        if (ws_size < WS_END) { fprintf(stderr, "workspace too small: %zu < %zu\n", ws_size, (size_t)WS_END); }
    }
    Args a{}; for (int i = 0; i < 12; ++i) a.in[i] = (const float*)d_in[i]; a.out = (float*)d_out; a.ws = (unsigned char*)d_ws;
#if MK_ONE_LAUNCH
    a.ph_lo = 0; a.ph_hi = N_PHASES; void* kargs[] = {&a};
    hipError_t e = hipLaunchCooperativeKernel((const void*)mega_fwd, dim3(grid), dim3(512), kargs, LDS_BYTES, stream);
    if (e != hipSuccess) fprintf(stderr, "cooperative launch failed: %s (grid %d)\n", hipGetErrorString(e), grid);
#else
    for (int p = 0; p < N_PHASES; ++p) { a.ph_lo = p; a.ph_hi = p + 1; hipLaunchKernelGGL(mega_fwd, dim3(grid), dim3(512), LDS_BYTES, stream, a); }
#endif
}
```

```cpp
#include <hip/hip_runtime.h>
#include <hip/hip_cooperative_groups.h>
#include <cstdio>
#include <cstdint>
namespace cg = cooperative_groups;
namespace pg8 {
#define PG8_LAS __attribute__((address_space(3)))
typedef unsigned short bf16_t;
typedef short bf16x8 __attribute__((ext_vector_type(8)));
typedef float f32x4 __attribute__((ext_vector_type(4)));
typedef unsigned u32x4 __attribute__((ext_vector_type(4)));
constexpr int BM = 256, BK = 64, HALF = 128, HTB = HALF * BK * 2  , STAGE_BYTES = 8 * HTB, NXCD = 8, WGM = 8;

__host__ __device__ __forceinline__ int lds_byte(int r, int c) { const int st = (r >> 4) * 2 + (c >> 5), rr = r & 15, cc = c & 31, ob = rr * 64 + cc * 2; return st * 1024 + (ob ^ (((ob >> 9) & 1) << 5)); }
__host__ __device__ __forceinline__ void stage_rc(int b, int& R, int& C) { const int st = b / 1024, sb = b % 1024, swz = sb ^ (((sb >> 9) & 1) << 5); R = (st >> 1) * 16 + swz / 64; C = (st & 1) * 32 + (swz % 64) / 2; }
__host__ __device__ __forceinline__ int perm32(int rho) { const int n = rho >> 4, i = rho & 15; return 8 * (i >> 2) + 4 * n + (i & 3); }

struct Unit { int pm, pn; };
struct Gemm { const bf16_t* A; const bf16_t* Bt; int M, N, K; };

struct StaticOrder {
    int nM, nN, nwg, G, c;
    __host__ __device__ void init(int M, int N, int G_, int c_) { nM = M / BM; nN = N / BM; nwg = nM * nN; G = G_; c = c_; }
    __host__ __device__ bool next(int i, Unit& u) const {
        const long L = (long)i * G + c; if (L >= nwg) return false;
        int wgid = (int)L; { const int q = nwg / NXCD, r = nwg % NXCD, xcd = wgid % NXCD, off = wgid / NXCD; wgid = (xcd < r ? xcd * (q + 1) : r * (q + 1) + (xcd - r) * q) + off; }
        const int nig = WGM * nN, gid = wgid / nig, fm = gid * WGM, gsz = (nM - fm) < WGM ? (nM - fm) : WGM;
        u.pm = fm + ((wgid % nig) % gsz); u.pn = (wgid % nig) / gsz; return true;
    }
    __device__ __forceinline__ void a_ready(const Unit&) const {}
    __device__ __forceinline__ void done(const Unit&) const {}
};

__device__ __forceinline__ unsigned cvt_pk_bf16(float lo, float hi) { unsigned r; asm volatile("v_cvt_pk_bf16_f32 %0, %1, %2" : "=v"(r) : "v"(lo), "v"(hi)); return r; }
typedef float f32x2 __attribute__((ext_vector_type(2)));
constexpr int PROJ_W = 7424;
struct EpiProj {
    static constexpr bool PERM = true, AFTER_DRAIN = false;
    bf16_t* O; float* small; const unsigned long long* ss; float* xch; const float* gaq; const float* gak; const float* gbq; const float* gbk;
    __device__ __forceinline__ void operator()(const f32x4 (&acc)[2][2][4][2], const Unit& u, int wr, int wc, int fr, int fq) const {
        const int row0 = u.pm * BM + wr * 64 + fr;
        float rsv[2][4];
        { unsigned long long sv[2][4];
#pragma unroll
          for (int ai = 0; ai < 2; ++ai)
#pragma unroll
              for (int m = 0; m < 4; ++m) sv[ai][m] = ss[row0 + ai * HALF + m * 16];
          asm volatile("" : "+v"(sv[0][0]), "+v"(sv[0][1]), "+v"(sv[0][2]), "+v"(sv[0][3])); asm volatile("" : "+v"(sv[1][0]), "+v"(sv[1][1]), "+v"(sv[1][2]), "+v"(sv[1][3]));
#pragma unroll
          for (int ai = 0; ai < 2; ++ai)
#pragma unroll
              for (int m = 0; m < 4; ++m) rsv[ai][m] = rsqrtf((float)sv[ai][m] * (1.0f / 1048576.0f / 2048.0f) + 1e-6f); }
        if (u.pn < 29) {
            const int col0 = u.pn * BM + wc * 32 + 8 * fq;
            const bool isA = u.pn < 6, isB = (u.pn >= 12 && u.pn < 16);
            if (isA || isB) {
#pragma unroll
                for (int ai = 0; ai < 2; ++ai)
#pragma unroll
                    for (int m = 0; m < 4; ++m) { const int row = row0 + ai * HALF + m * 16; const float rs = rsv[ai][m];
#pragma unroll
                        for (int bj = 0; bj < 2; ++bj) { const f32x4 v0 = acc[ai][bj][m][0] * rs, v1 = acc[ai][bj][m][1] * rs;
                            float sq = (v0[0] * v0[0] + v0[1] * v0[1]) + (v0[2] * v0[2] + v0[3] * v0[3]) + (v1[0] * v1[0] + v1[1] * v1[1]) + (v1[2] * v1[2] + v1[3] * v1[3]);
                            sq += __shfl_xor(sq, 16); sq += __shfl_xor(sq, 32);
                            if (fq == 0) xch[((ai * HALF + wr * 64 + m * 16 + fr) * 2 + bj) * 4 + wc] = sq; } }
                asm volatile("s_waitcnt lgkmcnt(0)" ::: "memory"); __builtin_amdgcn_s_barrier(); asm volatile("" ::: "memory");
                const bool isq = (u.pn < 3) || (u.pn == 12) || (u.pn == 13);
                const float* ga0 = gaq; const float* ga1 = gak; const float* gb0 = gbq; const float* gb1 = gbk;
                const float* gsel = isA ? ga0 : gb0; { const float* gk = isA ? ga1 : gb1; if (!isq) gsel = gk; }
                const float* g = gsel + 32 * (wc & 1) + 8 * fq;
                const float sc = isq ? 0.18033688011112042f : 1.0f;
                const f32x4 g0 = *(const f32x4*)g * sc, g1 = *(const f32x4*)(g + 4) * sc;
#pragma unroll
                for (int ai = 0; ai < 2; ++ai)
#pragma unroll
                    for (int m = 0; m < 4; ++m) { const int row = row0 + ai * HALF + m * 16; bf16_t* rowp = O + (size_t)row * PROJ_W + col0;
                        const float rs = rsv[ai][m];
#pragma unroll
                        for (int bj = 0; bj < 2; ++bj) { const float* xp = xch + ((ai * HALF + wr * 64 + m * 16 + fr) * 2 + bj) * 4 + (wc & 2); const float tot = xp[0] + xp[1];
                            const float r2 = rsqrtf(tot * (1.0f / 64.0f) + 1e-6f) * rs;
                            const f32x4 v0 = acc[ai][bj][m][0] * r2 * g0, v1 = acc[ai][bj][m][1] * r2 * g1;
                            u32x4 w; w.x = cvt_pk_bf16(v0[0], v0[1]); w.y = cvt_pk_bf16(v0[2], v0[3]); w.z = cvt_pk_bf16(v1[0], v1[1]); w.w = cvt_pk_bf16(v1[2], v1[3]);
                            *(u32x4*)(rowp + bj * HALF) = w; } }
            } else {
#pragma unroll
            for (int ai = 0; ai < 2; ++ai)
#pragma unroll
                for (int m = 0; m < 4; ++m) { const int row = row0 + ai * HALF + m * 16; const float rs = rsv[ai][m];
                    bf16_t* rowp = O + (size_t)row * PROJ_W + col0;
#pragma unroll
                    for (int bj = 0; bj < 2; ++bj) { const f32x4 v0 = acc[ai][bj][m][0] * rs, v1 = acc[ai][bj][m][1] * rs;
                        u32x4 w; w.x = cvt_pk_bf16(v0[0], v0[1]); w.y = cvt_pk_bf16(v0[2], v0[3]); w.z = cvt_pk_bf16(v1[0], v1[1]); w.w = cvt_pk_bf16(v1[2], v1[3]);
                        *(u32x4*)(rowp + bj * HALF) = w; } }
            }
        } else if (wc == 0) {
#pragma unroll
            for (int ai = 0; ai < 2; ++ai)
#pragma unroll
                for (int m = 0; m < 4; ++m) { const int row = row0 + ai * HALF + m * 16; const float rs = rsv[ai][m];
                    float* p = small + (size_t)row * 32 + 8 * fq;
                    *(f32x4*)p = acc[ai][0][m][0] * rs; *(f32x4*)(p + 4) = acc[ai][0][m][1] * rs; }
        }
    }
};
struct EpiOut {
    static constexpr bool PERM = true, AFTER_DRAIN = false;
    const float* xin32; float* out; bf16_t* xb; unsigned long long* ssn;
    __device__ __forceinline__ void operator()(const f32x4 (&acc)[2][2][4][2], const Unit& u, int wr, int wc, int fr, int fq) const {
        const int row0 = u.pm * BM + wr * 64 + fr, col0 = u.pn * BM + wc * 32 + 8 * fq;
#pragma unroll
        for (int ai = 0; ai < 2; ++ai) {
            f32x4 xo[4][2][2];
            if (xin32) {
#pragma unroll
                for (int m = 0; m < 4; ++m)
#pragma unroll
                    for (int bj = 0; bj < 2; ++bj) { const size_t p = (size_t)(row0 + ai * HALF + m * 16) * 2048 + col0 + bj * HALF; xo[m][bj][0] = *(const f32x4*)(xin32 + p); xo[m][bj][1] = *(const f32x4*)(xin32 + p + 4); }
#pragma unroll
                for (int m = 0; m < 4; ++m) asm volatile("" : "+v"(xo[m][0][0]), "+v"(xo[m][0][1]), "+v"(xo[m][1][0]), "+v"(xo[m][1][1]));
            } else { u32x4 xr[4][2];
#pragma unroll
                for (int m = 0; m < 4; ++m)
#pragma unroll
                    for (int bj = 0; bj < 2; ++bj) xr[m][bj] = *(const u32x4*)(xb + (size_t)(row0 + ai * HALF + m * 16) * 2048 + col0 + bj * HALF);
#pragma unroll
                for (int m = 0; m < 4; m += 2) asm volatile("" : "+v"(xr[m][0]), "+v"(xr[m][1]), "+v"(xr[m + 1][0]), "+v"(xr[m + 1][1]));
#pragma unroll
                for (int m = 0; m < 4; ++m)
#pragma unroll
                    for (int bj = 0; bj < 2; ++bj) { const u32x4 w = xr[m][bj];
                        xo[m][bj][0] = (f32x4){__uint_as_float(w.x << 16), __uint_as_float(w.x & 0xffff0000u), __uint_as_float(w.y << 16), __uint_as_float(w.y & 0xffff0000u)};
                        xo[m][bj][1] = (f32x4){__uint_as_float(w.z << 16), __uint_as_float(w.z & 0xffff0000u), __uint_as_float(w.w << 16), __uint_as_float(w.w & 0xffff0000u)}; } }
#pragma unroll
            for (int m = 0; m < 4; ++m) { const int row = row0 + ai * HALF + m * 16; float sq = 0.f;
#pragma unroll
                for (int bj = 0; bj < 2; ++bj) { const size_t p = (size_t)row * 2048 + col0 + bj * HALF;
                    const f32x4 a = xo[m][bj][0] + acc[ai][bj][m][0], b = xo[m][bj][1] + acc[ai][bj][m][1];
                    if (out) { *(f32x4*)(out + p) = a; *(f32x4*)(out + p + 4) = b; }
                    if (xb && ssn) { u32x4 w; w.x = cvt_pk_bf16(a[0], a[1]); w.y = cvt_pk_bf16(a[2], a[3]); w.z = cvt_pk_bf16(b[0], b[1]); w.w = cvt_pk_bf16(b[2], b[3]); *(u32x4*)(xb + p) = w; }
                    sq += (a[0] * a[0] + a[1] * a[1]) + (a[2] * a[2] + a[3] * a[3]) + (b[0] * b[0] + b[1] * b[1]) + (b[2] * b[2] + b[3] * b[3]); }
                sq += __shfl_xor(sq, 16); sq += __shfl_xor(sq, 32);
                if (fq == 0 && ssn) atomicAdd(ssn + row, (unsigned long long)(sq * 1048576.0f + 0.5f)); } }
    }
};

template <class Epi, class Sched, bool ALIGN_EPI = false, bool SP2 = false>
__device__ __forceinline__ void gemm_phase(PG8_LAS unsigned char* lds, const Gemm g, const Sched& S, const Epi& E) {
    int tid_ = threadIdx.x; asm volatile("" : "+v"(tid_)); const int tid = tid_, wid = __builtin_amdgcn_readfirstlane(tid >> 6), lane = tid & 63, wr = wid >> 2, wc = wid & 3, fr = lane & 15, fq = lane >> 4;
    const int K = g.K, nt = K / BK;
    unsigned voffA[2], voffB[2];
#pragma unroll
    for (int i = 0; i < 2; ++i) { int R, C; stage_rc(tid * 16 + i * 8192, R, C); const int Rb = Epi::PERM ? ((R & ~31) + perm32(R & 31)) : R;
        voffA[i] = (unsigned)(R * K + C) * 2u; voffB[i] = (unsigned)(Rb * K + C) * 2u; }
    const size_t kstep = (size_t)(BK * 2);
    const size_t hstep = (size_t)HALF * K * 2;
    const size_t tstep = 2 * hstep;
    const unsigned ldsw = (unsigned)wid * 1024u;
    const int aoff = lds_byte(wr * 64 + fr, fq * 8), boff = lds_byte(wc * 32 + fr, fq * 8);
#define PG8_SA(b, h) (((b) * 2 + (h)) * HTB)
#define PG8_SB(b, h) ((4 + (b) * 2 + (h)) * HTB)
#define PG8_STAGE(bufoff, gbase, voff) do { _Pragma("unroll") for (int _i = 0; _i < 2; ++_i) \
        __builtin_amdgcn_global_load_lds((const unsigned*)((const char*)(gbase) + (voff)[_i]), (PG8_LAS unsigned*)(lds + (bufoff) + ldsw + _i * 8192), 16, 0, 0); } while (0)
#define PG8_LDA(dst, b, h) do { _Pragma("unroll") for (int m = 0; m < 4; ++m) _Pragma("unroll") for (int k = 0; k < 2; ++k) dst[m][k] = *(const PG8_LAS bf16x8*)(lds + PG8_SA(b, h) + aoff + m * 2048 + k * 1024); } while (0)
#define PG8_LDB(dst, b, h) do { _Pragma("unroll") for (int n = 0; n < 2; ++n) _Pragma("unroll") for (int k = 0; k < 2; ++k) dst[n][k] = *(const PG8_LAS bf16x8*)(lds + PG8_SB(b, h) + boff + n * 2048 + k * 1024); } while (0)
#define PG8_MMA(ai, bj, At, Bt) do { __builtin_amdgcn_s_setprio(1); _Pragma("unroll") for (int m = 0; m < 4; ++m) _Pragma("unroll") for (int n = 0; n < 2; ++n) _Pragma("unroll") for (int k = 0; k < 2; ++k) \
        acc[ai][bj][m][n] = __builtin_amdgcn_mfma_f32_16x16x32_bf16(Bt[n][k], At[m][k], acc[ai][bj][m][n], 0, 0, 0); __builtin_amdgcn_s_setprio(0); } while (0)
#define PG8_WAIT_V(n) asm volatile("s_waitcnt vmcnt(" #n ")" ::: "memory")
#define PG8_WAIT_L(n) asm volatile("s_waitcnt lgkmcnt(" #n ")" ::: "memory")
#define PG8_BAR __builtin_amdgcn_s_barrier()
#define PG8_SCHED __builtin_amdgcn_sched_barrier(0)
    Unit cur, nxt; int ui = 0;
    if (!S.next(0, cur)) return;
    f32x4 acc[2][2][4][2];
#pragma unroll
    for (int a = 0; a < 2; ++a)
#pragma unroll
        for (int b = 0; b < 2; ++b)
#pragma unroll
            for (int m = 0; m < 4; ++m)
#pragma unroll
                for (int n = 0; n < 2; ++n) acc[a][b][m][n] = (f32x4){0.f, 0.f, 0.f, 0.f};
    bf16x8 At[4][2], B0[2][2], B1[2][2];
    const char* cA = (const char*)g.A + (size_t)cur.pm * tstep; const char* cB = (const char*)g.Bt + (size_t)cur.pn * tstep;
    S.a_ready(cur);
    if constexpr (SP2) {
        PG8_STAGE(PG8_SB(0, 0), cB, voffB); PG8_STAGE(PG8_SB(0, 1), cB + hstep, voffB); PG8_STAGE(PG8_SA(0, 0), cA, voffA); PG8_STAGE(PG8_SA(0, 1), cA + hstep, voffA);
        if (wr == 1) PG8_BAR;
        PG8_WAIT_V(2); PG8_BAR;
        PG8_STAGE(PG8_SB(1, 0), cB + kstep, voffB); PG8_STAGE(PG8_SA(1, 0), cA + kstep, voffA); PG8_STAGE(PG8_SB(1, 1), cB + hstep + kstep, voffB);
        PG8_WAIT_V(6); PG8_BAR;
    } else {
        PG8_STAGE(PG8_SB(0, 0), cB, voffB); PG8_STAGE(PG8_SA(0, 0), cA, voffA); PG8_STAGE(PG8_SB(0, 1), cB + hstep, voffB); PG8_STAGE(PG8_SA(0, 1), cA + hstep, voffA);
        if (wr == 1) PG8_BAR;
        PG8_WAIT_V(4); PG8_BAR;
        PG8_STAGE(PG8_SB(1, 0), cB + kstep, voffB); PG8_STAGE(PG8_SA(1, 0), cA + kstep, voffA); PG8_STAGE(PG8_SB(1, 1), cB + hstep + kstep, voffB);
        PG8_WAIT_V(6); PG8_BAR;
    }
    for (;;) {
        const bool has_next = S.next(ui + 1, nxt);
        const char* nA = has_next ? (const char*)g.A + (size_t)nxt.pm * tstep : cA; const char* nB = has_next ? (const char*)g.Bt + (size_t)nxt.pn * tstep : cB;
        for (int t = 0; t < nt; t += 2) {
            const bool last = (t == nt - 2);
            const char* a1 = cA + (size_t)(t + 1) * kstep;
            const char* a2 = last ? nA : cA + (size_t)(t + 2) * kstep; const char* b2 = last ? nB : cB + (size_t)(t + 2) * kstep;
            const char* a3 = a2 + kstep; const char* b3 = b2 + kstep;
            if (last && has_next) S.a_ready(nxt);
            if constexpr (SP2) {
            PG8_LDB(B0, 0, 0); PG8_LDB(B1, 0, 1); PG8_SCHED; PG8_LDA(At, 0, 0); PG8_STAGE(PG8_SA(1, 1), a1 + hstep, voffA);
            PG8_WAIT_V(8); PG8_WAIT_L(0); PG8_BAR; PG8_MMA(0, 0, At, B0); PG8_MMA(0, 1, At, B1); PG8_BAR; PG8_SCHED;
            PG8_LDA(At, 0, 1); PG8_STAGE(PG8_SB(0, 0), b2, voffB); PG8_STAGE(PG8_SB(0, 1), b2 + hstep, voffB); PG8_STAGE(PG8_SA(0, 0), a2, voffA);
            PG8_WAIT_V(8); PG8_WAIT_L(0); PG8_BAR; PG8_MMA(1, 0, At, B0); PG8_MMA(1, 1, At, B1); PG8_BAR; PG8_SCHED;
            PG8_LDB(B0, 1, 0); PG8_LDB(B1, 1, 1); PG8_SCHED; PG8_LDA(At, 1, 0); PG8_STAGE(PG8_SA(0, 1), a2 + hstep, voffA);
            PG8_WAIT_V(8); PG8_WAIT_L(0); PG8_BAR; PG8_MMA(0, 0, At, B0); PG8_MMA(0, 1, At, B1); PG8_BAR; PG8_SCHED;
            PG8_LDA(At, 1, 1); PG8_STAGE(PG8_SB(1, 0), b3, voffB); PG8_STAGE(PG8_SB(1, 1), b3 + hstep, voffB); PG8_STAGE(PG8_SA(1, 0), a3, voffA);
            PG8_WAIT_V(8); PG8_WAIT_L(0); PG8_BAR; PG8_MMA(1, 0, At, B0); PG8_MMA(1, 1, At, B1); PG8_BAR; PG8_SCHED;
            } else {
            PG8_LDB(B0, 0, 0); PG8_SCHED; PG8_LDA(At, 0, 0); PG8_STAGE(PG8_SA(1, 1), a1 + hstep, voffA);
            PG8_WAIT_L(8); PG8_BAR; PG8_WAIT_L(0); PG8_MMA(0, 0, At, B0); PG8_BAR; PG8_SCHED;
            PG8_LDB(B1, 0, 1); PG8_STAGE(PG8_SB(0, 0), b2, voffB);
            PG8_BAR; PG8_WAIT_L(0); PG8_MMA(0, 1, At, B1); PG8_BAR;
            PG8_LDA(At, 0, 1); PG8_STAGE(PG8_SA(0, 0), a2, voffA);
            PG8_BAR; PG8_WAIT_L(0); PG8_MMA(1, 0, At, B0); PG8_BAR; PG8_SCHED;
            PG8_STAGE(PG8_SB(0, 1), b2 + hstep, voffB);
            PG8_WAIT_V(6); PG8_BAR; PG8_MMA(1, 1, At, B1); PG8_BAR;
            PG8_LDB(B0, 1, 0); PG8_SCHED; PG8_LDA(At, 1, 0); PG8_STAGE(PG8_SA(0, 1), a2 + hstep, voffA);
            PG8_WAIT_L(8); PG8_BAR; PG8_WAIT_L(0); PG8_MMA(0, 0, At, B0); PG8_BAR; PG8_SCHED;
            PG8_LDB(B1, 1, 1); PG8_STAGE(PG8_SB(1, 0), b3, voffB);
            PG8_BAR; PG8_WAIT_L(0); PG8_MMA(0, 1, At, B1); PG8_BAR;
            PG8_LDA(At, 1, 1); PG8_STAGE(PG8_SA(1, 0), a3, voffA);
            PG8_BAR; PG8_WAIT_L(0); PG8_MMA(1, 0, At, B0); PG8_BAR; PG8_SCHED;
            PG8_STAGE(PG8_SB(1, 1), b3 + hstep, voffB);
            PG8_WAIT_V(6); PG8_BAR; PG8_MMA(1, 1, At, B1); PG8_BAR;
            }
        }
        if constexpr (ALIGN_EPI) { if (wr == 0) PG8_BAR; }
        if constexpr (!Epi::AFTER_DRAIN) { E(acc, cur, wr, wc, fr, fq); S.done(cur); }
        if (!has_next) break;
#pragma unroll
        for (int a = 0; a < 2; ++a)
#pragma unroll
            for (int b = 0; b < 2; ++b)
#pragma unroll
                for (int m = 0; m < 4; ++m)
#pragma unroll
                    for (int n = 0; n < 2; ++n) acc[a][b][m][n] = (f32x4){0.f, 0.f, 0.f, 0.f};
        cur = nxt; cA = nA; cB = nB; ++ui;
        if constexpr (ALIGN_EPI) { if (wr == 1) PG8_BAR; }
    }
    PG8_WAIT_V(0);
    if constexpr (!ALIGN_EPI) { if (wr == 0) PG8_BAR; }
    PG8_BAR;
    if constexpr (Epi::AFTER_DRAIN) { E.fused(acc, cur, wr, wc, fr, fq, lds, wid, lane); S.done(cur); }
#undef PG8_SA
#undef PG8_SB
#undef PG8_STAGE
#undef PG8_LDA
#undef PG8_LDB
#undef PG8_MMA
#undef PG8_WAIT_V
#undef PG8_WAIT_L
#undef PG8_BAR
#undef PG8_SCHED
}
}
constexpr int SEQ = 8192, DM = 2048, NLAYER = 4, INW = 7448, NPAD = 7680, PW = pg8::PROJ_W;
constexpr int C_AQ = 0, C_AK = 768, C_AV = 1536, C_AZ = 2304, C_BQ = 3072, C_BK = 3584, C_BV = 4096, C_BZ = 4608, C_CQ = 5120, C_CK = 5504, C_CV = 5888, C_CZ = 6656;
constexpr float LOG2E = 1.4426950408889634f, QSCALE = 0.125f * 1.4426950408889634f, EPS = 1e-6f;
constexpr size_t MiB = 1u << 20;
constexpr size_t WS_CTL = 0, WS_SS = 1 * MiB, WS_WTIN = 2 * MiB, WS_WTOUT = 122 * MiB, WS_XB = 154 * MiB, WS_PROJ = 186 * MiB, WS_SMALL = 302 * MiB,
                 WS_MIXED = 304 * MiB, WS_OA = 336 * MiB, WS_LA = 372 * MiB, WS_OB = 374 * MiB, WS_LB = 438 * MiB, WS_CL = 439 * MiB, WS_BT = WS_CL + 512 * 1024,
                 WS_DS = 440 * MiB, WS_ST = 476 * MiB, WS_DEC = 494 * MiB, WS_END = 496 * MiB;
constexpr int RING_BYTES = 131072, LDS_BYTES = 147456, QSLOT_OFF = RING_BYTES + 64, MISC_OFF = RING_BYTES + 256;
constexpr int P3_EXT = RING_BYTES + 1024;
constexpr int N_SCAN = 72, N_FOX = 640, N_AU = 1152, N_ITEMS = N_SCAN + N_FOX + N_AU;

typedef unsigned short bf16;
typedef short bf16x8 __attribute__((ext_vector_type(8)));
typedef short s16x4 __attribute__((ext_vector_type(4)));
typedef float f32x4 __attribute__((ext_vector_type(4)));
typedef float f32x2 __attribute__((ext_vector_type(2)));
typedef float f32x16 __attribute__((ext_vector_type(16)));
typedef unsigned u32x4 __attribute__((ext_vector_type(4)));
typedef unsigned u32x2 __attribute__((ext_vector_type(2)));
typedef __attribute__((address_space(3))) const char* lds_cptr;
#define LAS3 __attribute__((address_space(3)))

__device__ __forceinline__ float bf2f(unsigned b) { return __uint_as_float(b << 16); }
__device__ __forceinline__ unsigned pk2(float lo, float hi) { return pg8::cvt_pk_bf16(lo, hi); }
__device__ __forceinline__ float blo(unsigned w) { return __uint_as_float(w << 16); }
__device__ __forceinline__ float bhi(unsigned w) { return __uint_as_float(w & 0xffff0000u); }
__device__ __forceinline__ float logsig(float x) { return fminf(x, 0.f) - log1pf(expf(-fabsf(x))); }
__device__ __forceinline__ float silu(float x) { return x / (1.f + __expf(-x)); }
__device__ __forceinline__ s16x4 vtr(lds_cptr p) { return __builtin_bit_cast(s16x4, __builtin_amdgcn_ds_read_tr16_b64_v4i16((LAS3 s16x4*)p)); }
__device__ __forceinline__ bf16x8 frag_tr(lds_cptr img, int stride, int kbase, int m0, int lane) {
    const int i = lane & 15, g = lane >> 4;
    lds_cptr p = img + (kbase + 4 * (g >> 1) + (i >> 2)) * stride + (m0 + 16 * (g & 1) + 4 * (i & 3)) * 2;
    const s16x4 a = vtr(p), b = vtr(p + 8 * stride);
    return (bf16x8){a[0], a[1], a[2], a[3], b[0], b[1], b[2], b[3]};
}
__device__ __forceinline__ int rowidx(int reg, int hh) { return (reg & 3) + 8 * (reg >> 2) + 4 * hh; }
__device__ __forceinline__ void pack_p(const f32x16& p, bf16x8& f0, bf16x8& f1) {
    u32x4 a, b; a.x = pk2(p[0], p[1]); a.y = pk2(p[2], p[3]); a.z = pk2(p[4], p[5]); a.w = pk2(p[6], p[7]);
    b.x = pk2(p[8], p[9]); b.y = pk2(p[10], p[11]); b.z = pk2(p[12], p[13]); b.w = pk2(p[14], p[15]);
    f0 = __builtin_bit_cast(bf16x8, a); f1 = __builtin_bit_cast(bf16x8, b);
}
#define MFMA32(a, b, c) __builtin_amdgcn_mfma_f32_32x32x16_bf16((a), (b), (c), 0, 0, 0)

struct Ctx {
    const float *x, *norm_g, *w_in, *aqg, *akg, *bqg, *bkg, *fox_bias, *gate_up, *gate_bias, *out_gain, *w_out;
    float* out; unsigned char* ws;
    unsigned* ctl; unsigned long long* ss; bf16* wtin; bf16* wtout; bf16* xb; bf16* proj; float* small; bf16* mixed; bf16* oa; float* la; float* ob; float* lb; float* cl; float* bt;
    float* ds; bf16* st; float* dec;
    unsigned char* lds; int tid, lane, wave, G, bid;
};

__device__ __forceinline__ int orig_col(int np) { if (np < 5120) return np; if (np < 7424) return np + 8; if (np < 7432) return 5120 + (np - 7424); if (np < 7448) return np; return -1; }
__device__ __forceinline__ void p0_load(const float* W, int N, const float* g, int mode, int kb, int nb, int lane, f32x4 (&v)[8], float (&gs)[8]) {
    const int k0 = 64 * kb, np = 32 * nb + 4 * (lane & 7);
    const int oc = mode ? orig_col(np) : np;
#pragma unroll
    for (int i = 0; i < 8; ++i) { const int kk = 8 * i + (lane >> 3); v[i] = (f32x4){0.f, 0.f, 0.f, 0.f}; gs[i] = 1.0f;
        if (oc >= 0) { v[i] = *(const f32x4*)(W + (size_t)(k0 + kk) * N + oc); if (mode) gs[i] = g[k0 + kk]; } }
}
__device__ __forceinline__ void p0_finish(bf16* WT, int mode, int kb, int nb, int lane, float* scr, const f32x4 (&v)[8], const float (&gs)[8]) {
    const int k0 = 64 * kb, n0 = 32 * nb, c4 = 4 * (lane & 7), np = n0 + c4;
    const float cs = (mode && np >= C_CQ && np < C_CK) ? 0.10206207261596577f : 1.0f;
#pragma unroll
    for (int i = 0; i < 8; ++i) { const int kk = 8 * i + (lane >> 3); float* d = scr + kk * 33 + c4; const float sc = cs * gs[i]; d[0] = v[i].x * sc; d[1] = v[i].y * sc; d[2] = v[i].z * sc; d[3] = v[i].w * sc; }
    asm volatile("s_waitcnt lgkmcnt(0)" ::: "memory");
    const int c = lane & 7;
#pragma unroll
    for (int j = 0; j < 4; ++j) { const int n = (lane >> 3) + 8 * j; const float* s = scr + (8 * c) * 33 + n;
        u32x4 o; o.x = pk2(s[0 * 33], s[1 * 33]); o.y = pk2(s[2 * 33], s[3 * 33]); o.z = pk2(s[4 * 33], s[5 * 33]); o.w = pk2(s[6 * 33], s[7 * 33]);
        *(u32x4*)(WT + (size_t)(n0 + n) * 2048 + k0 + 8 * c) = o; }
    asm volatile("s_waitcnt lgkmcnt(0)" ::: "memory");
}
__device__ __forceinline__ void phase0(Ctx& F) {
    float* scr = (float*)(F.lds + F.wave * 16384);
    const int gw = F.bid * 8 + F.wave, NGW = F.G * 8;
    if (F.bid == 0) for (int i = F.tid; i < 16384; i += 512) F.ctl[i] = 0u;
    for (int i = F.bid * 512 + F.tid; i < 3 * SEQ; i += F.G * 512) F.ss[SEQ + i] = 0ull;
    constexpr int I_IN = 32 * 233, I_OUT = 32 * 64, I_L = I_IN + I_OUT, I_ALL = NLAYER * I_L;
#define P0_DECODE(it_, W_, N_, WT_, g_, mode_, kb_, nb_) do { const int l_ = (it_) / I_L; int r_ = (it_) % I_L; \
        if (r_ < I_IN) { W_ = F.w_in + (size_t)l_ * DM * INW; N_ = INW; WT_ = F.wtin + (size_t)l_ * NPAD * DM; g_ = F.norm_g + l_ * DM; mode_ = 1; kb_ = r_ / 233; nb_ = r_ % 233; } \
        else { r_ -= I_IN; W_ = F.w_out + (size_t)l_ * DM * DM; N_ = DM; WT_ = F.wtout + (size_t)l_ * DM * DM; g_ = F.norm_g; mode_ = 0; kb_ = r_ / 64; nb_ = r_ % 64; } } while (0)
    { f32x4 va[8], vb[8]; float ga[8], gb[8];
      const float* W = nullptr; const float* g = nullptr; bf16* WT = nullptr; int N = 0, mode = 0, kb = 0, nb = 0;
      int it = gw;
      if (it < I_ALL) { P0_DECODE(it, W, N, WT, g, mode, kb, nb); p0_load(W, N, g, mode, kb, nb, F.lane, va, ga); }
      while (it < I_ALL) { const int nit = it + NGW;
          const float* W2 = nullptr; const float* g2 = nullptr; bf16* WT2 = nullptr; int N2 = 0, mode2 = 0, kb2 = 0, nb2 = 0;
          if (nit < I_ALL) { P0_DECODE(nit, W2, N2, WT2, g2, mode2, kb2, nb2); p0_load(W2, N2, g2, mode2, kb2, nb2, F.lane, vb, gb); }
          p0_finish(WT, mode, kb, nb, F.lane, scr, va, ga);
#pragma unroll
          for (int i = 0; i < 8; ++i) { va[i] = vb[i]; ga[i] = gb[i]; }
          it = nit; WT = WT2; mode = mode2; kb = kb2; nb = nb2; } }
#undef P0_DECODE
    for (int m = gw; m < SEQ; m += NGW) {
        const f32x4* xr = (const f32x4*)(F.x + (size_t)m * DM) + F.lane; float s = 0.f; u32x2* o8 = (u32x2*)(F.xb + (size_t)m * DM) + F.lane;
#pragma unroll
        for (int j = 0; j < 8; ++j) { const f32x4 v = xr[64 * j]; s += (v.x * v.x + v.y * v.y) + (v.z * v.z + v.w * v.w); u32x2 w; w.x = pk2(v.x, v.y); w.y = pk2(v.z, v.w); o8[64 * j] = w; }
#pragma unroll
        for (int o = 1; o < 64; o <<= 1) s += __shfl_xor(s, o);
        if (F.lane == 0) F.ss[m] = (unsigned long long)(s * 1048576.0f + 0.5f);
    }
}

__device__ __forceinline__ void phase2(Ctx& F, int l) {
    { const int gw = F.bid * 8 + F.wave, NGW = F.G * 8;
      for (int wi = gw; wi < 512; wi += NGW) { const int blk = wi >> 3, h = wi & 7, t = blk * 128 + 2 * F.lane; const float fb = F.fox_bias[l * 8 + h];
        const float l0 = logsig(F.small[(size_t)t * 32 + h] + fb), l1 = logsig(F.small[(size_t)(t + 1) * 32 + h] + fb);
        float s = l0 + l1;
#pragma unroll
        for (int o = 1; o < 64; o <<= 1) { const float y = __shfl_up(s, o); if (F.lane >= o) s += y; }
        const float ex = s - (l0 + l1); F.cl[t * 8 + h] = ex + l0; F.cl[(t + 1) * 8 + h] = s; if (F.lane == 63) F.bt[blk * 8 + h] = s; } }
    { float* CR = (float*)F.lds;
      float* GT = (float*)(F.lds + 4096);
      unsigned char* KH = F.lds + 8192;
      unsigned char* VV = F.lds + 8192 + 13312;
      const float* gup = F.gate_up + (size_t)l * 16 * 384; const float* gbs = F.gate_bias + l * 384;
      for (int u = F.bid; u < 512; u += F.G) { const int h = u & 3, n = u >> 2, t0 = n * 64;
        if (F.tid < 256) *(f32x4*)(CR + F.tid * 4) = *(const f32x4*)(F.small + (size_t)(t0 + (F.tid >> 2)) * 32 + 8 + 4 * (F.tid & 3));
        { u32x4 vv[3];
#pragma unroll
          for (int i = 0; i < 3; ++i) { const int e = F.tid + 512 * i, row = e / 24, ch = e % 24; vv[i] = *(const u32x4*)(F.proj + (size_t)(t0 + row) * PW + C_CV + h * 192 + ch * 8); }
          asm volatile("" : "+v"(vv[0]), "+v"(vv[1]), "+v"(vv[2]));
#pragma unroll
          for (int i = 0; i < 3; ++i) { const int e = F.tid + 512 * i, row = e / 24, ch = e % 24; *(u32x4*)(VV + row * 400 + ch * 16) = vv[i]; } }
        __syncthreads();
        const int d = F.tid % 96, tg = F.tid / 96;
        float bc[16];
        if (F.tid < 384) { float g[16];
#pragma unroll
            for (int r = 0; r < 16; ++r) g[r] = gup[r * 384 + h * 96 + d];
            const float gb = gbs[h * 96 + d]; float run = 0.f;
#pragma unroll
            for (int i = 0; i < 16; ++i) { const float* cr = CR + (16 * tg + i) * 16; float a = gb;
#pragma unroll
                for (int r4 = 0; r4 < 4; ++r4) { const f32x4 c = *(const f32x4*)(cr + 4 * r4); a += c.x * g[4 * r4] + c.y * g[4 * r4 + 1] + c.z * g[4 * r4 + 2] + c.w * g[4 * r4 + 3]; }
                const float ls = fminf(a, 0.f) - __logf(1.f + __expf(-fabsf(a)));
                run += ls * (1.f / 16.f); bc[i] = run; }
            GT[tg * 96 + d] = run; }
        __syncthreads();
        if (F.tid < 384) { const float g0 = GT[d], g1 = GT[96 + d], g2 = GT[192 + d], g3 = GT[288 + d];
            const float pre = (tg > 0 ? g0 : 0.f) + (tg > 1 ? g1 : 0.f) + (tg > 2 ? g2 : 0.f);
            const float bm = g0 + g1, bl = (g0 + g1) + (g2 + g3);
            bf16* qp = F.proj + (size_t)(t0 + 16 * tg) * PW + C_CQ + h * 96 + d; bf16* kp = F.proj + (size_t)(t0 + 16 * tg) * PW + C_CK + h * 96 + d;
            float qv[16], kv[16]; unsigned qr[16], kr[16];
#pragma unroll
            for (int i = 0; i < 16; ++i) { qr[i] = qp[(size_t)i * PW]; kr[i] = kp[(size_t)i * PW]; }
#pragma unroll
            for (int i = 0; i < 16; i += 4) { asm volatile("" : "+v"(qr[i]), "+v"(qr[i + 1]), "+v"(qr[i + 2]), "+v"(qr[i + 3])); asm volatile("" : "+v"(kr[i]), "+v"(kr[i + 1]), "+v"(kr[i + 2]), "+v"(kr[i + 3])); }
#pragma unroll
            for (int i = 0; i < 16; ++i) { qv[i] = bf2f(qr[i]); kv[i] = bf2f(kr[i]); }
#pragma unroll
            for (int i = 0; i < 16; ++i) { const float b = bc[i] + pre; const float eq = __expf(b - bm), ek = __expf(bm - b), eh = __expf(bl - b);
                qp[(size_t)i * PW] = (bf16)(pk2(qv[i] * eq, 0.f) & 0xffffu); kp[(size_t)i * PW] = (bf16)(pk2(kv[i] * ek, 0.f) & 0xffffu);
                *(bf16*)(KH + (16 * tg + i) * 208 + d * 2) = (bf16)(pk2(kv[i] * eh, 0.f) & 0xffffu); }
            if (tg == 0) { F.dec[(n * 4 + h) * 96 + d] = __expf(bl); F.dec[49152 + (n * 4 + h) * 96 + d] = __expf(bm); } }
        __syncthreads();
        for (int id = F.wave; id < 18; id += 8) { const int vt = id / 3, dt = id % 3; f32x16 acc = {};
#pragma unroll
            for (int s = 0; s < 4; ++s) { const bf16x8 a = frag_tr((lds_cptr)VV, 400, 16 * s, 32 * vt, F.lane), b = frag_tr((lds_cptr)KH, 208, 16 * s, 32 * dt, F.lane); acc = MFMA32(a, b, acc); }
            float* dst = F.ds + ((size_t)(n * 4 + h) * 192 + 32 * vt) * 96 + 32 * dt + (F.lane & 31);
#pragma unroll
            for (int r = 0; r < 16; ++r) dst[(size_t)rowidx(r, F.lane >> 5) * 96] = acc[r]; }
        __syncthreads(); } }
}
__device__ __forceinline__ float softmax_ref2(const float* gq, const float* gk) {
    float mq = 0.f, mk = 0.f;
    for (int i = 0; i < 64; ++i) { mq = fmaxf(mq, fabsf(gq[i])); mk = fmaxf(mk, fabsf(gk[i])); }
    return 8.25f * mq * mk * LOG2E;
}
__device__ __forceinline__ void scan_item(Ctx& F, int si) {
    const int p = si * 512 + F.tid, d = 2 * (p % 48), v = (p / 48) % 192, h = p / (48 * 192);
    float s0 = 0.f, s1 = 0.f;
    for (int nb = 0; nb < 128; nb += 8) { f32x2 dd[8], a[8], em[8];
#pragma unroll
        for (int j = 0; j < 8; ++j) { const int n = nb + j; const size_t idx = ((size_t)(n * 4 + h) * 192 + v) * 96 + d; const int di = (n * 4 + h) * 96 + d;
            dd[j] = *(const f32x2*)(F.ds + idx); a[j] = *(const f32x2*)(F.dec + di); em[j] = *(const f32x2*)(F.dec + 49152 + di); }
#pragma unroll
        for (int j = 0; j < 8; j += 4) { asm volatile("" : "+v"(dd[j]), "+v"(dd[j + 1]), "+v"(dd[j + 2]), "+v"(dd[j + 3])); asm volatile("" : "+v"(a[j]), "+v"(a[j + 1]), "+v"(a[j + 2]), "+v"(a[j + 3])); asm volatile("" : "+v"(em[j]), "+v"(em[j + 1]), "+v"(em[j + 2]), "+v"(em[j + 3])); }
#pragma unroll
        for (int j = 0; j < 8; ++j) { const int n = nb + j; const size_t idx = ((size_t)(n * 4 + h) * 192 + v) * 96 + d;
            *(unsigned*)(F.st + idx) = pk2(em[j].x * s0, em[j].y * s1);
            s0 = a[j].x * s0 + dd[j].x; s1 = a[j].y * s1 + dd[j].y; } }
}
#define PIN4(a, b, c, d) asm volatile("" : "+v"(a), "+v"(b), "+v"(c), "+v"(d))
#define SBAR0() __builtin_amdgcn_sched_barrier(0)
template <int KSTR, int VSTR>
__device__ __forceinline__ void attn_sub(const unsigned char* Kt, const unsigned char* Vt, int key_row0, const bf16x8 (&qf)[4], f32x16 S, f32x16 (&o)[2], float& lsum, int lane,
                                         bool use_mask, int lo, int hi_) {
    const int r = lane & 31, hh = lane >> 5;
    bf16x8 kf[4];
#pragma unroll
    for (int s = 0; s < 4; ++s) kf[s] = *(const bf16x8*)(Kt + (key_row0 + r) * KSTR + (16 * s + 8 * hh) * 2);
    bf16x8 vf[2][2];
#pragma unroll
    for (int dt = 0; dt < 2; ++dt) { vf[dt][0] = frag_tr((lds_cptr)Vt, VSTR, key_row0, 32 * dt, lane); vf[dt][1] = frag_tr((lds_cptr)Vt, VSTR, key_row0 + 16, 32 * dt, lane); }
    PIN4(kf[0], kf[1], kf[2], kf[3]);
#pragma unroll
    for (int s = 0; s < 4; ++s) S = MFMA32(kf[s], qf[s], S);
    if (use_mask) {
#pragma unroll
        for (int g = 0; g < 16; ++g) { const int k = rowidx(g, hh); if (k < lo || k > hi_) S[g] = -INFINITY; } }
    float acc = 0.f;
#pragma unroll
    for (int g = 0; g < 16; ++g) { S[g] = __builtin_amdgcn_exp2f(S[g]); acc += S[g]; }
    lsum += acc;
    bf16x8 p0, p1; pack_p(S, p0, p1);
    PIN4(vf[0][0], vf[0][1], vf[1][0], vf[1][1]);
#pragma unroll
    for (int dt = 0; dt < 2; ++dt) { o[dt] = MFMA32(vf[dt][0], p0, o[dt]); o[dt] = MFMA32(vf[dt][1], p1, o[dt]); }
}
template <int NSUB, int KSTR, int VSTR>
__device__ __forceinline__ void attn_multi(const unsigned char* Kt, const unsigned char* Vt, int key_row0, const bf16x8 (&qf)[4], f32x16 (&S)[NSUB], f32x16 (&o)[2], float& lsum, int lane) {
    const int r = lane & 31, hh = lane >> 5;
    bf16x8 kf[NSUB][4];
#pragma unroll
    for (int u = 0; u < NSUB; ++u)
#pragma unroll
        for (int s = 0; s < 4; ++s) kf[u][s] = *(const bf16x8*)(Kt + (key_row0 + 32 * u + r) * KSTR + (16 * s + 8 * hh) * 2);
#pragma unroll
    for (int u = 0; u < NSUB; ++u) PIN4(kf[u][0], kf[u][1], kf[u][2], kf[u][3]);
#pragma unroll
    for (int s = 0; s < 4; ++s)
#pragma unroll
        for (int u = 0; u < NSUB; ++u) S[u] = MFMA32(kf[u][s], qf[s], S[u]);
#pragma unroll
    for (int u = 0; u < NSUB; ++u) {
        bf16x8 vf[2][2];
#pragma unroll
        for (int dt = 0; dt < 2; ++dt) { vf[dt][0] = frag_tr((lds_cptr)Vt, VSTR, key_row0 + 32 * u, 32 * dt, lane); vf[dt][1] = frag_tr((lds_cptr)Vt, VSTR, key_row0 + 32 * u + 16, 32 * dt, lane); }
        SBAR0();
        float acc = 0.f;
#pragma unroll
        for (int g = 0; g < 16; ++g) { S[u][g] = __builtin_amdgcn_exp2f(S[u][g]); acc += S[u][g]; }
        lsum += acc;
        bf16x8 p0, p1; pack_p(S[u], p0, p1);
        PIN4(vf[0][0], vf[0][1], vf[1][0], vf[1][1]);
#pragma unroll
        for (int dt = 0; dt < 2; ++dt) { o[dt] = MFMA32(vf[dt][0], p0, o[dt]); o[dt] = MFMA32(vf[dt][1], p1, o[dt]); } }
}
__device__ __forceinline__ void fox_unit(Ctx& F, int l, int h, int qb, int seg) {
    constexpr int KS = 144, VS = 192, BUFB = 128 * KS, BUFV = 128 * VS;
    unsigned char* KT = F.lds; unsigned char* VT = F.lds + 2 * BUFB; float* CS = (float*)(F.lds + 2 * BUFB + 2 * BUFV);
    const float* PEX = (const float*)(F.lds + P3_EXT) + h * 64;
    const int r = F.lane & 31, hh = F.lane >> 5, w = F.wave, t0 = 256 * qb, NT = 2 * qb + 2;
    const int kfirst = __builtin_amdgcn_readfirstlane(((const int*)(F.lds + P3_EXT + 2048))[h * 32 + qb]);
    const int nuse = (NT - kfirst + 15) >> 4;
    if (seg >= nuse) return;
    const int kt0 = kfirst + 16 * seg, te = (kt0 + 16 < NT) ? kt0 + 16 : NT;
    const float mb2 = ((const float*)(F.lds + P3_EXT + 3072))[1];
    const int tq = t0 + 32 * w + r; const float pq0 = PEX[t0 >> 7];
    const float ctq = ((PEX[tq >> 7] - pq0) + F.cl[tq * 8 + h]) * LOG2E - mb2;
    bf16x8 qf[4];
#pragma unroll
    for (int s = 0; s < 4; ++s) qf[s] = *(const bf16x8*)(F.proj + (size_t)tq * PW + C_BQ + h * 64 + 16 * s + 8 * hh);
    f32x16 o[2]; o[0] = f32x16{}; o[1] = f32x16{}; float lsum = 0.f;
    const int lrow = F.tid >> 3, lch = F.tid & 7;
    u32x4 kreg[2], vreg[2]; float creg = 0.f;
    if (kt0 < te) {
#pragma unroll
        for (int i = 0; i < 2; ++i) { const size_t g = (size_t)(128 * kt0 + 64 * i + lrow) * PW + h * 64 + lch * 8; kreg[i] = *(const u32x4*)(F.proj + g + C_BK); vreg[i] = *(const u32x4*)(F.proj + g + C_BV); }
        if (F.tid < 128) creg = ((PEX[kt0] - pq0) + F.cl[(128 * kt0 + F.tid) * 8 + h]) * LOG2E; }
    for (int kt = kt0; kt < te; ++kt) { const int buf = (kt - kt0) & 1;
#pragma unroll
        for (int i = 0; i < 2; ++i) { *(u32x4*)(KT + buf * BUFB + (64 * i + lrow) * KS + lch * 16) = kreg[i]; *(u32x4*)(VT + buf * BUFV + (64 * i + lrow) * VS + lch * 16) = vreg[i]; }
        if (F.tid < 128) CS[buf * 128 + F.tid] = creg;
        __syncthreads();
        if (kt + 1 < te) {
#pragma unroll
            for (int i = 0; i < 2; ++i) { const size_t g = (size_t)(128 * (kt + 1) + 64 * i + lrow) * PW + h * 64 + lch * 8; kreg[i] = *(const u32x4*)(F.proj + g + C_BK); vreg[i] = *(const u32x4*)(F.proj + g + C_BV); }
            if (F.tid < 128) creg = ((PEX[kt + 1] - pq0) + F.cl[(128 * (kt + 1) + F.tid) * 8 + h]) * LOG2E; }
        const unsigned char* Kb = KT + buf * BUFB; const unsigned char* Vb = VT + buf * BUFV; const float* Cb = CS + buf * 128;
        if (kt < 2 * qb) {
#pragma unroll
            for (int hf = 0; hf < 2; ++hf) { f32x16 S[2]; f32x4 c4[2][4];
#pragma unroll
                for (int u = 0; u < 2; ++u)
#pragma unroll
                    for (int i = 0; i < 4; ++i) c4[u][i] = *(const f32x4*)(Cb + 64 * hf + 32 * u + 8 * i + 4 * hh);
                PIN4(c4[0][0], c4[0][1], c4[0][2], c4[0][3]); PIN4(c4[1][0], c4[1][1], c4[1][2], c4[1][3]);
#pragma unroll
                for (int u = 0; u < 2; ++u)
#pragma unroll
                    for (int i = 0; i < 4; ++i) { S[u][4 * i] = ctq - c4[u][i].x; S[u][4 * i + 1] = ctq - c4[u][i].y; S[u][4 * i + 2] = ctq - c4[u][i].z; S[u][4 * i + 3] = ctq - c4[u][i].w; }
                attn_multi<2, KS, VS>(Kb, Vb, 64 * hf, qf, S, o, lsum, F.lane); }
        } else {
            const int qlo = t0 + 32 * w;
#pragma unroll
            for (int sub = 0; sub < 4; ++sub) { const int key0 = 128 * kt + 32 * sub;
                if (key0 <= qlo + 31) {
                    f32x16 S;
#pragma unroll
                    for (int i = 0; i < 4; ++i) { const f32x4 c4 = *(const f32x4*)(Cb + 32 * sub + 8 * i + 4 * hh); S[4 * i] = ctq - c4.x; S[4 * i + 1] = ctq - c4.y; S[4 * i + 2] = ctq - c4.z; S[4 * i + 3] = ctq - c4.w; }
                    attn_sub<KS, VS>(Kb, Vb, 32 * sub, qf, S, o, lsum, F.lane, key0 + 31 > qlo, 0, tq - key0); } }
        }
    }
    lsum += __shfl_xor(lsum, 32);
    float* ob = F.ob + ((size_t)seg * SEQ + tq) * 512 + h * 64 + 4 * hh;
#pragma unroll
    for (int dt = 0; dt < 2; ++dt)
#pragma unroll
        for (int i = 0; i < 4; ++i) *(f32x4*)(ob + 32 * dt + 8 * i) = (f32x4){o[dt][4 * i], o[dt][4 * i + 1], o[dt][4 * i + 2], o[dt][4 * i + 3]};
    if (hh == 0) F.lb[((size_t)seg * SEQ + tq) * 8 + h] = lsum;
    __syncthreads();
}
__device__ __forceinline__ void a_unit(Ctx& F, int l, int a, int n, int rres, int b2) {
    constexpr int KS = 144, VS = 192;
    unsigned char* KA = F.lds; unsigned char* VA = F.lds + 384 * KS;
    const int r = F.lane & 31, hh = F.lane >> 5, w = F.wave, d = (n == 0) ? 1 : (n == 1) ? 4 : 16, i0 = 256 * b2;
    { u32x4 kv[6], vv[6]; const int ch = F.tid & 7;
#pragma unroll
      for (int i = 0; i < 6; ++i) { const int j = (F.tid >> 3) + 64 * i, idx = i0 - 128 + j; kv[i] = (u32x4){0u, 0u, 0u, 0u}; vv[i] = (u32x4){0u, 0u, 0u, 0u};
          if (idx >= 0) { const size_t g = (size_t)(rres + d * idx) * PW + a * 64 + ch * 8; kv[i] = *(const u32x4*)(F.proj + g + C_AK); vv[i] = *(const u32x4*)(F.proj + g + C_AV); } }
      asm volatile("" : "+v"(kv[0]), "+v"(kv[1]), "+v"(kv[2]), "+v"(kv[3]), "+v"(kv[4]), "+v"(kv[5]));
      asm volatile("" : "+v"(vv[0]), "+v"(vv[1]), "+v"(vv[2]), "+v"(vv[3]), "+v"(vv[4]), "+v"(vv[5]));
#pragma unroll
      for (int i = 0; i < 6; ++i) { const int j = (F.tid >> 3) + 64 * i; *(u32x4*)(KA + j * KS + ch * 16) = kv[i]; *(u32x4*)(VA + j * VS + ch * 16) = vv[i]; } }
    const int tokq = rres + d * (i0 + 32 * w + r);
    bf16x8 qf[4];
#pragma unroll
    for (int s = 0; s < 4; ++s) qf[s] = *(const bf16x8*)(F.proj + (size_t)tokq * PW + C_AQ + a * 64 + 16 * s + 8 * hh);
    const float mb2 = ((const float*)(F.lds + P3_EXT + 3072))[0];
    __syncthreads();
    f32x16 o[2]; o[0] = f32x16{}; o[1] = f32x16{}; float lsum = 0.f;
    const int qj = 32 * w + r + 128;
    if (i0 != 0) {
        { f32x16 S;
#pragma unroll
          for (int g = 0; g < 16; ++g) S[g] = -mb2;
          attn_sub<KS, VS>(KA, VA, 32 * w, qf, S, o, lsum, F.lane, true, qj - 128 - 32 * w, 31); }
        { f32x16 S[3];
#pragma unroll
          for (int u = 0; u < 3; ++u)
#pragma unroll
              for (int g = 0; g < 16; ++g) S[u][g] = -mb2;
          attn_multi<3, KS, VS>(KA, VA, 32 * (w + 1), qf, S, o, lsum, F.lane); }
        { f32x16 S;
#pragma unroll
          for (int g = 0; g < 16; ++g) S[g] = -mb2;
          attn_sub<KS, VS>(KA, VA, 32 * (w + 4), qf, S, o, lsum, F.lane, true, 0, qj - 32 * (w + 4)); }
    } else
    for (int jt = w; jt < w + 5; ++jt) { const int j0 = 32 * jt;
        if (j0 + 31 < 128) continue;
        f32x16 S;
#pragma unroll
        for (int g = 0; g < 16; ++g) S[g] = -mb2;
        int lo = qj - 128 - j0; const int hi_ = qj - j0; if (128 - j0 > lo) lo = 128 - j0;
        attn_sub<KS, VS>(KA, VA, j0, qf, S, o, lsum, F.lane, true, lo, hi_); }
    lsum += __shfl_xor(lsum, 32);
    bf16* oa = F.oa + ((size_t)n * SEQ + tokq) * 768 + a * 64 + 4 * hh;
#pragma unroll
    for (int dt = 0; dt < 2; ++dt)
#pragma unroll
        for (int i = 0; i < 4; ++i) { u32x2 wv; wv.x = pk2(o[dt][4 * i], o[dt][4 * i + 1]); wv.y = pk2(o[dt][4 * i + 2], o[dt][4 * i + 3]); *(u32x2*)(oa + 32 * dt + 8 * i) = wv; }
    if (hh == 0) F.la[((size_t)n * SEQ + tokq) * 12 + a] = lsum;
    __syncthreads();
}
__device__ __forceinline__ void phase3(Ctx& F, int l) {
    volatile unsigned* slot = (volatile unsigned*)(F.lds + QSLOT_OFF);
    { float* PEXA = (float*)(F.lds + P3_EXT); int* KFT = (int*)(F.lds + P3_EXT + 2048); float* MB = (float*)(F.lds + P3_EXT + 3072);
      { const float v = F.bt[F.lane * 8 + F.wave]; float sc = v;
#pragma unroll
        for (int o = 1; o < 64; o <<= 1) { const float y = __shfl_up(sc, o); if (F.lane >= o) sc += y; }
        PEXA[F.wave * 64 + F.lane] = sc - v; }
      if (F.tid == 0) { MB[0] = softmax_ref2(F.aqg + l * 64, F.akg + l * 64); MB[1] = softmax_ref2(F.bqg + l * 64, F.bkg + l * 64); }
      __syncthreads();
      if (F.tid < 256) { const int h = F.tid >> 5, qb = F.tid & 31; const float thr = -(26.f + 2.f * MB[1] * (1.f / LOG2E)), pq0 = PEXA[h * 64 + 2 * qb];
          int kt = 0; while (kt < 2 * qb && (pq0 - PEXA[h * 64 + kt + 1]) < thr) ++kt;
          KFT[F.tid] = kt; if (F.bid == 0) F.ctl[8192 + F.tid] = (unsigned)kt; }
      __syncthreads(); }
    for (;;) {
        if (F.tid == 0) *slot = atomicAdd(F.ctl + l, 1u);
        __syncthreads();
        const int item = __builtin_amdgcn_readfirstlane((int)*slot);
        __syncthreads();
        if (item >= N_ITEMS) break;
        if (item < N_SCAN) scan_item(F, item);
        else if (item < N_SCAN + N_FOX) { int f = item - N_SCAN, ns, qhi;
            if (f < 256) { ns = 4; qhi = 31; } else if (f < 448) { f -= 256; ns = 3; qhi = 23; } else if (f < 576) { f -= 448; ns = 2; qhi = 15; } else { f -= 576; ns = 1; qhi = 7; }
            const int per = ns * 8, qb = qhi - f / per, rem = f % per;
            fox_unit(F, l, rem & 7, qb, rem >> 3); }
        else { const int au = item - N_SCAN - N_FOX, n = au / 384, rest = au % 384, a = rest >> 5, u = rest & 31;
            const int per = (n == 0) ? 32 : (n == 1) ? 8 : 2;
            a_unit(F, l, a, n, u / per, u % per); }
    }
}
#define PIN6(a) asm volatile("" : "+v"(a[0]), "+v"(a[1]), "+v"(a[2]), "+v"(a[3]), "+v"(a[4]), "+v"(a[5]))
__device__ __forceinline__ void phase4(Ctx& F, int l) {
    unsigned char* VV = F.lds;
    float* SSQ = (float*)(F.lds + 51200);
    const int r = F.lane & 31, hh = F.lane >> 5, w = F.wave, ui = w >> 2, th = (w >> 1) & 1, vh = w & 1;
    const float* gain = F.out_gain + l * 192;
    for (int pu = F.bid; pu < 256; pu += F.G) {
        const int u = 2 * pu + ui, h = u & 3, n = u >> 2, t0 = n * 64, tq = th * 32 + r;
        bf16x8 qf[6], kf0[6], kf1[6], sfa[6], sfb[6];
        const bf16* stb = F.st + ((size_t)(n * 4 + h) * 192 + 32 * (vh * 3) + r) * 96 + 8 * hh;
#pragma unroll
        for (int kd = 0; kd < 6; ++kd) { qf[kd] = *(const bf16x8*)(F.proj + (size_t)(t0 + tq) * PW + C_CQ + h * 96 + 16 * kd + 8 * hh);
            kf0[kd] = *(const bf16x8*)(F.proj + (size_t)(t0 + r) * PW + C_CK + h * 96 + 16 * kd + 8 * hh);
            kf1[kd] = *(const bf16x8*)(F.proj + (size_t)(t0 + 32 + r) * PW + C_CK + h * 96 + 16 * kd + 8 * hh);
            sfa[kd] = *(const bf16x8*)(stb + 16 * kd); }
        { u32x4 vv[6];
#pragma unroll
          for (int i = 0; i < 6; ++i) { const int e = F.tid + 512 * i, uu = e / 1536, e2 = e % 1536, row = e2 / 24, ch = e2 % 24, u2 = 2 * pu + uu, h2 = u2 & 3, n2 = u2 >> 2;
              vv[i] = *(const u32x4*)(F.proj + (size_t)(n2 * 64 + row) * PW + C_CV + h2 * 192 + ch * 8); }
          asm volatile("" : "+v"(vv[0]), "+v"(vv[1]), "+v"(vv[2]), "+v"(vv[3]), "+v"(vv[4]), "+v"(vv[5]));
#pragma unroll
          for (int i = 0; i < 6; ++i) { const int e = F.tid + 512 * i, uu = e / 1536, e2 = e % 1536, row = e2 / 24, ch = e2 % 24; *(u32x4*)(VV + uu * 25600 + row * 400 + ch * 16) = vv[i]; } }
        __syncthreads();
        PIN6(qf); PIN6(kf0); PIN6(kf1);
        bf16x8 pf[2][2];
        { f32x16 X = {};
#pragma unroll
          for (int kd = 0; kd < 6; ++kd) X = MFMA32(kf0[kd], qf[kd], X);
          if (th == 0) {
#pragma unroll
              for (int g = 0; g < 16; ++g) if (rowidx(g, hh) > r) X[g] = 0.f; }
          pack_p(X, pf[0][0], pf[0][1]); }
        if (th == 1) { f32x16 X = {};
#pragma unroll
          for (int kd = 0; kd < 6; ++kd) X = MFMA32(kf1[kd], qf[kd], X);
#pragma unroll
          for (int g = 0; g < 16; ++g) if (rowidx(g, hh) > r) X[g] = 0.f;
          pack_p(X, pf[1][0], pf[1][1]); }
        f32x16 O[3]; float sq = 0.f;
#pragma unroll
        for (int vt = 0; vt < 3; ++vt) { const int vtile = vh * 3 + vt; f32x16 acc = {};
            if (vt == 0) {
#pragma unroll
                for (int kd = 0; kd < 6; ++kd) sfb[kd] = *(const bf16x8*)(stb + (size_t)32 * 96 + 16 * kd); }
            if (vt == 1) {
#pragma unroll
                for (int kd = 0; kd < 6; ++kd) sfa[kd] = *(const bf16x8*)(stb + (size_t)64 * 96 + 16 * kd); }
#pragma unroll
            for (int si = 0; si < 2; ++si) if (si <= th) {
#pragma unroll
                for (int s2 = 0; s2 < 2; ++s2) { const bf16x8 vf = frag_tr((lds_cptr)(VV + ui * 25600), 400, 32 * si + 16 * s2, 32 * vtile, F.lane); acc = MFMA32(vf, pf[si][s2], acc); } }
            if (vt == 1) { PIN6(sfb);
#pragma unroll
                for (int kd = 0; kd < 6; ++kd) acc = MFMA32(sfb[kd], qf[kd], acc); }
            else { PIN6(sfa);
#pragma unroll
                for (int kd = 0; kd < 6; ++kd) acc = MFMA32(sfa[kd], qf[kd], acc); }
#pragma unroll
            for (int g = 0; g < 16; ++g) sq += acc[g] * acc[g];
            O[vt] = acc; }
        u32x2 zw[3][4]; f32x4 gg[3][4];
#pragma unroll
        for (int vt = 0; vt < 3; ++vt)
#pragma unroll
            for (int i = 0; i < 4; ++i) { const int v = 32 * (vh * 3 + vt) + 8 * i + 4 * hh;
                zw[vt][i] = *(const u32x2*)(F.proj + (size_t)(t0 + tq) * PW + C_CZ + h * 192 + v); gg[vt][i] = *(const f32x4*)(gain + v); }
        sq += __shfl_xor(sq, 32);
        if (hh == 0) SSQ[(ui * 2 + vh) * 64 + tq] = sq;
        __syncthreads();
        const float rs = rsqrtf((SSQ[(ui * 2) * 64 + tq] + SSQ[(ui * 2 + 1) * 64 + tq]) * (1.f / 192.f) + EPS);
#pragma unroll
        for (int vt = 0; vt < 3; ++vt) { PIN4(zw[vt][0], zw[vt][1], zw[vt][2], zw[vt][3]);
#pragma unroll
            for (int i = 0; i < 4; ++i) { const int v = 32 * (vh * 3 + vt) + 8 * i + 4 * hh; const u32x2 z = zw[vt][i]; const f32x4 g4 = gg[vt][i];
                const float y0 = O[vt][4 * i] * rs * g4.x * silu(blo(z.x)), y1 = O[vt][4 * i + 1] * rs * g4.y * silu(bhi(z.x)), y2 = O[vt][4 * i + 2] * rs * g4.z * silu(blo(z.y)), y3 = O[vt][4 * i + 3] * rs * g4.w * silu(bhi(z.y));
                u32x2 ov; ov.x = pk2(y0, y1); ov.y = pk2(y2, y3); *(u32x2*)(F.mixed + (size_t)(t0 + tq) * DM + 1280 + h * 192 + v) = ov; } }
        __syncthreads();
    }
    const int NT = F.G * 512, gt = F.bid * 512 + F.tid;
    for (int idx0 = gt; idx0 < SEQ * 96; idx0 += 2 * NT) {
        u32x4 wv[2][3], zw[2]; float la[2][3]; int tt[2], cc[2]; bool ok[2];
#pragma unroll
        for (int j = 0; j < 2; ++j) { const int idx = idx0 + j * NT; ok[j] = idx < SEQ * 96; const int id2 = ok[j] ? idx : gt; const int t = id2 / 96, c = (id2 % 96) * 8, a = c >> 6; tt[j] = t; cc[j] = c;
#pragma unroll
            for (int n = 0; n < 3; ++n) { wv[j][n] = *(const u32x4*)(F.oa + ((size_t)n * SEQ + t) * 768 + c); la[j][n] = F.la[((size_t)n * SEQ + t) * 12 + a]; }
            zw[j] = *(const u32x4*)(F.proj + (size_t)t * PW + C_AZ + c); }
        PIN4(wv[0][0], wv[0][1], wv[0][2], zw[0]); PIN4(wv[1][0], wv[1][1], wv[1][2], zw[1]);
#pragma unroll
        for (int j = 0; j < 2; ++j) { float o[8] = {0.f, 0.f, 0.f, 0.f, 0.f, 0.f, 0.f, 0.f};
#pragma unroll
            for (int n = 0; n < 3; ++n) { const u32x4 x = wv[j][n]; o[0] += blo(x.x); o[1] += bhi(x.x); o[2] += blo(x.y); o[3] += bhi(x.y); o[4] += blo(x.z); o[5] += bhi(x.z); o[6] += blo(x.w); o[7] += bhi(x.w); }
            const float il = 1.f / ((la[j][0] + la[j][1]) + la[j][2]); const u32x4 z = zw[j];
            u32x4 ov; ov.x = pk2(o[0] * il * silu(blo(z.x)), o[1] * il * silu(bhi(z.x))); ov.y = pk2(o[2] * il * silu(blo(z.y)), o[3] * il * silu(bhi(z.y)));
            ov.z = pk2(o[4] * il * silu(blo(z.z)), o[5] * il * silu(bhi(z.z))); ov.w = pk2(o[6] * il * silu(blo(z.w)), o[7] * il * silu(bhi(z.w)));
            if (ok[j]) *(u32x4*)(F.mixed + (size_t)tt[j] * DM + cc[j]) = ov; } }
    for (int idx0 = gt; idx0 < SEQ * 64; idx0 += 2 * NT) {
        f32x4 a0[2][4], a1[2][4]; float lv[2][4]; u32x4 zw[2]; int tt[2], cc[2], ns[2]; bool ok[2];
#pragma unroll
        for (int j = 0; j < 2; ++j) { const int idx = idx0 + j * NT; ok[j] = idx < SEQ * 64; const int id2 = ok[j] ? idx : gt; const int t = id2 / 64, c = (id2 % 64) * 8, h = c >> 6; tt[j] = t; cc[j] = c;
            ns[j] = (2 * (t >> 8) + 2 - (int)F.ctl[8192 + h * 32 + (t >> 8)] + 15) >> 4;
#pragma unroll
            for (int sg = 0; sg < 4; ++sg) { a0[j][sg] = (f32x4){0.f, 0.f, 0.f, 0.f}; a1[j][sg] = (f32x4){0.f, 0.f, 0.f, 0.f}; lv[j][sg] = 0.f;
                if (sg < ns[j]) { const float* p = F.ob + ((size_t)sg * SEQ + t) * 512 + c; a0[j][sg] = *(const f32x4*)p; a1[j][sg] = *(const f32x4*)(p + 4); lv[j][sg] = F.lb[((size_t)sg * SEQ + t) * 8 + h]; } }
            zw[j] = *(const u32x4*)(F.proj + (size_t)t * PW + C_BZ + c); }
#pragma unroll
        for (int j = 0; j < 2; ++j) { const f32x4 o0 = (a0[j][0] + a0[j][1]) + (a0[j][2] + a0[j][3]), o1 = (a1[j][0] + a1[j][1]) + (a1[j][2] + a1[j][3]);
            const float il = 1.f / ((lv[j][0] + lv[j][1]) + (lv[j][2] + lv[j][3])); const u32x4 z = zw[j];
            u32x4 ov; ov.x = pk2(o0.x * il * silu(blo(z.x)), o0.y * il * silu(bhi(z.x))); ov.y = pk2(o0.z * il * silu(blo(z.y)), o0.w * il * silu(bhi(z.y)));
            ov.z = pk2(o1.x * il * silu(blo(z.z)), o1.y * il * silu(bhi(z.z))); ov.w = pk2(o1.z * il * silu(blo(z.w)), o1.w * il * silu(bhi(z.w)));
            if (ok[j]) *(u32x4*)(F.mixed + (size_t)tt[j] * DM + 768 + cc[j]) = ov; } }
}

#define LAS __attribute__((address_space(3)))
#define XB_TMO      128
#define XB_XCNT(j)  (256  + 64 * (j))
#define XB_XSUB(j)  (1280 + 64 * (j))
#define XB_XGEN(j)  (2304 + 64 * (j))
#define XB_TOP      3328
#define XB_TOPGEN   3392
#define XCD_BAR_WORDS 3456
#define XB_SPIN_CAP (1u << 18)

__device__ __forceinline__ unsigned xb_ld(unsigned* p)              { return __hip_atomic_load(p, __ATOMIC_RELAXED, __HIP_MEMORY_SCOPE_AGENT); }
__device__ __forceinline__ unsigned xb_add(unsigned* p, unsigned v) { return __hip_atomic_fetch_add(p, v, __ATOMIC_RELAXED, __HIP_MEMORY_SCOPE_AGENT); }
__device__ __forceinline__ unsigned xb_xcc_id() { return (unsigned)__builtin_amdgcn_s_getreg((3 << 11) | 20) & 0xFu; }
#define XB_SPIN(cond, bar) do { unsigned _sp = 0; while (cond) { __builtin_amdgcn_s_sleep(1); \
    if ((++_sp & 255u) == 0u) { if (xb_ld(&(bar)[XB_TMO])) break; if (_sp > XB_SPIN_CAP) { atomicAdd(&(bar)[XB_TMO], 1u); break; } } } } while (0)

struct XcdBarrier {
    unsigned* bar; unsigned x;
    volatile LAS unsigned* st;
};

__device__ __forceinline__ XcdBarrier xcd_barrier_post(unsigned* bar, volatile LAS unsigned* st) {
    XcdBarrier b; b.bar = bar; b.x = xb_xcc_id(); b.st = st;
    if (threadIdx.x == 0) (void)xb_add(&bar[XB_XCNT(b.x)], 1u);
    return b;
}
__device__ __forceinline__ void xcd_barrier_complete(unsigned* bar, unsigned x, unsigned& nloc, unsigned& nx) {
    const unsigned G = gridDim.x * gridDim.y * gridDim.z;
    unsigned sum, cnt, mine, sp = 0u;
    for (;;) {
        sum = 0u; cnt = 0u; mine = 0u;
#pragma unroll
        for (unsigned j = 0; j < 16; ++j) { const unsigned c = xb_ld(&bar[XB_XCNT(j)]); sum += c; cnt += (c > 0u) ? 1u : 0u; mine = (j == x) ? c : mine; }
        if (sum == G) break;
        __builtin_amdgcn_s_sleep(1);
        if ((++sp & 255u) == 0u) { if (xb_ld(&bar[XB_TMO])) break; if (sp > XB_SPIN_CAP) { atomicAdd(&bar[XB_TMO], 1u); break; } }
    }
    nloc = mine > 0u ? mine : 1u; nx = cnt > 0u ? cnt : 1u;
}

__device__ __forceinline__ void xcd_barrier(const XcdBarrier& b) {
    asm volatile("s_waitcnt vmcnt(0)" ::: "memory");
    __syncthreads();
    if (threadIdx.x == 0) {
        unsigned* bar = b.bar;
        __builtin_amdgcn_s_waitcnt(0);
        unsigned nloc = b.st[0], nx = b.st[1];
        if (nloc == 0u) { xcd_barrier_complete(bar, b.x, nloc, nx); b.st[0] = nloc; b.st[1] = nx; }
        const unsigned old = xb_add(&bar[XB_XSUB(b.x)], 1u);
        const unsigned gen = old / nloc;
        if (old + 1u == (gen + 1u) * nloc) {
            __builtin_amdgcn_fence(__ATOMIC_RELEASE, "agent");
            asm volatile("s_waitcnt vmcnt(0)" ::: "memory");
            const unsigned og = xb_add(&bar[XB_TOP], 1u);
            const unsigned tg = og / nx;
            if (og + 1u == (tg + 1u) * nx) xb_add(&bar[XB_TOPGEN], 1u);
            else XB_SPIN(xb_ld(&bar[XB_TOPGEN]) == tg, bar);
            __builtin_amdgcn_fence(__ATOMIC_ACQUIRE, "agent");
            xb_add(&bar[XB_XGEN(b.x)], 1u);
            asm volatile("s_waitcnt vmcnt(0)" ::: "memory");
        } else {
            XB_SPIN(xb_ld(&bar[XB_XGEN(b.x)]) == gen, bar);
            __builtin_amdgcn_fence(__ATOMIC_ACQUIRE, "agent");
            asm volatile("s_waitcnt vmcnt(0)" ::: "memory");
        }
    }
    __syncthreads();
}

struct Args { const float* in[12]; float* out; unsigned char* ws; int ph_lo, ph_hi; };
constexpr int N_PHASES = 1 + 5 * NLAYER;
__global__ void __launch_bounds__(512, 2) mega_fwd(Args args) {
    extern __shared__ __attribute__((aligned(16))) unsigned char lds[];
    Ctx F;
#define BUILD() do { const Args* ap_ = &args; \
    F.x = ap_->in[0]; F.norm_g = ap_->in[1]; F.w_in = ap_->in[2]; F.aqg = ap_->in[3]; F.akg = ap_->in[4]; F.bqg = ap_->in[5]; F.bkg = ap_->in[6]; \
    F.fox_bias = ap_->in[7]; F.gate_up = ap_->in[8]; F.gate_bias = ap_->in[9]; F.out_gain = ap_->in[10]; F.w_out = ap_->in[11]; \
    F.out = ap_->out; unsigned char* ws = ap_->ws; F.ws = ws; \
    F.ctl = (unsigned*)(ws + WS_CTL); F.ss = (unsigned long long*)(ws + WS_SS); F.wtin = (bf16*)(ws + WS_WTIN); F.wtout = (bf16*)(ws + WS_WTOUT); F.xb = (bf16*)(ws + WS_XB); \
    F.proj = (bf16*)(ws + WS_PROJ); F.small = (float*)(ws + WS_SMALL); F.mixed = (bf16*)(ws + WS_MIXED); F.oa = (bf16*)(ws + WS_OA); F.la = (float*)(ws + WS_LA); \
    F.ob = (float*)(ws + WS_OB); F.lb = (float*)(ws + WS_LB); F.cl = (float*)(ws + WS_CL); F.bt = (float*)(ws + WS_BT); F.ds = (float*)(ws + WS_DS); F.st = (bf16*)(ws + WS_ST); F.dec = (float*)(ws + WS_DEC); \
    F.lds = lds; F.G = gridDim.x; F.bid = blockIdx.x; \
    int t_ = threadIdx.x; asm volatile("" : "+v"(t_)); F.tid = t_; F.lane = t_ & 63; F.wave = __builtin_amdgcn_readfirstlane(t_ >> 6); } while (0)
    BUILD();
    cg::grid_group grid = cg::this_grid();
    if (threadIdx.x < 8) ((volatile LAS unsigned*)((LAS unsigned char*)lds + MISC_OFF))[threadIdx.x] = 0u;
    __syncthreads();
    XcdBarrier bar; bar.bar = (unsigned*)(F.ws + WS_CTL) + 4096; bar.x = 0; bar.st = (volatile LAS unsigned*)((LAS unsigned char*)lds + MISC_OFF);
    const int lo = args.ph_lo, hi = args.ph_hi;
#define IN(k) (lo <= (k) && (k) < hi)
#define RELAUNDER() do { int t_ = threadIdx.x; asm volatile("" : "+v"(t_)); F.tid = t_; F.lane = t_ & 63; F.wave = __builtin_amdgcn_readfirstlane(t_ >> 6); } while (0)
#define SEAM(k) do { if (IN(k) && IN((k) + 1)) { if ((k) == 0) grid.sync(); else xcd_barrier(bar); } } while (0)
    if (IN(0)) { BUILD(); phase0(F); }
    SEAM(0);
    bar = xcd_barrier_post(bar.bar, bar.st);
    for (int l = 0; l < NLAYER; ++l) { const int pb = 1 + 5 * l;
        if (IN(pb)) { BUILD(); pg8::Gemm g{F.xb, F.wtin + (size_t)l * NPAD * DM, SEQ, NPAD, DM}; pg8::StaticOrder S; S.init(SEQ, NPAD, F.G, F.bid);
            pg8::EpiProj E{F.proj, F.small, F.ss + l * SEQ, (float*)(lds + RING_BYTES + 1024), F.aqg + l * 64, F.akg + l * 64, F.bqg + l * 64, F.bkg + l * 64};
            pg8::gemm_phase<pg8::EpiProj, pg8::StaticOrder, true, true>((PG8_LAS unsigned char*)lds, g, S, E); __syncthreads(); }
        SEAM(pb);
        if (IN(pb + 1)) { BUILD(); phase2(F, l); }
        SEAM(pb + 1);
        if (IN(pb + 2)) { BUILD(); phase3(F, l); }
        SEAM(pb + 2);
        if (IN(pb + 3)) { BUILD(); phase4(F, l); }
        SEAM(pb + 3);
        if (IN(pb + 4)) { BUILD(); pg8::Gemm g{F.mixed, F.wtout + (size_t)l * DM * DM, SEQ, DM, DM}; pg8::StaticOrder S; S.init(SEQ, DM, F.G, F.bid);
            const bool last = (l == NLAYER - 1);
            pg8::EpiOut E{l == 0 ? F.x : nullptr, last ? F.out : nullptr, F.xb, last ? nullptr : F.ss + (l + 1) * SEQ};
            pg8::gemm_phase<pg8::EpiOut, pg8::StaticOrder, true, true>((PG8_LAS unsigned char*)lds, g, S, E); __syncthreads(); }
        SEAM(pb + 4);
    }
#undef IN
#undef SEAM
}

#ifndef MK_ONE_LAUNCH
#define MK_ONE_LAUNCH 1
#endif
extern "C" void kernel_launch(void* const* d_in, const int* in_sizes, int n_in, void* d_out, int out_size, void* d_ws, size_t ws_size, hipStream_t stream) {
    static int grid = 0;
    if (grid == 0) {
        int dev = 0, cus = 0, per_cu = 0;
        hipGetDevice(&dev); hipDeviceGetAttribute(&cus, hipDeviceAttributeMultiprocessorCount, dev);
        hipFuncSetAttribute((const void*)mega_fwd, hipFuncAttributeMaxDynamicSharedMemorySize, LDS_BYTES);
        hipOccupancyMaxActiveBlocksPerMultiprocessor(&per_cu, mega_fwd, 512, LDS_BYTES);
        grid = cus * per_cu; if (grid <= 0) grid = 256;
        if (ws_size < WS_END) { fprintf(stderr, "workspace too small: %zu < %zu\n", ws_size, (size_t)WS_END); }
    }
    Args a{}; for (int i = 0; i < 12; ++i) a.in[i] = (const float*)d_in[i]; a.out = (float*)d_out; a.ws = (unsigned char*)d_ws;
#if MK_ONE_LAUNCH
    a.ph_lo = 0; a.ph_hi = N_PHASES; void* kargs[] = {&a};
    hipError_t e = hipLaunchCooperativeKernel((const void*)mega_fwd, dim3(grid), dim3(512), kargs, LDS_BYTES, stream);
    if (e != hipSuccess) fprintf(stderr, "cooperative launch failed: %s (grid %d)\n", hipGetErrorString(e), grid);
#else
    for (int p = 0; p < N_PHASES; ++p) { a.ph_lo = p; a.ph_hi = p + 1; hipLaunchKernelGGL(mega_fwd, dim3(grid), dim3(512), LDS_BYTES, stream, a); }
#endif
}
```

```cpp
#include <hip/hip_runtime.h>
#include <hip/hip_cooperative_groups.h>
#include <cstdio>
#include <cstdint>
namespace cg = cooperative_groups;
namespace pg8 {
#define PG8_LAS __attribute__((address_space(3)))
typedef unsigned short bf16_t;
typedef short bf16x8 __attribute__((ext_vector_type(8)));
typedef float f32x4 __attribute__((ext_vector_type(4)));
typedef unsigned u32x4 __attribute__((ext_vector_type(4)));
constexpr int BM = 256, BK = 64, HALF = 128, HTB = HALF * BK * 2  , STAGE_BYTES = 8 * HTB, NXCD = 8, WGM = 8;

__host__ __device__ __forceinline__ int lds_byte(int r, int c) { const int st = (r >> 4) * 2 + (c >> 5), rr = r & 15, cc = c & 31, ob = rr * 64 + cc * 2; return st * 1024 + (ob ^ (((ob >> 9) & 1) << 5)); }
__host__ __device__ __forceinline__ void stage_rc(int b, int& R, int& C) { const int st = b / 1024, sb = b % 1024, swz = sb ^ (((sb >> 9) & 1) << 5); R = (st >> 1) * 16 + swz / 64; C = (st & 1) * 32 + (swz % 64) / 2; }
__host__ __device__ __forceinline__ int perm32(int rho) { const int n = rho >> 4, i = rho & 15; return 8 * (i >> 2) + 4 * n + (i & 3); }

struct Unit { int pm, pn; };
struct Gemm { const bf16_t* A; const bf16_t* Bt; int M, N, K; };

struct StaticOrder {
    int nM, nN, nwg, G, c;
    __host__ __device__ void init(int M, int N, int G_, int c_) { nM = M / BM; nN = N / BM; nwg = nM * nN; G = G_; c = c_; }
    __host__ __device__ bool next(int i, Unit& u) const {
        const long L = (long)i * G + c; if (L >= nwg) return false;
        int wgid = (int)L; { const int q = nwg / NXCD, r = nwg % NXCD, xcd = wgid % NXCD, off = wgid / NXCD; wgid = (xcd < r ? xcd * (q + 1) : r * (q + 1) + (xcd - r) * q) + off; }
        const int nig = WGM * nN, gid = wgid / nig, fm = gid * WGM, gsz = (nM - fm) < WGM ? (nM - fm) : WGM;
        u.pm = fm + ((wgid % nig) % gsz); u.pn = (wgid % nig) / gsz; return true;
    }
    __device__ __forceinline__ void a_ready(const Unit&) const {}
    __device__ __forceinline__ void done(const Unit&) const {}
};

__device__ __forceinline__ unsigned cvt_pk_bf16(float lo, float hi) { unsigned r; asm volatile("v_cvt_pk_bf16_f32 %0, %1, %2" : "=v"(r) : "v"(lo), "v"(hi)); return r; }
typedef float f32x2 __attribute__((ext_vector_type(2)));
constexpr int PROJ_W = 7424;
struct EpiProj {
    static constexpr bool PERM = true, AFTER_DRAIN = false;
    bf16_t* O; float* small; const unsigned long long* ss; float* xch; const float* gaq; const float* gak; const float* gbq; const float* gbk;
    __device__ __forceinline__ void operator()(const f32x4 (&acc)[2][2][4][2], const Unit& u, int wr, int wc, int fr, int fq) const {
        const int row0 = u.pm * BM + wr * 64 + fr;
        float rsv[2][4];
        { unsigned long long sv[2][4];
#pragma unroll
          for (int ai = 0; ai < 2; ++ai)
#pragma unroll
              for (int m = 0; m < 4; ++m) sv[ai][m] = ss[row0 + ai * HALF + m * 16];
          asm volatile("" : "+v"(sv[0][0]), "+v"(sv[0][1]), "+v"(sv[0][2]), "+v"(sv[0][3])); asm volatile("" : "+v"(sv[1][0]), "+v"(sv[1][1]), "+v"(sv[1][2]), "+v"(sv[1][3]));
#pragma unroll
          for (int ai = 0; ai < 2; ++ai)
#pragma unroll
              for (int m = 0; m < 4; ++m) rsv[ai][m] = rsqrtf((float)sv[ai][m] * (1.0f / 1048576.0f / 2048.0f) + 1e-6f); }
        if (u.pn < 29) {
            const int col0 = u.pn * BM + wc * 32 + 8 * fq;
            const bool isA = u.pn < 6, isB = (u.pn >= 12 && u.pn < 16);
            if (isA || isB) {
#pragma unroll
                for (int ai = 0; ai < 2; ++ai)
#pragma unroll
                    for (int m = 0; m < 4; ++m) { const int row = row0 + ai * HALF + m * 16; const float rs = rsv[ai][m];
#pragma unroll
                        for (int bj = 0; bj < 2; ++bj) { const f32x4 v0 = acc[ai][bj][m][0] * rs, v1 = acc[ai][bj][m][1] * rs;
                            float sq = (v0[0] * v0[0] + v0[1] * v0[1]) + (v0[2] * v0[2] + v0[3] * v0[3]) + (v1[0] * v1[0] + v1[1] * v1[1]) + (v1[2] * v1[2] + v1[3] * v1[3]);
                            sq += __shfl_xor(sq, 16); sq += __shfl_xor(sq, 32);
                            if (fq == 0) xch[((ai * HALF + wr * 64 + m * 16 + fr) * 2 + bj) * 4 + wc] = sq; } }
                asm volatile("s_waitcnt lgkmcnt(0)" ::: "memory"); __builtin_amdgcn_s_barrier(); asm volatile("" ::: "memory");
                const bool isq = (u.pn < 3) || (u.pn == 12) || (u.pn == 13);
                const float* ga0 = gaq; const float* ga1 = gak; const float* gb0 = gbq; const float* gb1 = gbk;
                const float* gsel = isA ? ga0 : gb0; { const float* gk = isA ? ga1 : gb1; if (!isq) gsel = gk; }
                const float* g = gsel + 32 * (wc & 1) + 8 * fq;
                const float sc = isq ? 0.18033688011112042f : 1.0f;
                const f32x4 g0 = *(const f32x4*)g * sc, g1 = *(const f32x4*)(g + 4) * sc;
#pragma unroll
                for (int ai = 0; ai < 2; ++ai)
#pragma unroll
                    for (int m = 0; m < 4; ++m) { const int row = row0 + ai * HALF + m * 16; bf16_t* rowp = O + (size_t)row * PROJ_W + col0;
                        const float rs = rsv[ai][m];
#pragma unroll
                        for (int bj = 0; bj < 2; ++bj) { const float* xp = xch + ((ai * HALF + wr * 64 + m * 16 + fr) * 2 + bj) * 4 + (wc & 2); const float tot = xp[0] + xp[1];
                            const float r2 = rsqrtf(tot * (1.0f / 64.0f) + 1e-6f) * rs;
                            const f32x4 v0 = acc[ai][bj][m][0] * r2 * g0, v1 = acc[ai][bj][m][1] * r2 * g1;
                            u32x4 w; w.x = cvt_pk_bf16(v0[0], v0[1]); w.y = cvt_pk_bf16(v0[2], v0[3]); w.z = cvt_pk_bf16(v1[0], v1[1]); w.w = cvt_pk_bf16(v1[2], v1[3]);
                            *(u32x4*)(rowp + bj * HALF) = w; } }
            } else {
#pragma unroll
            for (int ai = 0; ai < 2; ++ai)
#pragma unroll
                for (int m = 0; m < 4; ++m) { const int row = row0 + ai * HALF + m * 16; const float rs = rsv[ai][m];
                    bf16_t* rowp = O + (size_t)row * PROJ_W + col0;
#pragma unroll
                    for (int bj = 0; bj < 2; ++bj) { const f32x4 v0 = acc[ai][bj][m][0] * rs, v1 = acc[ai][bj][m][1] * rs;
                        u32x4 w; w.x = cvt_pk_bf16(v0[0], v0[1]); w.y = cvt_pk_bf16(v0[2], v0[3]); w.z = cvt_pk_bf16(v1[0], v1[1]); w.w = cvt_pk_bf16(v1[2], v1[3]);
                        *(u32x4*)(rowp + bj * HALF) = w; } }
            }
        } else if (wc == 0) {
#pragma unroll
            for (int ai = 0; ai < 2; ++ai)
#pragma unroll
                for (int m = 0; m < 4; ++m) { const int row = row0 + ai * HALF + m * 16; const float rs = rsv[ai][m];
                    float* p = small + (size_t)row * 32 + 8 * fq;
                    *(f32x4*)p = acc[ai][0][m][0] * rs; *(f32x4*)(p + 4) = acc[ai][0][m][1] * rs; }
        }
    }
};
struct EpiOut {
    static constexpr bool PERM = true, AFTER_DRAIN = false;
    const float* xin32; float* out; bf16_t* xb; unsigned long long* ssn;
    __device__ __forceinline__ void operator()(const f32x4 (&acc)[2][2][4][2], const Unit& u, int wr, int wc, int fr, int fq) const {
        const int row0 = u.pm * BM + wr * 64 + fr, col0 = u.pn * BM + wc * 32 + 8 * fq;
#pragma unroll
        for (int ai = 0; ai < 2; ++ai) {
            f32x4 xo[4][2][2];
            if (xin32) {
#pragma unroll
                for (int m = 0; m < 4; ++m)
#pragma unroll
                    for (int bj = 0; bj < 2; ++bj) { const size_t p = (size_t)(row0 + ai * HALF + m * 16) * 2048 + col0 + bj * HALF; xo[m][bj][0] = *(const f32x4*)(xin32 + p); xo[m][bj][1] = *(const f32x4*)(xin32 + p + 4); }
#pragma unroll
                for (int m = 0; m < 4; ++m) asm volatile("" : "+v"(xo[m][0][0]), "+v"(xo[m][0][1]), "+v"(xo[m][1][0]), "+v"(xo[m][1][1]));
            } else { u32x4 xr[4][2];
#pragma unroll
                for (int m = 0; m < 4; ++m)
#pragma unroll
                    for (int bj = 0; bj < 2; ++bj) xr[m][bj] = *(const u32x4*)(xb + (size_t)(row0 + ai * HALF + m * 16) * 2048 + col0 + bj * HALF);
#pragma unroll
                for (int m = 0; m < 4; m += 2) asm volatile("" : "+v"(xr[m][0]), "+v"(xr[m][1]), "+v"(xr[m + 1][0]), "+v"(xr[m + 1][1]));
#pragma unroll
                for (int m = 0; m < 4; ++m)
#pragma unroll
                    for (int bj = 0; bj < 2; ++bj) { const u32x4 w = xr[m][bj];
                        xo[m][bj][0] = (f32x4){__uint_as_float(w.x << 16), __uint_as_float(w.x & 0xffff0000u), __uint_as_float(w.y << 16), __uint_as_float(w.y & 0xffff0000u)};
                        xo[m][bj][1] = (f32x4){__uint_as_float(w.z << 16), __uint_as_float(w.z & 0xffff0000u), __uint_as_float(w.w << 16), __uint_as_float(w.w & 0xffff0000u)}; } }
#pragma unroll
            for (int m = 0; m < 4; ++m) { const int row = row0 + ai * HALF + m * 16; float sq = 0.f;
#pragma unroll
                for (int bj = 0; bj < 2; ++bj) { const size_t p = (size_t)row * 2048 + col0 + bj * HALF;
                    const f32x4 a = xo[m][bj][0] + acc[ai][bj][m][0], b = xo[m][bj][1] + acc[ai][bj][m][1];
                    if (out) { *(f32x4*)(out + p) = a; *(f32x4*)(out + p + 4) = b; }
                    if (xb && ssn) { u32x4 w; w.x = cvt_pk_bf16(a[0], a[1]); w.y = cvt_pk_bf16(a[2], a[3]); w.z = cvt_pk_bf16(b[0], b[1]); w.w = cvt_pk_bf16(b[2], b[3]); *(u32x4*)(xb + p) = w; }
                    sq += (a[0] * a[0] + a[1] * a[1]) + (a[2] * a[2] + a[3] * a[3]) + (b[0] * b[0] + b[1] * b[1]) + (b[2] * b[2] + b[3] * b[3]); }
                sq += __shfl_xor(sq, 16); sq += __shfl_xor(sq, 32);
                if (fq == 0 && ssn) atomicAdd(ssn + row, (unsigned long long)(sq * 1048576.0f + 0.5f)); } }
    }
};

template <class Epi, class Sched, bool ALIGN_EPI = false, bool SP2 = false>
__device__ __forceinline__ void gemm_phase(PG8_LAS unsigned char* lds, const Gemm g, const Sched& S, const Epi& E) {
    int tid_ = threadIdx.x; asm volatile("" : "+v"(tid_)); const int tid = tid_, wid = __builtin_amdgcn_readfirstlane(tid >> 6), lane = tid & 63, wr = wid >> 2, wc = wid & 3, fr = lane & 15, fq = lane >> 4;
    const int K = g.K, nt = K / BK;
    unsigned voffA[2], voffB[2];
#pragma unroll
    for (int i = 0; i < 2; ++i) { int R, C; stage_rc(tid * 16 + i * 8192, R, C); const int Rb = Epi::PERM ? ((R & ~31) + perm32(R & 31)) : R;
        voffA[i] = (unsigned)(R * K + C) * 2u; voffB[i] = (unsigned)(Rb * K + C) * 2u; }
    const size_t kstep = (size_t)(BK * 2);
    const size_t hstep = (size_t)HALF * K * 2;
    const size_t tstep = 2 * hstep;
    const unsigned ldsw = (unsigned)wid * 1024u;
    const int aoff = lds_byte(wr * 64 + fr, fq * 8), boff = lds_byte(wc * 32 + fr, fq * 8);
#define PG8_SA(b, h) (((b) * 2 + (h)) * HTB)
#define PG8_SB(b, h) ((4 + (b) * 2 + (h)) * HTB)
#define PG8_STAGE(bufoff, gbase, voff) do { _Pragma("unroll") for (int _i = 0; _i < 2; ++_i) \
        __builtin_amdgcn_global_load_lds((const unsigned*)((const char*)(gbase) + (voff)[_i]), (PG8_LAS unsigned*)(lds + (bufoff) + ldsw + _i * 8192), 16, 0, 0); } while (0)
#define PG8_LDA(dst, b, h) do { _Pragma("unroll") for (int m = 0; m < 4; ++m) _Pragma("unroll") for (int k = 0; k < 2; ++k) dst[m][k] = *(const PG8_LAS bf16x8*)(lds + PG8_SA(b, h) + aoff + m * 2048 + k * 1024); } while (0)
#define PG8_LDB(dst, b, h) do { _Pragma("unroll") for (int n = 0; n < 2; ++n) _Pragma("unroll") for (int k = 0; k < 2; ++k) dst[n][k] = *(const PG8_LAS bf16x8*)(lds + PG8_SB(b, h) + boff + n * 2048 + k * 1024); } while (0)
#define PG8_MMA(ai, bj, At, Bt) do { __builtin_amdgcn_s_setprio(1); _Pragma("unroll") for (int m = 0; m < 4; ++m) _Pragma("unroll") for (int n = 0; n < 2; ++n) _Pragma("unroll") for (int k = 0; k < 2; ++k) \
        acc[ai][bj][m][n] = __builtin_amdgcn_mfma_f32_16x16x32_bf16(Bt[n][k], At[m][k], acc[ai][bj][m][n], 0, 0, 0); __builtin_amdgcn_s_setprio(0); } while (0)
#define PG8_WAIT_V(n) asm volatile("s_waitcnt vmcnt(" #n ")" ::: "memory")
#define PG8_WAIT_L(n) asm volatile("s_waitcnt lgkmcnt(" #n ")" ::: "memory")
#define PG8_BAR __builtin_amdgcn_s_barrier()
#define PG8_SCHED __builtin_amdgcn_sched_barrier(0)
    Unit cur, nxt; int ui = 0;
    if (!S.next(0, cur)) return;
    f32x4 acc[2][2][4][2];
#pragma unroll
    for (int a = 0; a < 2; ++a)
#pragma unroll
        for (int b = 0; b < 2; ++b)
#pragma unroll
            for (int m = 0; m < 4; ++m)
#pragma unroll
                for (int n = 0; n < 2; ++n) acc[a][b][m][n] = (f32x4){0.f, 0.f, 0.f, 0.f};
    bf16x8 At[4][2], B0[2][2], B1[2][2];
    const char* cA = (const char*)g.A + (size_t)cur.pm * tstep; const char* cB = (const char*)g.Bt + (size_t)cur.pn * tstep;
    S.a_ready(cur);
    if constexpr (SP2) {
        PG8_STAGE(PG8_SB(0, 0), cB, voffB); PG8_STAGE(PG8_SB(0, 1), cB + hstep, voffB); PG8_STAGE(PG8_SA(0, 0), cA, voffA); PG8_STAGE(PG8_SA(0, 1), cA + hstep, voffA);
        if (wr == 1) PG8_BAR;
        PG8_WAIT_V(2); PG8_BAR;
        PG8_STAGE(PG8_SB(1, 0), cB + kstep, voffB); PG8_STAGE(PG8_SA(1, 0), cA + kstep, voffA); PG8_STAGE(PG8_SB(1, 1), cB + hstep + kstep, voffB);
        PG8_WAIT_V(6); PG8_BAR;
    } else {
        PG8_STAGE(PG8_SB(0, 0), cB, voffB); PG8_STAGE(PG8_SA(0, 0), cA, voffA); PG8_STAGE(PG8_SB(0, 1), cB + hstep, voffB); PG8_STAGE(PG8_SA(0, 1), cA + hstep, voffA);
        if (wr == 1) PG8_BAR;
        PG8_WAIT_V(4); PG8_BAR;
        PG8_STAGE(PG8_SB(1, 0), cB + kstep, voffB); PG8_STAGE(PG8_SA(1, 0), cA + kstep, voffA); PG8_STAGE(PG8_SB(1, 1), cB + hstep + kstep, voffB);
        PG8_WAIT_V(6); PG8_BAR;
    }
    for (;;) {
        const bool has_next = S.next(ui + 1, nxt);
        const char* nA = has_next ? (const char*)g.A + (size_t)nxt.pm * tstep : cA; const char* nB = has_next ? (const char*)g.Bt + (size_t)nxt.pn * tstep : cB;
        for (int t = 0; t < nt; t += 2) {
            const bool last = (t == nt - 2);
            const char* a1 = cA + (size_t)(t + 1) * kstep;
            const char* a2 = last ? nA : cA + (size_t)(t + 2) * kstep; const char* b2 = last ? nB : cB + (size_t)(t + 2) * kstep;
            const char* a3 = a2 + kstep; const char* b3 = b2 + kstep;
            if (last && has_next) S.a_ready(nxt);
            if constexpr (SP2) {
            PG8_LDB(B0, 0, 0); PG8_LDB(B1, 0, 1); PG8_SCHED; PG8_LDA(At, 0, 0); PG8_STAGE(PG8_SA(1, 1), a1 + hstep, voffA);
            PG8_WAIT_V(8); PG8_WAIT_L(0); PG8_BAR; PG8_MMA(0, 0, At, B0); PG8_MMA(0, 1, At, B1); PG8_BAR; PG8_SCHED;
            PG8_LDA(At, 0, 1); PG8_STAGE(PG8_SB(0, 0), b2, voffB); PG8_STAGE(PG8_SB(0, 1), b2 + hstep, voffB); PG8_STAGE(PG8_SA(0, 0), a2, voffA);
            PG8_WAIT_V(8); PG8_WAIT_L(0); PG8_BAR; PG8_MMA(1, 0, At, B0); PG8_MMA(1, 1, At, B1); PG8_BAR; PG8_SCHED;
            PG8_LDB(B0, 1, 0); PG8_LDB(B1, 1, 1); PG8_SCHED; PG8_LDA(At, 1, 0); PG8_STAGE(PG8_SA(0, 1), a2 + hstep, voffA);
            PG8_WAIT_V(8); PG8_WAIT_L(0); PG8_BAR; PG8_MMA(0, 0, At, B0); PG8_MMA(0, 1, At, B1); PG8_BAR; PG8_SCHED;
            PG8_LDA(At, 1, 1); PG8_STAGE(PG8_SB(1, 0), b3, voffB); PG8_STAGE(PG8_SB(1, 1), b3 + hstep, voffB); PG8_STAGE(PG8_SA(1, 0), a3, voffA);
            PG8_WAIT_V(8); PG8_WAIT_L(0); PG8_BAR; PG8_MMA(1, 0, At, B0); PG8_MMA(1, 1, At, B1); PG8_BAR; PG8_SCHED;
            } else {
            PG8_LDB(B0, 0, 0); PG8_SCHED; PG8_LDA(At, 0, 0); PG8_STAGE(PG8_SA(1, 1), a1 + hstep, voffA);
            PG8_WAIT_L(8); PG8_BAR; PG8_WAIT_L(0); PG8_MMA(0, 0, At, B0); PG8_BAR; PG8_SCHED;
            PG8_LDB(B1, 0, 1); PG8_STAGE(PG8_SB(0, 0), b2, voffB);
            PG8_BAR; PG8_WAIT_L(0); PG8_MMA(0, 1, At, B1); PG8_BAR;
            PG8_LDA(At, 0, 1); PG8_STAGE(PG8_SA(0, 0), a2, voffA);
            PG8_BAR; PG8_WAIT_L(0); PG8_MMA(1, 0, At, B0); PG8_BAR; PG8_SCHED;
            PG8_STAGE(PG8_SB(0, 1), b2 + hstep, voffB);
            PG8_WAIT_V(6); PG8_BAR; PG8_MMA(1, 1, At, B1); PG8_BAR;
            PG8_LDB(B0, 1, 0); PG8_SCHED; PG8_LDA(At, 1, 0); PG8_STAGE(PG8_SA(0, 1), a2 + hstep, voffA);
            PG8_WAIT_L(8); PG8_BAR; PG8_WAIT_L(0); PG8_MMA(0, 0, At, B0); PG8_BAR; PG8_SCHED;
            PG8_LDB(B1, 1, 1); PG8_STAGE(PG8_SB(1, 0), b3, voffB);
            PG8_BAR; PG8_WAIT_L(0); PG8_MMA(0, 1, At, B1); PG8_BAR;
            PG8_LDA(At, 1, 1); PG8_STAGE(PG8_SA(1, 0), a3, voffA);
            PG8_BAR; PG8_WAIT_L(0); PG8_MMA(1, 0, At, B0); PG8_BAR; PG8_SCHED;
            PG8_STAGE(PG8_SB(1, 1), b3 + hstep, voffB);
            PG8_WAIT_V(6); PG8_BAR; PG8_MMA(1, 1, At, B1); PG8_BAR;
            }
        }
        if constexpr (ALIGN_EPI) { if (wr == 0) PG8_BAR; }
        if constexpr (!Epi::AFTER_DRAIN) { E(acc, cur, wr, wc, fr, fq); S.done(cur); }
        if (!has_next) break;
#pragma unroll
        for (int a = 0; a < 2; ++a)
#pragma unroll
            for (int b = 0; b < 2; ++b)
#pragma unroll
                for (int m = 0; m < 4; ++m)
#pragma unroll
                    for (int n = 0; n < 2; ++n) acc[a][b][m][n] = (f32x4){0.f, 0.f, 0.f, 0.f};
        cur = nxt; cA = nA; cB = nB; ++ui;
        if constexpr (ALIGN_EPI) { if (wr == 1) PG8_BAR; }
    }
    PG8_WAIT_V(0);
    if constexpr (!ALIGN_EPI) { if (wr == 0) PG8_BAR; }
    PG8_BAR;
    if constexpr (Epi::AFTER_DRAIN) { E.fused(acc, cur, wr, wc, fr, fq, lds, wid, lane); S.done(cur); }
#undef PG8_SA
#undef PG8_SB
#undef PG8_STAGE
#undef PG8_LDA
#undef PG8_LDB
#undef PG8_MMA
#undef PG8_WAIT_V
#undef PG8_WAIT_L
#undef PG8_BAR
#undef PG8_SCHED
}
}
constexpr int SEQ = 8192, DM = 2048, NLAYER = 4, INW = 7448, NPAD = 7680, PW = pg8::PROJ_W;
constexpr int C_AQ = 0, C_AK = 768, C_AV = 1536, C_AZ = 2304, C_BQ = 3072, C_BK = 3584, C_BV = 4096, C_BZ = 4608, C_CQ = 5120, C_CK = 5504, C_CV = 5888, C_CZ = 6656;
constexpr float LOG2E = 1.4426950408889634f, QSCALE = 0.125f * 1.4426950408889634f, EPS = 1e-6f;
constexpr size_t MiB = 1u << 20;
constexpr size_t WS_CTL = 0, WS_SS = 1 * MiB, WS_WTIN = 2 * MiB, WS_WTOUT = 122 * MiB, WS_XB = 154 * MiB, WS_PROJ = 186 * MiB, WS_SMALL = 302 * MiB,
                 WS_MIXED = 304 * MiB, WS_OA = 336 * MiB, WS_LA = 372 * MiB, WS_OB = 374 * MiB, WS_LB = 438 * MiB, WS_CL = 439 * MiB, WS_BT = WS_CL + 512 * 1024,
                 WS_DS = 440 * MiB, WS_ST = 476 * MiB, WS_DEC = 494 * MiB, WS_END = 496 * MiB;
constexpr int RING_BYTES = 131072, LDS_BYTES = 147456, QSLOT_OFF = RING_BYTES + 64, MISC_OFF = RING_BYTES + 256;
constexpr int P3_EXT = RING_BYTES + 1024;
constexpr int N_SCAN = 72, N_FOX = 640, N_AU = 1152, N_ITEMS = N_SCAN + N_FOX + N_AU;

typedef unsigned short bf16;
typedef short bf16x8 __attribute__((ext_vector_type(8)));
typedef short s16x4 __attribute__((ext_vector_type(4)));
typedef float f32x4 __attribute__((ext_vector_type(4)));
typedef float f32x2 __attribute__((ext_vector_type(2)));
typedef float f32x16 __attribute__((ext_vector_type(16)));
typedef unsigned u32x4 __attribute__((ext_vector_type(4)));
typedef unsigned u32x2 __attribute__((ext_vector_type(2)));
typedef __attribute__((address_space(3))) const char* lds_cptr;
#define LAS3 __attribute__((address_space(3)))

__device__ __forceinline__ float bf2f(unsigned b) { return __uint_as_float(b << 16); }
__device__ __forceinline__ unsigned pk2(float lo, float hi) { return pg8::cvt_pk_bf16(lo, hi); }
__device__ __forceinline__ float blo(unsigned w) { return __uint_as_float(w << 16); }
__device__ __forceinline__ float bhi(unsigned w) { return __uint_as_float(w & 0xffff0000u); }
__device__ __forceinline__ float logsig(float x) { return fminf(x, 0.f) - log1pf(expf(-fabsf(x))); }
__device__ __forceinline__ float silu(float x) { return x / (1.f + __expf(-x)); }
__device__ __forceinline__ s16x4 vtr(lds_cptr p) { return __builtin_bit_cast(s16x4, __builtin_amdgcn_ds_read_tr16_b64_v4i16((LAS3 s16x4*)p)); }
__device__ __forceinline__ bf16x8 frag_tr(lds_cptr img, int stride, int kbase, int m0, int lane) {
    const int i = lane & 15, g = lane >> 4;
    lds_cptr p = img + (kbase + 4 * (g >> 1) + (i >> 2)) * stride + (m0 + 16 * (g & 1) + 4 * (i & 3)) * 2;
    const s16x4 a = vtr(p), b = vtr(p + 8 * stride);
    return (bf16x8){a[0], a[1], a[2], a[3], b[0], b[1], b[2], b[3]};
}
__device__ __forceinline__ int rowidx(int reg, int hh) { return (reg & 3) + 8 * (reg >> 2) + 4 * hh; }
__device__ __forceinline__ void pack_p(const f32x16& p, bf16x8& f0, bf16x8& f1) {
    u32x4 a, b; a.x = pk2(p[0], p[1]); a.y = pk2(p[2], p[3]); a.z = pk2(p[4], p[5]); a.w = pk2(p[6], p[7]);
    b.x = pk2(p[8], p[9]); b.y = pk2(p[10], p[11]); b.z = pk2(p[12], p[13]); b.w = pk2(p[14], p[15]);
    f0 = __builtin_bit_cast(bf16x8, a); f1 = __builtin_bit_cast(bf16x8, b);
}
#define MFMA32(a, b, c) __builtin_amdgcn_mfma_f32_32x32x16_bf16((a), (b), (c), 0, 0, 0)

struct Ctx {
    const float *x, *norm_g, *w_in, *aqg, *akg, *bqg, *bkg, *fox_bias, *gate_up, *gate_bias, *out_gain, *w_out;
    float* out; unsigned char* ws;
    unsigned* ctl; unsigned long long* ss; bf16* wtin; bf16* wtout; bf16* xb; bf16* proj; float* small; bf16* mixed; bf16* oa; float* la; float* ob; float* lb; float* cl; float* bt;
    float* ds; bf16* st; float* dec;
    unsigned char* lds; int tid, lane, wave, G, bid;
};

__device__ __forceinline__ int orig_col(int np) { if (np < 5120) return np; if (np < 7424) return np + 8; if (np < 7432) return 5120 + (np - 7424); if (np < 7448) return np; return -1; }
__device__ __forceinline__ void p0_load(const float* W, int N, const float* g, int mode, int kb, int nb, int lane, f32x4 (&v)[8], float (&gs)[8]) {
    const int k0 = 64 * kb, np = 32 * nb + 4 * (lane & 7);
    const int oc = mode ? orig_col(np) : np;
#pragma unroll
    for (int i = 0; i < 8; ++i) { const int kk = 8 * i + (lane >> 3); v[i] = (f32x4){0.f, 0.f, 0.f, 0.f}; gs[i] = 1.0f;
        if (oc >= 0) { v[i] = *(const f32x4*)(W + (size_t)(k0 + kk) * N + oc); if (mode) gs[i] = g[k0 + kk]; } }
}
__device__ __forceinline__ void p0_finish(bf16* WT, int mode, int kb, int nb, int lane, float* scr, const f32x4 (&v)[8], const float (&gs)[8]) {
    const int k0 = 64 * kb, n0 = 32 * nb, c4 = 4 * (lane & 7), np = n0 + c4;
    const float cs = (mode && np >= C_CQ && np < C_CK) ? 0.10206207261596577f : 1.0f;
#pragma unroll
    for (int i = 0; i < 8; ++i) { const int kk = 8 * i + (lane >> 3); float* d = scr + kk * 33 + c4; const float sc = cs * gs[i]; d[0] = v[i].x * sc; d[1] = v[i].y * sc; d[2] = v[i].z * sc; d[3] = v[i].w * sc; }
    asm volatile("s_waitcnt lgkmcnt(0)" ::: "memory");
    const int c = lane & 7;
#pragma unroll
    for (int j = 0; j < 4; ++j) { const int n = (lane >> 3) + 8 * j; const float* s = scr + (8 * c) * 33 + n;
        u32x4 o; o.x = pk2(s[0 * 33], s[1 * 33]); o.y = pk2(s[2 * 33], s[3 * 33]); o.z = pk2(s[4 * 33], s[5 * 33]); o.w = pk2(s[6 * 33], s[7 * 33]);
        *(u32x4*)(WT + (size_t)(n0 + n) * 2048 + k0 + 8 * c) = o; }
    asm volatile("s_waitcnt lgkmcnt(0)" ::: "memory");
}
__device__ __forceinline__ void phase0(Ctx& F) {
    float* scr = (float*)(F.lds + F.wave * 16384);
    const int gw = F.bid * 8 + F.wave, NGW = F.G * 8;
    if (F.bid == 0) for (int i = F.tid; i < 16384; i += 512) F.ctl[i] = 0u;
    for (int i = F.bid * 512 + F.tid; i < 3 * SEQ; i += F.G * 512) F.ss[SEQ + i] = 0ull;
    constexpr int I_IN = 32 * 233, I_OUT = 32 * 64, I_L = I_IN + I_OUT, I_ALL = NLAYER * I_L;
#define P0_DECODE(it_, W_, N_, WT_, g_, mode_, kb_, nb_) do { const int l_ = (it_) / I_L; int r_ = (it_) % I_L; \
        if (r_ < I_IN) { W_ = F.w_in + (size_t)l_ * DM * INW; N_ = INW; WT_ = F.wtin + (size_t)l_ * NPAD * DM; g_ = F.norm_g + l_ * DM; mode_ = 1; kb_ = r_ / 233; nb_ = r_ % 233; } \
        else { r_ -= I_IN; W_ = F.w_out + (size_t)l_ * DM * DM; N_ = DM; WT_ = F.wtout + (size_t)l_ * DM * DM; g_ = F.norm_g; mode_ = 0; kb_ = r_ / 64; nb_ = r_ % 64; } } while (0)
    { f32x4 va[8], vb[8]; float ga[8], gb[8];
      const float* W = nullptr; const float* g = nullptr; bf16* WT = nullptr; int N = 0, mode = 0, kb = 0, nb = 0;
      int it = gw;
      if (it < I_ALL) { P0_DECODE(it, W, N, WT, g, mode, kb, nb); p0_load(W, N, g, mode, kb, nb, F.lane, va, ga); }
      while (it < I_ALL) { const int nit = it + NGW;
          const float* W2 = nullptr; const float* g2 = nullptr; bf16* WT2 = nullptr; int N2 = 0, mode2 = 0, kb2 = 0, nb2 = 0;
          if (nit < I_ALL) { P0_DECODE(nit, W2, N2, WT2, g2, mode2, kb2, nb2); p0_load(W2, N2, g2, mode2, kb2, nb2, F.lane, vb, gb); }
          p0_finish(WT, mode, kb, nb, F.lane, scr, va, ga);
#pragma unroll
          for (int i = 0; i < 8; ++i) { va[i] = vb[i]; ga[i] = gb[i]; }
          it = nit; WT = WT2; mode = mode2; kb = kb2; nb = nb2; } }
#undef P0_DECODE
    for (int m = gw; m < SEQ; m += NGW) {
        const f32x4* xr = (const f32x4*)(F.x + (size_t)m * DM) + F.lane; float s = 0.f; u32x2* o8 = (u32x2*)(F.xb + (size_t)m * DM) + F.lane;
#pragma unroll
        for (int j = 0; j < 8; ++j) { const f32x4 v = xr[64 * j]; s += (v.x * v.x + v.y * v.y) + (v.z * v.z + v.w * v.w); u32x2 w; w.x = pk2(v.x, v.y); w.y = pk2(v.z, v.w); o8[64 * j] = w; }
#pragma unroll
        for (int o = 1; o < 64; o <<= 1) s += __shfl_xor(s, o);
        if (F.lane == 0) F.ss[m] = (unsigned long long)(s * 1048576.0f + 0.5f);
    }
}

__device__ __forceinline__ void phase2(Ctx& F, int l) {
    { const int gw = F.bid * 8 + F.wave, NGW = F.G * 8;
      for (int wi = gw; wi < 512; wi += NGW) { const int blk = wi >> 3, h = wi & 7, t = blk * 128 + 2 * F.lane; const float fb = F.fox_bias[l * 8 + h];
        const float l0 = logsig(F.small[(size_t)t * 32 + h] + fb), l1 = logsig(F.small[(size_t)(t + 1) * 32 + h] + fb);
        float s = l0 + l1;
#pragma unroll
        for (int o = 1; o < 64; o <<= 1) { const float y = __shfl_up(s, o); if (F.lane >= o) s += y; }
        const float ex = s - (l0 + l1); F.cl[t * 8 + h] = ex + l0; F.cl[(t + 1) * 8 + h] = s; if (F.lane == 63) F.bt[blk * 8 + h] = s; } }
    { float* CR = (float*)F.lds;
      float* GT = (float*)(F.lds + 4096);
      unsigned char* KH = F.lds + 8192;
      unsigned char* VV = F.lds + 8192 + 13312;
      const float* gup = F.gate_up + (size_t)l * 16 * 384; const float* gbs = F.gate_bias + l * 384;
      for (int u = F.bid; u < 512; u += F.G) { const int h = u & 3, n = u >> 2, t0 = n * 64;
        if (F.tid < 256) *(f32x4*)(CR + F.tid * 4) = *(const f32x4*)(F.small + (size_t)(t0 + (F.tid >> 2)) * 32 + 8 + 4 * (F.tid & 3));
        { u32x4 vv[3];
#pragma unroll
          for (int i = 0; i < 3; ++i) { const int e = F.tid + 512 * i, row = e / 24, ch = e % 24; vv[i] = *(const u32x4*)(F.proj + (size_t)(t0 + row) * PW + C_CV + h * 192 + ch * 8); }
          asm volatile("" : "+v"(vv[0]), "+v"(vv[1]), "+v"(vv[2]));
#pragma unroll
          for (int i = 0; i < 3; ++i) { const int e = F.tid + 512 * i, row = e / 24, ch = e % 24; *(u32x4*)(VV + row * 400 + ch * 16) = vv[i]; } }
        __syncthreads();
        const int d = F.tid % 96, tg = F.tid / 96;
        float bc[16];
        if (F.tid < 384) { float g[16];
#pragma unroll
            for (int r = 0; r < 16; ++r) g[r] = gup[r * 384 + h * 96 + d];
            const float gb = gbs[h * 96 + d]; float run = 0.f;
#pragma unroll
            for (int i = 0; i < 16; ++i) { const float* cr = CR + (16 * tg + i) * 16; float a = gb;
#pragma unroll
                for (int r4 = 0; r4 < 4; ++r4) { const f32x4 c = *(const f32x4*)(cr + 4 * r4); a += c.x * g[4 * r4] + c.y * g[4 * r4 + 1] + c.z * g[4 * r4 + 2] + c.w * g[4 * r4 + 3]; }
                const float ls = fminf(a, 0.f) - __logf(1.f + __expf(-fabsf(a)));
                run += ls * (1.f / 16.f); bc[i] = run; }
            GT[tg * 96 + d] = run; }
        __syncthreads();
        if (F.tid < 384) { const float g0 = GT[d], g1 = GT[96 + d], g2 = GT[192 + d], g3 = GT[288 + d];
            const float pre = (tg > 0 ? g0 : 0.f) + (tg > 1 ? g1 : 0.f) + (tg > 2 ? g2 : 0.f);
            const float bm = g0 + g1, bl = (g0 + g1) + (g2 + g3);
            bf16* qp = F.proj + (size_t)(t0 + 16 * tg) * PW + C_CQ + h * 96 + d; bf16* kp = F.proj + (size_t)(t0 + 16 * tg) * PW + C_CK + h * 96 + d;
            float qv[16], kv[16]; unsigned qr[16], kr[16];
#pragma unroll
            for (int i = 0; i < 16; ++i) { qr[i] = qp[(size_t)i * PW]; kr[i] = kp[(size_t)i * PW]; }
#pragma unroll
            for (int i = 0; i < 16; i += 4) { asm volatile("" : "+v"(qr[i]), "+v"(qr[i + 1]), "+v"(qr[i + 2]), "+v"(qr[i + 3])); asm volatile("" : "+v"(kr[i]), "+v"(kr[i + 1]), "+v"(kr[i + 2]), "+v"(kr[i + 3])); }
#pragma unroll
            for (int i = 0; i < 16; ++i) { qv[i] = bf2f(qr[i]); kv[i] = bf2f(kr[i]); }
#pragma unroll
            for (int i = 0; i < 16; ++i) { const float b = bc[i] + pre; const float eq = __expf(b - bm), ek = __expf(bm - b), eh = __expf(bl - b);
                qp[(size_t)i * PW] = (bf16)(pk2(qv[i] * eq, 0.f) & 0xffffu); kp[(size_t)i * PW] = (bf16)(pk2(kv[i] * ek, 0.f) & 0xffffu);
                *(bf16*)(KH + (16 * tg + i) * 208 + d * 2) = (bf16)(pk2(kv[i] * eh, 0.f) & 0xffffu); }
            if (tg == 0) { F.dec[(n * 4 + h) * 96 + d] = __expf(bl); F.dec[49152 + (n * 4 + h) * 96 + d] = __expf(bm); } }
        __syncthreads();
        for (int id = F.wave; id < 18; id += 8) { const int vt = id / 3, dt = id % 3; f32x16 acc = {};
#pragma unroll
            for (int s = 0; s < 4; ++s) { const bf16x8 a = frag_tr((lds_cptr)VV, 400, 16 * s, 32 * vt, F.lane), b = frag_tr((lds_cptr)KH, 208, 16 * s, 32 * dt, F.lane); acc = MFMA32(a, b, acc); }
            float* dst = F.ds + ((size_t)(n * 4 + h) * 192 + 32 * vt) * 96 + 32 * dt + (F.lane & 31);
#pragma unroll
            for (int r = 0; r < 16; ++r) dst[(size_t)rowidx(r, F.lane >> 5) * 96] = acc[r]; }
        __syncthreads(); } }
}
__device__ __forceinline__ float softmax_ref2(const float* gq, const float* gk) {
    float mq = 0.f, mk = 0.f;
    for (int i = 0; i < 64; ++i) { mq = fmaxf(mq, fabsf(gq[i])); mk = fmaxf(mk, fabsf(gk[i])); }
    return 8.25f * mq * mk * LOG2E;
}
__device__ __forceinline__ void scan_item(Ctx& F, int si) {
    const int p = si * 512 + F.tid, d = 2 * (p % 48), v = (p / 48) % 192, h = p / (48 * 192);
    float s0 = 0.f, s1 = 0.f;
    for (int nb = 0; nb < 128; nb += 8) { f32x2 dd[8], a[8], em[8];
#pragma unroll
        for (int j = 0; j < 8; ++j) { const int n = nb + j; const size_t idx = ((size_t)(n * 4 + h) * 192 + v) * 96 + d; const int di = (n * 4 + h) * 96 + d;
            dd[j] = *(const f32x2*)(F.ds + idx); a[j] = *(const f32x2*)(F.dec + di); em[j] = *(const f32x2*)(F.dec + 49152 + di); }
#pragma unroll
        for (int j = 0; j < 8; j += 4) { asm volatile("" : "+v"(dd[j]), "+v"(dd[j + 1]), "+v"(dd[j + 2]), "+v"(dd[j + 3])); asm volatile("" : "+v"(a[j]), "+v"(a[j + 1]), "+v"(a[j + 2]), "+v"(a[j + 3])); asm volatile("" : "+v"(em[j]), "+v"(em[j + 1]), "+v"(em[j + 2]), "+v"(em[j + 3])); }
#pragma unroll
        for (int j = 0; j < 8; ++j) { const int n = nb + j; const size_t idx = ((size_t)(n * 4 + h) * 192 + v) * 96 + d;
            *(unsigned*)(F.st + idx) = pk2(em[j].x * s0, em[j].y * s1);
            s0 = a[j].x * s0 + dd[j].x; s1 = a[j].y * s1 + dd[j].y; } }
}
#define PIN4(a, b, c, d) asm volatile("" : "+v"(a), "+v"(b), "+v"(c), "+v"(d))
#define SBAR0() __builtin_amdgcn_sched_barrier(0)
template <int KSTR, int VSTR>
__device__ __forceinline__ void attn_sub(const unsigned char* Kt, const unsigned char* Vt, int key_row0, const bf16x8 (&qf)[4], f32x16 S, f32x16 (&o)[2], float& lsum, int lane,
                                         bool use_mask, int lo, int hi_) {
    const int r = lane & 31, hh = lane >> 5;
    bf16x8 kf[4];
#pragma unroll
    for (int s = 0; s < 4; ++s) kf[s] = *(const bf16x8*)(Kt + (key_row0 + r) * KSTR + (16 * s + 8 * hh) * 2);
    bf16x8 vf[2][2];
#pragma unroll
    for (int dt = 0; dt < 2; ++dt) { vf[dt][0] = frag_tr((lds_cptr)Vt, VSTR, key_row0, 32 * dt, lane); vf[dt][1] = frag_tr((lds_cptr)Vt, VSTR, key_row0 + 16, 32 * dt, lane); }
    PIN4(kf[0], kf[1], kf[2], kf[3]);
#pragma unroll
    for (int s = 0; s < 4; ++s) S = MFMA32(kf[s], qf[s], S);
    if (use_mask) {
#pragma unroll
        for (int g = 0; g < 16; ++g) { const int k = rowidx(g, hh); if (k < lo || k > hi_) S[g] = -INFINITY; } }
    float acc = 0.f;
#pragma unroll
    for (int g = 0; g < 16; ++g) { S[g] = __builtin_amdgcn_exp2f(S[g]); acc += S[g]; }
    lsum += acc;
    bf16x8 p0, p1; pack_p(S, p0, p1);
    PIN4(vf[0][0], vf[0][1], vf[1][0], vf[1][1]);
#pragma unroll
    for (int dt = 0; dt < 2; ++dt) { o[dt] = MFMA32(vf[dt][0], p0, o[dt]); o[dt] = MFMA32(vf[dt][1], p1, o[dt]); }
}
template <int NSUB, int KSTR, int VSTR>
__device__ __forceinline__ void attn_multi(const unsigned char* Kt, const unsigned char* Vt, int key_row0, const bf16x8 (&qf)[4], f32x16 (&S)[NSUB], f32x16 (&o)[2], float& lsum, int lane) {
    const int r = lane & 31, hh = lane >> 5;
    bf16x8 kf[NSUB][4];
#pragma unroll
    for (int u = 0; u < NSUB; ++u)
#pragma unroll
        for (int s = 0; s < 4; ++s) kf[u][s] = *(const bf16x8*)(Kt + (key_row0 + 32 * u + r) * KSTR + (16 * s + 8 * hh) * 2);
#pragma unroll
    for (int u = 0; u < NSUB; ++u) PIN4(kf[u][0], kf[u][1], kf[u][2], kf[u][3]);
#pragma unroll
    for (int s = 0; s < 4; ++s)
#pragma unroll
        for (int u = 0; u < NSUB; ++u) S[u] = MFMA32(kf[u][s], qf[s], S[u]);
#pragma unroll
    for (int u = 0; u < NSUB; ++u) {
        bf16x8 vf[2][2];
#pragma unroll
        for (int dt = 0; dt < 2; ++dt) { vf[dt][0] = frag_tr((lds_cptr)Vt, VSTR, key_row0 + 32 * u, 32 * dt, lane); vf[dt][1] = frag_tr((lds_cptr)Vt, VSTR, key_row0 + 32 * u + 16, 32 * dt, lane); }
        SBAR0();
        float acc = 0.f;
#pragma unroll
        for (int g = 0; g < 16; ++g) { S[u][g] = __builtin_amdgcn_exp2f(S[u][g]); acc += S[u][g]; }
        lsum += acc;
        bf16x8 p0, p1; pack_p(S[u], p0, p1);
        PIN4(vf[0][0], vf[0][1], vf[1][0], vf[1][1]);
#pragma unroll
        for (int dt = 0; dt < 2; ++dt) { o[dt] = MFMA32(vf[dt][0], p0, o[dt]); o[dt] = MFMA32(vf[dt][1], p1, o[dt]); } }
}
__device__ __forceinline__ void fox_unit(Ctx& F, int l, int h, int qb, int seg) {
    constexpr int KS = 144, VS = 192, BUFB = 128 * KS, BUFV = 128 * VS;
    unsigned char* KT = F.lds; unsigned char* VT = F.lds + 2 * BUFB; float* CS = (float*)(F.lds + 2 * BUFB + 2 * BUFV);
    const float* PEX = (const float*)(F.lds + P3_EXT) + h * 64;
    const int r = F.lane & 31, hh = F.lane >> 5, w = F.wave, t0 = 256 * qb, NT = 2 * qb + 2;
    const int kfirst = __builtin_amdgcn_readfirstlane(((const int*)(F.lds + P3_EXT + 2048))[h * 32 + qb]);
    const int nuse = (NT - kfirst + 15) >> 4;
    if (seg >= nuse) return;
    const int kt0 = kfirst + 16 * seg, te = (kt0 + 16 < NT) ? kt0 + 16 : NT;
    const float mb2 = ((const float*)(F.lds + P3_EXT + 3072))[1];
    const int tq = t0 + 32 * w + r; const float pq0 = PEX[t0 >> 7];
    const float ctq = ((PEX[tq >> 7] - pq0) + F.cl[tq * 8 + h]) * LOG2E - mb2;
    bf16x8 qf[4];
#pragma unroll
    for (int s = 0; s < 4; ++s) qf[s] = *(const bf16x8*)(F.proj + (size_t)tq * PW + C_BQ + h * 64 + 16 * s + 8 * hh);
    f32x16 o[2]; o[0] = f32x16{}; o[1] = f32x16{}; float lsum = 0.f;
    const int lrow = F.tid >> 3, lch = F.tid & 7;
    u32x4 kreg[2], vreg[2]; float creg = 0.f;
    if (kt0 < te) {
#pragma unroll
        for (int i = 0; i < 2; ++i) { const size_t g = (size_t)(128 * kt0 + 64 * i + lrow) * PW + h * 64 + lch * 8; kreg[i] = *(const u32x4*)(F.proj + g + C_BK); vreg[i] = *(const u32x4*)(F.proj + g + C_BV); }
        if (F.tid < 128) creg = ((PEX[kt0] - pq0) + F.cl[(128 * kt0 + F.tid) * 8 + h]) * LOG2E; }
    for (int kt = kt0; kt < te; ++kt) { const int buf = (kt - kt0) & 1;
#pragma unroll
        for (int i = 0; i < 2; ++i) { *(u32x4*)(KT + buf * BUFB + (64 * i + lrow) * KS + lch * 16) = kreg[i]; *(u32x4*)(VT + buf * BUFV + (64 * i + lrow) * VS + lch * 16) = vreg[i]; }
        if (F.tid < 128) CS[buf * 128 + F.tid] = creg;
        __syncthreads();
        if (kt + 1 < te) {
#pragma unroll
            for (int i = 0; i < 2; ++i) { const size_t g = (size_t)(128 * (kt + 1) + 64 * i + lrow) * PW + h * 64 + lch * 8; kreg[i] = *(const u32x4*)(F.proj + g + C_BK); vreg[i] = *(const u32x4*)(F.proj + g + C_BV); }
            if (F.tid < 128) creg = ((PEX[kt + 1] - pq0) + F.cl[(128 * (kt + 1) + F.tid) * 8 + h]) * LOG2E; }
        const unsigned char* Kb = KT + buf * BUFB; const unsigned char* Vb = VT + buf * BUFV; const float* Cb = CS + buf * 128;
        if (kt < 2 * qb) {
#pragma unroll
            for (int hf = 0; hf < 2; ++hf) { f32x16 S[2]; f32x4 c4[2][4];
#pragma unroll
                for (int u = 0; u < 2; ++u)
#pragma unroll
                    for (int i = 0; i < 4; ++i) c4[u][i] = *(const f32x4*)(Cb + 64 * hf + 32 * u + 8 * i + 4 * hh);
                PIN4(c4[0][0], c4[0][1], c4[0][2], c4[0][3]); PIN4(c4[1][0], c4[1][1], c4[1][2], c4[1][3]);
#pragma unroll
                for (int u = 0; u < 2; ++u)
#pragma unroll
                    for (int i = 0; i < 4; ++i) { S[u][4 * i] = ctq - c4[u][i].x; S[u][4 * i + 1] = ctq - c4[u][i].y; S[u][4 * i + 2] = ctq - c4[u][i].z; S[u][4 * i + 3] = ctq - c4[u][i].w; }
                attn_multi<2, KS, VS>(Kb, Vb, 64 * hf, qf, S, o, lsum, F.lane); }
        } else {
            const int qlo = t0 + 32 * w;
#pragma unroll
            for (int sub = 0; sub < 4; ++sub) { const int key0 = 128 * kt + 32 * sub;
                if (key0 <= qlo + 31) {
                    f32x16 S;
#pragma unroll
                    for (int i = 0; i < 4; ++i) { const f32x4 c4 = *(const f32x4*)(Cb + 32 * sub + 8 * i + 4 * hh); S[4 * i] = ctq - c4.x; S[4 * i + 1] = ctq - c4.y; S[4 * i + 2] = ctq - c4.z; S[4 * i + 3] = ctq - c4.w; }
                    attn_sub<KS, VS>(Kb, Vb, 32 * sub, qf, S, o, lsum, F.lane, key0 + 31 > qlo, 0, tq - key0); } }
        }
    }
    lsum += __shfl_xor(lsum, 32);
    float* ob = F.ob + ((size_t)seg * SEQ + tq) * 512 + h * 64 + 4 * hh;
#pragma unroll
    for (int dt = 0; dt < 2; ++dt)
#pragma unroll
        for (int i = 0; i < 4; ++i) *(f32x4*)(ob + 32 * dt + 8 * i) = (f32x4){o[dt][4 * i], o[dt][4 * i + 1], o[dt][4 * i + 2], o[dt][4 * i + 3]};
    if (hh == 0) F.lb[((size_t)seg * SEQ + tq) * 8 + h] = lsum;
    __syncthreads();
}
__device__ __forceinline__ void a_unit(Ctx& F, int l, int a, int n, int rres, int b2) {
    constexpr int KS = 144, VS = 192;
    unsigned char* KA = F.lds; unsigned char* VA = F.lds + 384 * KS;
    const int r = F.lane & 31, hh = F.lane >> 5, w = F.wave, d = (n == 0) ? 1 : (n == 1) ? 4 : 16, i0 = 256 * b2;
    { u32x4 kv[6], vv[6]; const int ch = F.tid & 7;
#pragma unroll
      for (int i = 0; i < 6; ++i) { const int j = (F.tid >> 3) + 64 * i, idx = i0 - 128 + j; kv[i] = (u32x4){0u, 0u, 0u, 0u}; vv[i] = (u32x4){0u, 0u, 0u, 0u};
          if (idx >= 0) { const size_t g = (size_t)(rres + d * idx) * PW + a * 64 + ch * 8; kv[i] = *(const u32x4*)(F.proj + g + C_AK); vv[i] = *(const u32x4*)(F.proj + g + C_AV); } }
      asm volatile("" : "+v"(kv[0]), "+v"(kv[1]), "+v"(kv[2]), "+v"(kv[3]), "+v"(kv[4]), "+v"(kv[5]));
      asm volatile("" : "+v"(vv[0]), "+v"(vv[1]), "+v"(vv[2]), "+v"(vv[3]), "+v"(vv[4]), "+v"(vv[5]));
#pragma unroll
      for (int i = 0; i < 6; ++i) { const int j = (F.tid >> 3) + 64 * i; *(u32x4*)(KA + j * KS + ch * 16) = kv[i]; *(u32x4*)(VA + j * VS + ch * 16) = vv[i]; } }
    const int tokq = rres + d * (i0 + 32 * w + r);
    bf16x8 qf[4];
#pragma unroll
    for (int s = 0; s < 4; ++s) qf[s] = *(const bf16x8*)(F.proj + (size_t)tokq * PW + C_AQ + a * 64 + 16 * s + 8 * hh);
    const float mb2 = ((const float*)(F.lds + P3_EXT + 3072))[0];
    __syncthreads();
    f32x16 o[2]; o[0] = f32x16{}; o[1] = f32x16{}; float lsum = 0.f;
    const int qj = 32 * w + r + 128;
    if (i0 != 0) {
        { f32x16 S;
#pragma unroll
          for (int g = 0; g < 16; ++g) S[g] = -mb2;
          attn_sub<KS, VS>(KA, VA, 32 * w, qf, S, o, lsum, F.lane, true, qj - 128 - 32 * w, 31); }
        { f32x16 S[3];
#pragma unroll
          for (int u = 0; u < 3; ++u)
#pragma unroll
              for (int g = 0; g < 16; ++g) S[u][g] = -mb2;
          attn_multi<3, KS, VS>(KA, VA, 32 * (w + 1), qf, S, o, lsum, F.lane); }
        { f32x16 S;
#pragma unroll
          for (int g = 0; g < 16; ++g) S[g] = -mb2;
          attn_sub<KS, VS>(KA, VA, 32 * (w + 4), qf, S, o, lsum, F.lane, true, 0, qj - 32 * (w + 4)); }
    } else
    for (int jt = w; jt < w + 5; ++jt) { const int j0 = 32 * jt;
        if (j0 + 31 < 128) continue;
        f32x16 S;
#pragma unroll
        for (int g = 0; g < 16; ++g) S[g] = -mb2;
        int lo = qj - 128 - j0; const int hi_ = qj - j0; if (128 - j0 > lo) lo = 128 - j0;
        attn_sub<KS, VS>(KA, VA, j0, qf, S, o, lsum, F.lane, true, lo, hi_); }
    lsum += __shfl_xor(lsum, 32);
    bf16* oa = F.oa + ((size_t)n * SEQ + tokq) * 768 + a * 64 + 4 * hh;
#pragma unroll
    for (int dt = 0; dt < 2; ++dt)
#pragma unroll
        for (int i = 0; i < 4; ++i) { u32x2 wv; wv.x = pk2(o[dt][4 * i], o[dt][4 * i + 1]); wv.y = pk2(o[dt][4 * i + 2], o[dt][4 * i + 3]); *(u32x2*)(oa + 32 * dt + 8 * i) = wv; }
    if (hh == 0) F.la[((size_t)n * SEQ + tokq) * 12 + a] = lsum;
    __syncthreads();
}
__device__ __forceinline__ void phase3(Ctx& F, int l) {
    volatile unsigned* slot = (volatile unsigned*)(F.lds + QSLOT_OFF);
    { float* PEXA = (float*)(F.lds + P3_EXT); int* KFT = (int*)(F.lds + P3_EXT + 2048); float* MB = (float*)(F.lds + P3_EXT + 3072);
      { const float v = F.bt[F.lane * 8 + F.wave]; float sc = v;
#pragma unroll
        for (int o = 1; o < 64; o <<= 1) { const float y = __shfl_up(sc, o); if (F.lane >= o) sc += y; }
        PEXA[F.wave * 64 + F.lane] = sc - v; }
      if (F.tid == 0) { MB[0] = softmax_ref2(F.aqg + l * 64, F.akg + l * 64); MB[1] = softmax_ref2(F.bqg + l * 64, F.bkg + l * 64); }
      __syncthreads();
      if (F.tid < 256) { const int h = F.tid >> 5, qb = F.tid & 31; const float thr = -(26.f + 2.f * MB[1] * (1.f / LOG2E)), pq0 = PEXA[h * 64 + 2 * qb];
          int kt = 0; while (kt < 2 * qb && (pq0 - PEXA[h * 64 + kt + 1]) < thr) ++kt;
          KFT[F.tid] = kt; if (F.bid == 0) F.ctl[8192 + F.tid] = (unsigned)kt; }
      __syncthreads(); }
    for (;;) {
        if (F.tid == 0) *slot = atomicAdd(F.ctl + l, 1u);
        __syncthreads();
        const int item = __builtin_amdgcn_readfirstlane((int)*slot);
        __syncthreads();
        if (item >= N_ITEMS) break;
        if (item < N_SCAN) scan_item(F, item);
        else if (item < N_SCAN + N_FOX) { int f = item - N_SCAN, ns, qhi;
            if (f < 256) { ns = 4; qhi = 31; } else if (f < 448) { f -= 256; ns = 3; qhi = 23; } else if (f < 576) { f -= 448; ns = 2; qhi = 15; } else { f -= 576; ns = 1; qhi = 7; }
            const int per = ns * 8, qb = qhi - f / per, rem = f % per;
            fox_unit(F, l, rem & 7, qb, rem >> 3); }
        else { const int au = item - N_SCAN - N_FOX, n = au / 384, rest = au % 384, a = rest >> 5, u = rest & 31;
            const int per = (n == 0) ? 32 : (n == 1) ? 8 : 2;
            a_unit(F, l, a, n, u / per, u % per); }
    }
}
#define PIN6(a) asm volatile("" : "+v"(a[0]), "+v"(a[1]), "+v"(a[2]), "+v"(a[3]), "+v"(a[4]), "+v"(a[5]))
__device__ __forceinline__ void phase4(Ctx& F, int l) {
    unsigned char* VV = F.lds;
    float* SSQ = (float*)(F.lds + 51200);
    const int r = F.lane & 31, hh = F.lane >> 5, w = F.wave, ui = w >> 2, th = (w >> 1) & 1, vh = w & 1;
    const float* gain = F.out_gain + l * 192;
    for (int pu = F.bid; pu < 256; pu += F.G) {
        const int u = 2 * pu + ui, h = u & 3, n = u >> 2, t0 = n * 64, tq = th * 32 + r;
        bf16x8 qf[6], kf0[6], kf1[6], sfa[6], sfb[6];
        const bf16* stb = F.st + ((size_t)(n * 4 + h) * 192 + 32 * (vh * 3) + r) * 96 + 8 * hh;
#pragma unroll
        for (int kd = 0; kd < 6; ++kd) { qf[kd] = *(const bf16x8*)(F.proj + (size_t)(t0 + tq) * PW + C_CQ + h * 96 + 16 * kd + 8 * hh);
            kf0[kd] = *(const bf16x8*)(F.proj + (size_t)(t0 + r) * PW + C_CK + h * 96 + 16 * kd + 8 * hh);
            kf1[kd] = *(const bf16x8*)(F.proj + (size_t)(t0 + 32 + r) * PW + C_CK + h * 96 + 16 * kd + 8 * hh);
            sfa[kd] = *(const bf16x8*)(stb + 16 * kd); }
        { u32x4 vv[6];
#pragma unroll
          for (int i = 0; i < 6; ++i) { const int e = F.tid + 512 * i, uu = e / 1536, e2 = e % 1536, row = e2 / 24, ch = e2 % 24, u2 = 2 * pu + uu, h2 = u2 & 3, n2 = u2 >> 2;
              vv[i] = *(const u32x4*)(F.proj + (size_t)(n2 * 64 + row) * PW + C_CV + h2 * 192 + ch * 8); }
          asm volatile("" : "+v"(vv[0]), "+v"(vv[1]), "+v"(vv[2]), "+v"(vv[3]), "+v"(vv[4]), "+v"(vv[5]));
#pragma unroll
          for (int i = 0; i < 6; ++i) { const int e = F.tid + 512 * i, uu = e / 1536, e2 = e % 1536, row = e2 / 24, ch = e2 % 24; *(u32x4*)(VV + uu * 25600 + row * 400 + ch * 16) = vv[i]; } }
        __syncthreads();
        PIN6(qf); PIN6(kf0); PIN6(kf1);
        bf16x8 pf[2][2];
        { f32x16 X = {};
#pragma unroll
          for (int kd = 0; kd < 6; ++kd) X = MFMA32(kf0[kd], qf[kd], X);
          if (th == 0) {
#pragma unroll
              for (int g = 0; g < 16; ++g) if (rowidx(g, hh) > r) X[g] = 0.f; }
          pack_p(X, pf[0][0], pf[0][1]); }
        if (th == 1) { f32x16 X = {};
#pragma unroll
          for (int kd = 0; kd < 6; ++kd) X = MFMA32(kf1[kd], qf[kd], X);
#pragma unroll
          for (int g = 0; g < 16; ++g) if (rowidx(g, hh) > r) X[g] = 0.f;
          pack_p(X, pf[1][0], pf[1][1]); }
        f32x16 O[3]; float sq = 0.f;
#pragma unroll
        for (int vt = 0; vt < 3; ++vt) { const int vtile = vh * 3 + vt; f32x16 acc = {};
            if (vt == 0) {
#pragma unroll
                for (int kd = 0; kd < 6; ++kd) sfb[kd] = *(const bf16x8*)(stb + (size_t)32 * 96 + 16 * kd); }
            if (vt == 1) {
#pragma unroll
                for (int kd = 0; kd < 6; ++kd) sfa[kd] = *(const bf16x8*)(stb + (size_t)64 * 96 + 16 * kd); }
#pragma unroll
            for (int si = 0; si < 2; ++si) if (si <= th) {
#pragma unroll
                for (int s2 = 0; s2 < 2; ++s2) { const bf16x8 vf = frag_tr((lds_cptr)(VV + ui * 25600), 400, 32 * si + 16 * s2, 32 * vtile, F.lane); acc = MFMA32(vf, pf[si][s2], acc); } }
            if (vt == 1) { PIN6(sfb);
#pragma unroll
                for (int kd = 0; kd < 6; ++kd) acc = MFMA32(sfb[kd], qf[kd], acc); }
            else { PIN6(sfa);
#pragma unroll
                for (int kd = 0; kd < 6; ++kd) acc = MFMA32(sfa[kd], qf[kd], acc); }
#pragma unroll
            for (int g = 0; g < 16; ++g) sq += acc[g] * acc[g];
            O[vt] = acc; }
        u32x2 zw[3][4]; f32x4 gg[3][4];
#pragma unroll
        for (int vt = 0; vt < 3; ++vt)
#pragma unroll
            for (int i = 0; i < 4; ++i) { const int v = 32 * (vh * 3 + vt) + 8 * i + 4 * hh;
                zw[vt][i] = *(const u32x2*)(F.proj + (size_t)(t0 + tq) * PW + C_CZ + h * 192 + v); gg[vt][i] = *(const f32x4*)(gain + v); }
        sq += __shfl_xor(sq, 32);
        if (hh == 0) SSQ[(ui * 2 + vh) * 64 + tq] = sq;
        __syncthreads();
        const float rs = rsqrtf((SSQ[(ui * 2) * 64 + tq] + SSQ[(ui * 2 + 1) * 64 + tq]) * (1.f / 192.f) + EPS);
#pragma unroll
        for (int vt = 0; vt < 3; ++vt) { PIN4(zw[vt][0], zw[vt][1], zw[vt][2], zw[vt][3]);
#pragma unroll
            for (int i = 0; i < 4; ++i) { const int v = 32 * (vh * 3 + vt) + 8 * i + 4 * hh; const u32x2 z = zw[vt][i]; const f32x4 g4 = gg[vt][i];
                const float y0 = O[vt][4 * i] * rs * g4.x * silu(blo(z.x)), y1 = O[vt][4 * i + 1] * rs * g4.y * silu(bhi(z.x)), y2 = O[vt][4 * i + 2] * rs * g4.z * silu(blo(z.y)), y3 = O[vt][4 * i + 3] * rs * g4.w * silu(bhi(z.y));
                u32x2 ov; ov.x = pk2(y0, y1); ov.y = pk2(y2, y3); *(u32x2*)(F.mixed + (size_t)(t0 + tq) * DM + 1280 + h * 192 + v) = ov; } }
        __syncthreads();
    }
    const int NT = F.G * 512, gt = F.bid * 512 + F.tid;
    for (int idx0 = gt; idx0 < SEQ * 96; idx0 += 2 * NT) {
        u32x4 wv[2][3], zw[2]; float la[2][3]; int tt[2], cc[2]; bool ok[2];
#pragma unroll
        for (int j = 0; j < 2; ++j) { const int idx = idx0 + j * NT; ok[j] = idx < SEQ * 96; const int id2 = ok[j] ? idx : gt; const int t = id2 / 96, c = (id2 % 96) * 8, a = c >> 6; tt[j] = t; cc[j] = c;
#pragma unroll
            for (int n = 0; n < 3; ++n) { wv[j][n] = *(const u32x4*)(F.oa + ((size_t)n * SEQ + t) * 768 + c); la[j][n] = F.la[((size_t)n * SEQ + t) * 12 + a]; }
            zw[j] = *(const u32x4*)(F.proj + (size_t)t * PW + C_AZ + c); }
        PIN4(wv[0][0], wv[0][1], wv[0][2], zw[0]); PIN4(wv[1][0], wv[1][1], wv[1][2], zw[1]);
#pragma unroll
        for (int j = 0; j < 2; ++j) { float o[8] = {0.f, 0.f, 0.f, 0.f, 0.f, 0.f, 0.f, 0.f};
#pragma unroll
            for (int n = 0; n < 3; ++n) { const u32x4 x = wv[j][n]; o[0] += blo(x.x); o[1] += bhi(x.x); o[2] += blo(x.y); o[3] += bhi(x.y); o[4] += blo(x.z); o[5] += bhi(x.z); o[6] += blo(x.w); o[7] += bhi(x.w); }
            const float il = 1.f / ((la[j][0] + la[j][1]) + la[j][2]); const u32x4 z = zw[j];
            u32x4 ov; ov.x = pk2(o[0] * il * silu(blo(z.x)), o[1] * il * silu(bhi(z.x))); ov.y = pk2(o[2] * il * silu(blo(z.y)), o[3] * il * silu(bhi(z.y)));
            ov.z = pk2(o[4] * il * silu(blo(z.z)), o[5] * il * silu(bhi(z.z))); ov.w = pk2(o[6] * il * silu(blo(z.w)), o[7] * il * silu(bhi(z.w)));
            if (ok[j]) *(u32x4*)(F.mixed + (size_t)tt[j] * DM + cc[j]) = ov; } }
    for (int idx0 = gt; idx0 < SEQ * 64; idx0 += 2 * NT) {
        f32x4 a0[2][4], a1[2][4]; float lv[2][4]; u32x4 zw[2]; int tt[2], cc[2], ns[2]; bool ok[2];
#pragma unroll
        for (int j = 0; j < 2; ++j) { const int idx = idx0 + j * NT; ok[j] = idx < SEQ * 64; const int id2 = ok[j] ? idx : gt; const int t = id2 / 64, c = (id2 % 64) * 8, h = c >> 6; tt[j] = t; cc[j] = c;
            ns[j] = (2 * (t >> 8) + 2 - (int)F.ctl[8192 + h * 32 + (t >> 8)] + 15) >> 4;
#pragma unroll
            for (int sg = 0; sg < 4; ++sg) { a0[j][sg] = (f32x4){0.f, 0.f, 0.f, 0.f}; a1[j][sg] = (f32x4){0.f, 0.f, 0.f, 0.f}; lv[j][sg] = 0.f;
                if (sg < ns[j]) { const float* p = F.ob + ((size_t)sg * SEQ + t) * 512 + c; a0[j][sg] = *(const f32x4*)p; a1[j][sg] = *(const f32x4*)(p + 4); lv[j][sg] = F.lb[((size_t)sg * SEQ + t) * 8 + h]; } }
            zw[j] = *(const u32x4*)(F.proj + (size_t)t * PW + C_BZ + c); }
#pragma unroll
        for (int j = 0; j < 2; ++j) { const f32x4 o0 = (a0[j][0] + a0[j][1]) + (a0[j][2] + a0[j][3]), o1 = (a1[j][0] + a1[j][1]) + (a1[j][2] + a1[j][3]);
            const float il = 1.f / ((lv[j][0] + lv[j][1]) + (lv[j][2] + lv[j][3])); const u32x4 z = zw[j];
            u32x4 ov; ov.x = pk2(o0.x * il * silu(blo(z.x)), o0.y * il * silu(bhi(z.x))); ov.y = pk2(o0.z * il * silu(blo(z.y)), o0.w * il * silu(bhi(z.y)));
            ov.z = pk2(o1.x * il * silu(blo(z.z)), o1.y * il * silu(bhi(z.z))); ov.w = pk2(o1.z * il * silu(blo(z.w)), o1.w * il * silu(bhi(z.w)));
            if (ok[j]) *(u32x4*)(F.mixed + (size_t)tt[j] * DM + 768 + cc[j]) = ov; } }
}

#define LAS __attribute__((address_space(3)))
#define XB_TMO      128
#define XB_XCNT(j)  (256  + 64 * (j))
#define XB_XSUB(j)  (1280 + 64 * (j))
#define XB_XGEN(j)  (2304 + 64 * (j))
#define XB_TOP      3328
#define XB_TOPGEN   3392
#define XCD_BAR_WORDS 3456
#define XB_SPIN_CAP (1u << 18)

__device__ __forceinline__ unsigned xb_ld(unsigned* p)              { return __hip_atomic_load(p, __ATOMIC_RELAXED, __HIP_MEMORY_SCOPE_AGENT); }
__device__ __forceinline__ unsigned xb_add(unsigned* p, unsigned v) { return __hip_atomic_fetch_add(p, v, __ATOMIC_RELAXED, __HIP_MEMORY_SCOPE_AGENT); }
__device__ __forceinline__ unsigned xb_xcc_id() { return (unsigned)__builtin_amdgcn_s_getreg((3 << 11) | 20) & 0xFu; }
#define XB_SPIN(cond, bar) do { unsigned _sp = 0; while (cond) { __builtin_amdgcn_s_sleep(1); \
    if ((++_sp & 255u) == 0u) { if (xb_ld(&(bar)[XB_TMO])) break; if (_sp > XB_SPIN_CAP) { atomicAdd(&(bar)[XB_TMO], 1u); break; } } } } while (0)

struct XcdBarrier {
    unsigned* bar; unsigned x;
    volatile LAS unsigned* st;
};

__device__ __forceinline__ XcdBarrier xcd_barrier_post(unsigned* bar, volatile LAS unsigned* st) {
    XcdBarrier b; b.bar = bar; b.x = xb_xcc_id(); b.st = st;
    if (threadIdx.x == 0) (void)xb_add(&bar[XB_XCNT(b.x)], 1u);
    return b;
}
__device__ __forceinline__ void xcd_barrier_complete(unsigned* bar, unsigned x, unsigned& nloc, unsigned& nx) {
    const unsigned G = gridDim.x * gridDim.y * gridDim.z;
    unsigned sum, cnt, mine, sp = 0u;
    for (;;) {
        sum = 0u; cnt = 0u; mine = 0u;
#pragma unroll
        for (unsigned j = 0; j < 16; ++j) { const unsigned c = xb_ld(&bar[XB_XCNT(j)]); sum += c; cnt += (c > 0u) ? 1u : 0u; mine = (j == x) ? c : mine; }
        if (sum == G) break;
        __builtin_amdgcn_s_sleep(1);
        if ((++sp & 255u) == 0u) { if (xb_ld(&bar[XB_TMO])) break; if (sp > XB_SPIN_CAP) { atomicAdd(&bar[XB_TMO], 1u); break; } }
    }
    nloc = mine > 0u ? mine : 1u; nx = cnt > 0u ? cnt : 1u;
}

__device__ __forceinline__ void xcd_barrier(const XcdBarrier& b) {
    asm volatile("s_waitcnt vmcnt(0)" ::: "memory");
    __syncthreads();
    if (threadIdx.x == 0) {
        unsigned* bar = b.bar;
        __builtin_amdgcn_s_waitcnt(0);
        unsigned nloc = b.st[0], nx = b.st[1];
        if (nloc == 0u) { xcd_barrier_complete(bar, b.x, nloc, nx); b.st[0] = nloc; b.st[1] = nx; }
        const unsigned old = xb_add(&bar[XB_XSUB(b.x)], 1u);
        const unsigned gen = old / nloc;
        if (old + 1u == (gen + 1u) * nloc) {
            __builtin_amdgcn_fence(__ATOMIC_RELEASE, "agent");
            asm volatile("s_waitcnt vmcnt(0)" ::: "memory");
            const unsigned og = xb_add(&bar[XB_TOP], 1u);
            const unsigned tg = og / nx;
            if (og + 1u == (tg + 1u) * nx) xb_add(&bar[XB_TOPGEN], 1u);
            else XB_SPIN(xb_ld(&bar[XB_TOPGEN]) == tg, bar);
            __builtin_amdgcn_fence(__ATOMIC_ACQUIRE, "agent");
            xb_add(&bar[XB_XGEN(b.x)], 1u);
            asm volatile("s_waitcnt vmcnt(0)" ::: "memory");
        } else {
            XB_SPIN(xb_ld(&bar[XB_XGEN(b.x)]) == gen, bar);
            __builtin_amdgcn_fence(__ATOMIC_ACQUIRE, "agent");
            asm volatile("s_waitcnt vmcnt(0)" ::: "memory");
        }
    }
    __syncthreads();
}

struct Args { const float* in[12]; float* out; unsigned char* ws; int ph_lo, ph_hi; };
constexpr int N_PHASES = 1 + 5 * NLAYER;
__global__ void __launch_bounds__(512, 2) mega_fwd(Args args) {
    extern __shared__ __attribute__((aligned(16))) unsigned char lds[];
    Ctx F;
#define BUILD() do { const Args* ap_ = &args; \
    F.x = ap_->in[0]; F.norm_g = ap_->in[1]; F.w_in = ap_->in[2]; F.aqg = ap_->in[3]; F.akg = ap_->in[4]; F.bqg = ap_->in[5]; F.bkg = ap_->in[6]; \
    F.fox_bias = ap_->in[7]; F.gate_up = ap_->in[8]; F.gate_bias = ap_->in[9]; F.out_gain = ap_->in[10]; F.w_out = ap_->in[11]; \
    F.out = ap_->out; unsigned char* ws = ap_->ws; F.ws = ws; \
    F.ctl = (unsigned*)(ws + WS_CTL); F.ss = (unsigned long long*)(ws + WS_SS); F.wtin = (bf16*)(ws + WS_WTIN); F.wtout = (bf16*)(ws + WS_WTOUT); F.xb = (bf16*)(ws + WS_XB); \
    F.proj = (bf16*)(ws + WS_PROJ); F.small = (float*)(ws + WS_SMALL); F.mixed = (bf16*)(ws + WS_MIXED); F.oa = (bf16*)(ws + WS_OA); F.la = (float*)(ws + WS_LA); \
    F.ob = (float*)(ws + WS_OB); F.lb = (float*)(ws + WS_LB); F.cl = (float*)(ws + WS_CL); F.bt = (float*)(ws + WS_BT); F.ds = (float*)(ws + WS_DS); F.st = (bf16*)(ws + WS_ST); F.dec = (float*)(ws + WS_DEC); \
    F.lds = lds; F.G = gridDim.x; F.bid = blockIdx.x; \
    int t_ = threadIdx.x; asm volatile("" : "+v"(t_)); F.tid = t_; F.lane = t_ & 63; F.wave = __builtin_amdgcn_readfirstlane(t_ >> 6); } while (0)
    BUILD();
    cg::grid_group grid = cg::this_grid();
    if (threadIdx.x < 8) ((volatile LAS unsigned*)((LAS unsigned char*)lds + MISC_OFF))[threadIdx.x] = 0u;
    __syncthreads();
    XcdBarrier bar; bar.bar = (unsigned*)(F.ws + WS_CTL) + 4096; bar.x = 0; bar.st = (volatile LAS unsigned*)((LAS unsigned char*)lds + MISC_OFF);
    const int lo = args.ph_lo, hi = args.ph_hi;
#define IN(k) (lo <= (k) && (k) < hi)
#define RELAUNDER() do { int t_ = threadIdx.x; asm volatile("" : "+v"(t_)); F.tid = t_; F.lane = t_ & 63; F.wave = __builtin_amdgcn_readfirstlane(t_ >> 6); } while (0)
#define SEAM(k) do { if (IN(k) && IN((k) + 1)) { if ((k) == 0) grid.sync(); else xcd_barrier(bar); } } while (0)
    if (IN(0)) { BUILD(); phase0(F); }
    SEAM(0);
    bar = xcd_barrier_post(bar.bar, bar.st);
    for (int l = 0; l < NLAYER; ++l) { const int pb = 1 + 5 * l;
        if (IN(pb)) { BUILD(); pg8::Gemm g{F.xb, F.wtin + (size_t)l * NPAD * DM, SEQ, NPAD, DM}; pg8::StaticOrder S; S.init(SEQ, NPAD, F.G, F.bid);
            pg8::EpiProj E{F.proj, F.small, F.ss + l * SEQ, (float*)(lds + RING_BYTES + 1024), F.aqg + l * 64, F.akg + l * 64, F.bqg + l * 64, F.bkg + l * 64};
            pg8::gemm_phase<pg8::EpiProj, pg8::StaticOrder, true, true>((PG8_LAS unsigned char*)lds, g, S, E); __syncthreads(); }
        SEAM(pb);
        if (IN(pb + 1)) { BUILD(); phase2(F, l); }
        SEAM(pb + 1);
        if (IN(pb + 2)) { BUILD(); phase3(F, l); }
        SEAM(pb + 2);
        if (IN(pb + 3)) { BUILD(); phase4(F, l); }
        SEAM(pb + 3);
        if (IN(pb + 4)) { BUILD(); pg8::Gemm g{F.mixed, F.wtout + (size_t)l * DM * DM, SEQ, DM, DM}; pg8::StaticOrder S; S.init(SEQ, DM, F.G, F.bid);
            const bool last = (l == NLAYER - 1);
            pg8::EpiOut E{nullptr, last ? F.out : nullptr, F.xb, last ? nullptr : F.ss + (l + 1) * SEQ};
            pg8::gemm_phase<pg8::EpiOut, pg8::StaticOrder, true, true>((PG8_LAS unsigned char*)lds, g, S, E); __syncthreads(); }
        SEAM(pb + 4);
    }
#undef IN
#undef SEAM
}

#ifndef MK_ONE_LAUNCH
#define MK_ONE_LAUNCH 1
#endif
extern "C" void kernel_launch(void* const* d_in, const int* in_sizes, int n_in, void* d_out, int out_size, void* d_ws, size_t ws_size, hipStream_t stream) {
    static int grid = 0;
    if (grid == 0) {
        int dev = 0, cus = 0, per_cu = 0;
        hipGetDevice(&dev); hipDeviceGetAttribute(&cus, hipDeviceAttributeMultiprocessorCount, dev);
        hipFuncSetAttribute((const void*)mega_fwd, hipFuncAttributeMaxDynamicSharedMemorySize, LDS_BYTES);
        hipOccupancyMaxActiveBlocksPerMultiprocessor(&per_cu, mega_fwd, 512, LDS_BYTES);
        grid = cus * per_cu; if (grid <= 0) grid = 256;
        if (ws_size < WS_END) { fprintf(stderr, "workspace too small: %zu < %zu\n", ws_size, (size_t)WS_END); }
    }
    Args a{}; for (int i = 0; i < 12; ++i) a.in[i] = (const float*)d_in[i]; a.out = (float*)d_out; a.ws = (unsigned char*)d_ws;
#if MK_ONE_LAUNCH
    a.ph_lo = 0; a.ph_hi = N_PHASES; void* kargs[] = {&a};
    hipError_t e = hipLaunchCooperativeKernel((const void*)mega_fwd, dim3(grid), dim3(512), kargs, LDS_BYTES, stream);
    if (e != hipSuccess) fprintf(stderr, "cooperative launch failed: %s (grid %d)\n", hipGetErrorString(e), grid);
#else
    for (int p = 0; p < N_PHASES; ++p) { a.ph_lo = p; a.ph_hi = p + 1; hipLaunchKernelGGL(mega_fwd, dim3(grid), dim3(512), LDS_BYTES, stream, a); }
#endif
}
```
